# Optimizing an MI355X kernel written in HIP

```python
import jax, jax.numpy as jnp
from jax import lax
import numpy as np

D_MODEL = 1024
BATCH = 8
SEQ = 4096
DEPTH = 4

GRID_W = 64
Q_BLOCK = 128
ROPE_THETA = 10000.0
EPS = 1e-6

GQA_HEADS = 8
GQA_KV_HEADS = 2
GQA_GROUP = GQA_HEADS // GQA_KV_HEADS
GQA_HEAD_DIM = 64
GQA_WIDTH = GQA_HEADS * GQA_HEAD_DIM
GQA_KV_WIDTH = GQA_KV_HEADS * GQA_HEAD_DIM

MLA_HEADS = 8
MLA_Q_RANK = 256
MLA_KV_RANK = 128
MLA_NOPE_DIM = 64
MLA_ROPE_DIM = 32
MLA_V_DIM = 64
MLA_QK_DIM = MLA_NOPE_DIM + MLA_ROPE_DIM
MLA_WIDTH = MLA_HEADS * MLA_V_DIM

MIX_WIDTH = GQA_WIDTH + MLA_WIDTH
IN_SIZES = (GQA_WIDTH, GQA_KV_WIDTH, GQA_KV_WIDTH, MLA_Q_RANK, MLA_KV_RANK + MLA_ROPE_DIM)
IN_WIDTH = sum(IN_SIZES)
IN_OFFSETS = tuple(int(v) for v in np.cumsum(IN_SIZES)[:-1])

MEM_TOKENS = 256
MEM_HEADS = 4
MEM_HEAD_DIM = 128
MEM_WIDTH = MEM_HEADS * MEM_HEAD_DIM

N_EXPERTS = 16
EXPERT_FF = 512
EC_CAPACITY_FACTOR = 2

kernel_name = "hybrid_gqa_mla_memxattn_ecmoe_encoder"


def rms_norm(x, g):
    xf = x.astype(jnp.float32)
    y = xf * lax.rsqrt(jnp.mean(xf * xf, axis=-1, keepdims=True) + EPS)
    return (y * g.astype(jnp.float32)).astype(x.dtype)


def axial_rope_angles(seq_len, rot_dim):
    rows = seq_len // GRID_W
    row = jnp.repeat(jnp.arange(rows, dtype=jnp.float32), GRID_W)
    col = jnp.tile(jnp.arange(GRID_W, dtype=jnp.float32), rows)
    axis_dim = rot_dim // 2
    inv_freq = ROPE_THETA ** (-jnp.arange(0, axis_dim, 2, dtype=jnp.float32) / axis_dim)
    ang = jnp.concatenate([row[:, None] * inv_freq[None, :], col[:, None] * inv_freq[None, :]], axis=-1)
    return jnp.cos(ang), jnp.sin(ang)


def apply_rope(x, cos, sin):
    c = cos[None, :, None, :].astype(x.dtype)
    s = sin[None, :, None, :].astype(x.dtype)
    half = x.shape[-1] // 2
    x1, x2 = x[..., :half], x[..., half:]
    return jnp.concatenate([x1 * c - x2 * s, x2 * c + x1 * s], axis=-1)


def blocked_attention(q, k, v, scale):
    B, S, K, G, Dk = q.shape
    Dv = v.shape[-1]
    nblk = S // Q_BLOCK
    qb = q.reshape(B, nblk, Q_BLOCK, K, G, Dk).transpose(1, 0, 2, 3, 4, 5)

    def one_block(qblk):
        s = jnp.einsum('bqkgd,btkd->bkgqt', qblk, k).astype(jnp.float32) * scale
        p = jax.nn.softmax(s, axis=-1).astype(v.dtype)
        return jnp.einsum('bkgqt,btkd->bqkgd', p, v)

    o = lax.map(one_block, qb)
    return o.transpose(1, 0, 2, 3, 4, 5).reshape(B, S, K * G * Dv)


def parallel_mixer(h, w_in, gqa_q_norm, gqa_k_norm, mla_q_norm, mla_kv_norm, w_q_b, w_kv_b,
                   out_norm_gqa, out_norm_mla, w_o, cos_g, sin_g, cos_m, sin_m):
    B, S, _ = h.shape
    proj = h @ w_in
    q_g, k_g, v_g, q_lat, kv_lat = jnp.split(proj, IN_OFFSETS, axis=-1)

    q_g = apply_rope(rms_norm(q_g.reshape(B, S, GQA_HEADS, GQA_HEAD_DIM), gqa_q_norm), cos_g, sin_g)
    k_g = apply_rope(rms_norm(k_g.reshape(B, S, GQA_KV_HEADS, GQA_HEAD_DIM), gqa_k_norm), cos_g, sin_g)
    v_g = v_g.reshape(B, S, GQA_KV_HEADS, GQA_HEAD_DIM)
    o_g = blocked_attention(q_g.reshape(B, S, GQA_KV_HEADS, GQA_GROUP, GQA_HEAD_DIM), k_g, v_g,
                            GQA_HEAD_DIM ** -0.5)

    c_q = rms_norm(q_lat, mla_q_norm)
    q_m = (c_q @ w_q_b).reshape(B, S, MLA_HEADS, MLA_QK_DIM)
    q_m = jnp.concatenate([q_m[..., :MLA_NOPE_DIM], apply_rope(q_m[..., MLA_NOPE_DIM:], cos_m, sin_m)], axis=-1)
    c_kv = rms_norm(kv_lat[..., :MLA_KV_RANK], mla_kv_norm)
    k_rope = apply_rope(kv_lat[..., MLA_KV_RANK:].reshape(B, S, 1, MLA_ROPE_DIM), cos_m, sin_m)
    kv = (c_kv @ w_kv_b).reshape(B, S, MLA_HEADS, MLA_NOPE_DIM + MLA_V_DIM)
    k_m = jnp.concatenate([kv[..., :MLA_NOPE_DIM],
                           jnp.broadcast_to(k_rope, (B, S, MLA_HEADS, MLA_ROPE_DIM))], axis=-1)
    v_m = kv[..., MLA_NOPE_DIM:]
    o_m = blocked_attention(q_m[:, :, :, None, :], k_m, v_m, MLA_QK_DIM ** -0.5)

    merged = jnp.concatenate([rms_norm(o_g, out_norm_gqa), rms_norm(o_m, out_norm_mla)], axis=-1)
    return merged @ w_o


def memory_cross_attention(h, m, w_mem_q, w_mem_kv, w_mem_o):
    B, S, _ = h.shape
    M = m.shape[1]
    q = (h @ w_mem_q).reshape(B, S, MEM_HEADS, MEM_HEAD_DIM)
    kv = (m @ w_mem_kv).reshape(B, M, 2, MEM_HEADS, MEM_HEAD_DIM)
    k, v = kv[:, :, 0], kv[:, :, 1]
    s = jnp.einsum('bshd,bmhd->bhsm', q, k).astype(jnp.float32) * (MEM_HEAD_DIM ** -0.5)
    p = jax.nn.softmax(s, axis=-1).astype(v.dtype)
    o = jnp.einsum('bhsm,bmhd->bshd', p, v).reshape(B, S, MEM_WIDTH)
    return o @ w_mem_o


def expert_choice_moe(h, w_router, w_gate, w_up, w_down):
    B, S, D = h.shape
    cap = EC_CAPACITY_FACTOR * S // N_EXPERTS
    affinity = jax.nn.softmax((h @ w_router).astype(jnp.float32), axis=-1)
    gate, idx = lax.top_k(jnp.swapaxes(affinity, 1, 2), cap)
    x_in = jax.vmap(lambda hb, ib: hb[ib])(h, idx)
    a = jnp.einsum('becd,edf->becf', x_in, w_gate)
    u = jnp.einsum('becd,edf->becf', x_in, w_up)
    y = jnp.einsum('becf,efd->becd', jax.nn.silu(a) * u, w_down)
    y = y * gate[..., None].astype(y.dtype)
    return jax.vmap(lambda ib, yb: jnp.zeros((S, D), yb.dtype).at[ib.reshape(-1)].add(yb.reshape(-1, D)))(idx, y)


def setup_inputs(seed: int = 0) -> dict:
    key = jax.random.key(seed)
    ks = iter(jax.random.split(key, 32))
    L = DEPTH

    def w(shape, fan_in):
        return jax.random.normal(next(ks), shape, jnp.float32) * fan_in ** -0.5

    def gain(shape):
        return 1.0 + 0.02 * jax.random.normal(next(ks), shape, jnp.float32)

    return {
        "x": jax.random.normal(next(ks), (BATCH, SEQ, D_MODEL), jnp.float32),
        "mem": jax.random.normal(next(ks), (BATCH, MEM_TOKENS, D_MODEL), jnp.float32),
        "ln_mix": gain((L, D_MODEL)),
        "w_in": w((L, D_MODEL, IN_WIDTH), D_MODEL),
        "gqa_q_norm": gain((L, GQA_HEAD_DIM)),
        "gqa_k_norm": gain((L, GQA_HEAD_DIM)),
        "mla_q_norm": gain((L, MLA_Q_RANK)),
        "mla_kv_norm": gain((L, MLA_KV_RANK)),
        "w_q_b": w((L, MLA_Q_RANK, MLA_HEADS * MLA_QK_DIM), MLA_Q_RANK),
        "w_kv_b": w((L, MLA_KV_RANK, MLA_HEADS * (MLA_NOPE_DIM + MLA_V_DIM)), MLA_KV_RANK),
        "out_norm_gqa": gain((L, GQA_WIDTH)),
        "out_norm_mla": gain((L, MLA_WIDTH)),
        "w_o": w((L, MIX_WIDTH, D_MODEL), MIX_WIDTH),
        "ln_mem": gain((L, D_MODEL)),
        "ln_mem_kv": gain((L, D_MODEL)),
        "w_mem_q": w((L, D_MODEL, MEM_WIDTH), D_MODEL),
        "w_mem_kv": w((L, D_MODEL, 2 * MEM_WIDTH), D_MODEL),
        "w_mem_o": w((L, MEM_WIDTH, D_MODEL), MEM_WIDTH),
        "ln_ffn": gain((L, D_MODEL)),
        "w_router": w((L, D_MODEL, N_EXPERTS), D_MODEL),
        "w_gate": w((L, N_EXPERTS, D_MODEL, EXPERT_FF), D_MODEL),
        "w_up": w((L, N_EXPERTS, D_MODEL, EXPERT_FF), D_MODEL),
        "w_down": w((L, N_EXPERTS, EXPERT_FF, D_MODEL), EXPERT_FF),
        "ln_final": gain((D_MODEL,)),
    }


def reference(x, mem, ln_mix, w_in, gqa_q_norm, gqa_k_norm, mla_q_norm, mla_kv_norm, w_q_b, w_kv_b,
              out_norm_gqa, out_norm_mla, w_o, ln_mem, ln_mem_kv, w_mem_q, w_mem_kv, w_mem_o,
              ln_ffn, w_router, w_gate, w_up, w_down, ln_final):
    S = x.shape[1]
    cos_g, sin_g = axial_rope_angles(S, GQA_HEAD_DIM)
    cos_m, sin_m = axial_rope_angles(S, MLA_ROPE_DIM)
    for l in range(DEPTH):
        h = rms_norm(x, ln_mix[l])
        x = x + parallel_mixer(h, w_in[l], gqa_q_norm[l], gqa_k_norm[l], mla_q_norm[l], mla_kv_norm[l],
                               w_q_b[l], w_kv_b[l], out_norm_gqa[l], out_norm_mla[l], w_o[l],
                               cos_g, sin_g, cos_m, sin_m)
        h = rms_norm(x, ln_mem[l])
        x = x + memory_cross_attention(h, rms_norm(mem, ln_mem_kv[l]), w_mem_q[l], w_mem_kv[l], w_mem_o[l])
        h = rms_norm(x, ln_ffn[l])
        x = x + expert_choice_moe(h, w_router[l], w_gate[l], w_up[l], w_down[l])
    return rms_norm(x, ln_final)
```

```cpp
#include <hip/hip_runtime.h>
#include <cstdio>
#include <cstdint>

namespace pg8 {
#define PG8_LAS __attribute__((address_space(3)))
typedef unsigned short bf16_t;
typedef short bf16x8 __attribute__((ext_vector_type(8)));
typedef float f32x4 __attribute__((ext_vector_type(4)));
typedef unsigned u32x4 __attribute__((ext_vector_type(4)));
constexpr int BM = 256, BK = 64, HALF = 128, HTB = HALF * BK * 2  , STAGE_BYTES = 8 * HTB, NXCD = 8, WGM = 8;

__host__ __device__ __forceinline__ int lds_byte(int r, int c) { const int st = (r >> 4) * 2 + (c >> 5), rr = r & 15, cc = c & 31, ob = rr * 64 + cc * 2; return st * 1024 + (ob ^ (((ob >> 9) & 1) << 5)); }
__host__ __device__ __forceinline__ void stage_rc(int b, int& R, int& C) { const int st = b / 1024, sb = b % 1024, swz = sb ^ (((sb >> 9) & 1) << 5); R = (st >> 1) * 16 + swz / 64; C = (st & 1) * 32 + (swz % 64) / 2; }
__host__ __device__ __forceinline__ int perm32(int rho) { const int n = rho >> 4, i = rho & 15; return 8 * (i >> 2) + 4 * n + (i & 3); }

struct Unit { int pm, pn; };
struct Gemm { const bf16_t* A; const bf16_t* Bt; int lda, ldb, K, gdiv, amod; size_t gstride; const int* idx; const float* ss; };

struct StaticOrder {
    int nM, nN, nwg, G, c;
    __host__ __device__ void init(int nM_, int nN_, int G_, int c_) { nM = nM_; nN = nN_; nwg = nM * nN; G = G_; c = c_; }
    __host__ __device__ bool next(int i, Unit& u) const {
        const long L = (long)i * G + c; if (L >= nwg) return false;
        int wgid = (int)L; { const int q = nwg / NXCD, r = nwg % NXCD, xcd = wgid % NXCD, off = wgid / NXCD; wgid = (xcd < r ? xcd * (q + 1) : r * (q + 1) + (xcd - r) * q) + off; }
        const int nig = WGM * nN, gid = wgid / nig, fm = gid * WGM, gsz = (nM - fm) < WGM ? (nM - fm) : WGM;
        u.pm = fm + ((wgid % nig) % gsz); u.pn = (wgid % nig) / gsz; return true;
    }
};

struct LinearOrder {
    int nM, nN, G, c, per;
    __host__ __device__ void init(int nM_, int nN_, int G_, int c_, int per_) { nM = nM_; nN = nN_; G = G_; c = c_; per = per_; }
    __host__ __device__ bool next(int i, Unit& u) const { const int idx = (c + (i / per) * G) * per + (i % per); if (idx >= nM * nN) return false; u.pm = idx / nN; u.pn = idx % nN; return true; }
};

__device__ __forceinline__ unsigned cvt_pk_bf16(float lo, float hi) { unsigned r; asm volatile("v_cvt_pk_bf16_f32 %0, %1, %2" : "=v"(r) : "v"(lo), "v"(hi)); return r; }

struct EpiBf16 {
    static constexpr bool PERM = true;
    bf16_t* O; int ldc; float scale; const float* rs; const float* ssl; float ssl_inv, ssl_eps;
    __device__ __forceinline__ void operator()(const f32x4 (&acc)[2][2][4][2], const Unit& u, int wr, int wc, int fr, int fq) const {
        const int row0 = u.pm * BM + wr * 64 + fr, col0 = u.pn * BM + wc * 32 + 8 * fq;
#pragma unroll
        for (int ai = 0; ai < 2; ++ai)
#pragma unroll
            for (int m = 0; m < 4; ++m) { const int row = row0 + ai * HALF + m * 16; bf16_t* rowp = O + (size_t)row * ldc + col0; float sc = rs ? scale * rs[row] : scale;
                if (ssl) { const f32x4 q_ = *(const f32x4*)(ssl + (size_t)row * 8); sc *= __builtin_amdgcn_rsqf(((q_[0] + q_[1]) + (q_[2] + q_[3])) * ssl_inv + ssl_eps); }
#pragma unroll
                for (int bj = 0; bj < 2; ++bj) { const f32x4 v0 = acc[ai][bj][m][0] * sc, v1 = acc[ai][bj][m][1] * sc;
                    u32x4 w; w.x = cvt_pk_bf16(v0[0], v0[1]); w.y = cvt_pk_bf16(v0[2], v0[3]); w.z = cvt_pk_bf16(v1[0], v1[1]); w.w = cvt_pk_bf16(v1[2], v1[3]);
                    *(u32x4*)(rowp + bj * HALF) = w; } }
    }
};
struct EpiQmRope {
    static constexpr bool PERM = true;
    bf16_t* O; int ldc; float scale; const float* tab; const float* ssl; float ssl_inv, ssl_eps;
    __device__ __forceinline__ void operator()(const f32x4 (&acc)[2][2][4][2], const Unit& u, int wr, int wc, int fr, int fq) const {
        const int row0 = u.pm * BM + wr * 64 + fr, col0 = u.pn * BM + wc * 32 + 8 * fq;
        const bool rope = (u.pn == 2);
        const int j0 = (8 * fq) >> 1;
#pragma unroll
        for (int ai = 0; ai < 2; ++ai)
#pragma unroll
            for (int m = 0; m < 4; ++m) { const int row = row0 + ai * HALF + m * 16; bf16_t* rowp = O + (size_t)row * ldc + col0; const int s = row & 4095;
                const f32x4 q_ = *(const f32x4*)(ssl + (size_t)row * 8); const float sc_ = scale * __builtin_amdgcn_rsqf(((q_[0] + q_[1]) + (q_[2] + q_[3])) * ssl_inv + ssl_eps);
                f32x4 t0 = (f32x4){1.f, 0.f, 1.f, 0.f}, t1 = (f32x4){1.f, 0.f, 1.f, 0.f};
                if (rope) { t0 = *(const f32x4*)(tab + ((size_t)s * 16 + j0) * 2); t1 = *(const f32x4*)(tab + ((size_t)s * 16 + j0 + 2) * 2); }
#pragma unroll
                for (int bj = 0; bj < 2; ++bj) { const f32x4 v0 = acc[ai][bj][m][0], v1 = acc[ai][bj][m][1];
                    f32x4 r0, r1;
                    r0[0] = v0[0] * t0[0] - v0[1] * t0[1]; r0[1] = v0[1] * t0[0] + v0[0] * t0[1];
                    r0[2] = v0[2] * t0[2] - v0[3] * t0[3]; r0[3] = v0[3] * t0[2] + v0[2] * t0[3];
                    r1[0] = v1[0] * t1[0] - v1[1] * t1[1]; r1[1] = v1[1] * t1[0] + v1[0] * t1[1];
                    r1[2] = v1[2] * t1[2] - v1[3] * t1[3]; r1[3] = v1[3] * t1[2] + v1[2] * t1[3];
                    r0 = r0 * sc_; r1 = r1 * sc_;
                    u32x4 w; w.x = cvt_pk_bf16(r0[0], r0[1]); w.y = cvt_pk_bf16(r0[2], r0[3]); w.z = cvt_pk_bf16(r1[0], r1[1]); w.w = cvt_pk_bf16(r1[2], r1[3]);
                    *(u32x4*)(rowp + bj * HALF) = w; }
                asm volatile("" ::: "memory"); }
    }
};
struct EpiBf16RowNorm {
    static constexpr bool PERM = true;
    bf16_t* O; int ldc; float scale; const float* ss; float inv_n, eps;
    __device__ __forceinline__ void operator()(const f32x4 (&acc)[2][2][4][2], const Unit& u, int wr, int wc, int fr, int fq) const {
        const int row0 = u.pm * BM + wr * 64 + fr, col0 = u.pn * BM + wc * 32 + 8 * fq;
#pragma unroll
        for (int ai = 0; ai < 2; ++ai)
#pragma unroll
            for (int m = 0; m < 4; ++m) { const int row = row0 + ai * HALF + m * 16; bf16_t* rowp = O + (size_t)row * ldc + col0;
                const f32x4 q0 = *(const f32x4*)(ss + (size_t)row * 16), q1 = *(const f32x4*)(ss + (size_t)row * 16 + 4), q2 = *(const f32x4*)(ss + (size_t)row * 16 + 8), q3 = *(const f32x4*)(ss + (size_t)row * 16 + 12);
                const float tot = ((((q0[0] + q0[1]) + (q0[2] + q0[3])) + ((q1[0] + q1[1]) + (q1[2] + q1[3]))) + (((q2[0] + q2[1]) + (q2[2] + q2[3])) + ((q3[0] + q3[1]) + (q3[2] + q3[3]))));
                const float sc = scale * __builtin_amdgcn_rsqf(tot * inv_n + eps);
#pragma unroll
                for (int bj = 0; bj < 2; ++bj) { const f32x4 v0 = acc[ai][bj][m][0] * sc, v1 = acc[ai][bj][m][1] * sc;
                    u32x4 w; w.x = cvt_pk_bf16(v0[0], v0[1]); w.y = cvt_pk_bf16(v0[2], v0[3]); w.z = cvt_pk_bf16(v1[0], v1[1]); w.w = cvt_pk_bf16(v1[2], v1[3]);
                    *(u32x4*)(rowp + bj * HALF) = w; } }
    }
};
__device__ __forceinline__ float bf_lo(unsigned w) { return __uint_as_float(w << 16); }
__device__ __forceinline__ float bf_hi(unsigned w) { return __uint_as_float(w & 0xffff0000u); }
struct EpiResidualX {
    static constexpr bool PERM = true;
    bf16_t* X; float* SSX; int ldc; float inv_n, eps, mul;
    __device__ __forceinline__ void operator()(const f32x4 (&acc)[2][2][4][2], const Unit& u, int wr, int wc, int fr, int fq, const PG8_LAS float* tab) const {
        const int rl0 = wr * 64 + fr, col0 = u.pn * BM + wc * 32 + 8 * fq;
#pragma unroll
        for (int ai = 0; ai < 2; ++ai)
#pragma unroll
            for (int m = 0; m < 4; ++m) { const int rl = rl0 + ai * HALF + m * 16, row = u.pm * BM + rl; bf16_t* rowp = X + (size_t)row * ldc + col0;
                const float rm = mul * __builtin_amdgcn_rsqf((tab[rl * 4 + 2] + tab[rl * 4 + 3]) * inv_n + eps);
                u32x4 xv[2]; float s = 0.f;
#pragma unroll
                for (int bj = 0; bj < 2; ++bj) xv[bj] = *(const u32x4*)(rowp + bj * HALF);
#pragma unroll
                for (int bj = 0; bj < 2; ++bj) { const f32x4 a0 = acc[ai][bj][m][0] * rm, a1 = acc[ai][bj][m][1] * rm; u32x4 w;
                    w.x = cvt_pk_bf16(bf_lo(xv[bj].x) + a0[0], bf_hi(xv[bj].x) + a0[1]); w.y = cvt_pk_bf16(bf_lo(xv[bj].y) + a0[2], bf_hi(xv[bj].y) + a0[3]);
                    w.z = cvt_pk_bf16(bf_lo(xv[bj].z) + a1[0], bf_hi(xv[bj].z) + a1[1]); w.w = cvt_pk_bf16(bf_lo(xv[bj].w) + a1[2], bf_hi(xv[bj].w) + a1[3]);
                    *(u32x4*)(rowp + bj * HALF) = w;
                    const float r0 = bf_lo(w.x), r1 = bf_hi(w.x), r2 = bf_lo(w.y), r3 = bf_hi(w.y), r4 = bf_lo(w.z), r5 = bf_hi(w.z), r6 = bf_lo(w.w), r7 = bf_hi(w.w);
                    s += ((r0 * r0 + r1 * r1) + (r2 * r2 + r3 * r3)) + ((r4 * r4 + r5 * r5) + (r6 * r6 + r7 * r7)); }
                s += __shfl_xor(s, 16); s += __shfl_xor(s, 32);
                if (fq == 0) SSX[(size_t)row * 16 + u.pn * 4 + wc] = s;
                if (m & 1) asm volatile("" ::: "memory"); }
    }
};
struct EpiResidual {
    static constexpr bool PERM = true;
    bf16_t* X; int ldc; float mul;
    __device__ __forceinline__ void operator()(const f32x4 (&acc)[2][2][4][2], const Unit& u, int wr, int wc, int fr, int fq) const {
        const int row0 = u.pm * BM + wr * 64 + fr, col0 = u.pn * BM + wc * 32 + 8 * fq;
#pragma unroll
        for (int ai = 0; ai < 2; ++ai)
#pragma unroll
            for (int m = 0; m < 4; ++m) { bf16_t* rowp = X + (size_t)(row0 + ai * HALF + m * 16) * ldc + col0;
                u32x4 xv[2];
#pragma unroll
                for (int bj = 0; bj < 2; ++bj) xv[bj] = *(const u32x4*)(rowp + bj * HALF);
#pragma unroll
                for (int bj = 0; bj < 2; ++bj) { const f32x4 a0 = acc[ai][bj][m][0] * mul, a1 = acc[ai][bj][m][1] * mul; u32x4 w;
                    w.x = cvt_pk_bf16(bf_lo(xv[bj].x) + a0[0], bf_hi(xv[bj].x) + a0[1]); w.y = cvt_pk_bf16(bf_lo(xv[bj].y) + a0[2], bf_hi(xv[bj].y) + a0[3]);
                    w.z = cvt_pk_bf16(bf_lo(xv[bj].z) + a1[0], bf_hi(xv[bj].z) + a1[1]); w.w = cvt_pk_bf16(bf_lo(xv[bj].w) + a1[2], bf_hi(xv[bj].w) + a1[3]);
                    *(u32x4*)(rowp + bj * HALF) = w; } }
    }
};
struct EpiInProj {
    static constexpr bool PERM = true;
    const float* rs; const float* gq; const float* gk; const float* tabg; const float* tabm;
    bf16_t* QG; bf16_t* KG; bf16_t* VG; bf16_t* LAT; bf16_t* KROPE; float* SSL; float qscale, eps;
    __device__ __forceinline__ static void rope2(f32x4& v, const f32x4 t) { const float a0 = v[0], b0 = v[1], a1 = v[2], b1 = v[3];
        v[0] = a0 * t[0] - b0 * t[1]; v[1] = b0 * t[0] + a0 * t[1]; v[2] = a1 * t[2] - b1 * t[3]; v[3] = b1 * t[2] + a1 * t[3]; }
    __device__ __forceinline__ static u32x4 pack(const f32x4 a, const f32x4 b) { u32x4 w; w.x = cvt_pk_bf16(a[0], a[1]); w.y = cvt_pk_bf16(a[2], a[3]); w.z = cvt_pk_bf16(b[0], b[1]); w.w = cvt_pk_bf16(b[2], b[3]); return w; }
    __device__ __forceinline__ void operator()(const f32x4 (&acc)[2][2][4][2], const Unit& u, int wr, int wc, int fr, int fq) const {
        const int row0 = u.pm * BM + wr * 64 + fr;
        if (u.pn < 2 || (u.pn == 2 && wc < 2)) {
            const bool isq = u.pn < 2; const float* g = isq ? gq : gk; bf16_t* dst = isq ? QG : KG; const int ld = isq ? 512 : 128, hcol = (isq ? (u.pn * 4 + wc) : wc) * 64; const float osc = isq ? qscale : 1.0f;
            f32x4 gv[2][2];
#pragma unroll
            for (int bj = 0; bj < 2; ++bj)
#pragma unroll
                for (int n = 0; n < 2; ++n)
#pragma unroll
                    for (int i = 0; i < 4; ++i) { const int p = 32 * bj + 8 * fq + 4 * n + i; gv[bj][n][i] = g[(p >> 1) + 32 * (p & 1)]; }
#pragma unroll
            for (int ai = 0; ai < 2; ++ai)
#pragma unroll
                for (int m = 0; m < 4; ++m) { const int row = row0 + ai * HALF + m * 16, s = row & 4095; const float sc = rs[row];
                    f32x4 v[2][2]; float ss = 0.f;
#pragma unroll
                    for (int bj = 0; bj < 2; ++bj)
#pragma unroll
                        for (int n = 0; n < 2; ++n) { v[bj][n] = acc[ai][bj][m][n] * sc; ss += (v[bj][n][0] * v[bj][n][0] + v[bj][n][1] * v[bj][n][1]) + (v[bj][n][2] * v[bj][n][2] + v[bj][n][3] * v[bj][n][3]); }
                    ss += __shfl_xor(ss, 16); ss += __shfl_xor(ss, 32);
                    const float rstd = __builtin_amdgcn_rsqf(ss * (1.0f / 64.0f) + eps);
#pragma unroll
                    for (int bj = 0; bj < 2; ++bj) {
#pragma unroll
                        for (int n = 0; n < 2; ++n) { v[bj][n] = v[bj][n] * rstd * gv[bj][n];
                            const f32x4 t = *(const f32x4*)(tabg + ((size_t)s * 32 + 16 * bj + 4 * fq + 2 * n) * 2); rope2(v[bj][n], t); v[bj][n] = v[bj][n] * osc; }
                        *(u32x4*)(dst + (size_t)row * ld + hcol + 32 * bj + 8 * fq) = pack(v[bj][0], v[bj][1]); }
                    if (m & 1) asm volatile("" ::: "memory"); }
        } else if (u.pn == 2) {
#pragma unroll
            for (int ai = 0; ai < 2; ++ai)
#pragma unroll
                for (int m = 0; m < 4; ++m) { const int row = row0 + ai * HALF + m * 16; const float sc = rs[row];
#pragma unroll
                    for (int bj = 0; bj < 2; ++bj) *(u32x4*)(VG + (size_t)row * 128 + (wc - 2) * 64 + 32 * bj + 8 * fq) = pack(acc[ai][bj][m][0] * sc, acc[ai][bj][m][1] * sc); }
        } else if (u.pn == 3) {
#pragma unroll
            for (int ai = 0; ai < 2; ++ai)
#pragma unroll
                for (int m = 0; m < 4; ++m) { const int row = row0 + ai * HALF + m * 16; const float sc = rs[row]; float ss = 0.f;
#pragma unroll
                    for (int bj = 0; bj < 2; ++bj) { const f32x4 a = acc[ai][bj][m][0] * sc, b = acc[ai][bj][m][1] * sc;
                        ss += ((a[0] * a[0] + a[1] * a[1]) + (a[2] * a[2] + a[3] * a[3])) + ((b[0] * b[0] + b[1] * b[1]) + (b[2] * b[2] + b[3] * b[3]));
                        *(u32x4*)(LAT + (size_t)row * 512 + 128 * bj + 32 * wc + 8 * fq) = pack(a, b); }
                    ss += __shfl_xor(ss, 16); ss += __shfl_xor(ss, 32);
                    if (fq == 0) SSL[(size_t)row * 8 + wc] = ss; }
        } else {
#pragma unroll
            for (int ai = 0; ai < 2; ++ai)
#pragma unroll
                for (int m = 0; m < 4; ++m) { const int row = row0 + ai * HALF + m * 16, s = row & 4095; const float sc = rs[row];
                    const f32x4 a = acc[ai][0][m][0] * sc, b = acc[ai][0][m][1] * sc;
                    float ss = ((a[0] * a[0] + a[1] * a[1]) + (a[2] * a[2] + a[3] * a[3])) + ((b[0] * b[0] + b[1] * b[1]) + (b[2] * b[2] + b[3] * b[3]));
                    *(u32x4*)(LAT + (size_t)row * 512 + 256 + 32 * wc + 8 * fq) = pack(a, b);
                    ss += __shfl_xor(ss, 16); ss += __shfl_xor(ss, 32);
                    if (fq == 0) SSL[(size_t)row * 8 + 4 + wc] = ss;
                    if (wc == 0) { f32x4 c = acc[ai][1][m][0] * sc, d = acc[ai][1][m][1] * sc;
                        rope2(c, *(const f32x4*)(tabm + ((size_t)s * 16 + 4 * fq) * 2)); rope2(d, *(const f32x4*)(tabm + ((size_t)s * 16 + 4 * fq + 2) * 2));
                        *(u32x4*)(KROPE + (size_t)row * 32 + 8 * fq) = pack(c, d); } }
        }
    }
};
struct EpiSwiGLU {
    static constexpr bool PERM = true;
    bf16_t* O; int ldc; const float* rs;
    __device__ __forceinline__ static float silu_mul(float g, float u) { return g * u * __builtin_amdgcn_rcpf(1.0f + __builtin_amdgcn_exp2f(-1.4426950408889634f * g)); }
    __device__ __forceinline__ void operator()(const f32x4 (&acc)[2][2][4][2], const Unit& u, int wr, int wc, int fr, int fq) const {
        const int row0 = u.pm * BM + wr * 64 + fr, col0 = u.pn * HALF + wc * 32 + 8 * fq;
#pragma unroll
        for (int ai = 0; ai < 2; ++ai)
#pragma unroll
            for (int m = 0; m < 4; ++m) { const int row = row0 + ai * HALF + m * 16; bf16_t* rowp = O + (size_t)row * ldc + col0; const float sc = rs[row];
                const f32x4 g0 = acc[ai][0][m][0] * sc, g1 = acc[ai][0][m][1] * sc, u0 = acc[ai][1][m][0] * sc, u1 = acc[ai][1][m][1] * sc;
                u32x4 w; w.x = cvt_pk_bf16(silu_mul(g0[0], u0[0]), silu_mul(g0[1], u0[1])); w.y = cvt_pk_bf16(silu_mul(g0[2], u0[2]), silu_mul(g0[3], u0[3]));
                w.z = cvt_pk_bf16(silu_mul(g1[0], u1[0]), silu_mul(g1[1], u1[1])); w.w = cvt_pk_bf16(silu_mul(g1[2], u1[2]), silu_mul(g1[3], u1[3]));
                *(u32x4*)rowp = w; }
    }
};

template <class Epi, class Sched, bool ALIGN_EPI = false, bool GATHER = false, bool MIDSCALE = false>
__device__ __forceinline__ void gemm_phase(PG8_LAS unsigned char* lds, const Gemm g, const Sched& S, const Epi& E, PG8_LAS unsigned char* gtab = nullptr, float ms_inv_n = 0.f, float ms_eps = 0.f) {
    int tid_ = threadIdx.x; asm volatile("" : "+v"(tid_));
    const int tid = tid_, wid = __builtin_amdgcn_readfirstlane(tid >> 6), lane = tid & 63, wr = wid >> 2, wc = wid & 3, fr = lane & 15, fq = lane >> 4;
    const int K = g.K, nt = K / BK;
    unsigned voffA[2], voffB[2]; int gR[2], gC[2];
#pragma unroll
    for (int i = 0; i < 2; ++i) { int R, C; stage_rc(tid * 16 + i * 8192, R, C); const int Rb = Epi::PERM ? ((R & ~31) + perm32(R & 31)) : R; gR[i] = R; gC[i] = C;
        voffA[i] = (unsigned)(R * g.lda + C) * 2u; voffB[i] = (unsigned)(Rb * g.ldb + C) * 2u; }
    unsigned goffc[2][2], goffn[2][2];
#define PG8_GISSUE(u) do { _Pragma("unroll") for (int h_ = 0; h_ < 2; ++h_) _Pragma("unroll") for (int i_ = 0; i_ < 2; ++i_) \
        __builtin_amdgcn_global_load_lds((const unsigned*)(g.idx + (u).pm * BM + h_ * HALF + gR[i_]), (PG8_LAS unsigned*)(gtab + ((h_ * 2 + i_) * 8 + wid) * 256), 4, 0, 0); } while (0)
#define PG8_GREAD(dst, u) do { asm volatile("" ::: "memory"); _Pragma("unroll") for (int h_ = 0; h_ < 2; ++h_) _Pragma("unroll") for (int i_ = 0; i_ < 2; ++i_) { \
        const int tok_ = *(const PG8_LAS int*)(gtab + ((h_ * 2 + i_) * 8 + wid) * 256 + lane * 4); \
        dst[h_][i_] = (unsigned)(((((u).pm >> 1) & 7) * 4096 + tok_) * g.lda + gC[i_]) * 2u; } } while (0)
    const size_t kstep = (size_t)(BK * 2);
    const size_t hstepA = (size_t)HALF * g.lda * 2, hstepB = (size_t)HALF * g.ldb * 2;
    const size_t tstepA = 2 * hstepA, tstepB = 2 * hstepB;
    const unsigned ldsw = (unsigned)wid * 1024u;
    const int aoff = lds_byte(wr * 64 + fr, fq * 8), boff = lds_byte(wc * 32 + fr, fq * 8);
#define PG8_SA(b, h) (((b) * 2 + (h)) * HTB)
#define PG8_SB(b, h) ((4 + (b) * 2 + (h)) * HTB)
#define PG8_STAGE(bufoff, gbase, voff) do { _Pragma("unroll") for (int _i = 0; _i < 2; ++_i) \
        __builtin_amdgcn_global_load_lds((const unsigned*)((const char*)(gbase) + (voff)[_i]), (PG8_LAS unsigned*)(lds + (bufoff) + ldsw + _i * 8192), 16, 0, 0); } while (0)
#define PG8_LDA(dst, b, h) do { _Pragma("unroll") for (int m = 0; m < 4; ++m) _Pragma("unroll") for (int k = 0; k < 2; ++k) dst[m][k] = *(const PG8_LAS bf16x8*)(lds + PG8_SA(b, h) + aoff + m * 2048 + k * 1024); } while (0)
#define PG8_LDB(dst, b, h) do { _Pragma("unroll") for (int n = 0; n < 2; ++n) _Pragma("unroll") for (int k = 0; k < 2; ++k) dst[n][k] = *(const PG8_LAS bf16x8*)(lds + PG8_SB(b, h) + boff + n * 2048 + k * 1024); } while (0)
#define PG8_MMA(ai, bj, At, Bt) do { __builtin_amdgcn_s_setprio(1); _Pragma("unroll") for (int m = 0; m < 4; ++m) _Pragma("unroll") for (int n = 0; n < 2; ++n) _Pragma("unroll") for (int k = 0; k < 2; ++k) \
        acc[ai][bj][m][n] = __builtin_amdgcn_mfma_f32_16x16x32_bf16(Bt[n][k], At[m][k], acc[ai][bj][m][n], 0, 0, 0); __builtin_amdgcn_s_setprio(0); } while (0)
#define PG8_WAIT_V(n) asm volatile("s_waitcnt vmcnt(" #n ")" ::: "memory")
#define PG8_WAIT_L(n) asm volatile("s_waitcnt lgkmcnt(" #n ")" ::: "memory")
#define PG8_BAR __builtin_amdgcn_s_barrier()
#define PG8_SCHED __builtin_amdgcn_sched_barrier(0)
#define PG8_ABASE(u) (GATHER ? (const char*)g.A : (const char*)g.A + (size_t)((u).pm % g.amod) * tstepA)
#define PG8_STA(bufoff, kptr, h, nx) do { if constexpr (GATHER) { unsigned o_[2]; o_[0] = (nx) ? goffn[h][0] : goffc[h][0]; o_[1] = (nx) ? goffn[h][1] : goffc[h][1]; PG8_STAGE(bufoff, kptr, o_); } \
        else { PG8_STAGE(bufoff, (kptr) + (h) * hstepA, voffA); } } while (0)
#define PG8_BBASE(u) ((const char*)g.Bt + ((size_t)((u).pm / g.gdiv) * g.gstride) * 2 + (size_t)(u).pn * tstepB)
    Unit cur, nxt; int ui = 0;
    if (!S.next(0, cur)) return;
    f32x4 acc[2][2][4][2];
#pragma unroll
    for (int a = 0; a < 2; ++a)
#pragma unroll
        for (int b = 0; b < 2; ++b)
#pragma unroll
            for (int m = 0; m < 4; ++m)
#pragma unroll
                for (int n = 0; n < 2; ++n) acc[a][b][m][n] = (f32x4){0.f, 0.f, 0.f, 0.f};
    bf16x8 At[4][2], B0[2][2], B1[2][2];
    const char* cA = PG8_ABASE(cur); const char* cB = PG8_BBASE(cur);
    if constexpr (GATHER) { PG8_GISSUE(cur); PG8_WAIT_V(0); PG8_GREAD(goffc, cur);
#pragma unroll
        for (int h_ = 0; h_ < 2; ++h_) { goffn[h_][0] = goffc[h_][0]; goffn[h_][1] = goffc[h_][1]; } }
    PG8_STAGE(PG8_SB(0, 0), cB, voffB); PG8_STAGE(PG8_SB(0, 1), cB + hstepB, voffB); PG8_STA(PG8_SA(0, 0), cA, 0, false); PG8_STA(PG8_SA(0, 1), cA, 1, false);
    if (wr == 1) PG8_BAR;
    PG8_WAIT_V(2); PG8_BAR;
    PG8_STAGE(PG8_SB(1, 0), cB + kstep, voffB); PG8_STA(PG8_SA(1, 0), cA + kstep, 0, false); PG8_STAGE(PG8_SB(1, 1), cB + hstepB + kstep, voffB);
    PG8_WAIT_V(6); PG8_BAR;
    for (;;) {
        const bool has_next = S.next(ui + 1, nxt);
        const char* nA = has_next ? PG8_ABASE(nxt) : cA; const char* nB = has_next ? PG8_BBASE(nxt) : cB;
        if constexpr (GATHER) { if (has_next) PG8_GISSUE(nxt); }
        if constexpr (MIDSCALE) {
#pragma unroll
            for (int q_ = 0; q_ < 2; ++q_) __builtin_amdgcn_global_load_lds((const unsigned*)(g.ss + (size_t)cur.pm * 1024 + q_ * 512 + wid * 64 + lane), (PG8_LAS unsigned*)(gtab + (ui & 1) * 4096 + q_ * 2048 + wid * 256), 4, 0, 0); }
#pragma nounroll
        for (int t = 0; t < nt; t += 2) {
            const bool last = (t == nt - 2);
            const char* a1 = cA + (size_t)(t + 1) * kstep;
            const char* a2 = last ? nA : cA + (size_t)(t + 2) * kstep; const char* b2 = last ? nB : cB + (size_t)(t + 2) * kstep;
            const char* a3 = a2 + kstep; const char* b3 = b2 + kstep;
            if constexpr (GATHER) { if (last && has_next) PG8_GREAD(goffn, nxt); }
            if constexpr (MIDSCALE) { if (t == nt / 2) { asm volatile("" ::: "memory"); const PG8_LAS float* tab = (const PG8_LAS float*)(gtab + (ui & 1) * 4096);
#pragma unroll
                for (int ai = 0; ai < 2; ++ai)
#pragma unroll
                    for (int m = 0; m < 4; ++m) { const int rl = ai * HALF + wr * 64 + m * 16 + fr; const float sg = tab[rl * 4] + tab[rl * 4 + 1], sm = tab[rl * 4 + 2] + tab[rl * 4 + 3];
                        const float ratio = __builtin_amdgcn_rsqf(sg * ms_inv_n + ms_eps) * __builtin_amdgcn_rcpf(__builtin_amdgcn_rsqf(sm * ms_inv_n + ms_eps));
#pragma unroll
                        for (int bj = 0; bj < 2; ++bj)
#pragma unroll
                            for (int n = 0; n < 2; ++n) acc[ai][bj][m][n] = acc[ai][bj][m][n] * ratio; } } }
            PG8_LDB(B0, 0, 0); PG8_LDB(B1, 0, 1); PG8_SCHED; PG8_LDA(At, 0, 0); PG8_STA(PG8_SA(1, 1), a1, 1, false);
            PG8_WAIT_V(8); PG8_WAIT_L(0); PG8_BAR; PG8_MMA(0, 0, At, B0); PG8_MMA(0, 1, At, B1); PG8_BAR; PG8_SCHED;
            PG8_LDA(At, 0, 1); PG8_STAGE(PG8_SB(0, 0), b2, voffB); PG8_STAGE(PG8_SB(0, 1), b2 + hstepB, voffB); PG8_STA(PG8_SA(0, 0), a2, 0, last);
            PG8_WAIT_V(8); PG8_WAIT_L(0); PG8_BAR; PG8_MMA(1, 0, At, B0); PG8_MMA(1, 1, At, B1); PG8_BAR; PG8_SCHED;
            PG8_LDB(B0, 1, 0); PG8_LDB(B1, 1, 1); PG8_SCHED; PG8_LDA(At, 1, 0); PG8_STA(PG8_SA(0, 1), a2, 1, last);
            PG8_WAIT_V(8); PG8_WAIT_L(0); PG8_BAR; PG8_MMA(0, 0, At, B0); PG8_MMA(0, 1, At, B1); PG8_BAR; PG8_SCHED;
            PG8_LDA(At, 1, 1); PG8_STAGE(PG8_SB(1, 0), b3, voffB); PG8_STAGE(PG8_SB(1, 1), b3 + hstepB, voffB); PG8_STA(PG8_SA(1, 0), a3, 0, last);
            PG8_WAIT_V(8); PG8_WAIT_L(0); PG8_BAR; PG8_MMA(1, 0, At, B0); PG8_MMA(1, 1, At, B1); PG8_BAR; PG8_SCHED;
        }
        if constexpr (ALIGN_EPI) { if (wr == 0) PG8_BAR; }
        if constexpr (MIDSCALE) E(acc, cur, wr, wc, fr, fq, (const PG8_LAS float*)(gtab + (ui & 1) * 4096)); else E(acc, cur, wr, wc, fr, fq);
        if (!has_next) break;
#pragma unroll
        for (int a = 0; a < 2; ++a)
#pragma unroll
            for (int b = 0; b < 2; ++b)
#pragma unroll
                for (int m = 0; m < 4; ++m)
#pragma unroll
                    for (int n = 0; n < 2; ++n) acc[a][b][m][n] = (f32x4){0.f, 0.f, 0.f, 0.f};
        cur = nxt; cA = nA; cB = nB; ++ui;
        if constexpr (GATHER) {
#pragma unroll
            for (int h_ = 0; h_ < 2; ++h_) { goffc[h_][0] = goffn[h_][0]; goffc[h_][1] = goffn[h_][1]; } }
        if constexpr (ALIGN_EPI) { if (wr == 1) PG8_BAR; }
    }
    PG8_WAIT_V(0);
    if constexpr (!ALIGN_EPI) { if (wr == 0) PG8_BAR; }
    PG8_BAR;
#undef PG8_SA
#undef PG8_SB
#undef PG8_STAGE
#undef PG8_LDA
#undef PG8_LDB
#undef PG8_MMA
#undef PG8_WAIT_V
#undef PG8_WAIT_L
#undef PG8_BAR
#undef PG8_SCHED
#undef PG8_ABASE
#undef PG8_STA
#undef PG8_GISSUE
#undef PG8_GREAD
#undef PG8_BBASE
}
}
namespace att {
typedef unsigned short bf16;
using bf16x8 = __attribute__((ext_vector_type(8))) short;
using s16x4  = __attribute__((ext_vector_type(4))) short;
using f32x16 = __attribute__((ext_vector_type(16))) float;
using u32x4  = __attribute__((ext_vector_type(4))) unsigned;
#define ATT_SBAR() __builtin_amdgcn_sched_barrier(0)
constexpr int KCH = 1040;
constexpr float THR = 8.0f;
__device__ __forceinline__ int crow(int r, int hi) { return (r & 3) + 8 * (r >> 2) + 4 * hi; }
__device__ __forceinline__ unsigned cvtpk(float lo, float hi) { unsigned r; asm volatile("v_cvt_pk_bf16_f32 %0, %1, %2" : "=v"(r) : "v"(lo), "v"(hi)); return r; }
__device__ __forceinline__ unsigned short f2bf1(float f) { unsigned u = __builtin_bit_cast(unsigned, f); return (unsigned short)((u + 0x7fffu + ((u >> 16) & 1u)) >> 16); }

#define ATT_MX3(a, b, c) __builtin_fmaxf(__builtin_fmaxf((a), (b)), (c))
template <int MODE, bool FIRST>
__device__ __forceinline__ void partialSM(f32x16& p0, f32x16& p1, float& m_run, f32x16& negm, float& alpha) {
  if constexpr (MODE == 0) {
    float a = ATT_MX3(p0[0], p0[1], p1[0]), b = ATT_MX3(p0[2], p0[3], p1[1]); a = ATT_MX3(a, p1[2], p1[3]);
#pragma unroll
    for (int r = 4; r < 16; r += 4) { a = ATT_MX3(a, p0[r], p0[r + 1]); b = ATT_MX3(b, p0[r + 2], p0[r + 3]); a = ATT_MX3(a, p1[r], p1[r + 1]); b = ATT_MX3(b, p1[r + 2], p1[r + 3]); }
    float pmax = fmaxf(a, b);
    { auto rr = __builtin_amdgcn_permlane32_swap(__float_as_uint(pmax), __float_as_uint(pmax), false, false);
      pmax = fmaxf(__uint_as_float(rr[0]), __uint_as_float(rr[1])); }
    alpha = 1.f;
    if (FIRST || __builtin_expect(__any(pmax > THR), 0)) {
      const float dl = FIRST ? pmax : fmaxf(pmax, 0.f);
      m_run += dl;
#pragma unroll
      for (int r = 0; r < 16; ++r) { p0[r] -= dl; p1[r] -= dl; }
#pragma unroll
      for (int r = 0; r < 16; ++r) negm[r] = -m_run;
      asm volatile("" : "+v"(negm));
      alpha = FIRST ? 1.f : __builtin_amdgcn_exp2f(-dl);
    }
  } else { alpha = 1.f; }
#pragma unroll
  for (int r = 0; r < 16; ++r) p0[r] = __builtin_amdgcn_exp2f(p0[r]);
}
__device__ __forceinline__ void finishSM(f32x16& p0, f32x16& p1, float alpha, float& l_reg, bf16x8& pa0, bf16x8& pa1, bf16x8& pa2, bf16x8& pa3) {
#pragma unroll
  for (int r = 0; r < 16; ++r) p1[r] = __builtin_amdgcn_exp2f(p1[r]);
  float ps = 0;
#pragma unroll
  for (int r = 0; r < 16; ++r) ps += p0[r];
#pragma unroll
  for (int r = 0; r < 16; ++r) ps += p1[r];
  { auto rr = __builtin_amdgcn_permlane32_swap(__float_as_uint(ps), __float_as_uint(ps), false, false);
    ps = __uint_as_float(rr[0]) + __uint_as_float(rr[1]); }
  l_reg = l_reg * alpha + ps;
#define ATT_PK4(P, BASE, OUT) do { unsigned a0 = cvtpk(P[BASE + 0], P[BASE + 1]), a1 = cvtpk(P[BASE + 2], P[BASE + 3]);   \
    unsigned b0 = cvtpk(P[BASE + 4], P[BASE + 5]), b1 = cvtpk(P[BASE + 6], P[BASE + 7]);                              \
    auto r0 = __builtin_amdgcn_permlane32_swap(a0, b0, false, false); auto r1 = __builtin_amdgcn_permlane32_swap(a1, b1, false, false); \
    u32x4 w = {r0[0], r1[0], r0[1], r1[1]}; OUT = *reinterpret_cast<bf16x8*>(&w); } while (0)
  ATT_PK4(p0, 0, pa0); ATT_PK4(p0, 8, pa1); ATT_PK4(p1, 0, pa2); ATT_PK4(p1, 8, pa3);
#undef ATT_PK4
}
template <int ND0>
__device__ __forceinline__ void qkt(f32x16& p0, f32x16& p1, const char* Ks, const bf16x8* qr, const f32x16& negm, int r32, int hi) {
#pragma unroll
  for (int d0 = 0; d0 < ND0; ++d0) {
    const char* kb = Ks + (2 * d0 + hi) * KCH + r32 * 16;
    bf16x8 b0 = *reinterpret_cast<const bf16x8*>(kb);
    bf16x8 b1 = *reinterpret_cast<const bf16x8*>(kb + 512);
    if (d0 == 0) { p0 = __builtin_amdgcn_mfma_f32_32x32x16_bf16(b0, qr[0], negm, 0, 0, 0); p1 = __builtin_amdgcn_mfma_f32_32x32x16_bf16(b1, qr[0], negm, 0, 0, 0); }
    else { p0 = __builtin_amdgcn_mfma_f32_32x32x16_bf16(b0, qr[d0], p0, 0, 0, 0); p1 = __builtin_amdgcn_mfma_f32_32x32x16_bf16(b1, qr[d0], p1, 0, 0, 0); } }
}
template <int NB> __device__ __forceinline__ int v_st(int k, int c) { const int kk = (k & ~0xC) | ((k & 4) << 1) | ((k & 8) >> 1); return ((kk >> 3) * NB + (c >> 5)) * 512 + ((kk & 7) * 32 + (c & 31)) * 2; }
__device__ __forceinline__ int v_rd_base(int lane) { return ((lane & 3) << 3) | (((lane >> 2) & 3) << 6) | (((lane >> 4) & 1) << 5) | (((lane >> 5) & 1) << 8); }
template <int OFF> __device__ __forceinline__ s16x4 tr_read(int vb) {
  s16x4 r; asm volatile("ds_read_b64_tr_b16 %0, %1 offset:%2" : "=&v"(r) : "v"(vb), "i"(OFF) : "memory"); return r;
}
template <int NB, int D0> __device__ __forceinline__ void pv_one(f32x16& od, int vb, bf16x8 pa0, bf16x8 pa1, bf16x8 pa2, bf16x8 pa3) {
#define ATT_VO(ks, half) (D0 * 512 + (2 * (ks) + (half)) * NB * 512)
  const s16x4 l0 = tr_read<ATT_VO(0, 0)>(vb), h0 = tr_read<ATT_VO(0, 1)>(vb), l1 = tr_read<ATT_VO(1, 0)>(vb), h1 = tr_read<ATT_VO(1, 1)>(vb);
  const s16x4 l2 = tr_read<ATT_VO(2, 0)>(vb), h2 = tr_read<ATT_VO(2, 1)>(vb), l3 = tr_read<ATT_VO(3, 0)>(vb), h3 = tr_read<ATT_VO(3, 1)>(vb);
#undef ATT_VO
  asm volatile("s_waitcnt lgkmcnt(0)" ::: "memory"); ATT_SBAR();
#define ATT_PK(L, H) (bf16x8){L[0], L[1], L[2], L[3], H[0], H[1], H[2], H[3]}
  od = __builtin_amdgcn_mfma_f32_32x32x16_bf16(pa0, ATT_PK(l0, h0), od, 0, 0, 0);
  od = __builtin_amdgcn_mfma_f32_32x32x16_bf16(pa1, ATT_PK(l1, h1), od, 0, 0, 0);
  od = __builtin_amdgcn_mfma_f32_32x32x16_bf16(pa2, ATT_PK(l2, h2), od, 0, 0, 0);
  od = __builtin_amdgcn_mfma_f32_32x32x16_bf16(pa3, ATT_PK(l3, h3), od, 0, 0, 0);
#undef ATT_PK
}
template <int NB> __device__ __forceinline__ void pv_all(f32x16* o, int vb, bf16x8 pa0, bf16x8 pa1, bf16x8 pa2, bf16x8 pa3) {
  if constexpr (NB == 2) {
#define ATT_VO(d0, ks, half) ((d0) * 512 + (2 * (ks) + (half)) * NB * 512)
    const s16x4 l0 = tr_read<ATT_VO(0, 0, 0)>(vb), h0 = tr_read<ATT_VO(0, 0, 1)>(vb), l1 = tr_read<ATT_VO(0, 1, 0)>(vb), h1 = tr_read<ATT_VO(0, 1, 1)>(vb);
    const s16x4 l2 = tr_read<ATT_VO(0, 2, 0)>(vb), h2 = tr_read<ATT_VO(0, 2, 1)>(vb), l3 = tr_read<ATT_VO(0, 3, 0)>(vb), h3 = tr_read<ATT_VO(0, 3, 1)>(vb);
    const s16x4 m0 = tr_read<ATT_VO(1, 0, 0)>(vb), n0 = tr_read<ATT_VO(1, 0, 1)>(vb), m1 = tr_read<ATT_VO(1, 1, 0)>(vb), n1 = tr_read<ATT_VO(1, 1, 1)>(vb);
    const s16x4 m2 = tr_read<ATT_VO(1, 2, 0)>(vb), n2 = tr_read<ATT_VO(1, 2, 1)>(vb), m3 = tr_read<ATT_VO(1, 3, 0)>(vb), n3 = tr_read<ATT_VO(1, 3, 1)>(vb);
#undef ATT_VO
#define ATT_PK(L, H) (bf16x8){L[0], L[1], L[2], L[3], H[0], H[1], H[2], H[3]}
    asm volatile("s_waitcnt lgkmcnt(8)" ::: "memory"); ATT_SBAR();
    o[0] = __builtin_amdgcn_mfma_f32_32x32x16_bf16(pa0, ATT_PK(l0, h0), o[0], 0, 0, 0);
    o[0] = __builtin_amdgcn_mfma_f32_32x32x16_bf16(pa1, ATT_PK(l1, h1), o[0], 0, 0, 0);
    o[0] = __builtin_amdgcn_mfma_f32_32x32x16_bf16(pa2, ATT_PK(l2, h2), o[0], 0, 0, 0);
    o[0] = __builtin_amdgcn_mfma_f32_32x32x16_bf16(pa3, ATT_PK(l3, h3), o[0], 0, 0, 0);
    asm volatile("s_waitcnt lgkmcnt(0)" ::: "memory"); ATT_SBAR();
    o[1] = __builtin_amdgcn_mfma_f32_32x32x16_bf16(pa0, ATT_PK(m0, n0), o[1], 0, 0, 0);
    o[1] = __builtin_amdgcn_mfma_f32_32x32x16_bf16(pa1, ATT_PK(m1, n1), o[1], 0, 0, 0);
    o[1] = __builtin_amdgcn_mfma_f32_32x32x16_bf16(pa2, ATT_PK(m2, n2), o[1], 0, 0, 0);
    o[1] = __builtin_amdgcn_mfma_f32_32x32x16_bf16(pa3, ATT_PK(m3, n3), o[1], 0, 0, 0);
#undef ATT_PK
  } else {
    pv_one<NB, 0>(o[0], vb, pa0, pa1, pa2, pa3); pv_one<NB, 1>(o[1], vb, pa0, pa1, pa2, pa3);
    pv_one<NB, 2>(o[2], vb, pa0, pa1, pa2, pa3); pv_one<NB, 3>(o[3], vb, pa0, pa1, pa2, pa3);
  }
}

template <int W1, int W2, int DV> struct AttnCfg {
  static constexpr int DQK = W1 + W2, NCH = DQK / 8, ND0 = DQK / 16, NB = DV / 32;
  static constexpr int KT_BYTES = NCH * KCH, VT_BYTES = 64 * DV * 2;
  static constexpr int OST_BYTES = 32 * DV * 2;
  static constexpr bool OSTAGE = (DV == 64);
  static constexpr int LDS_BYTES = 3 * VT_BYTES + 3 * KT_BYTES + 8 * 64 * 4 + (OSTAGE ? 8 * OST_BYTES : 0);
  static constexpr int CW1 = W1 / 8, N1 = (64 * CW1) / 512;
  static constexpr int CWV = DV / 8, NV = (64 * CWV) / 512;
  static_assert(W1 == 64 || W1 == 128, "W1"); static_assert(W2 == 0 || W2 == 32, "W2"); static_assert(DV == 64 || DV == 128, "DV");
};

template <int W1, int W2, int DV, int MODE, bool SSQ>
__device__ __forceinline__ void attn_unit(const bf16* __restrict__ Qb, const bf16* __restrict__ Qb2, int ldq, const bf16* __restrict__ K1, int ldk1, const bf16* __restrict__ K2, int ldk2,
                                          const bf16* __restrict__ Vh, int ldv, bf16* __restrict__ Ob, int ldo, int nkeys, char* lds, float (&ssacc)[16]) {
  using C = AttnCfg<W1, W2, DV>;
  constexpr int ND0 = C::ND0, NB = C::NB, N1 = C::N1, NV = C::NV, CW1 = C::CW1, CWV = C::CWV;
  constexpr int SHM_V = C::VT_BYTES, SHM_K = C::KT_BYTES;
  int tid_ = threadIdx.x; asm volatile("" : "+v"(tid_));
  const int tid = tid_, wid = tid >> 6, lane = tid & 63, r32 = lane & 31, hi = lane >> 5;
  char* V_lds = lds; char* K_lds = lds + 3 * SHM_V;
  float* ws = (float*)(lds + 3 * SHM_V + 3 * SHM_K) + wid * 64; float* li_l = ws; float* al_l = ws + 32;
  float m_reg = 0.f, l_reg = 0; f32x16 o[NB]; bf16x8 qr[ND0]; f32x16 negm = f32x16{}; asm volatile("" : "+v"(negm));
#pragma unroll
  for (int d = 0; d < NB; ++d) o[d] = f32x16{};
  const bf16* Qw = Qb + (long)(wid * 32 + r32) * ldq + hi * 8;
#pragma unroll
  for (int d0 = 0; d0 < W1 / 16; ++d0) qr[d0] = *reinterpret_cast<const bf16x8*>(Qw + d0 * 16);
  if constexpr (W2 > 0) { const bf16* Qw2 = Qb2 + (long)(wid * 32 + r32) * ldq + hi * 8;
#pragma unroll
    for (int d0 = 0; d0 < W2 / 16; ++d0) qr[W1 / 16 + d0] = *reinterpret_cast<const bf16x8*>(Qw2 + d0 * 16); }
  int k1row[N1], k1col[N1], k1lds[N1], vrow[NV], vcol[NV], vlds[NV];
#pragma unroll
  for (int i = 0; i < N1; ++i) { const int p = tid + 512 * i; k1row[i] = p / CW1; k1col[i] = (p % CW1) * 8; k1lds[i] = (p % CW1) * KCH + (p / CW1) * 16; }
#pragma unroll
  for (int i = 0; i < NV; ++i) { const int p = tid + 512 * i; vrow[i] = p / CWV; vcol[i] = (p % CWV) * 8; vlds[i] = v_st<NB>(p / CWV, (p % CWV) * 8); }
  const int k2row = tid >> 2, k2col = (tid & 3) * 8, k2lds = (CW1 + (tid & 3)) * KCH + (tid >> 2) * 16; const bool k2on = (W2 > 0) && (tid < 256);
  const int vb0 = (int)(uintptr_t)V_lds + v_rd_base(lane);
  struct Slot { bf16x8 k1[N1]; bf16x8 k2; bf16x8 v[NV]; } sr_[2];
#define ATT_SLOAD(i, k0) do { _Pragma("unroll") for (int _j = 0; _j < N1; ++_j) sr_[i].k1[_j] = *reinterpret_cast<const bf16x8*>(&K1[(long)((k0) + k1row[_j]) * ldk1 + k1col[_j]]); \
    if constexpr (W2 > 0) { if (k2on) sr_[i].k2 = *reinterpret_cast<const bf16x8*>(&K2[(long)((k0) + k2row) * ldk2 + k2col]); } \
    _Pragma("unroll") for (int _j = 0; _j < NV; ++_j) sr_[i].v[_j] = *reinterpret_cast<const bf16x8*>(&Vh[(long)((k0) + vrow[_j]) * ldv + vcol[_j]]); } while (0)
#define ATT_SWRITE(b, i) do { _Pragma("unroll") for (int _j = 0; _j < NV; ++_j) *(bf16x8*)(V_lds + (b) * SHM_V + vlds[_j]) = sr_[i].v[_j]; \
    _Pragma("unroll") for (int _j = 0; _j < N1; ++_j) *(bf16x8*)(K_lds + (b) * SHM_K + k1lds[_j]) = sr_[i].k1[_j]; \
    if constexpr (W2 > 0) { if (k2on) *(bf16x8*)(K_lds + (b) * SHM_K + k2lds) = sr_[i].k2; } } while (0)
#define ATT_SWAIT() asm volatile("s_waitcnt vmcnt(%0)" :: "n"(N1 + NV) : "memory")
#define ATT_RESC(a) do { if (MODE == 0 && __any((a) != 1.f)) { if (hi == 0) al_l[r32] = (a); asm volatile("s_waitcnt lgkmcnt(0)" ::: "memory"); \
    _Pragma("unroll") for (int d = 0; d < NB; ++d) _Pragma("unroll") for (int r = 0; r < 16; ++r) o[d][r] *= al_l[crow(r, hi)]; } } while (0)
  f32x16 pA0, pA1, pB0, pB1; float alA, alB; bf16x8 pa0, pa1, pa2, pa3; const int NT = nkeys / 64;
  ATT_SLOAD(0, 0); asm volatile("s_waitcnt vmcnt(0)" ::: "memory"); ATT_SWRITE(0, 0); __syncthreads();
  qkt<ND0>(pA0, pA1, K_lds, qr, negm, r32, hi); partialSM<MODE, true>(pA0, pA1, m_reg, negm, alA);
  ATT_SLOAD(1, 64); if (2 < NT) ATT_SLOAD(0, 128);
  ATT_SWAIT(); ATT_SWRITE(1, 1); __syncthreads();
  int bp = 0, bc = 1, bn = 2;
  if (wid >= 4) __builtin_amdgcn_s_setprio(1);
#define ATT_ROT() do { const int t_ = bp; bp = bc; bc = bn; bn = t_; } while (0)
  for (int j = 1; j + 1 < NT; j += 2) {
    ATT_SBAR(); qkt<ND0>(pB0, pB1, K_lds + bc * SHM_K, qr, negm, r32, hi);
    finishSM(pA0, pA1, alA, l_reg, pa0, pa1, pa2, pa3); ATT_SBAR();
    ATT_SLOAD(1, (j + 2) * 64); ATT_SBAR();
    pv_all<NB>(o, vb0 + bp * SHM_V, pa0, pa1, pa2, pa3); partialSM<MODE, false>(pB0, pB1, m_reg, negm, alB);
    ATT_SWAIT(); ATT_SWRITE(bn, 0);
    ATT_RESC(alB); __syncthreads(); ATT_ROT();
    ATT_SBAR(); qkt<ND0>(pA0, pA1, K_lds + bc * SHM_K, qr, negm, r32, hi);
    finishSM(pB0, pB1, alB, l_reg, pa0, pa1, pa2, pa3); ATT_SBAR();
    if (j + 3 < NT) ATT_SLOAD(0, (j + 3) * 64); ATT_SBAR();
    pv_all<NB>(o, vb0 + bp * SHM_V, pa0, pa1, pa2, pa3); partialSM<MODE, false>(pA0, pA1, m_reg, negm, alA);
    ATT_SWAIT(); ATT_SWRITE(bn, 1);
    ATT_RESC(alA); __syncthreads(); ATT_ROT();
  }
  ATT_SBAR(); qkt<ND0>(pB0, pB1, K_lds + bc * SHM_K, qr, negm, r32, hi);
  finishSM(pA0, pA1, alA, l_reg, pa0, pa1, pa2, pa3); ATT_SBAR();
  pv_all<NB>(o, vb0 + bp * SHM_V, pa0, pa1, pa2, pa3); partialSM<MODE, false>(pB0, pB1, m_reg, negm, alB);
  ATT_RESC(alB);
  finishSM(pB0, pB1, alB, l_reg, pa0, pa1, pa2, pa3); ATT_SBAR();
  pv_all<NB>(o, vb0 + bc * SHM_V, pa0, pa1, pa2, pa3);
#undef ATT_ROT
  __builtin_amdgcn_s_setprio(0);
  if (hi == 0) li_l[r32] = l_reg; asm volatile("s_waitcnt lgkmcnt(0)" ::: "memory");
  float rli[16];
#pragma unroll
  for (int r = 0; r < 16; ++r) rli[r] = __builtin_amdgcn_rcpf(li_l[crow(r, hi)]);
  bf16* Ow = Ob + (long)(wid * 32) * ldo;
  if constexpr (C::OSTAGE) { unsigned short* stg = (unsigned short*)(lds + 3 * SHM_V + 3 * SHM_K + 8 * 64 * 4 + wid * C::OST_BYTES);
#pragma unroll
    for (int r = 0; r < 16; ++r) { const int orow = crow(r, hi);
#pragma unroll
      for (int d0 = 0; d0 < NB; ++d0) stg[orow * DV + d0 * 32 + r32] = f2bf1(o[d0][r] * rli[r]); }
    asm volatile("s_waitcnt lgkmcnt(0)" ::: "memory");
    constexpr int CPR = DV / 8;
#pragma unroll
    for (int i = 0; i < (32 * CPR) / 64; ++i) { const int p = i * 64 + lane, row = p / CPR, ch = p % CPR;
      const u32x4 v = *(const u32x4*)(stg + row * DV + ch * 8); *(u32x4*)(Ow + (long)row * ldo + ch * 8) = v; } }
  else {
#pragma unroll
    for (int r = 0; r < 16; ++r) { const int orow = crow(r, hi);
#pragma unroll
      for (int d0 = 0; d0 < NB; ++d0) Ow[(long)orow * ldo + d0 * 32 + r32] = f2bf1(o[d0][r] * rli[r]); } }
  if constexpr (SSQ) {
#pragma unroll
    for (int r = 0; r < 16; ++r) {
#pragma unroll
      for (int d0 = 0; d0 < NB; ++d0) { const float v = o[d0][r] * rli[r]; ssacc[r] += v * v; } } }
  __syncthreads();
#undef ATT_SLOAD
#undef ATT_SWRITE
#undef ATT_SWAIT
#undef ATT_RESC
}
#undef ATT_SBAR
}
constexpr int NWAVES = 8;
#ifndef MK_N_LAUNCHES
#define MK_N_LAUNCHES 1
#endif
constexpr int BATCH = 8, SEQ = 4096, DM = 1024, DEPTH = 4, MTOK = BATCH * SEQ;
constexpr int IN_W = 1184, IN_WP = 1280;
constexpr int MEM_T = 256, MROWS = BATCH * MEM_T;
constexpr int NEXP = 16, CAP = 512, EFF = 512, MOE_ROWS = NEXP * BATCH * CAP;
constexpr float EPS = 1e-6f, LOG2E = 1.4426950408889634f;
constexpr int NPH = 2 + 16 * DEPTH;
constexpr size_t MiB = 1u << 20;
constexpr size_t WS_CTL = 0, CTL_ZERO_BYTES = 1 * MiB;
constexpr size_t WS_TABG = 1 * MiB, WS_TABM = 2 * MiB, WS_WR = 2 * MiB + 512 * 1024, WS_GAINS = 3 * MiB, WS_SSO = 3 * MiB + 64 * 1024, WS_SSX = 346 * MiB, WS_RS1 = WS_SSO + 512 * 1024, WS_RS3 = WS_RS1 + 128 * 1024, WS_RG = 118 * MiB + 256 * 1024, WS_SSL = 118 * MiB + 512 * 1024;
constexpr size_t WS_WSMALL = 4 * MiB, WSMALL_STRIDE = 10 * MiB;
constexpr size_t OFF_WIN = 0, OFF_WQB = 5 * MiB / 2, OFF_WKVB = 3 * MiB, OFF_WO = 7 * MiB / 2, OFF_WMQ = 11 * MiB / 2, OFF_WMKV = 13 * MiB / 2, OFF_WMO = 17 * MiB / 2;
constexpr size_t WS_WGU = 44 * MiB, WS_WD = 76 * MiB;
constexpr size_t WS_MEMN = 92 * MiB, WS_MEMKV = 96 * MiB;
constexpr size_t WS_AFF = 112 * MiB, WS_AFFT = 114 * MiB, WS_SLOT = 116 * MiB, WS_IDX = 118 * MiB;
constexpr size_t WS_H = 120 * MiB, WS_PROJ = 184 * MiB, WS_QG = 264 * MiB, WS_KG = 296 * MiB, WS_VG = 304 * MiB, WS_LAT = 312 * MiB, WS_KROPE = 344 * MiB, WS_QM = 346 * MiB;
constexpr size_t WS_XB = 264 * MiB;
constexpr size_t WS_O = WS_H, WS_KVM = WS_PROJ, WS_QMEM = 184 * MiB, WS_OMEM = 216 * MiB, WS_XG = 184 * MiB, WS_Y = WS_XG, WS_ACT = 312 * MiB;
constexpr size_t WS_WGU2 = 394 * MiB, WS_WD2 = 426 * MiB;
constexpr size_t WS_X = 442 * MiB;
constexpr size_t WS_END = 506 * MiB;
constexpr int CW_BAR = 4096;
constexpr int RING_BYTES = 131072, LDSCTL_OFF = 135168, MISC_OFF = LDSCTL_OFF + 320, GTAB_OFF = LDSCTL_OFF + 1024, STAB_OFF = GTAB_OFF + 8192, LDS_BYTES = 163840;

#define GAS __attribute__((address_space(1)))
#define LAS __attribute__((address_space(3)))
typedef unsigned short bf16;
typedef unsigned v4u __attribute__((ext_vector_type(4)));
typedef float f32x4 __attribute__((ext_vector_type(4)));
#define LDS_WAIT() asm volatile("s_waitcnt lgkmcnt(0)" ::: "memory")
__device__ __forceinline__ unsigned pk2(float lo, float hi) { unsigned r; asm volatile("v_cvt_pk_bf16_f32 %0, %1, %2" : "=v"(r) : "v"(lo), "v"(hi)); return r; }
__device__ __forceinline__ float bflo(unsigned w) { return __uint_as_float(w << 16); }
__device__ __forceinline__ float bfhi(unsigned w) { return __uint_as_float(w & 0xffff0000u); }
#define UNPACK8(W_, V_) do { V_[0] = bflo(W_[0]); V_[1] = bfhi(W_[0]); V_[2] = bflo(W_[1]); V_[3] = bfhi(W_[1]); V_[4] = bflo(W_[2]); V_[5] = bfhi(W_[2]); V_[6] = bflo(W_[3]); V_[7] = bfhi(W_[3]); } while (0)
#define PACK8(V_, W_) do { W_[0] = pk2(V_[0], V_[1]); W_[1] = pk2(V_[2], V_[3]); W_[2] = pk2(V_[4], V_[5]); W_[3] = pk2(V_[6], V_[7]); } while (0)
__device__ __forceinline__ float wave_sum(float v) {
#pragma unroll
    for (int o = 1; o < 64; o <<= 1) v += __shfl_xor(v, o);
    return v;
}
__device__ __forceinline__ int wave_sum_i(int v) {
#pragma unroll
    for (int o = 1; o < 64; o <<= 1) v += __shfl_xor(v, o);
    return v;
}

#define XB_TMO      128
#define XB_XCNT(j)  (256  + 64 * (j))
#define XB_XSUB(j)  (1280 + 64 * (j))
#define XB_XGEN(j)  (2304 + 64 * (j))
#define XB_TOP      3328
#define XB_TOPGEN   3392
#define XCD_BAR_WORDS 3456
#define XB_SPIN_CAP (1u << 20)
__device__ __forceinline__ unsigned xb_ld(unsigned* p)              { return __hip_atomic_load(p, __ATOMIC_RELAXED, __HIP_MEMORY_SCOPE_AGENT); }
__device__ __forceinline__ unsigned xb_add(unsigned* p, unsigned v) { return __hip_atomic_fetch_add(p, v, __ATOMIC_RELAXED, __HIP_MEMORY_SCOPE_AGENT); }
__device__ __forceinline__ unsigned xb_xcc_id() { return (unsigned)__builtin_amdgcn_s_getreg((3 << 11) | 20) & 0xFu; }
#define XB_SPIN(cond, bar) do { unsigned _sp = 0; while (cond) { __builtin_amdgcn_s_sleep(1); \
    if ((++_sp & 255u) == 0u) { if (xb_ld(&(bar)[XB_TMO])) break; if (_sp > XB_SPIN_CAP) { atomicAdd(&(bar)[XB_TMO], 1u); break; } } } } while (0)
struct XcdBarrier { unsigned* bar; unsigned x; volatile LAS unsigned* st; };
__device__ __forceinline__ XcdBarrier xcd_barrier_post(unsigned* bar, volatile LAS unsigned* st) {
    XcdBarrier b; b.bar = bar; b.x = xb_xcc_id(); b.st = st;
    if (threadIdx.x == 0) (void)xb_add(&bar[XB_XCNT(b.x)], 1u);
    return b;
}
__device__ __forceinline__ void xcd_barrier_complete(unsigned* bar, unsigned x, unsigned& nloc, unsigned& nx) {
    const unsigned G = gridDim.x * gridDim.y * gridDim.z;
    unsigned sum, cnt, mine, sp = 0u;
    for (;;) {
        sum = 0u; cnt = 0u; mine = 0u;
#pragma unroll
        for (unsigned j = 0; j < 16; ++j) { const unsigned c = xb_ld(&bar[XB_XCNT(j)]); sum += c; cnt += (c > 0u) ? 1u : 0u; mine = (j == x) ? c : mine; }
        if (sum == G) break;
        __builtin_amdgcn_s_sleep(1);
        if ((++sp & 255u) == 0u) { if (xb_ld(&bar[XB_TMO])) break; if (sp > XB_SPIN_CAP) { atomicAdd(&bar[XB_TMO], 1u); break; } }
    }
    nloc = mine > 0u ? mine : 1u; nx = cnt > 0u ? cnt : 1u;
}
__device__ __forceinline__ void xcd_barrier(const XcdBarrier& b) {
    asm volatile("s_waitcnt vmcnt(0)" ::: "memory");
    __syncthreads();
    if (threadIdx.x == 0) {
        unsigned* bar = b.bar;
        __builtin_amdgcn_s_waitcnt(0);
        unsigned nloc = b.st[0], nx = b.st[1];
        if (nloc == 0u) { xcd_barrier_complete(bar, b.x, nloc, nx); b.st[0] = nloc; b.st[1] = nx; }
        const unsigned old = xb_add(&bar[XB_XSUB(b.x)], 1u);
        const unsigned gen = old / nloc;
        if (old + 1u == (gen + 1u) * nloc) {
            __builtin_amdgcn_fence(__ATOMIC_RELEASE, "agent");
            asm volatile("s_waitcnt vmcnt(0)" ::: "memory");
            const unsigned og = xb_add(&bar[XB_TOP], 1u);
            const unsigned tg = og / nx;
            if (og + 1u == (tg + 1u) * nx) xb_add(&bar[XB_TOPGEN], 1u);
            else XB_SPIN(xb_ld(&bar[XB_TOPGEN]) == tg, bar);
            __builtin_amdgcn_fence(__ATOMIC_ACQUIRE, "agent");
            xb_add(&bar[XB_XGEN(b.x)], 1u);
            asm volatile("s_waitcnt vmcnt(0)" ::: "memory");
        } else {
            XB_SPIN(xb_ld(&bar[XB_XGEN(b.x)]) == gen, bar);
            __builtin_amdgcn_fence(__ATOMIC_ACQUIRE, "agent");
            asm volatile("s_waitcnt vmcnt(0)" ::: "memory");
        }
    }
    __syncthreads();
}

struct Args { const float* in[24]; float* out; unsigned char* ws; int ph_lo, ph_hi; };
struct Ctx {
    LAS unsigned char* lds; char* ldsg;
    int tid, lane, wave, vcu, vcu0, G, G0, gw, NGW;
    bf16* x; float* out;
    unsigned char* ws;
};
#define WSP(T, off) ((T*)(F.ws + (off)))
__device__ __forceinline__ void refresh(Ctx& F) { int t = threadIdx.x; asm volatile("" : "+v"(t)); F.tid = t; F.lane = t & 63;
    int w = __builtin_amdgcn_readfirstlane(t >> 6), v = F.vcu0, g = F.G0; asm volatile("" : "+s"(w), "+s"(v), "+s"(g)); F.wave = w; F.vcu = v; F.G = g; F.gw = v * NWAVES + w; F.NGW = g * NWAVES; }

__device__ __forceinline__ int il32(int i) { return (i < 16) ? 2 * i : 2 * (i - 16) + 1; }
__device__ __forceinline__ int il64(int d) { return (d < 32) ? 2 * d : 2 * (d - 32) + 1; }
__device__ __forceinline__ int dstrow(int kind, int n) {
    if (kind == 1) {
        if (n < 512) { const int h = n >> 6, p = il64(n & 63); return 256 * (h >> 2) + 128 * (p >> 5) + 32 * (h & 3) + (p & 31); }
        if (n < 640) { const int kh = (n - 512) >> 6, p = il64(n & 63); return 512 + 128 * (p >> 5) + 32 * kh + (p & 31); }
        if (n < 768) { const int vh = (n - 640) >> 6, d = n & 63; return 512 + 128 * (d >> 5) + 32 * (2 + vh) + (d & 31); }
        if (n >= 1152) return 1152 + il32(n - 1152);
        return n; }
    if (kind == 2) { const int h = n / 96, p = n % 96; return (p < 64) ? h * 64 + p : 512 + h * 32 + il32(p - 64); }
    if (kind == 3) return (n >> 7) * 256 + (n & 127);
    if (kind == 4) return (n >> 7) * 256 + 128 + (n & 127);
    return n;
}
__device__ __forceinline__ void tr_item(const float* W, int N, const float* gain, bf16* WT, int ldk, int kind, int item, LAS float* scr, int lane) {
    const int nblk = (N + 63) / 64, kb = item / nblk, nb = item % nblk, k0 = 64 * kb, n0 = 64 * nb;
    const int lr = lane >> 4, lc = (lane & 15) * 4; const bool okc = (n0 + lc) < N;
    f32x4 v[16];
#pragma unroll
    for (int i = 0; i < 16; ++i) v[i] = okc ? *(const GAS f32x4*)(W + (size_t)(k0 + 4 * i + lr) * N + n0 + lc) : (f32x4){0.f, 0.f, 0.f, 0.f};
#pragma unroll
    for (int i = 0; i < 16; ++i) { const int kk = 4 * i + lr; const float gk = gain ? gain[k0 + kk] : 1.0f; LAS float* d = scr + kk * 65 + lc;
        d[0] = v[i].x * gk; d[1] = v[i].y * gk; d[2] = v[i].z * gk; d[3] = v[i].w * gk; }
    LDS_WAIT(); asm volatile("" ::: "memory");
    const int c = lane & 7;
#pragma unroll
    for (int j = 0; j < 8; ++j) { const int n = (lane >> 3) + 8 * j; const LAS float* s = scr + (8 * c) * 65 + n;
        v4u o; o.x = pk2(s[0 * 65], s[1 * 65]); o.y = pk2(s[2 * 65], s[3 * 65]); o.z = pk2(s[4 * 65], s[5 * 65]); o.w = pk2(s[6 * 65], s[7 * 65]);
        if (n0 + n < N) *(GAS v4u*)(WT + (size_t)dstrow(kind, n0 + n) * ldk + k0 + 8 * c) = o; }
    LDS_WAIT(); asm volatile("" ::: "memory");
}
constexpr int SMALL_ITEMS = 1152;
__device__ __forceinline__ void small_weight_item(const Ctx& F, const Args& A, int l, int r, LAS float* scr) {
    bf16* wl = WSP(bf16, WS_WSMALL + (size_t)l * WSMALL_STRIDE);
    if (r < 304) { tr_item(A.in[3] + (size_t)l * DM * IN_W, IN_W, A.in[2] + l * DM, wl + OFF_WIN / 2, DM, 1, r, scr, F.lane); return; } r -= 304;
    if (r < 48)  { tr_item(A.in[8] + (size_t)l * 256 * 768, 768, A.in[6] + l * 256, wl + OFF_WQB / 2, 256, 2, r, scr, F.lane); return; } r -= 48;
    if (r < 32)  { tr_item(A.in[9] + (size_t)l * 128 * 1024, 1024, A.in[7] + l * 128, wl + OFF_WKVB / 2, 256, 0, r, scr, F.lane); return; } r -= 32;
    if (r < 256) { const int kb = r / 16; const float* gain = (kb < 8) ? (A.in[10] + l * 512) : (A.in[11] + l * 512 - 512);
                   tr_item(A.in[12] + (size_t)l * DM * DM, DM, gain, wl + OFF_WO / 2, DM, 0, r, scr, F.lane); return; } r -= 256;
    if (r < 128) { tr_item(A.in[15] + (size_t)l * DM * 512, 512, A.in[13] + l * DM, wl + OFF_WMQ / 2, DM, 0, r, scr, F.lane); return; } r -= 128;
    if (r < 256) { tr_item(A.in[16] + (size_t)l * DM * DM, DM, A.in[14] + l * DM, wl + OFF_WMKV / 2, DM, 0, r, scr, F.lane); return; } r -= 256;
    tr_item(A.in[17] + (size_t)l * 512 * DM, DM, nullptr, wl + OFF_WMO / 2, 512, 0, r, scr, F.lane);
}
constexpr int MOE_ITEMS = 3 * 2048;
__device__ __forceinline__ void moe_weight_item(const Ctx& F, const Args& A, int l, int it, LAS float* scr) {
    bf16* wgu = WSP(bf16, (l & 1) ? WS_WGU2 : WS_WGU); bf16* wd = WSP(bf16, (l & 1) ? WS_WD2 : WS_WD);
    const int which = it >> 11, e = (it >> 7) & 15, r = it & 127;
    if (which < 2) tr_item((which == 0 ? A.in[20] : A.in[21]) + (size_t)(l * NEXP + e) * DM * EFF, EFF, A.in[18] + l * DM, wgu + (size_t)e * 1024 * 1024, DM, 3 + which, r, scr, F.lane);
    else           tr_item(A.in[22] + (size_t)(l * NEXP + e) * EFF * DM, DM, nullptr, wd + (size_t)e * 1024 * 512, EFF, 0, r, scr, F.lane);
}
__device__ __forceinline__ void convert_moe_weights(const Ctx& F, const Args& A, int l) {
    LAS float* scr = (LAS float*)(F.lds + F.wave * 16640);
    for (int it = F.gw; it < MOE_ITEMS; it += F.NGW) moe_weight_item(F, A, l, it, scr);
}

__device__ __forceinline__ void rms_row_f32(const float* xrow, bf16* xb, bf16* orow, float* rs, int lane) {
    const GAS f32x4* xr = (const GAS f32x4*)xrow + lane;
    f32x4 v[4]; float s = 0.f;
#pragma unroll
    for (int j = 0; j < 4; ++j) { v[j] = xr[64 * j]; s += (v[j].x * v[j].x + v[j].y * v[j].y) + (v[j].z * v[j].z + v[j].w * v[j].w); }
    const float rstd = __builtin_amdgcn_rsqf(wave_sum(s) * (1.f / DM) + EPS);
    if (xb) { GAS unsigned long long* x8 = (GAS unsigned long long*)xb + lane;
#pragma unroll
        for (int j = 0; j < 4; ++j) x8[64 * j] = (unsigned long long)pk2(v[j].x, v[j].y) | ((unsigned long long)pk2(v[j].z, v[j].w) << 32); }
    if (rs && lane == 0) *rs = rstd;
    if (orow) { GAS unsigned long long* o8 = (GAS unsigned long long*)orow + lane;
#pragma unroll
        for (int j = 0; j < 4; ++j) o8[64 * j] = (unsigned long long)pk2(v[j].x * rstd, v[j].y * rstd) | ((unsigned long long)pk2(v[j].z * rstd, v[j].w * rstd) << 32); }
}
__device__ __forceinline__ void phase_prologue(const Ctx& F, const Args& A) {
    LAS float* scr = (LAS float*)(F.lds + F.wave * 16640);
    for (int it = F.gw; it < DEPTH * SMALL_ITEMS; it += F.NGW) small_weight_item(F, A, it / SMALL_ITEMS, it % SMALL_ITEMS, scr);
    convert_moe_weights(F, A, 0);
    const int gt = F.vcu * (NWAVES * 64) + F.tid, NGT = F.G * NWAVES * 64;
    for (int i = gt; i < DEPTH * (12288 + 16384); i += NGT) { const int l = i / (12288 + 16384), r = i % (12288 + 16384);
        bf16* wl = WSP(bf16, WS_WSMALL + (size_t)l * WSMALL_STRIDE);
        if (r < 12288) *(GAS v4u*)(wl + OFF_WIN / 2 + (size_t)IN_W * DM + (size_t)r * 8) = (v4u){0u, 0u, 0u, 0u};
        else { const int q = r - 12288; *(GAS v4u*)(wl + OFF_WKVB / 2 + (size_t)(q >> 4) * 256 + 128 + (q & 15) * 8) = (v4u){0u, 0u, 0u, 0u}; } }
    for (int i = gt; i < MTOK * 16; i += NGT) *(GAS v4u*)(WSP(bf16, WS_LAT) + (size_t)(i >> 4) * 512 + 384 + (i & 15) * 8) = (v4u){0u, 0u, 0u, 0u};
    for (int i = gt; i < 1536; i += NGT) WSP(float, WS_GAINS)[i] = (i < 256) ? A.in[4][i] : (i < 512) ? A.in[5][i - 256] : A.in[23][i - 512];
    for (int i = gt; i < DEPTH * NEXP * DM; i += NGT) { const int l = i / (NEXP * DM), e = (i / DM) % NEXP, k = i % DM;
        WSP(float, WS_WR)[i] = A.in[19][(size_t)(l * DM + k) * NEXP + e] * A.in[18][l * DM + k]; }
    for (int i = gt; i < SEQ * 48; i += NGT) { const int s = i / 48, j = i % 48; const float row = (float)(s >> 6), col = (float)(s & 63);
        const bool isg = (j < 32); const int j2 = isg ? j : j - 32, half = isg ? 16 : 8, jj = j2 & (half - 1);
        const float inv = __builtin_amdgcn_exp2f(-(float)(2 * jj) / (float)(2 * half) * 13.287712379549449f);
        const float ang = ((j2 < half) ? row : col) * inv;
        double td = (double)ang * 0.15915494309189535; td -= rint(td);
        const float sn = __builtin_amdgcn_sinf((float)td), cs = __builtin_amdgcn_cosf((float)td);
        float* dst = isg ? (WSP(float, WS_TABG) + ((size_t)s * 32 + j2) * 2) : (WSP(float, WS_TABM) + ((size_t)s * 16 + j2) * 2);
        dst[0] = cs; dst[1] = sn; }
    for (int m = F.gw; m < MROWS; m += F.NGW) rms_row_f32(A.in[1] + (size_t)m * DM, nullptr, WSP(bf16, WS_MEMN) + (size_t)m * DM, nullptr, F.lane);
    for (int m = F.gw; m < MTOK; m += F.NGW) rms_row_f32(A.in[0] + (size_t)m * DM, F.x + (size_t)m * DM, nullptr, WSP(float, WS_RS1) + m, F.lane);
}

__device__ __forceinline__ void rope4(float* v, const float* tab) {
    const f32x4 t0 = *(const f32x4*)tab, t1 = *(const f32x4*)(tab + 4);
    float a, b;
    a = v[0]; b = v[1]; v[0] = a * t0[0] - b * t0[1]; v[1] = b * t0[0] + a * t0[1];
    a = v[2]; b = v[3]; v[2] = a * t0[2] - b * t0[3]; v[3] = b * t0[2] + a * t0[3];
    a = v[4]; b = v[5]; v[4] = a * t1[0] - b * t1[1]; v[5] = b * t1[0] + a * t1[1];
    a = v[6]; b = v[7]; v[6] = a * t1[2] - b * t1[3]; v[7] = b * t1[2] + a * t1[3];
}
__device__ __forceinline__ void phase_postproj(const Ctx& F, int l) {
    int lane_ = F.lane; asm volatile("" : "+v"(lane_)); const int lane = lane_;
    const float* gq = WSP(float, WS_GAINS) + l * 64; const float* gk = WSP(float, WS_GAINS) + 256 + l * 64;
    float gqv[8], gkv[8];
#pragma unroll
    for (int i = 0; i < 8; ++i) { const int p = 8 * (lane & 7) + i, d = (p >> 1) + 32 * (p & 1); gqv[i] = gq[d]; gkv[i] = gk[d]; }
    const float* tabg = WSP(float, WS_TABG); const float* tabm = WSP(float, WS_TABM);
    const float C2G = 0.125f * LOG2E;
    v4u wa_n = (v4u){0u, 0u, 0u, 0u}, wb_n = wa_n, wc_n = wa_n;
    if (F.gw < MTOK) { const bf16* pr = WSP(bf16, WS_PROJ) + (size_t)F.gw * IN_WP; wa_n = *(const GAS v4u*)(pr + 8 * lane); wb_n = *(const GAS v4u*)(pr + 512 + 8 * lane); if (lane < 20) wc_n = *(const GAS v4u*)(pr + 1024 + 8 * lane); }
    for (int m = F.gw; m < MTOK; m += F.NGW) {
        const int s = m & (SEQ - 1);
        const v4u wa = wa_n, wb = wb_n, wc = wc_n;
        if (m + F.NGW < MTOK) { const bf16* pr = WSP(bf16, WS_PROJ) + (size_t)(m + F.NGW) * IN_WP; wa_n = *(const GAS v4u*)(pr + 8 * lane); wb_n = *(const GAS v4u*)(pr + 512 + 8 * lane); if (lane < 20) wc_n = *(const GAS v4u*)(pr + 1024 + 8 * lane); }
        { const v4u w = wa; float v[8]; UNPACK8(w, v);
          float ss = 0.f;
#pragma unroll
          for (int i = 0; i < 8; ++i) ss += v[i] * v[i];
          ss += __shfl_xor(ss, 1); ss += __shfl_xor(ss, 2); ss += __shfl_xor(ss, 4);
          const float rstd = __builtin_amdgcn_rsqf(ss * (1.f / 64.f) + EPS);
#pragma unroll
          for (int i = 0; i < 8; ++i) v[i] = v[i] * rstd * gqv[i];
          rope4(v, tabg + ((size_t)s * 32 + 4 * (lane & 7)) * 2);
#pragma unroll
          for (int i = 0; i < 8; ++i) v[i] *= C2G;
          v4u o; PACK8(v, o); *(GAS v4u*)(WSP(bf16, WS_QG) + (size_t)m * 512 + 8 * lane) = o; }
        { const v4u w = wb; float v[8]; UNPACK8(w, v);
          float ss = 0.f;
#pragma unroll
          for (int i = 0; i < 8; ++i) ss += v[i] * v[i];
          ss += __shfl_xor(ss, 1); ss += __shfl_xor(ss, 2); ss += __shfl_xor(ss, 4);
          const float ss8 = ss;
          ss += __shfl_xor(ss, 8); ss += __shfl_xor(ss, 16);
          if (lane < 16) {
              const float rstd = __builtin_amdgcn_rsqf(ss8 * (1.f / 64.f) + EPS);
#pragma unroll
              for (int i = 0; i < 8; ++i) v[i] = v[i] * rstd * gkv[i];
              rope4(v, tabg + ((size_t)s * 32 + 4 * (lane & 7)) * 2);
              v4u o; PACK8(v, o); *(GAS v4u*)(WSP(bf16, WS_KG) + (size_t)m * 128 + 8 * lane) = o;
          } else if (lane < 32) {
              *(GAS v4u*)(WSP(bf16, WS_VG) + (size_t)m * 128 + 8 * (lane - 16)) = w;
          } else {
              const float rstd = __builtin_amdgcn_rsqf(ss * (1.f / 256.f) + EPS);
#pragma unroll
              for (int i = 0; i < 8; ++i) v[i] *= rstd;
              v4u o; PACK8(v, o); *(GAS v4u*)(WSP(bf16, WS_LAT) + (size_t)m * 512 + 8 * (lane - 32)) = o;
          } }
        { const v4u w = wc;
          float v[8]; UNPACK8(w, v);
          float ss = 0.f;
#pragma unroll
          for (int i = 0; i < 8; ++i) ss += v[i] * v[i];
          ss += __shfl_xor(ss, 1); ss += __shfl_xor(ss, 2); ss += __shfl_xor(ss, 4); ss += __shfl_xor(ss, 8);
          if (lane < 16) {
              const float rstd = __builtin_amdgcn_rsqf(ss * (1.f / 128.f) + EPS);
#pragma unroll
              for (int i = 0; i < 8; ++i) v[i] *= rstd;
              v4u o; PACK8(v, o); *(GAS v4u*)(WSP(bf16, WS_LAT) + (size_t)m * 512 + 256 + 8 * lane) = o;
          } else if (lane < 20) {
              rope4(v, tabm + ((size_t)s * 16 + 4 * (lane - 16)) * 2);
              v4u o; PACK8(v, o); *(GAS v4u*)(WSP(bf16, WS_KROPE) + (size_t)m * 32 + 8 * (lane - 16)) = o;
          } else if (lane < 36) {
              *(GAS v4u*)(WSP(bf16, WS_LAT) + (size_t)m * 512 + 384 + 8 * (lane - 20)) = (v4u){0u, 0u, 0u, 0u};
          } }
    }
}

__device__ __forceinline__ void phase_outnorm(const Ctx& F) {
    int lane_ = F.lane; asm volatile("" : "+v"(lane_)); const int lane = lane_;
    for (int m = F.gw; m < MTOK; m += F.NGW) {
        bf16* orow = WSP(bf16, WS_O) + (size_t)m * DM;
#pragma unroll
        for (int g = 0; g < 2; ++g) {
            v4u w = *(const GAS v4u*)(orow + g * 512 + 8 * lane); float v[8]; UNPACK8(w, v);
            float ss = 0.f;
#pragma unroll
            for (int i = 0; i < 8; ++i) ss += v[i] * v[i];
            const float rstd = __builtin_amdgcn_rsqf(wave_sum(ss) * (1.f / 512.f) + EPS);
#pragma unroll
            for (int i = 0; i < 8; ++i) v[i] *= rstd;
            v4u o; PACK8(v, o); *(GAS v4u*)(orow + g * 512 + 8 * lane) = o;
        }
    }
}

__device__ __forceinline__ void phase_router(const Ctx& F, int l) {
    int lane_ = F.lane; asm volatile("" : "+v"(lane_)); const int lane = lane_;
    LAS float* wr = (LAS float*)F.lds;
    { const GAS f32x4* src = (const GAS f32x4*)(WSP(float, WS_WR) + (size_t)l * NEXP * DM);
      for (int i = F.tid; i < NEXP * DM / 4; i += NWAVES * 64) ((LAS f32x4*)wr)[i] = src[i]; }
    __syncthreads();
    for (int mp = F.gw; mp < MTOK / 2; mp += F.NGW) {
        const int m = 2 * mp;
        asm volatile("" ::: "memory");
        typedef unsigned u32x2 __attribute__((ext_vector_type(2)));
        const GAS u32x2* xr0 = (const GAS u32x2*)(F.x + (size_t)m * DM) + lane; const GAS u32x2* xr1 = xr0 + DM / 4;
        f32x4 v0[4], v1[4]; float s0 = 0.f, s1 = 0.f;
#pragma unroll
        for (int j = 0; j < 4; ++j) { const u32x2 q0 = xr0[64 * j], q1 = xr1[64 * j];
            v0[j] = (f32x4){bflo(q0.x), bfhi(q0.x), bflo(q0.y), bfhi(q0.y)}; v1[j] = (f32x4){bflo(q1.x), bfhi(q1.x), bflo(q1.y), bfhi(q1.y)}; }
#pragma unroll
        for (int j = 0; j < 4; ++j) { s0 += (v0[j].x * v0[j].x + v0[j].y * v0[j].y) + (v0[j].z * v0[j].z + v0[j].w * v0[j].w); s1 += (v1[j].x * v1[j].x + v1[j].y * v1[j].y) + (v1[j].z * v1[j].z + v1[j].w * v1[j].w); }
        const float rstd0 = __builtin_amdgcn_rsqf(wave_sum(s0) * (1.f / DM) + EPS), rstd1 = __builtin_amdgcn_rsqf(wave_sum(s1) * (1.f / DM) + EPS);
        if (lane == 0) { WSP(float, WS_RS3)[m] = rstd0; WSP(float, WS_RS3)[m + 1] = rstd1; }
        float a0[16], a1[16];
#pragma unroll
        for (int e = 0; e < 16; ++e) { float p = 0.f, q = 0.f;
#pragma unroll
            for (int j = 0; j < 4; ++j) { const f32x4 w = *((const LAS f32x4*)(wr + e * DM) + lane + 64 * j);
                p += (v0[j].x * w.x + v0[j].y * w.y) + (v0[j].z * w.z + v0[j].w * w.w); q += (v1[j].x * w.x + v1[j].y * w.y) + (v1[j].z * w.z + v1[j].w * w.w); }
            a0[e] = p; a1[e] = q; }
        float t16[16];
#pragma unroll
        for (int e = 0; e < 16; ++e) { const float send = (lane & 32) ? a0[e] : a1[e], keep = (lane & 32) ? a1[e] : a0[e]; t16[e] = keep + __shfl_xor(send, 32); }
        float t8[8];
#pragma unroll
        for (int e = 0; e < 8; ++e) { const float send = (lane & 16) ? t16[e] : t16[e + 8], keep = (lane & 16) ? t16[e + 8] : t16[e]; t8[e] = keep + __shfl_xor(send, 16); }
        float t4[4];
#pragma unroll
        for (int e = 0; e < 4; ++e) { const float send = (lane & 8) ? t8[e] : t8[e + 4], keep = (lane & 8) ? t8[e + 4] : t8[e]; t4[e] = keep + __shfl_xor(send, 8); }
        float t2[2];
#pragma unroll
        for (int e = 0; e < 2; ++e) { const float send = (lane & 4) ? t4[e] : t4[e + 2], keep = (lane & 4) ? t4[e + 2] : t4[e]; t2[e] = keep + __shfl_xor(send, 4); }
        float lg; { const float send = (lane & 2) ? t2[0] : t2[1], keep = (lane & 2) ? t2[1] : t2[0]; lg = keep + __shfl_xor(send, 2); }
        lg += __shfl_xor(lg, 1);
        lg *= (lane & 32) ? rstd1 : rstd0;
        float mx = lg;
        mx = fmaxf(mx, __shfl_xor(mx, 2)); mx = fmaxf(mx, __shfl_xor(mx, 4)); mx = fmaxf(mx, __shfl_xor(mx, 8)); mx = fmaxf(mx, __shfl_xor(mx, 16));
        const float ex = __expf(lg - mx);
        float den = ex; den += __shfl_xor(den, 2); den += __shfl_xor(den, 4); den += __shfl_xor(den, 8); den += __shfl_xor(den, 16);
        const float mine = ex / den;
        if ((lane & 1) == 0) { const int row = m + (lane >> 5), e = (lane >> 1) & 15;
            WSP(float, WS_AFF)[(size_t)row * 16 + e] = mine;
            WSP(float, WS_AFFT)[((size_t)(row >> 12) * 16 + e) * SEQ + (row & (SEQ - 1))] = mine; }
    }
    __syncthreads();
}

__device__ __forceinline__ int block_excl_scan(int v, LAS int* red, int lane, int wave, int& total) {
    int inc = v;
#pragma unroll
    for (int o = 1; o < 64; o <<= 1) { const int t = __shfl_up(inc, o); if (lane >= o) inc += t; }
    __syncthreads();
    if (lane == 63) red[wave] = inc;
    __syncthreads();
    int base = 0, tot = 0;
#pragma unroll
    for (int w = 0; w < 8; ++w) { const int t = red[w]; if (w < wave) base += t; tot += t; }
    total = tot;
    return base + inc - v;
}
__device__ __forceinline__ void phase_select(const Ctx& F, const Args& A, int l) {
    LAS int* red = (LAS int*)F.lds;
    int tid_ = F.tid; asm volatile("" : "+v"(tid_)); const int tid = tid_, lane = tid & 63, wave = F.wave;
    for (int pair = F.vcu; pair < BATCH * NEXP; pair += F.G) {
        const int b = pair >> 4, e = pair & 15;
        const GAS v4u* src = (const GAS v4u*)(WSP(float, WS_AFFT) + (size_t)pair * SEQ) + 2 * tid;
        const v4u w0 = src[0], w1 = src[1];
        unsigned v[8] = {w0.x, w0.y, w0.z, w0.w, w1.x, w1.y, w1.z, w1.w};
        unsigned T = 0u; int par = 0;
        for (int bit = 30; bit >= 0; --bit) {
            const unsigned cand = T | (1u << bit);
            int c = 0;
#pragma unroll
            for (int i = 0; i < 8; ++i) c += (v[i] >= cand) ? 1 : 0;
            c = wave_sum_i(c);
            if (lane == 0) red[par * 8 + wave] = c;
            __syncthreads();
            int tot = 0;
#pragma unroll
            for (int w = 0; w < 8; ++w) tot += red[par * 8 + w];
            if (tot >= CAP) T = cand;
            par ^= 1;
        }
        int cgt = 0, ceq = 0;
#pragma unroll
        for (int i = 0; i < 8; ++i) { cgt += (v[i] > T) ? 1 : 0; ceq += (v[i] == T) ? 1 : 0; }
        int ngt, neq_tot;
        (void)block_excl_scan(cgt, red + 16, lane, wave, ngt);
        int eqb = block_excl_scan(ceq, red + 16, lane, wave, neq_tot);
        const int need_eq = CAP - ngt;
        int sel[8], csel = 0;
#pragma unroll
        for (int i = 0; i < 8; ++i) { const bool iseq = (v[i] == T); sel[i] = ((v[i] > T) || (iseq && eqb < need_eq)) ? 1 : 0; eqb += iseq ? 1 : 0; csel += sel[i]; }
        int nsel;
        int pos = block_excl_scan(csel, red + 16, lane, wave, nsel);
        int* idx = WSP(int, WS_IDX) + (size_t)(e * BATCH + b) * CAP; float* rg = WSP(float, WS_RG) + (size_t)(e * BATCH + b) * CAP; const float* rs3 = WSP(float, WS_RS3) + (size_t)b * SEQ;
        int* slot = WSP(int, WS_SLOT) + ((size_t)b * SEQ + (size_t)tid * 8) * NEXP + e;
#pragma unroll
        for (int i = 0; i < 8; ++i) { if (sel[i]) { if (pos < CAP) { idx[pos] = tid * 8 + i; rg[pos] = rs3[tid * 8 + i]; } slot[i * NEXP] = pos; ++pos; } else slot[i * NEXP] = -1; }
        __syncthreads();
    }
    if (l + 1 < DEPTH) {
        const bool split = F.G > BATCH * NEXP; const int nw = split ? (F.G - BATCH * NEXP) * NWAVES : F.NGW, wi = split ? (F.vcu - BATCH * NEXP) * NWAVES + F.wave : F.gw;
        LAS float* scr = (LAS float*)(F.lds + F.wave * 16640);
        if (wi >= 0) for (int it = wi; it < MOE_ITEMS; it += nw) moe_weight_item(F, A, l + 1, it, scr);
    }
}

__device__ __forceinline__ void phase_gather(const Ctx& F) {
    int lane_ = F.lane; asm volatile("" : "+v"(lane_)); const int lane = lane_;
    for (int r = F.gw; r < MOE_ROWS; r += F.NGW) {
        const int b = (r >> 9) & 7; const int t = WSP(int, WS_IDX)[r];
        const GAS v4u* src = (const GAS v4u*)(WSP(bf16, WS_H) + ((size_t)b * SEQ + t) * DM) + lane;
        GAS v4u* dst = (GAS v4u*)(WSP(bf16, WS_XG) + (size_t)r * DM) + lane;
        const v4u a = src[0], c = src[64]; dst[0] = a; dst[64] = c;
    }
}

__device__ __forceinline__ void phase_combine(const Ctx& F, const Args& A, int l, float amul) {
    int lane_ = F.lane; asm volatile("" : "+v"(lane_)); const int lane = lane_; const bool lastl = (l == DEPTH - 1);
    const float* gfin = WSP(float, WS_GAINS) + 512;
    v4u xa_n = (v4u){0u, 0u, 0u, 0u}, xc_n = xa_n; int sl_n = -1; float af_n = 0.f;
    if (F.gw < MTOK) { const GAS v4u* xp = (const GAS v4u*)(F.x + (size_t)F.gw * DM) + lane; xa_n = xp[0]; xc_n = xp[64];
        sl_n = WSP(int, WS_SLOT)[(size_t)F.gw * NEXP + (lane & 15)]; af_n = WSP(float, WS_AFF)[(size_t)F.gw * NEXP + (lane & 15)]; }
    for (int m = F.gw; m < MTOK; m += F.NGW) {
        const int b = m >> 12;
        GAS v4u* xr = (GAS v4u*)(F.x + (size_t)m * DM) + lane;
        const v4u xa = xa_n, xc = xc_n; const int sl = sl_n; const float af = amul * af_n;
        if (m + F.NGW < MTOK) { const int mn = m + F.NGW; const GAS v4u* xp = (const GAS v4u*)(F.x + (size_t)mn * DM) + lane; xa_n = xp[0]; xc_n = xp[64];
            sl_n = WSP(int, WS_SLOT)[(size_t)mn * NEXP + (lane & 15)]; af_n = WSP(float, WS_AFF)[(size_t)mn * NEXP + (lane & 15)]; }
        f32x4 x0 = (f32x4){bflo(xa.x), bfhi(xa.x), bflo(xa.y), bfhi(xa.y)}, x1 = (f32x4){bflo(xa.z), bfhi(xa.z), bflo(xa.w), bfhi(xa.w)};
        f32x4 x2 = (f32x4){bflo(xc.x), bfhi(xc.x), bflo(xc.y), bfhi(xc.y)}, x3 = (f32x4){bflo(xc.z), bfhi(xc.z), bflo(xc.w), bfhi(xc.w)};
        unsigned mask = (unsigned)(__ballot(sl >= 0 && lane < 16));
#define CMB_ACC(Y0, Y1, AE) do { x0.x += AE * bflo(Y0.x); x0.y += AE * bfhi(Y0.x); x0.z += AE * bflo(Y0.y); x0.w += AE * bfhi(Y0.y); \
            x1.x += AE * bflo(Y0.z); x1.y += AE * bfhi(Y0.z); x1.z += AE * bflo(Y0.w); x1.w += AE * bfhi(Y0.w); \
            x2.x += AE * bflo(Y1.x); x2.y += AE * bfhi(Y1.x); x2.z += AE * bflo(Y1.y); x2.w += AE * bfhi(Y1.y); \
            x3.x += AE * bflo(Y1.z); x3.y += AE * bfhi(Y1.z); x3.z += AE * bflo(Y1.w); x3.w += AE * bfhi(Y1.w); } while (0)
        while (mask) {
            const int e1 = __builtin_ctz(mask); mask &= mask - 1u;
            const bool two = mask != 0u; const int e2 = two ? __builtin_ctz(mask) : e1; if (two) mask &= mask - 1u;
            const int s1 = __shfl(sl, e1), s2 = __shfl(sl, e2); const float a1 = __shfl(af, e1), a2 = two ? __shfl(af, e2) : 0.f;
            const GAS v4u* yr1 = (const GAS v4u*)(WSP(bf16, WS_Y) + ((size_t)(e1 * BATCH + b) * CAP + s1) * DM) + lane;
            const GAS v4u* yr2 = (const GAS v4u*)(WSP(bf16, WS_Y) + ((size_t)(e2 * BATCH + b) * CAP + s2) * DM) + lane;
            const v4u y0 = yr1[0], y1 = yr1[64], z0 = yr2[0], z1 = yr2[64];
            CMB_ACC(y0, y1, a1); CMB_ACC(z0, z1, a2);
        }
#undef CMB_ACC
        float s = (x0.x * x0.x + x0.y * x0.y) + (x0.z * x0.z + x0.w * x0.w) + (x1.x * x1.x + x1.y * x1.y) + (x1.z * x1.z + x1.w * x1.w)
                + (x2.x * x2.x + x2.y * x2.y) + (x2.z * x2.z + x2.w * x2.w) + (x3.x * x3.x + x3.y * x3.y) + (x3.z * x3.z + x3.w * x3.w);
        const float rstd = __builtin_amdgcn_rsqf(wave_sum(s) * (1.f / DM) + EPS);
        if (lastl) {
            const f32x4 g0 = *(const f32x4*)(gfin + 8 * lane), g1 = *(const f32x4*)(gfin + 8 * lane + 4), g2 = *(const f32x4*)(gfin + 512 + 8 * lane), g3 = *(const f32x4*)(gfin + 512 + 8 * lane + 4);
            GAS f32x4* ow = (GAS f32x4*)(F.out + (size_t)m * DM);
            ow[2 * lane] = x0 * rstd * g0; ow[2 * lane + 1] = x1 * rstd * g1; ow[128 + 2 * lane] = x2 * rstd * g2; ow[128 + 2 * lane + 1] = x3 * rstd * g3;
        } else {
            v4u n0, n1; n0.x = pk2(x0.x, x0.y); n0.y = pk2(x0.z, x0.w); n0.z = pk2(x1.x, x1.y); n0.w = pk2(x1.z, x1.w); n1.x = pk2(x2.x, x2.y); n1.y = pk2(x2.z, x2.w); n1.z = pk2(x3.x, x3.y); n1.w = pk2(x3.z, x3.w);
            xr[0] = n0; xr[64] = n1;
            if (lane == 0) WSP(float, WS_RS1)[m] = rstd;
            if (lane < 16) { unsigned z_; asm volatile("v_mov_b32 %0, 0" : "=v"(z_));
                *(GAS v4u*)(WSP(bf16, WS_LAT) + (size_t)m * 512 + 384 + 8 * lane) = (v4u){z_, z_, z_, z_}; }
        }
    }
}

__device__ __forceinline__ void phase_attn_self(const Ctx& F, int l) {
    float gmq = fabsf(WSP(float, WS_GAINS)[l * 64 + F.lane]), gmk = fabsf(WSP(float, WS_GAINS)[256 + l * 64 + F.lane]);
#pragma unroll
    for (int o = 1; o < 64; o <<= 1) { gmq = fmaxf(gmq, __shfl_xor(gmq, o)); gmk = fmaxf(gmk, __shfl_xor(gmk, o)); }
    const bool bounded = (8.0f * LOG2E * gmq * gmk) < 64.0f;
    const int lane = F.lane, r32 = lane & 31, hi = lane >> 5, wid = F.wave;
#ifndef DUPATT
#define DUPATT 0
#endif
    for (int g = 0; g < 2; ++g)
      for (int rep2_ = 0; rep2_ < 1 + ((DUPATT >> g) & 1); ++rep2_)
        for (int u = F.vcu; u < 256; u += F.G) {
            const int b = u >> 5, qb = (u >> 1) & 15, hh = u & 1;
            const size_t r0 = (size_t)b * SEQ, q0 = r0 + (size_t)qb * 256;
            float ssacc[16];
#pragma unroll
            for (int r = 0; r < 16; ++r) ssacc[r] = 0.f;
            for (int hq = 0; hq < 4; ++hq) {
                const int h = hh * 4 + hq;
                if (g == 0) {
                    if (bounded) att::attn_unit<64, 0, 64, 1, true>(WSP(bf16, WS_QG) + q0 * 512 + h * 64, nullptr, 512, WSP(bf16, WS_KG) + r0 * 128 + hh * 64, 128, nullptr, 0,
                                              WSP(bf16, WS_VG) + r0 * 128 + hh * 64, 128, WSP(bf16, WS_O) + q0 * DM + h * 64, DM, SEQ, F.ldsg, ssacc);
                    else         att::attn_unit<64, 0, 64, 0, true>(WSP(bf16, WS_QG) + q0 * 512 + h * 64, nullptr, 512, WSP(bf16, WS_KG) + r0 * 128 + hh * 64, 128, nullptr, 0,
                                              WSP(bf16, WS_VG) + r0 * 128 + hh * 64, 128, WSP(bf16, WS_O) + q0 * DM + h * 64, DM, SEQ, F.ldsg, ssacc);
                } else {
                    att::attn_unit<64, 32, 64, 0, true>(WSP(bf16, WS_QM) + q0 * 768 + h * 64, WSP(bf16, WS_QM) + q0 * 768 + 512 + h * 32, 768, WSP(bf16, WS_KVM) + r0 * DM + h * 128, DM, WSP(bf16, WS_KROPE) + r0 * 32, 32,
                                               WSP(bf16, WS_KVM) + r0 * DM + h * 128 + 64, DM, WSP(bf16, WS_O) + q0 * DM + 512 + h * 64, DM, SEQ, F.ldsg, ssacc);
                }
            }
#pragma unroll
            for (int r = 0; r < 16; ++r) { float s = ssacc[r];
                s += __shfl_xor(s, 1); s += __shfl_xor(s, 2); s += __shfl_xor(s, 4); s += __shfl_xor(s, 8); s += __shfl_xor(s, 16);
                if (r32 == 0) WSP(float, WS_SSO)[(q0 + wid * 32 + att::crow(r, hi)) * 4 + g * 2 + hh] = s; }
        }
}
__device__ __forceinline__ void phase_attn_mem(const Ctx& F, int l) {
    const bf16* kv = WSP(bf16, WS_MEMKV) + (size_t)l * MROWS * DM; float dummy[16];
    for (int idx = F.vcu; idx < 256; idx += F.G) {
        const int pm = idx >> 1, pn = idx & 1, b = pm >> 4;
        const size_t q0 = (size_t)pm * 256, k0 = (size_t)b * MEM_T;
        for (int hh = 0; hh < 2; ++hh) { const int h = 2 * pn + hh;
            att::attn_unit<128, 0, 128, 0, false>(WSP(bf16, WS_QMEM) + q0 * 512 + h * 128, nullptr, 512, kv + k0 * DM + h * 128, DM, nullptr, 0,
                                        kv + k0 * DM + 512 + h * 128, DM, WSP(bf16, WS_OMEM) + q0 * 512 + h * 128, 512, MEM_T, F.ldsg, dummy); }
    }
}

__global__ void __launch_bounds__(NWAVES * 64, 2) enc_fwd(Args args) {
    extern __shared__ __attribute__((aligned(16))) unsigned char lds[];
    Ctx F;
    F.lds = (LAS unsigned char*)lds; F.ldsg = (char*)lds;
    F.tid = threadIdx.x; F.lane = F.tid & 63; F.wave = __builtin_amdgcn_readfirstlane(F.tid >> 6);
    F.G = gridDim.x; F.G0 = F.G; { const int bx = blockIdx.x; F.vcu0 = (F.G % 8 == 0) ? (bx % 8) * (F.G / 8) + bx / 8 : bx; F.vcu = F.vcu0; }
    F.gw = F.vcu * NWAVES + F.wave; F.NGW = F.G * NWAVES;
    F.out = args.out; F.ws = args.ws; F.x = (bf16*)(args.ws + WS_X);
    volatile LAS unsigned* MISC = (volatile LAS unsigned*)(F.lds + MISC_OFF);
    for (int u = F.tid; u < (LDS_BYTES - LDSCTL_OFF) / 4; u += NWAVES * 64) ((LAS unsigned*)(F.lds + LDSCTL_OFF))[u] = 0u;
    __syncthreads();
    XcdBarrier bar; bar.bar = (unsigned*)(F.ws + WS_CTL) + CW_BAR; bar.x = 0; bar.st = nullptr;
    if (MK_N_LAUNCHES == 1) bar = xcd_barrier_post((unsigned*)(F.ws + WS_CTL) + CW_BAR, MISC + 8);
    const int lo = args.ph_lo, hi = args.ph_hi;
#ifndef ONLY_SITE
#define ONLY_SITE -1
#endif
#define ON(s) (ONLY_SITE < 0 || ONLY_SITE == (s))
#ifndef DUPMASK
#define DUPMASK 0u
#endif
#define REP(s) for (int rep_ = 0; rep_ < 1 + (int)((DUPMASK >> (s)) & 1u); ++rep_)
#define IN(k) (lo <= (k) && (k) < hi)
#define SEAM(k) do { if (IN(k) && IN((k) + 1)) xcd_barrier(bar); } while (0)
#define LOCAL_SEAM() do { asm volatile("s_waitcnt vmcnt(0)" ::: "memory"); __syncthreads(); __builtin_amdgcn_fence(__ATOMIC_ACQUIRE, "agent"); asm volatile("s_waitcnt vmcnt(0)" ::: "memory"); __syncthreads(); } while (0)
#define GEMM(EpiT, epi, Ap, lda_, Bp, ldb_, K_, nM_, nN_, gdiv_, gstride_) do { const pg8::Gemm g_{(const bf16*)(Ap), (const bf16*)(Bp), lda_, ldb_, K_, gdiv_, 1 << 30, (size_t)(gstride_), nullptr, nullptr}; \
        pg8::StaticOrder S_; S_.init(nM_, nN_, F.G, (int)blockIdx.x); pg8::gemm_phase<EpiT, pg8::StaticOrder, true>(F.lds, g_, S_, epi); } while (0)

    #ifndef PRODUP
#define PRODUP 0
#endif
    if (ON(100) && IN(0)) for (int rp_ = 0; rp_ <= PRODUP; ++rp_) { refresh(F); phase_prologue(F, args); }
    SEAM(0);
    if (ON(101) && IN(1)) {
        pg8::EpiBf16 E{WSP(bf16, WS_MEMKV), DM, 1.0f, nullptr, nullptr, 0.f, 0.f};
        const pg8::Gemm g_{WSP(bf16, WS_MEMN), WSP(bf16, WS_WSMALL + OFF_WMKV), DM, DM, DM, MROWS / 256, MROWS / 256, (size_t)(WSMALL_STRIDE / 2), nullptr, nullptr};
        pg8::StaticOrder S_; S_.init(DEPTH * MROWS / 256, DM / 256, F.G, (int)blockIdx.x); pg8::gemm_phase<pg8::EpiBf16, pg8::StaticOrder, true>(F.lds, g_, S_, E); }
    SEAM(1);
    for (int l = 0; l < DEPTH; ++l) {
        const int pb = 2 + 16 * l;
        unsigned char* wl = F.ws + WS_WSMALL + (size_t)l * WSMALL_STRIDE;
        if (ON(0) && IN(pb + 0)) REP(0) if (refresh(F), true) {
            pg8::EpiInProj E{WSP(float, WS_RS1), WSP(float, WS_GAINS) + l * 64, WSP(float, WS_GAINS) + 256 + l * 64, WSP(float, WS_TABG), WSP(float, WS_TABM),
                             WSP(bf16, WS_QG), WSP(bf16, WS_KG), WSP(bf16, WS_VG), WSP(bf16, WS_LAT), WSP(bf16, WS_KROPE), WSP(float, WS_SSL), 0.125f * LOG2E, EPS};
            GEMM(pg8::EpiInProj, E, F.x, DM, wl + OFF_WIN, DM, DM, MTOK / 256, IN_WP / 256, 1, 0); }
        SEAM(pb + 0);
        if ((ON(2) || ON(16) || ON(17)) && IN(pb + 2)) REP(2) { refresh(F);
            if (ON(2) || ON(17)) { pg8::EpiQmRope E{WSP(bf16, WS_QM), 768, 0.10206207261596577f * LOG2E, WSP(float, WS_TABM), WSP(float, WS_SSL), 1.0f / 256.0f, EPS}; GEMM(pg8::EpiQmRope, E, WSP(bf16, WS_LAT), 512, wl + OFF_WQB, 256, 256, MTOK / 256, 3, 1, 0); }
            if (ON(2) || ON(16)) { pg8::EpiBf16 E{WSP(bf16, WS_KVM), DM, 1.0f, nullptr, WSP(float, WS_SSL) + 4, 1.0f / 128.0f, EPS}; GEMM(pg8::EpiBf16, E, WSP(bf16, WS_LAT) + 256, 512, wl + OFF_WKVB, 256, 256, MTOK / 256, 4, 1, 0); } }
        SEAM(pb + 2);
        if (ON(3) && IN(pb + 3)) REP(3) if (refresh(F), true) phase_attn_self(F, l);
        SEAM(pb + 3);
        if (ON(5) && IN(pb + 5)) REP(5) if (refresh(F), true) {
            pg8::EpiResidualX E{F.x, WSP(float, WS_SSX), DM, 1.0f / 512.0f, EPS, rep_ ? 0.f : 1.f};
            const pg8::Gemm g_{WSP(bf16, WS_O), (const bf16*)(wl + OFF_WO), DM, DM, DM, 1, 1 << 30, 0, nullptr, WSP(float, WS_SSO)};
            pg8::StaticOrder S_; S_.init(MTOK / 256, 4, F.G, (int)blockIdx.x); pg8::gemm_phase<pg8::EpiResidualX, pg8::StaticOrder, true, false, true>(F.lds, g_, S_, E, F.lds + STAB_OFF, 1.0f / 512.0f, EPS); }
        SEAM(pb + 5);
        if (ON(7) && IN(pb + 7)) REP(7) if (refresh(F), true) { pg8::EpiBf16RowNorm E{WSP(bf16, WS_QMEM), 512, 0.08838834764831845f * LOG2E, WSP(float, WS_SSX), 1.0f / DM, EPS}; GEMM(pg8::EpiBf16RowNorm, E, F.x, DM, wl + OFF_WMQ, DM, DM, MTOK / 256, 2, 1, 0); }
        SEAM(pb + 7);
        if (ON(8) && IN(pb + 8)) REP(8) if (refresh(F), true) phase_attn_mem(F, l);
        SEAM(pb + 8);
        if (ON(9) && IN(pb + 9)) REP(9) if (refresh(F), true) { pg8::EpiResidual E{F.x, DM, rep_ ? 0.f : 1.f}; GEMM(pg8::EpiResidual, E, WSP(bf16, WS_OMEM), 512, wl + OFF_WMO, 512, 512, MTOK / 256, 4, 1, 0); }
        SEAM(pb + 9);
        if (ON(10) && IN(pb + 10)) REP(10) if (refresh(F), true) phase_router(F, l);
        SEAM(pb + 10);
        if (ON(11) && IN(pb + 11)) REP(11) if (refresh(F), true) phase_select(F, args, l);
        SEAM(pb + 11);
        if (ON(13) && IN(pb + 13)) REP(13) if (refresh(F), true) { pg8::EpiSwiGLU E{WSP(bf16, WS_ACT), EFF, WSP(float, WS_RG)};
            const pg8::Gemm g_{F.x, WSP(bf16, (l & 1) ? WS_WGU2 : WS_WGU), DM, DM, DM, 16, 1 << 30, (size_t)(1024 * 1024), WSP(int, WS_IDX), nullptr};
            pg8::StaticOrder S_; S_.init(MOE_ROWS / 256, 4, F.G, (int)blockIdx.x); pg8::gemm_phase<pg8::EpiSwiGLU, pg8::StaticOrder, true, true>(F.lds, g_, S_, E, F.lds + GTAB_OFF); }
        SEAM(pb + 13);
        if (ON(14) && IN(pb + 14)) REP(14) if (refresh(F), true) { pg8::EpiBf16 E{WSP(bf16, WS_Y), DM, 1.0f, nullptr, nullptr, 0.f, 0.f}; GEMM(pg8::EpiBf16, E, WSP(bf16, WS_ACT), EFF, WSP(bf16, (l & 1) ? WS_WD2 : WS_WD), EFF, EFF, MOE_ROWS / 256, 4, 16, 1024 * 512); }
        SEAM(pb + 14);
        if (ON(15) && IN(pb + 15)) REP(15) if (refresh(F), true) phase_combine(F, args, l, (rep_ && l < DEPTH - 1) ? 0.f : 1.f);
        SEAM(pb + 15);
    }
#undef IN
#undef SEAM
#undef GEMM
}

extern "C" void kernel_launch(void* const* d_in, const int* in_sizes, int n_in, void* d_out, int out_size, void* d_ws, size_t ws_size, hipStream_t stream) {
    static int grid = 0;
    if (grid == 0) {
        if (n_in != 24 || out_size != MTOK * DM || ws_size < WS_END) { fprintf(stderr, "kernel_launch: unexpected shapes: n_in %d out %d ws %zu (need %zu)\n", n_in, out_size, ws_size, (size_t)WS_END); grid = -1; return; }
        int dev = 0, cus = 0, per_cu = 0;
        if (hipGetDevice(&dev) != hipSuccess || hipDeviceGetAttribute(&cus, hipDeviceAttributeMultiprocessorCount, dev) != hipSuccess) { grid = -1; return; }
        if (hipFuncSetAttribute((const void*)enc_fwd, hipFuncAttributeMaxDynamicSharedMemorySize, LDS_BYTES) != hipSuccess) { fprintf(stderr, "kernel_launch: hipFuncSetAttribute failed\n"); grid = -1; return; }
        if (hipOccupancyMaxActiveBlocksPerMultiprocessor(&per_cu, (const void*)enc_fwd, NWAVES * 64, LDS_BYTES) != hipSuccess || per_cu < 1)
            fprintf(stderr, "kernel_launch: occupancy query reports %d workgroups per CU\n", per_cu);
        (void)hipGetLastError();
        grid = cus;
        fprintf(stderr, "kernel_launch: grid %d, ws %zu bytes\n", grid, ws_size);
    }
    if (grid < 0) return;
    (void)hipMemsetAsync((char*)d_ws + WS_CTL, 0, CTL_ZERO_BYTES, stream);
    Args a{};
    for (int i = 0; i < 24; ++i) a.in[i] = (const float*)d_in[i];
    a.out = (float*)d_out; a.ws = (unsigned char*)d_ws;
#if MK_N_LAUNCHES == 1
    a.ph_lo = 0; a.ph_hi = NPH;
    hipLaunchKernelGGL(enc_fwd, dim3(grid), dim3(NWAVES * 64), LDS_BYTES, stream, a);
#else
    for (int p = 0; p < NPH; ++p) { a.ph_lo = p; a.ph_hi = p + 1; hipLaunchKernelGGL(enc_fwd, dim3(grid), dim3(NWAVES * 64), LDS_BYTES, stream, a); }
#endif
    const hipError_t le = hipPeekAtLastError();
    if (le != hipSuccess) fprintf(stderr, "kernel_launch: launch failed: %s\n", hipGetErrorName(le));
}
```

```cpp
#include <hip/hip_runtime.h>
#include <cstdio>
#include <cstdint>

namespace pg8 {
#define PG8_LAS __attribute__((address_space(3)))
typedef unsigned short bf16_t;
typedef short bf16x8 __attribute__((ext_vector_type(8)));
typedef float f32x4 __attribute__((ext_vector_type(4)));
typedef unsigned u32x4 __attribute__((ext_vector_type(4)));
constexpr int BM = 256, BK = 64, HALF = 128, HTB = HALF * BK * 2  , STAGE_BYTES = 8 * HTB, NXCD = 8, WGM = 8;

__host__ __device__ __forceinline__ int lds_byte(int r, int c) { const int st = (r >> 4) * 2 + (c >> 5), rr = r & 15, cc = c & 31, ob = rr * 64 + cc * 2; return st * 1024 + (ob ^ (((ob >> 9) & 1) << 5)); }
__host__ __device__ __forceinline__ void stage_rc(int b, int& R, int& C) { const int st = b / 1024, sb = b % 1024, swz = sb ^ (((sb >> 9) & 1) << 5); R = (st >> 1) * 16 + swz / 64; C = (st & 1) * 32 + (swz % 64) / 2; }
__host__ __device__ __forceinline__ int perm32(int rho) { const int n = rho >> 4, i = rho & 15; return 8 * (i >> 2) + 4 * n + (i & 3); }

struct Unit { int pm, pn; };
struct Gemm { const bf16_t* A; const bf16_t* Bt; int lda, ldb, K, gdiv, amod; size_t gstride; const int* idx; const float* ss; };

struct StaticOrder {
    int nM, nN, nwg, G, c;
    __host__ __device__ void init(int nM_, int nN_, int G_, int c_) { nM = nM_; nN = nN_; nwg = nM * nN; G = G_; c = c_; }
    __host__ __device__ bool next(int i, Unit& u) const {
        const long L = (long)i * G + c; if (L >= nwg) return false;
        int wgid = (int)L; { const int q = nwg / NXCD, r = nwg % NXCD, xcd = wgid % NXCD, off = wgid / NXCD; wgid = (xcd < r ? xcd * (q + 1) : r * (q + 1) + (xcd - r) * q) + off; }
        const int nig = WGM * nN, gid = wgid / nig, fm = gid * WGM, gsz = (nM - fm) < WGM ? (nM - fm) : WGM;
        u.pm = fm + ((wgid % nig) % gsz); u.pn = (wgid % nig) / gsz; return true;
    }
};

struct LinearOrder {
    int nM, nN, G, c, per;
    __host__ __device__ void init(int nM_, int nN_, int G_, int c_, int per_) { nM = nM_; nN = nN_; G = G_; c = c_; per = per_; }
    __host__ __device__ bool next(int i, Unit& u) const { const int idx = (c + (i / per) * G) * per + (i % per); if (idx >= nM * nN) return false; u.pm = idx / nN; u.pn = idx % nN; return true; }
};

__device__ __forceinline__ unsigned cvt_pk_bf16(float lo, float hi) { unsigned r; asm volatile("v_cvt_pk_bf16_f32 %0, %1, %2" : "=v"(r) : "v"(lo), "v"(hi)); return r; }

struct EpiBf16 {
    static constexpr bool PERM = true;
    bf16_t* O; int ldc; float scale; const float* rs; const float* ssl; float ssl_inv, ssl_eps;
    __device__ __forceinline__ void operator()(const f32x4 (&acc)[2][2][4][2], const Unit& u, int wr, int wc, int fr, int fq) const {
        const int row0 = u.pm * BM + wr * 64 + fr, col0 = u.pn * BM + wc * 32 + 8 * fq;
#pragma unroll
        for (int ai = 0; ai < 2; ++ai)
#pragma unroll
            for (int m = 0; m < 4; ++m) { const int row = row0 + ai * HALF + m * 16; bf16_t* rowp = O + (size_t)row * ldc + col0; float sc = rs ? scale * rs[row] : scale;
                if (ssl) { const f32x4 q_ = *(const f32x4*)(ssl + (size_t)row * 8); sc *= __builtin_amdgcn_rsqf(((q_[0] + q_[1]) + (q_[2] + q_[3])) * ssl_inv + ssl_eps); }
#pragma unroll
                for (int bj = 0; bj < 2; ++bj) { const f32x4 v0 = acc[ai][bj][m][0] * sc, v1 = acc[ai][bj][m][1] * sc;
                    u32x4 w; w.x = cvt_pk_bf16(v0[0], v0[1]); w.y = cvt_pk_bf16(v0[2], v0[3]); w.z = cvt_pk_bf16(v1[0], v1[1]); w.w = cvt_pk_bf16(v1[2], v1[3]);
                    *(u32x4*)(rowp + bj * HALF) = w; } }
    }
};
struct EpiQmRope {
    static constexpr bool PERM = true;
    bf16_t* O; int ldc; float scale; const float* tab; const float* ssl; float ssl_inv, ssl_eps;
    __device__ __forceinline__ void operator()(const f32x4 (&acc)[2][2][4][2], const Unit& u, int wr, int wc, int fr, int fq) const {
        const int row0 = u.pm * BM + wr * 64 + fr, col0 = u.pn * BM + wc * 32 + 8 * fq;
        const bool rope = (u.pn == 2);
        const int j0 = (8 * fq) >> 1;
#pragma unroll
        for (int ai = 0; ai < 2; ++ai)
#pragma unroll
            for (int m = 0; m < 4; ++m) { const int row = row0 + ai * HALF + m * 16; bf16_t* rowp = O + (size_t)row * ldc + col0; const int s = row & 4095;
                const f32x4 q_ = *(const f32x4*)(ssl + (size_t)row * 8); const float sc_ = scale * __builtin_amdgcn_rsqf(((q_[0] + q_[1]) + (q_[2] + q_[3])) * ssl_inv + ssl_eps);
                f32x4 t0 = (f32x4){1.f, 0.f, 1.f, 0.f}, t1 = (f32x4){1.f, 0.f, 1.f, 0.f};
                if (rope) { t0 = *(const f32x4*)(tab + ((size_t)s * 16 + j0) * 2); t1 = *(const f32x4*)(tab + ((size_t)s * 16 + j0 + 2) * 2); }
#pragma unroll
                for (int bj = 0; bj < 2; ++bj) { const f32x4 v0 = acc[ai][bj][m][0], v1 = acc[ai][bj][m][1];
                    f32x4 r0, r1;
                    r0[0] = v0[0] * t0[0] - v0[1] * t0[1]; r0[1] = v0[1] * t0[0] + v0[0] * t0[1];
                    r0[2] = v0[2] * t0[2] - v0[3] * t0[3]; r0[3] = v0[3] * t0[2] + v0[2] * t0[3];
                    r1[0] = v1[0] * t1[0] - v1[1] * t1[1]; r1[1] = v1[1] * t1[0] + v1[0] * t1[1];
                    r1[2] = v1[2] * t1[2] - v1[3] * t1[3]; r1[3] = v1[3] * t1[2] + v1[2] * t1[3];
                    r0 = r0 * sc_; r1 = r1 * sc_;
                    u32x4 w; w.x = cvt_pk_bf16(r0[0], r0[1]); w.y = cvt_pk_bf16(r0[2], r0[3]); w.z = cvt_pk_bf16(r1[0], r1[1]); w.w = cvt_pk_bf16(r1[2], r1[3]);
                    *(u32x4*)(rowp + bj * HALF) = w; }
                asm volatile("" ::: "memory"); }
    }
};
struct EpiBf16RowNorm {
    static constexpr bool PERM = true;
    bf16_t* O; int ldc; float scale; const float* ss; float inv_n, eps;
    __device__ __forceinline__ void operator()(const f32x4 (&acc)[2][2][4][2], const Unit& u, int wr, int wc, int fr, int fq) const {
        const int row0 = u.pm * BM + wr * 64 + fr, col0 = u.pn * BM + wc * 32 + 8 * fq;
#pragma unroll
        for (int ai = 0; ai < 2; ++ai)
#pragma unroll
            for (int m = 0; m < 4; ++m) { const int row = row0 + ai * HALF + m * 16; bf16_t* rowp = O + (size_t)row * ldc + col0;
                const f32x4 q0 = *(const f32x4*)(ss + (size_t)row * 16), q1 = *(const f32x4*)(ss + (size_t)row * 16 + 4), q2 = *(const f32x4*)(ss + (size_t)row * 16 + 8), q3 = *(const f32x4*)(ss + (size_t)row * 16 + 12);
                const float tot = ((((q0[0] + q0[1]) + (q0[2] + q0[3])) + ((q1[0] + q1[1]) + (q1[2] + q1[3]))) + (((q2[0] + q2[1]) + (q2[2] + q2[3])) + ((q3[0] + q3[1]) + (q3[2] + q3[3]))));
                const float sc = scale * __builtin_amdgcn_rsqf(tot * inv_n + eps);
#pragma unroll
                for (int bj = 0; bj < 2; ++bj) { const f32x4 v0 = acc[ai][bj][m][0] * sc, v1 = acc[ai][bj][m][1] * sc;
                    u32x4 w; w.x = cvt_pk_bf16(v0[0], v0[1]); w.y = cvt_pk_bf16(v0[2], v0[3]); w.z = cvt_pk_bf16(v1[0], v1[1]); w.w = cvt_pk_bf16(v1[2], v1[3]);
                    *(u32x4*)(rowp + bj * HALF) = w; } }
    }
};
__device__ __forceinline__ float bf_lo(unsigned w) { return __uint_as_float(w << 16); }
__device__ __forceinline__ float bf_hi(unsigned w) { return __uint_as_float(w & 0xffff0000u); }
struct EpiResidualX {
    static constexpr bool PERM = true;
    bf16_t* X; float* SSX; int ldc; float inv_n, eps, mul;
    __device__ __forceinline__ void operator()(const f32x4 (&acc)[2][2][4][2], const Unit& u, int wr, int wc, int fr, int fq, const PG8_LAS float* tab) const {
        const int rl0 = wr * 64 + fr, col0 = u.pn * BM + wc * 32 + 8 * fq;
#pragma unroll
        for (int ai = 0; ai < 2; ++ai)
#pragma unroll
            for (int m = 0; m < 4; ++m) { const int rl = rl0 + ai * HALF + m * 16, row = u.pm * BM + rl; bf16_t* rowp = X + (size_t)row * ldc + col0;
                const float rm = mul * __builtin_amdgcn_rsqf((tab[rl * 4 + 2] + tab[rl * 4 + 3]) * inv_n + eps);
                u32x4 xv[2]; float s = 0.f;
#pragma unroll
                for (int bj = 0; bj < 2; ++bj) xv[bj] = *(const u32x4*)(rowp + bj * HALF);
#pragma unroll
                for (int bj = 0; bj < 2; ++bj) { const f32x4 a0 = acc[ai][bj][m][0] * rm, a1 = acc[ai][bj][m][1] * rm; u32x4 w;
                    w.x = cvt_pk_bf16(bf_lo(xv[bj].x) + a0[0], bf_hi(xv[bj].x) + a0[1]); w.y = cvt_pk_bf16(bf_lo(xv[bj].y) + a0[2], bf_hi(xv[bj].y) + a0[3]);
                    w.z = cvt_pk_bf16(bf_lo(xv[bj].z) + a1[0], bf_hi(xv[bj].z) + a1[1]); w.w = cvt_pk_bf16(bf_lo(xv[bj].w) + a1[2], bf_hi(xv[bj].w) + a1[3]);
                    *(u32x4*)(rowp + bj * HALF) = w;
                    const float r0 = bf_lo(w.x), r1 = bf_hi(w.x), r2 = bf_lo(w.y), r3 = bf_hi(w.y), r4 = bf_lo(w.z), r5 = bf_hi(w.z), r6 = bf_lo(w.w), r7 = bf_hi(w.w);
                    s += ((r0 * r0 + r1 * r1) + (r2 * r2 + r3 * r3)) + ((r4 * r4 + r5 * r5) + (r6 * r6 + r7 * r7)); }
                s += __shfl_xor(s, 16); s += __shfl_xor(s, 32);
                if (fq == 0) SSX[(size_t)row * 16 + u.pn * 4 + wc] = s;
                if (m & 1) asm volatile("" ::: "memory"); }
    }
};
struct EpiResidual {
    static constexpr bool PERM = true;
    bf16_t* X; int ldc; float mul;
    __device__ __forceinline__ void operator()(const f32x4 (&acc)[2][2][4][2], const Unit& u, int wr, int wc, int fr, int fq) const {
        const int row0 = u.pm * BM + wr * 64 + fr, col0 = u.pn * BM + wc * 32 + 8 * fq;
#pragma unroll
        for (int ai = 0; ai < 2; ++ai)
#pragma unroll
            for (int m = 0; m < 4; ++m) { bf16_t* rowp = X + (size_t)(row0 + ai * HALF + m * 16) * ldc + col0;
                u32x4 xv[2];
#pragma unroll
                for (int bj = 0; bj < 2; ++bj) xv[bj] = *(const u32x4*)(rowp + bj * HALF);
#pragma unroll
                for (int bj = 0; bj < 2; ++bj) { const f32x4 a0 = acc[ai][bj][m][0] * mul, a1 = acc[ai][bj][m][1] * mul; u32x4 w;
                    w.x = cvt_pk_bf16(bf_lo(xv[bj].x) + a0[0], bf_hi(xv[bj].x) + a0[1]); w.y = cvt_pk_bf16(bf_lo(xv[bj].y) + a0[2], bf_hi(xv[bj].y) + a0[3]);
                    w.z = cvt_pk_bf16(bf_lo(xv[bj].z) + a1[0], bf_hi(xv[bj].z) + a1[1]); w.w = cvt_pk_bf16(bf_lo(xv[bj].w) + a1[2], bf_hi(xv[bj].w) + a1[3]);
                    *(u32x4*)(rowp + bj * HALF) = w; } }
    }
};
struct EpiInProj {
    static constexpr bool PERM = true;
    const float* rs; const float* gq; const float* gk; const float* tabg; const float* tabm;
    bf16_t* QG; bf16_t* KG; bf16_t* VG; bf16_t* LAT; bf16_t* KROPE; float* SSL; float qscale, eps;
    __device__ __forceinline__ static void rope2(f32x4& v, const f32x4 t) { const float a0 = v[0], b0 = v[1], a1 = v[2], b1 = v[3];
        v[0] = a0 * t[0] - b0 * t[1]; v[1] = b0 * t[0] + a0 * t[1]; v[2] = a1 * t[2] - b1 * t[3]; v[3] = b1 * t[2] + a1 * t[3]; }
    __device__ __forceinline__ static u32x4 pack(const f32x4 a, const f32x4 b) { u32x4 w; w.x = cvt_pk_bf16(a[0], a[1]); w.y = cvt_pk_bf16(a[2], a[3]); w.z = cvt_pk_bf16(b[0], b[1]); w.w = cvt_pk_bf16(b[2], b[3]); return w; }
    __device__ __forceinline__ void operator()(const f32x4 (&acc)[2][2][4][2], const Unit& u, int wr, int wc, int fr, int fq) const {
        const int row0 = u.pm * BM + wr * 64 + fr;
        if (u.pn < 2 || (u.pn == 2 && wc < 2)) {
            const bool isq = u.pn < 2; const float* g = isq ? gq : gk; bf16_t* dst = isq ? QG : KG; const int ld = isq ? 512 : 128, hcol = (isq ? (u.pn * 4 + wc) : wc) * 64; const float osc = isq ? qscale : 1.0f;
            f32x4 gv[2][2];
#pragma unroll
            for (int bj = 0; bj < 2; ++bj)
#pragma unroll
                for (int n = 0; n < 2; ++n)
#pragma unroll
                    for (int i = 0; i < 4; ++i) { const int p = 32 * bj + 8 * fq + 4 * n + i; gv[bj][n][i] = g[(p >> 1) + 32 * (p & 1)]; }
#pragma unroll
            for (int ai = 0; ai < 2; ++ai)
#pragma unroll
                for (int m = 0; m < 4; ++m) { const int row = row0 + ai * HALF + m * 16, s = row & 4095; const float sc = rs[row];
                    f32x4 v[2][2]; float ss = 0.f;
#pragma unroll
                    for (int bj = 0; bj < 2; ++bj)
#pragma unroll
                        for (int n = 0; n < 2; ++n) { v[bj][n] = acc[ai][bj][m][n] * sc; ss += (v[bj][n][0] * v[bj][n][0] + v[bj][n][1] * v[bj][n][1]) + (v[bj][n][2] * v[bj][n][2] + v[bj][n][3] * v[bj][n][3]); }
                    ss += __shfl_xor(ss, 16); ss += __shfl_xor(ss, 32);
                    const float rstd = __builtin_amdgcn_rsqf(ss * (1.0f / 64.0f) + eps);
#pragma unroll
                    for (int bj = 0; bj < 2; ++bj) {
#pragma unroll
                        for (int n = 0; n < 2; ++n) { v[bj][n] = v[bj][n] * rstd * gv[bj][n];
                            const f32x4 t = *(const f32x4*)(tabg + ((size_t)s * 32 + 16 * bj + 4 * fq + 2 * n) * 2); rope2(v[bj][n], t); v[bj][n] = v[bj][n] * osc; }
                        *(u32x4*)(dst + (size_t)row * ld + hcol + 32 * bj + 8 * fq) = pack(v[bj][0], v[bj][1]); }
                    if (m & 1) asm volatile("" ::: "memory"); }
        } else if (u.pn == 2) {
#pragma unroll
            for (int ai = 0; ai < 2; ++ai)
#pragma unroll
                for (int m = 0; m < 4; ++m) { const int row = row0 + ai * HALF + m * 16; const float sc = rs[row];
#pragma unroll
                    for (int bj = 0; bj < 2; ++bj) *(u32x4*)(VG + (size_t)row * 128 + (wc - 2) * 64 + 32 * bj + 8 * fq) = pack(acc[ai][bj][m][0] * sc, acc[ai][bj][m][1] * sc); }
        } else if (u.pn == 3) {
#pragma unroll
            for (int ai = 0; ai < 2; ++ai)
#pragma unroll
                for (int m = 0; m < 4; ++m) { const int row = row0 + ai * HALF + m * 16; const float sc = rs[row]; float ss = 0.f;
#pragma unroll
                    for (int bj = 0; bj < 2; ++bj) { const f32x4 a = acc[ai][bj][m][0] * sc, b = acc[ai][bj][m][1] * sc;
                        ss += ((a[0] * a[0] + a[1] * a[1]) + (a[2] * a[2] + a[3] * a[3])) + ((b[0] * b[0] + b[1] * b[1]) + (b[2] * b[2] + b[3] * b[3]));
                        *(u32x4*)(LAT + (size_t)row * 512 + 128 * bj + 32 * wc + 8 * fq) = pack(a, b); }
                    ss += __shfl_xor(ss, 16); ss += __shfl_xor(ss, 32);
                    if (fq == 0) SSL[(size_t)row * 8 + wc] = ss; }
        } else {
#pragma unroll
            for (int ai = 0; ai < 2; ++ai)
#pragma unroll
                for (int m = 0; m < 4; ++m) { const int row = row0 + ai * HALF + m * 16, s = row & 4095; const float sc = rs[row];
                    const f32x4 a = acc[ai][0][m][0] * sc, b = acc[ai][0][m][1] * sc;
                    float ss = ((a[0] * a[0] + a[1] * a[1]) + (a[2] * a[2] + a[3] * a[3])) + ((b[0] * b[0] + b[1] * b[1]) + (b[2] * b[2] + b[3] * b[3]));
                    *(u32x4*)(LAT + (size_t)row * 512 + 256 + 32 * wc + 8 * fq) = pack(a, b);
                    ss += __shfl_xor(ss, 16); ss += __shfl_xor(ss, 32);
                    if (fq == 0) SSL[(size_t)row * 8 + 4 + wc] = ss;
                    if (wc == 0) { f32x4 c = acc[ai][1][m][0] * sc, d = acc[ai][1][m][1] * sc;
                        rope2(c, *(const f32x4*)(tabm + ((size_t)s * 16 + 4 * fq) * 2)); rope2(d, *(const f32x4*)(tabm + ((size_t)s * 16 + 4 * fq + 2) * 2));
                        *(u32x4*)(KROPE + (size_t)row * 32 + 8 * fq) = pack(c, d); } }
        }
    }
};
struct EpiSwiGLU {
    static constexpr bool PERM = true;
    bf16_t* O; int ldc; const float* rs;
    __device__ __forceinline__ static float silu_mul(float g, float u) { return g * u * __builtin_amdgcn_rcpf(1.0f + __builtin_amdgcn_exp2f(-1.4426950408889634f * g)); }
    __device__ __forceinline__ void operator()(const f32x4 (&acc)[2][2][4][2], const Unit& u, int wr, int wc, int fr, int fq) const {
        const int row0 = u.pm * BM + wr * 64 + fr, col0 = u.pn * HALF + wc * 32 + 8 * fq;
#pragma unroll
        for (int ai = 0; ai < 2; ++ai)
#pragma unroll
            for (int m = 0; m < 4; ++m) { const int row = row0 + ai * HALF + m * 16; bf16_t* rowp = O + (size_t)row * ldc + col0; const float sc = rs[row];
                const f32x4 g0 = acc[ai][0][m][0] * sc, g1 = acc[ai][0][m][1] * sc, u0 = acc[ai][1][m][0] * sc, u1 = acc[ai][1][m][1] * sc;
                u32x4 w; w.x = cvt_pk_bf16(silu_mul(g0[0], u0[0]), silu_mul(g0[1], u0[1])); w.y = cvt_pk_bf16(silu_mul(g0[2], u0[2]), silu_mul(g0[3], u0[3]));
                w.z = cvt_pk_bf16(silu_mul(g1[0], u1[0]), silu_mul(g1[1], u1[1])); w.w = cvt_pk_bf16(silu_mul(g1[2], u1[2]), silu_mul(g1[3], u1[3]));
                *(u32x4*)rowp = w; }
    }
};

template <class Epi, class Sched, bool ALIGN_EPI = false, bool GATHER = false, bool MIDSCALE = false>
__device__ __forceinline__ void gemm_phase(PG8_LAS unsigned char* lds, const Gemm g, const Sched& S, const Epi& E, PG8_LAS unsigned char* gtab = nullptr, float ms_inv_n = 0.f, float ms_eps = 0.f) {
    int tid_ = threadIdx.x; asm volatile("" : "+v"(tid_));
    const int tid = tid_, wid = __builtin_amdgcn_readfirstlane(tid >> 6), lane = tid & 63, wr = wid >> 2, wc = wid & 3, fr = lane & 15, fq = lane >> 4;
    const int K = g.K, nt = K / BK;
    unsigned voffA[2], voffB[2]; int gR[2], gC[2];
#pragma unroll
    for (int i = 0; i < 2; ++i) { int R, C; stage_rc(tid * 16 + i * 8192, R, C); const int Rb = Epi::PERM ? ((R & ~31) + perm32(R & 31)) : R; gR[i] = R; gC[i] = C;
        voffA[i] = (unsigned)(R * g.lda + C) * 2u; voffB[i] = (unsigned)(Rb * g.ldb + C) * 2u; }
    unsigned goffc[2][2], goffn[2][2];
#define PG8_GISSUE(u) do { _Pragma("unroll") for (int h_ = 0; h_ < 2; ++h_) _Pragma("unroll") for (int i_ = 0; i_ < 2; ++i_) \
        __builtin_amdgcn_global_load_lds((const unsigned*)(g.idx + (u).pm * BM + h_ * HALF + gR[i_]), (PG8_LAS unsigned*)(gtab + ((h_ * 2 + i_) * 8 + wid) * 256), 4, 0, 0); } while (0)
#define PG8_GREAD(dst, u) do { asm volatile("" ::: "memory"); _Pragma("unroll") for (int h_ = 0; h_ < 2; ++h_) _Pragma("unroll") for (int i_ = 0; i_ < 2; ++i_) { \
        const int tok_ = *(const PG8_LAS int*)(gtab + ((h_ * 2 + i_) * 8 + wid) * 256 + lane * 4); \
        dst[h_][i_] = (unsigned)(((((u).pm >> 1) & 7) * 4096 + tok_) * g.lda + gC[i_]) * 2u; } } while (0)
    const size_t kstep = (size_t)(BK * 2);
    const size_t hstepA = (size_t)HALF * g.lda * 2, hstepB = (size_t)HALF * g.ldb * 2;
    const size_t tstepA = 2 * hstepA, tstepB = 2 * hstepB;
    const unsigned ldsw = (unsigned)wid * 1024u;
    const int aoff = lds_byte(wr * 64 + fr, fq * 8), boff = lds_byte(wc * 32 + fr, fq * 8);
#define PG8_SA(b, h) (((b) * 2 + (h)) * HTB)
#define PG8_SB(b, h) ((4 + (b) * 2 + (h)) * HTB)
#define PG8_STAGE(bufoff, gbase, voff) do { _Pragma("unroll") for (int _i = 0; _i < 2; ++_i) \
        __builtin_amdgcn_global_load_lds((const unsigned*)((const char*)(gbase) + (voff)[_i]), (PG8_LAS unsigned*)(lds + (bufoff) + ldsw + _i * 8192), 16, 0, 0); } while (0)
#define PG8_LDA(dst, b, h) do { _Pragma("unroll") for (int m = 0; m < 4; ++m) _Pragma("unroll") for (int k = 0; k < 2; ++k) dst[m][k] = *(const PG8_LAS bf16x8*)(lds + PG8_SA(b, h) + aoff + m * 2048 + k * 1024); } while (0)
#define PG8_LDB(dst, b, h) do { _Pragma("unroll") for (int n = 0; n < 2; ++n) _Pragma("unroll") for (int k = 0; k < 2; ++k) dst[n][k] = *(const PG8_LAS bf16x8*)(lds + PG8_SB(b, h) + boff + n * 2048 + k * 1024); } while (0)
#define PG8_MMA(ai, bj, At, Bt) do { __builtin_amdgcn_s_setprio(1); _Pragma("unroll") for (int m = 0; m < 4; ++m) _Pragma("unroll") for (int n = 0; n < 2; ++n) _Pragma("unroll") for (int k = 0; k < 2; ++k) \
        acc[ai][bj][m][n] = __builtin_amdgcn_mfma_f32_16x16x32_bf16(Bt[n][k], At[m][k], acc[ai][bj][m][n], 0, 0, 0); __builtin_amdgcn_s_setprio(0); } while (0)
#define PG8_WAIT_V(n) asm volatile("s_waitcnt vmcnt(" #n ")" ::: "memory")
#define PG8_WAIT_L(n) asm volatile("s_waitcnt lgkmcnt(" #n ")" ::: "memory")
#define PG8_BAR __builtin_amdgcn_s_barrier()
#define PG8_SCHED __builtin_amdgcn_sched_barrier(0)
#define PG8_ABASE(u) (GATHER ? (const char*)g.A : (const char*)g.A + (size_t)((u).pm % g.amod) * tstepA)
#define PG8_STA(bufoff, kptr, h, nx) do { if constexpr (GATHER) { unsigned o_[2]; o_[0] = (nx) ? goffn[h][0] : goffc[h][0]; o_[1] = (nx) ? goffn[h][1] : goffc[h][1]; PG8_STAGE(bufoff, kptr, o_); } \
        else { PG8_STAGE(bufoff, (kptr) + (h) * hstepA, voffA); } } while (0)
#define PG8_BBASE(u) ((const char*)g.Bt + ((size_t)((u).pm / g.gdiv) * g.gstride) * 2 + (size_t)(u).pn * tstepB)
    Unit cur, nxt; int ui = 0;
    if (!S.next(0, cur)) return;
    f32x4 acc[2][2][4][2];
#pragma unroll
    for (int a = 0; a < 2; ++a)
#pragma unroll
        for (int b = 0; b < 2; ++b)
#pragma unroll
            for (int m = 0; m < 4; ++m)
#pragma unroll
                for (int n = 0; n < 2; ++n) acc[a][b][m][n] = (f32x4){0.f, 0.f, 0.f, 0.f};
    bf16x8 At[4][2], B0[2][2], B1[2][2];
    const char* cA = PG8_ABASE(cur); const char* cB = PG8_BBASE(cur);
    if constexpr (GATHER) { PG8_GISSUE(cur); PG8_WAIT_V(0); PG8_GREAD(goffc, cur);
#pragma unroll
        for (int h_ = 0; h_ < 2; ++h_) { goffn[h_][0] = goffc[h_][0]; goffn[h_][1] = goffc[h_][1]; } }
    PG8_STAGE(PG8_SB(0, 0), cB, voffB); PG8_STAGE(PG8_SB(0, 1), cB + hstepB, voffB); PG8_STA(PG8_SA(0, 0), cA, 0, false); PG8_STA(PG8_SA(0, 1), cA, 1, false);
    if (wr == 1) PG8_BAR;
    PG8_WAIT_V(2); PG8_BAR;
    PG8_STAGE(PG8_SB(1, 0), cB + kstep, voffB); PG8_STA(PG8_SA(1, 0), cA + kstep, 0, false); PG8_STAGE(PG8_SB(1, 1), cB + hstepB + kstep, voffB);
    PG8_WAIT_V(6); PG8_BAR;
    for (;;) {
        const bool has_next = S.next(ui + 1, nxt);
        const char* nA = has_next ? PG8_ABASE(nxt) : cA; const char* nB = has_next ? PG8_BBASE(nxt) : cB;
        if constexpr (GATHER) { if (has_next) PG8_GISSUE(nxt); }
        if constexpr (MIDSCALE) {
#pragma unroll
            for (int q_ = 0; q_ < 2; ++q_) __builtin_amdgcn_global_load_lds((const unsigned*)(g.ss + (size_t)cur.pm * 1024 + q_ * 512 + wid * 64 + lane), (PG8_LAS unsigned*)(gtab + (ui & 1) * 4096 + q_ * 2048 + wid * 256), 4, 0, 0); }
#pragma nounroll
        for (int t = 0; t < nt; t += 2) {
            const bool last = (t == nt - 2);
            const char* a1 = cA + (size_t)(t + 1) * kstep;
            const char* a2 = last ? nA : cA + (size_t)(t + 2) * kstep; const char* b2 = last ? nB : cB + (size_t)(t + 2) * kstep;
            const char* a3 = a2 + kstep; const char* b3 = b2 + kstep;
            if constexpr (GATHER) { if (last && has_next) PG8_GREAD(goffn, nxt); }
            if constexpr (MIDSCALE) { if (t == nt / 2) { asm volatile("" ::: "memory"); const PG8_LAS float* tab = (const PG8_LAS float*)(gtab + (ui & 1) * 4096);
#pragma unroll
                for (int ai = 0; ai < 2; ++ai)
#pragma unroll
                    for (int m = 0; m < 4; ++m) { const int rl = ai * HALF + wr * 64 + m * 16 + fr; const float sg = tab[rl * 4] + tab[rl * 4 + 1], sm = tab[rl * 4 + 2] + tab[rl * 4 + 3];
                        const float ratio = __builtin_amdgcn_rsqf(sg * ms_inv_n + ms_eps) * __builtin_amdgcn_rcpf(__builtin_amdgcn_rsqf(sm * ms_inv_n + ms_eps));
#pragma unroll
                        for (int bj = 0; bj < 2; ++bj)
#pragma unroll
                            for (int n = 0; n < 2; ++n) acc[ai][bj][m][n] = acc[ai][bj][m][n] * ratio; } } }
            PG8_LDB(B0, 0, 0); PG8_LDB(B1, 0, 1); PG8_SCHED; PG8_LDA(At, 0, 0); PG8_STA(PG8_SA(1, 1), a1, 1, false);
            PG8_WAIT_V(8); PG8_WAIT_L(0); PG8_BAR; PG8_MMA(0, 0, At, B0); PG8_MMA(0, 1, At, B1); PG8_BAR; PG8_SCHED;
            PG8_LDA(At, 0, 1); PG8_STAGE(PG8_SB(0, 0), b2, voffB); PG8_STAGE(PG8_SB(0, 1), b2 + hstepB, voffB); PG8_STA(PG8_SA(0, 0), a2, 0, last);
            PG8_WAIT_V(8); PG8_WAIT_L(0); PG8_BAR; PG8_MMA(1, 0, At, B0); PG8_MMA(1, 1, At, B1); PG8_BAR; PG8_SCHED;
            PG8_LDB(B0, 1, 0); PG8_LDB(B1, 1, 1); PG8_SCHED; PG8_LDA(At, 1, 0); PG8_STA(PG8_SA(0, 1), a2, 1, last);
            PG8_WAIT_V(8); PG8_WAIT_L(0); PG8_BAR; PG8_MMA(0, 0, At, B0); PG8_MMA(0, 1, At, B1); PG8_BAR; PG8_SCHED;
            PG8_LDA(At, 1, 1); PG8_STAGE(PG8_SB(1, 0), b3, voffB); PG8_STAGE(PG8_SB(1, 1), b3 + hstepB, voffB); PG8_STA(PG8_SA(1, 0), a3, 0, last);
            PG8_WAIT_V(8); PG8_WAIT_L(0); PG8_BAR; PG8_MMA(1, 0, At, B0); PG8_MMA(1, 1, At, B1); PG8_BAR; PG8_SCHED;
        }
        if constexpr (ALIGN_EPI) { if (wr == 0) PG8_BAR; }
        if constexpr (MIDSCALE) E(acc, cur, wr, wc, fr, fq, (const PG8_LAS float*)(gtab + (ui & 1) * 4096)); else E(acc, cur, wr, wc, fr, fq);
        if (!has_next) break;
#pragma unroll
        for (int a = 0; a < 2; ++a)
#pragma unroll
            for (int b = 0; b < 2; ++b)
#pragma unroll
                for (int m = 0; m < 4; ++m)
#pragma unroll
                    for (int n = 0; n < 2; ++n) acc[a][b][m][n] = (f32x4){0.f, 0.f, 0.f, 0.f};
        cur = nxt; cA = nA; cB = nB; ++ui;
        if constexpr (GATHER) {
#pragma unroll
            for (int h_ = 0; h_ < 2; ++h_) { goffc[h_][0] = goffn[h_][0]; goffc[h_][1] = goffn[h_][1]; } }
        if constexpr (ALIGN_EPI) { if (wr == 1) PG8_BAR; }
    }
    PG8_WAIT_V(0);
    if constexpr (!ALIGN_EPI) { if (wr == 0) PG8_BAR; }
    PG8_BAR;
#undef PG8_SA
#undef PG8_SB
#undef PG8_STAGE
#undef PG8_LDA
#undef PG8_LDB
#undef PG8_MMA
#undef PG8_WAIT_V
#undef PG8_WAIT_L
#undef PG8_BAR
#undef PG8_SCHED
#undef PG8_ABASE
#undef PG8_STA
#undef PG8_GISSUE
#undef PG8_GREAD
#undef PG8_BBASE
}
}
namespace att {
typedef unsigned short bf16;
using bf16x8 = __attribute__((ext_vector_type(8))) short;
using s16x4  = __attribute__((ext_vector_type(4))) short;
using f32x16 = __attribute__((ext_vector_type(16))) float;
using u32x4  = __attribute__((ext_vector_type(4))) unsigned;
#define ATT_SBAR() __builtin_amdgcn_sched_barrier(0)
constexpr int KCH = 1040;
constexpr float THR = 8.0f;
__device__ __forceinline__ int crow(int r, int hi) { return (r & 3) + 8 * (r >> 2) + 4 * hi; }
__device__ __forceinline__ unsigned cvtpk(float lo, float hi) { unsigned r; asm volatile("v_cvt_pk_bf16_f32 %0, %1, %2" : "=v"(r) : "v"(lo), "v"(hi)); return r; }
__device__ __forceinline__ unsigned short f2bf1(float f) { unsigned u = __builtin_bit_cast(unsigned, f); return (unsigned short)((u + 0x7fffu + ((u >> 16) & 1u)) >> 16); }

#define ATT_MX3(a, b, c) __builtin_fmaxf(__builtin_fmaxf((a), (b)), (c))
template <int MODE, bool FIRST>
__device__ __forceinline__ void partialSM(f32x16& p0, f32x16& p1, float& m_run, f32x16& negm, float& alpha) {
  if constexpr (MODE == 0) {
    float a = ATT_MX3(p0[0], p0[1], p1[0]), b = ATT_MX3(p0[2], p0[3], p1[1]); a = ATT_MX3(a, p1[2], p1[3]);
#pragma unroll
    for (int r = 4; r < 16; r += 4) { a = ATT_MX3(a, p0[r], p0[r + 1]); b = ATT_MX3(b, p0[r + 2], p0[r + 3]); a = ATT_MX3(a, p1[r], p1[r + 1]); b = ATT_MX3(b, p1[r + 2], p1[r + 3]); }
    float pmax = fmaxf(a, b);
    { auto rr = __builtin_amdgcn_permlane32_swap(__float_as_uint(pmax), __float_as_uint(pmax), false, false);
      pmax = fmaxf(__uint_as_float(rr[0]), __uint_as_float(rr[1])); }
    alpha = 1.f;
    if (FIRST || __builtin_expect(__any(pmax > THR), 0)) {
      const float dl = FIRST ? pmax : fmaxf(pmax, 0.f);
      m_run += dl;
#pragma unroll
      for (int r = 0; r < 16; ++r) { p0[r] -= dl; p1[r] -= dl; }
#pragma unroll
      for (int r = 0; r < 16; ++r) negm[r] = -m_run;
      asm volatile("" : "+v"(negm));
      alpha = FIRST ? 1.f : __builtin_amdgcn_exp2f(-dl);
    }
  } else { alpha = 1.f; }
#pragma unroll
  for (int r = 0; r < 16; ++r) p0[r] = __builtin_amdgcn_exp2f(p0[r]);
}
__device__ __forceinline__ void finishSM(f32x16& p0, f32x16& p1, float alpha, float& l_reg, bf16x8& pa0, bf16x8& pa1, bf16x8& pa2, bf16x8& pa3) {
#pragma unroll
  for (int r = 0; r < 16; ++r) p1[r] = __builtin_amdgcn_exp2f(p1[r]);
  float ps = 0;
#pragma unroll
  for (int r = 0; r < 16; ++r) ps += p0[r];
#pragma unroll
  for (int r = 0; r < 16; ++r) ps += p1[r];
  { auto rr = __builtin_amdgcn_permlane32_swap(__float_as_uint(ps), __float_as_uint(ps), false, false);
    ps = __uint_as_float(rr[0]) + __uint_as_float(rr[1]); }
  l_reg = l_reg * alpha + ps;
#define ATT_PK4(P, BASE, OUT) do { unsigned a0 = cvtpk(P[BASE + 0], P[BASE + 1]), a1 = cvtpk(P[BASE + 2], P[BASE + 3]);   \
    unsigned b0 = cvtpk(P[BASE + 4], P[BASE + 5]), b1 = cvtpk(P[BASE + 6], P[BASE + 7]);                              \
    auto r0 = __builtin_amdgcn_permlane32_swap(a0, b0, false, false); auto r1 = __builtin_amdgcn_permlane32_swap(a1, b1, false, false); \
    u32x4 w = {r0[0], r1[0], r0[1], r1[1]}; OUT = *reinterpret_cast<bf16x8*>(&w); } while (0)
  ATT_PK4(p0, 0, pa0); ATT_PK4(p0, 8, pa1); ATT_PK4(p1, 0, pa2); ATT_PK4(p1, 8, pa3);
#undef ATT_PK4
}
template <int ND0>
__device__ __forceinline__ void qkt(f32x16& p0, f32x16& p1, const char* Ks, const bf16x8* qr, const f32x16& negm, int r32, int hi) {
#pragma unroll
  for (int d0 = 0; d0 < ND0; ++d0) {
    const char* kb = Ks + (2 * d0 + hi) * KCH + r32 * 16;
    bf16x8 b0 = *reinterpret_cast<const bf16x8*>(kb);
    bf16x8 b1 = *reinterpret_cast<const bf16x8*>(kb + 512);
    if (d0 == 0) { p0 = __builtin_amdgcn_mfma_f32_32x32x16_bf16(b0, qr[0], negm, 0, 0, 0); p1 = __builtin_amdgcn_mfma_f32_32x32x16_bf16(b1, qr[0], negm, 0, 0, 0); }
    else { p0 = __builtin_amdgcn_mfma_f32_32x32x16_bf16(b0, qr[d0], p0, 0, 0, 0); p1 = __builtin_amdgcn_mfma_f32_32x32x16_bf16(b1, qr[d0], p1, 0, 0, 0); } }
}
template <int NB> __device__ __forceinline__ int v_st(int k, int c) { const int kk = (k & ~0xC) | ((k & 4) << 1) | ((k & 8) >> 1); return ((kk >> 3) * NB + (c >> 5)) * 512 + ((kk & 7) * 32 + (c & 31)) * 2; }
__device__ __forceinline__ int v_rd_base(int lane) { return ((lane & 3) << 3) | (((lane >> 2) & 3) << 6) | (((lane >> 4) & 1) << 5) | (((lane >> 5) & 1) << 8); }
template <int OFF> __device__ __forceinline__ s16x4 tr_read(int vb) {
  s16x4 r; asm volatile("ds_read_b64_tr_b16 %0, %1 offset:%2" : "=&v"(r) : "v"(vb), "i"(OFF) : "memory"); return r;
}
template <int NB, int D0> __device__ __forceinline__ void pv_one(f32x16& od, int vb, bf16x8 pa0, bf16x8 pa1, bf16x8 pa2, bf16x8 pa3) {
#define ATT_VO(ks, half) (D0 * 512 + (2 * (ks) + (half)) * NB * 512)
  const s16x4 l0 = tr_read<ATT_VO(0, 0)>(vb), h0 = tr_read<ATT_VO(0, 1)>(vb), l1 = tr_read<ATT_VO(1, 0)>(vb), h1 = tr_read<ATT_VO(1, 1)>(vb);
  const s16x4 l2 = tr_read<ATT_VO(2, 0)>(vb), h2 = tr_read<ATT_VO(2, 1)>(vb), l3 = tr_read<ATT_VO(3, 0)>(vb), h3 = tr_read<ATT_VO(3, 1)>(vb);
#undef ATT_VO
  asm volatile("s_waitcnt lgkmcnt(0)" ::: "memory"); ATT_SBAR();
#define ATT_PK(L, H) (bf16x8){L[0], L[1], L[2], L[3], H[0], H[1], H[2], H[3]}
  od = __builtin_amdgcn_mfma_f32_32x32x16_bf16(pa0, ATT_PK(l0, h0), od, 0, 0, 0);
  od = __builtin_amdgcn_mfma_f32_32x32x16_bf16(pa1, ATT_PK(l1, h1), od, 0, 0, 0);
  od = __builtin_amdgcn_mfma_f32_32x32x16_bf16(pa2, ATT_PK(l2, h2), od, 0, 0, 0);
  od = __builtin_amdgcn_mfma_f32_32x32x16_bf16(pa3, ATT_PK(l3, h3), od, 0, 0, 0);
#undef ATT_PK
}
template <int NB> __device__ __forceinline__ void pv_all(f32x16* o, int vb, bf16x8 pa0, bf16x8 pa1, bf16x8 pa2, bf16x8 pa3) {
  if constexpr (NB == 2) {
#define ATT_VO(d0, ks, half) ((d0) * 512 + (2 * (ks) + (half)) * NB * 512)
    const s16x4 l0 = tr_read<ATT_VO(0, 0, 0)>(vb), h0 = tr_read<ATT_VO(0, 0, 1)>(vb), l1 = tr_read<ATT_VO(0, 1, 0)>(vb), h1 = tr_read<ATT_VO(0, 1, 1)>(vb);
    const s16x4 l2 = tr_read<ATT_VO(0, 2, 0)>(vb), h2 = tr_read<ATT_VO(0, 2, 1)>(vb), l3 = tr_read<ATT_VO(0, 3, 0)>(vb), h3 = tr_read<ATT_VO(0, 3, 1)>(vb);
    const s16x4 m0 = tr_read<ATT_VO(1, 0, 0)>(vb), n0 = tr_read<ATT_VO(1, 0, 1)>(vb), m1 = tr_read<ATT_VO(1, 1, 0)>(vb), n1 = tr_read<ATT_VO(1, 1, 1)>(vb);
    const s16x4 m2 = tr_read<ATT_VO(1, 2, 0)>(vb), n2 = tr_read<ATT_VO(1, 2, 1)>(vb), m3 = tr_read<ATT_VO(1, 3, 0)>(vb), n3 = tr_read<ATT_VO(1, 3, 1)>(vb);
#undef ATT_VO
#define ATT_PK(L, H) (bf16x8){L[0], L[1], L[2], L[3], H[0], H[1], H[2], H[3]}
    asm volatile("s_waitcnt lgkmcnt(8)" ::: "memory"); ATT_SBAR();
    o[0] = __builtin_amdgcn_mfma_f32_32x32x16_bf16(pa0, ATT_PK(l0, h0), o[0], 0, 0, 0);
    o[0] = __builtin_amdgcn_mfma_f32_32x32x16_bf16(pa1, ATT_PK(l1, h1), o[0], 0, 0, 0);
    o[0] = __builtin_amdgcn_mfma_f32_32x32x16_bf16(pa2, ATT_PK(l2, h2), o[0], 0, 0, 0);
    o[0] = __builtin_amdgcn_mfma_f32_32x32x16_bf16(pa3, ATT_PK(l3, h3), o[0], 0, 0, 0);
    asm volatile("s_waitcnt lgkmcnt(0)" ::: "memory"); ATT_SBAR();
    o[1] = __builtin_amdgcn_mfma_f32_32x32x16_bf16(pa0, ATT_PK(m0, n0), o[1], 0, 0, 0);
    o[1] = __builtin_amdgcn_mfma_f32_32x32x16_bf16(pa1, ATT_PK(m1, n1), o[1], 0, 0, 0);
    o[1] = __builtin_amdgcn_mfma_f32_32x32x16_bf16(pa2, ATT_PK(m2, n2), o[1], 0, 0, 0);
    o[1] = __builtin_amdgcn_mfma_f32_32x32x16_bf16(pa3, ATT_PK(m3, n3), o[1], 0, 0, 0);
#undef ATT_PK
  } else {
    pv_one<NB, 0>(o[0], vb, pa0, pa1, pa2, pa3); pv_one<NB, 1>(o[1], vb, pa0, pa1, pa2, pa3);
    pv_one<NB, 2>(o[2], vb, pa0, pa1, pa2, pa3); pv_one<NB, 3>(o[3], vb, pa0, pa1, pa2, pa3);
  }
}

template <int W1, int W2, int DV> struct AttnCfg {
  static constexpr int DQK = W1 + W2, NCH = DQK / 8, ND0 = DQK / 16, NB = DV / 32;
  static constexpr int KT_BYTES = NCH * KCH, VT_BYTES = 64 * DV * 2;
  static constexpr int OST_BYTES = 32 * DV * 2;
  static constexpr bool OSTAGE = (DV == 64);
  static constexpr int LDS_BYTES = 3 * VT_BYTES + 3 * KT_BYTES + 8 * 64 * 4 + (OSTAGE ? 8 * OST_BYTES : 0);
  static constexpr int CW1 = W1 / 8, N1 = (64 * CW1) / 512;
  static constexpr int CWV = DV / 8, NV = (64 * CWV) / 512;
  static_assert(W1 == 64 || W1 == 128, "W1"); static_assert(W2 == 0 || W2 == 32, "W2"); static_assert(DV == 64 || DV == 128, "DV");
};

template <int W1, int W2, int DV, int MODE, bool SSQ>
__device__ __forceinline__ void attn_unit(const bf16* __restrict__ Qb, const bf16* __restrict__ Qb2, int ldq, const bf16* __restrict__ K1, int ldk1, const bf16* __restrict__ K2, int ldk2,
                                          const bf16* __restrict__ Vh, int ldv, bf16* __restrict__ Ob, int ldo, int nkeys, char* lds, float (&ssacc)[16]) {
  using C = AttnCfg<W1, W2, DV>;
  constexpr int ND0 = C::ND0, NB = C::NB, N1 = C::N1, NV = C::NV, CW1 = C::CW1, CWV = C::CWV;
  constexpr int SHM_V = C::VT_BYTES, SHM_K = C::KT_BYTES;
  int tid_ = threadIdx.x; asm volatile("" : "+v"(tid_));
  const int tid = tid_, wid = tid >> 6, lane = tid & 63, r32 = lane & 31, hi = lane >> 5;
  char* V_lds = lds; char* K_lds = lds + 3 * SHM_V;
  float* ws = (float*)(lds + 3 * SHM_V + 3 * SHM_K) + wid * 64; float* li_l = ws; float* al_l = ws + 32;
  float m_reg = 0.f, l_reg = 0; f32x16 o[NB]; bf16x8 qr[ND0]; f32x16 negm = f32x16{}; asm volatile("" : "+v"(negm));
#pragma unroll
  for (int d = 0; d < NB; ++d) o[d] = f32x16{};
  const bf16* Qw = Qb + (long)(wid * 32 + r32) * ldq + hi * 8;
#pragma unroll
  for (int d0 = 0; d0 < W1 / 16; ++d0) qr[d0] = *reinterpret_cast<const bf16x8*>(Qw + d0 * 16);
  if constexpr (W2 > 0) { const bf16* Qw2 = Qb2 + (long)(wid * 32 + r32) * ldq + hi * 8;
#pragma unroll
    for (int d0 = 0; d0 < W2 / 16; ++d0) qr[W1 / 16 + d0] = *reinterpret_cast<const bf16x8*>(Qw2 + d0 * 16); }
  int k1row[N1], k1col[N1], k1lds[N1], vrow[NV], vcol[NV], vlds[NV];
#pragma unroll
  for (int i = 0; i < N1; ++i) { const int p = tid + 512 * i; k1row[i] = p / CW1; k1col[i] = (p % CW1) * 8; k1lds[i] = (p % CW1) * KCH + (p / CW1) * 16; }
#pragma unroll
  for (int i = 0; i < NV; ++i) { const int p = tid + 512 * i; vrow[i] = p / CWV; vcol[i] = (p % CWV) * 8; vlds[i] = v_st<NB>(p / CWV, (p % CWV) * 8); }
  const int k2row = tid >> 2, k2col = (tid & 3) * 8, k2lds = (CW1 + (tid & 3)) * KCH + (tid >> 2) * 16; const bool k2on = (W2 > 0) && (tid < 256);
  const int vb0 = (int)(uintptr_t)V_lds + v_rd_base(lane);
  struct Slot { bf16x8 k1[N1]; bf16x8 k2; bf16x8 v[NV]; } sr_[2];
#define ATT_SLOAD(i, k0) do { _Pragma("unroll") for (int _j = 0; _j < N1; ++_j) sr_[i].k1[_j] = *reinterpret_cast<const bf16x8*>(&K1[(long)((k0) + k1row[_j]) * ldk1 + k1col[_j]]); \
    if constexpr (W2 > 0) { if (k2on) sr_[i].k2 = *reinterpret_cast<const bf16x8*>(&K2[(long)((k0) + k2row) * ldk2 + k2col]); } \
    _Pragma("unroll") for (int _j = 0; _j < NV; ++_j) sr_[i].v[_j] = *reinterpret_cast<const bf16x8*>(&Vh[(long)((k0) + vrow[_j]) * ldv + vcol[_j]]); } while (0)
#define ATT_SWRITE(b, i) do { _Pragma("unroll") for (int _j = 0; _j < NV; ++_j) *(bf16x8*)(V_lds + (b) * SHM_V + vlds[_j]) = sr_[i].v[_j]; \
    _Pragma("unroll") for (int _j = 0; _j < N1; ++_j) *(bf16x8*)(K_lds + (b) * SHM_K + k1lds[_j]) = sr_[i].k1[_j]; \
    if constexpr (W2 > 0) { if (k2on) *(bf16x8*)(K_lds + (b) * SHM_K + k2lds) = sr_[i].k2; } } while (0)
#define ATT_SWAIT() asm volatile("s_waitcnt vmcnt(%0)" :: "n"(N1 + NV) : "memory")
#define ATT_RESC(a) do { if (MODE == 0 && __any((a) != 1.f)) { if (hi == 0) al_l[r32] = (a); asm volatile("s_waitcnt lgkmcnt(0)" ::: "memory"); \
    _Pragma("unroll") for (int d = 0; d < NB; ++d) _Pragma("unroll") for (int r = 0; r < 16; ++r) o[d][r] *= al_l[crow(r, hi)]; } } while (0)
  f32x16 pA0, pA1, pB0, pB1; float alA, alB; bf16x8 pa0, pa1, pa2, pa3; const int NT = nkeys / 64;
  ATT_SLOAD(0, 0); asm volatile("s_waitcnt vmcnt(0)" ::: "memory"); ATT_SWRITE(0, 0); __syncthreads();
  qkt<ND0>(pA0, pA1, K_lds, qr, negm, r32, hi); partialSM<MODE, true>(pA0, pA1, m_reg, negm, alA);
  ATT_SLOAD(1, 64); if (2 < NT) ATT_SLOAD(0, 128);
  ATT_SWAIT(); ATT_SWRITE(1, 1); __syncthreads();
  int bp = 0, bc = 1, bn = 2;
  if (wid >= 4) __builtin_amdgcn_s_setprio(1);
#define ATT_ROT() do { const int t_ = bp; bp = bc; bc = bn; bn = t_; } while (0)
  for (int j = 1; j + 1 < NT; j += 2) {
    ATT_SBAR(); qkt<ND0>(pB0, pB1, K_lds + bc * SHM_K, qr, negm, r32, hi);
    finishSM(pA0, pA1, alA, l_reg, pa0, pa1, pa2, pa3); ATT_SBAR();
    ATT_SLOAD(1, (j + 2) * 64); ATT_SBAR();
    pv_all<NB>(o, vb0 + bp * SHM_V, pa0, pa1, pa2, pa3); partialSM<MODE, false>(pB0, pB1, m_reg, negm, alB);
    ATT_SWAIT(); ATT_SWRITE(bn, 0);
    ATT_RESC(alB); __syncthreads(); ATT_ROT();
    ATT_SBAR(); qkt<ND0>(pA0, pA1, K_lds + bc * SHM_K, qr, negm, r32, hi);
    finishSM(pB0, pB1, alB, l_reg, pa0, pa1, pa2, pa3); ATT_SBAR();
    if (j + 3 < NT) ATT_SLOAD(0, (j + 3) * 64); ATT_SBAR();
    pv_all<NB>(o, vb0 + bp * SHM_V, pa0, pa1, pa2, pa3); partialSM<MODE, false>(pA0, pA1, m_reg, negm, alA);
    ATT_SWAIT(); ATT_SWRITE(bn, 1);
    ATT_RESC(alA); __syncthreads(); ATT_ROT();
  }
  ATT_SBAR(); qkt<ND0>(pB0, pB1, K_lds + bc * SHM_K, qr, negm, r32, hi);
  finishSM(pA0, pA1, alA, l_reg, pa0, pa1, pa2, pa3); ATT_SBAR();
  pv_all<NB>(o, vb0 + bp * SHM_V, pa0, pa1, pa2, pa3); partialSM<MODE, false>(pB0, pB1, m_reg, negm, alB);
  ATT_RESC(alB);
  finishSM(pB0, pB1, alB, l_reg, pa0, pa1, pa2, pa3); ATT_SBAR();
  pv_all<NB>(o, vb0 + bc * SHM_V, pa0, pa1, pa2, pa3);
#undef ATT_ROT
  __builtin_amdgcn_s_setprio(0);
  if (hi == 0) li_l[r32] = l_reg; asm volatile("s_waitcnt lgkmcnt(0)" ::: "memory");
  float rli[16];
#pragma unroll
  for (int r = 0; r < 16; ++r) rli[r] = __builtin_amdgcn_rcpf(li_l[crow(r, hi)]);
  bf16* Ow = Ob + (long)(wid * 32) * ldo;
  if constexpr (C::OSTAGE) { unsigned short* stg = (unsigned short*)(lds + 3 * SHM_V + 3 * SHM_K + 8 * 64 * 4 + wid * C::OST_BYTES);
#pragma unroll
    for (int r = 0; r < 16; ++r) { const int orow = crow(r, hi);
#pragma unroll
      for (int d0 = 0; d0 < NB; ++d0) stg[orow * DV + d0 * 32 + r32] = f2bf1(o[d0][r] * rli[r]); }
    asm volatile("s_waitcnt lgkmcnt(0)" ::: "memory");
    constexpr int CPR = DV / 8;
#pragma unroll
    for (int i = 0; i < (32 * CPR) / 64; ++i) { const int p = i * 64 + lane, row = p / CPR, ch = p % CPR;
      const u32x4 v = *(const u32x4*)(stg + row * DV + ch * 8); *(u32x4*)(Ow + (long)row * ldo + ch * 8) = v; } }
  else {
#pragma unroll
    for (int r = 0; r < 16; ++r) { const int orow = crow(r, hi);
#pragma unroll
      for (int d0 = 0; d0 < NB; ++d0) Ow[(long)orow * ldo + d0 * 32 + r32] = f2bf1(o[d0][r] * rli[r]); } }
  if constexpr (SSQ) {
#pragma unroll
    for (int r = 0; r < 16; ++r) {
#pragma unroll
      for (int d0 = 0; d0 < NB; ++d0) { const float v = o[d0][r] * rli[r]; ssacc[r] += v * v; } } }
  __syncthreads();
#undef ATT_SLOAD
#undef ATT_SWRITE
#undef ATT_SWAIT
#undef ATT_RESC
}
#undef ATT_SBAR
}
constexpr int NWAVES = 8;
#ifndef MK_N_LAUNCHES
#define MK_N_LAUNCHES 1
#endif
constexpr int BATCH = 8, SEQ = 4096, DM = 1024, DEPTH = 4, MTOK = BATCH * SEQ;
constexpr int IN_W = 1184, IN_WP = 1280;
constexpr int MEM_T = 256, MROWS = BATCH * MEM_T;
constexpr int NEXP = 16, CAP = 512, EFF = 512, MOE_ROWS = NEXP * BATCH * CAP;
constexpr float EPS = 1e-6f, LOG2E = 1.4426950408889634f;
constexpr int NPH = 2 + 16 * DEPTH;
constexpr size_t MiB = 1u << 20;
constexpr size_t WS_CTL = 0, CTL_ZERO_BYTES = 1 * MiB;
constexpr size_t WS_TABG = 1 * MiB, WS_TABM = 2 * MiB, WS_WR = 2 * MiB + 512 * 1024, WS_GAINS = 3 * MiB, WS_SSO = 3 * MiB + 64 * 1024, WS_SSX = 346 * MiB, WS_RS1 = WS_SSO + 512 * 1024, WS_RS3 = WS_RS1 + 128 * 1024, WS_RG = 118 * MiB + 256 * 1024, WS_SSL = 118 * MiB + 512 * 1024;
constexpr size_t WS_WSMALL = 4 * MiB, WSMALL_STRIDE = 10 * MiB;
constexpr size_t OFF_WIN = 0, OFF_WQB = 5 * MiB / 2, OFF_WKVB = 3 * MiB, OFF_WO = 7 * MiB / 2, OFF_WMQ = 11 * MiB / 2, OFF_WMKV = 13 * MiB / 2, OFF_WMO = 17 * MiB / 2;
constexpr size_t WS_WGU = 44 * MiB, WS_WD = 76 * MiB;
constexpr size_t WS_MEMN = 92 * MiB, WS_MEMKV = 96 * MiB;
constexpr size_t WS_AFF = 112 * MiB, WS_AFFT = 114 * MiB, WS_SLOT = 116 * MiB, WS_IDX = 118 * MiB;
constexpr size_t WS_H = 120 * MiB, WS_PROJ = 184 * MiB, WS_QG = 264 * MiB, WS_KG = 296 * MiB, WS_VG = 304 * MiB, WS_LAT = 312 * MiB, WS_KROPE = 344 * MiB, WS_QM = 346 * MiB;
constexpr size_t WS_XB = 264 * MiB;
constexpr size_t WS_O = WS_H, WS_KVM = WS_PROJ, WS_QMEM = 184 * MiB, WS_OMEM = 216 * MiB, WS_XG = 184 * MiB, WS_Y = WS_XG, WS_ACT = 312 * MiB;
constexpr size_t WS_WGU2 = 394 * MiB, WS_WD2 = 426 * MiB;
constexpr size_t WS_X = 442 * MiB;
constexpr size_t WS_END = 506 * MiB;
constexpr int CW_BAR = 4096;
constexpr int RING_BYTES = 131072, LDSCTL_OFF = 135168, MISC_OFF = LDSCTL_OFF + 320, GTAB_OFF = LDSCTL_OFF + 1024, STAB_OFF = GTAB_OFF + 8192, LDS_BYTES = 163840;

#define GAS __attribute__((address_space(1)))
#define LAS __attribute__((address_space(3)))
typedef unsigned short bf16;
typedef unsigned v4u __attribute__((ext_vector_type(4)));
typedef float f32x4 __attribute__((ext_vector_type(4)));
#define LDS_WAIT() asm volatile("s_waitcnt lgkmcnt(0)" ::: "memory")
__device__ __forceinline__ unsigned pk2(float lo, float hi) { unsigned r; asm volatile("v_cvt_pk_bf16_f32 %0, %1, %2" : "=v"(r) : "v"(lo), "v"(hi)); return r; }
__device__ __forceinline__ float bflo(unsigned w) { return __uint_as_float(w << 16); }
__device__ __forceinline__ float bfhi(unsigned w) { return __uint_as_float(w & 0xffff0000u); }
#define UNPACK8(W_, V_) do { V_[0] = bflo(W_[0]); V_[1] = bfhi(W_[0]); V_[2] = bflo(W_[1]); V_[3] = bfhi(W_[1]); V_[4] = bflo(W_[2]); V_[5] = bfhi(W_[2]); V_[6] = bflo(W_[3]); V_[7] = bfhi(W_[3]); } while (0)
#define PACK8(V_, W_) do { W_[0] = pk2(V_[0], V_[1]); W_[1] = pk2(V_[2], V_[3]); W_[2] = pk2(V_[4], V_[5]); W_[3] = pk2(V_[6], V_[7]); } while (0)
__device__ __forceinline__ float wave_sum(float v) {
#pragma unroll
    for (int o = 1; o < 64; o <<= 1) v += __shfl_xor(v, o);
    return v;
}
__device__ __forceinline__ int wave_sum_i(int v) {
#pragma unroll
    for (int o = 1; o < 64; o <<= 1) v += __shfl_xor(v, o);
    return v;
}

#define XB_TMO      128
#define XB_XCNT(j)  (256  + 64 * (j))
#define XB_XSUB(j)  (1280 + 64 * (j))
#define XB_XGEN(j)  (2304 + 64 * (j))
#define XB_TOP      3328
#define XB_TOPGEN   3392
#define XCD_BAR_WORDS 3456
#define XB_SPIN_CAP (1u << 20)
__device__ __forceinline__ unsigned xb_ld(unsigned* p)              { return __hip_atomic_load(p, __ATOMIC_RELAXED, __HIP_MEMORY_SCOPE_AGENT); }
__device__ __forceinline__ unsigned xb_add(unsigned* p, unsigned v) { return __hip_atomic_fetch_add(p, v, __ATOMIC_RELAXED, __HIP_MEMORY_SCOPE_AGENT); }
__device__ __forceinline__ unsigned xb_xcc_id() { return (unsigned)__builtin_amdgcn_s_getreg((3 << 11) | 20) & 0xFu; }
#define XB_SPIN(cond, bar) do { unsigned _sp = 0; while (cond) { __builtin_amdgcn_s_sleep(1); \
    if ((++_sp & 255u) == 0u) { if (xb_ld(&(bar)[XB_TMO])) break; if (_sp > XB_SPIN_CAP) { atomicAdd(&(bar)[XB_TMO], 1u); break; } } } } while (0)
struct XcdBarrier { unsigned* bar; unsigned x; volatile LAS unsigned* st; };
__device__ __forceinline__ XcdBarrier xcd_barrier_post(unsigned* bar, volatile LAS unsigned* st) {
    XcdBarrier b; b.bar = bar; b.x = xb_xcc_id(); b.st = st;
    if (threadIdx.x == 0) (void)xb_add(&bar[XB_XCNT(b.x)], 1u);
    return b;
}
__device__ __forceinline__ void xcd_barrier_complete(unsigned* bar, unsigned x, unsigned& nloc, unsigned& nx) {
    const unsigned G = gridDim.x * gridDim.y * gridDim.z;
    unsigned sum, cnt, mine, sp = 0u;
    for (;;) {
        sum = 0u; cnt = 0u; mine = 0u;
#pragma unroll
        for (unsigned j = 0; j < 16; ++j) { const unsigned c = xb_ld(&bar[XB_XCNT(j)]); sum += c; cnt += (c > 0u) ? 1u : 0u; mine = (j == x) ? c : mine; }
        if (sum == G) break;
        __builtin_amdgcn_s_sleep(1);
        if ((++sp & 255u) == 0u) { if (xb_ld(&bar[XB_TMO])) break; if (sp > XB_SPIN_CAP) { atomicAdd(&bar[XB_TMO], 1u); break; } }
    }
    nloc = mine > 0u ? mine : 1u; nx = cnt > 0u ? cnt : 1u;
}
__device__ __forceinline__ void xcd_barrier(const XcdBarrier& b) {
    asm volatile("s_waitcnt vmcnt(0)" ::: "memory");
    __syncthreads();
    if (threadIdx.x == 0) {
        unsigned* bar = b.bar;
        __builtin_amdgcn_s_waitcnt(0);
        unsigned nloc = b.st[0], nx = b.st[1];
        if (nloc == 0u) { xcd_barrier_complete(bar, b.x, nloc, nx); b.st[0] = nloc; b.st[1] = nx; }
        const unsigned old = xb_add(&bar[XB_XSUB(b.x)], 1u);
        const unsigned gen = old / nloc;
        if (old + 1u == (gen + 1u) * nloc) {
            __builtin_amdgcn_fence(__ATOMIC_RELEASE, "agent");
            asm volatile("s_waitcnt vmcnt(0)" ::: "memory");
            const unsigned og = xb_add(&bar[XB_TOP], 1u);
            const unsigned tg = og / nx;
            if (og + 1u == (tg + 1u) * nx) xb_add(&bar[XB_TOPGEN], 1u);
            else XB_SPIN(xb_ld(&bar[XB_TOPGEN]) == tg, bar);
            __builtin_amdgcn_fence(__ATOMIC_ACQUIRE, "agent");
            xb_add(&bar[XB_XGEN(b.x)], 1u);
            asm volatile("s_waitcnt vmcnt(0)" ::: "memory");
        } else {
            XB_SPIN(xb_ld(&bar[XB_XGEN(b.x)]) == gen, bar);
            __builtin_amdgcn_fence(__ATOMIC_ACQUIRE, "agent");
            asm volatile("s_waitcnt vmcnt(0)" ::: "memory");
        }
    }
    __syncthreads();
}

struct Args { const float* in[24]; float* out; unsigned char* ws; int ph_lo, ph_hi; };
struct Ctx {
    LAS unsigned char* lds; char* ldsg;
    int tid, lane, wave, vcu, vcu0, G, G0, gw, NGW;
    bf16* x; float* out;
    unsigned char* ws;
};
#define WSP(T, off) ((T*)(F.ws + (off)))
__device__ __forceinline__ void refresh(Ctx& F) { int t = threadIdx.x; asm volatile("" : "+v"(t)); F.tid = t; F.lane = t & 63;
    int w = __builtin_amdgcn_readfirstlane(t >> 6), v = F.vcu0, g = F.G0; asm volatile("" : "+s"(w), "+s"(v), "+s"(g)); F.wave = w; F.vcu = v; F.G = g; F.gw = v * NWAVES + w; F.NGW = g * NWAVES; }

__device__ __forceinline__ int il32(int i) { return (i < 16) ? 2 * i : 2 * (i - 16) + 1; }
__device__ __forceinline__ int il64(int d) { return (d < 32) ? 2 * d : 2 * (d - 32) + 1; }
__device__ __forceinline__ int dstrow(int kind, int n) {
    if (kind == 1) {
        if (n < 512) { const int h = n >> 6, p = il64(n & 63); return 256 * (h >> 2) + 128 * (p >> 5) + 32 * (h & 3) + (p & 31); }
        if (n < 640) { const int kh = (n - 512) >> 6, p = il64(n & 63); return 512 + 128 * (p >> 5) + 32 * kh + (p & 31); }
        if (n < 768) { const int vh = (n - 640) >> 6, d = n & 63; return 512 + 128 * (d >> 5) + 32 * (2 + vh) + (d & 31); }
        if (n >= 1152) return 1152 + il32(n - 1152);
        return n; }
    if (kind == 2) { const int h = n / 96, p = n % 96; return (p < 64) ? h * 64 + p : 512 + h * 32 + il32(p - 64); }
    if (kind == 3) return (n >> 7) * 256 + (n & 127);
    if (kind == 4) return (n >> 7) * 256 + 128 + (n & 127);
    return n;
}
__device__ __forceinline__ void tr_item(const float* W, int N, const float* gain, bf16* WT, int ldk, int kind, int item, LAS float* scr, int lane) {
    const int nblk = (N + 63) / 64, kb = item / nblk, nb = item % nblk, k0 = 64 * kb, n0 = 64 * nb;
    const int lr = lane >> 4, lc = (lane & 15) * 4; const bool okc = (n0 + lc) < N;
    f32x4 v[16];
#pragma unroll
    for (int i = 0; i < 16; ++i) v[i] = okc ? *(const GAS f32x4*)(W + (size_t)(k0 + 4 * i + lr) * N + n0 + lc) : (f32x4){0.f, 0.f, 0.f, 0.f};
#pragma unroll
    for (int i = 0; i < 16; ++i) { const int kk = 4 * i + lr; const float gk = gain ? gain[k0 + kk] : 1.0f; LAS float* d = scr + kk * 65 + lc;
        d[0] = v[i].x * gk; d[1] = v[i].y * gk; d[2] = v[i].z * gk; d[3] = v[i].w * gk; }
    LDS_WAIT(); asm volatile("" ::: "memory");
    const int c = lane & 7;
#pragma unroll
    for (int j = 0; j < 8; ++j) { const int n = (lane >> 3) + 8 * j; const LAS float* s = scr + (8 * c) * 65 + n;
        v4u o; o.x = pk2(s[0 * 65], s[1 * 65]); o.y = pk2(s[2 * 65], s[3 * 65]); o.z = pk2(s[4 * 65], s[5 * 65]); o.w = pk2(s[6 * 65], s[7 * 65]);
        if (n0 + n < N) *(GAS v4u*)(WT + (size_t)dstrow(kind, n0 + n) * ldk + k0 + 8 * c) = o; }
    LDS_WAIT(); asm volatile("" ::: "memory");
}
constexpr int SMALL_ITEMS = 1152;
__device__ __forceinline__ void small_weight_item(const Ctx& F, const Args& A, int l, int r, LAS float* scr) {
    bf16* wl = WSP(bf16, WS_WSMALL + (size_t)l * WSMALL_STRIDE);
    if (r < 304) { tr_item(A.in[3] + (size_t)l * DM * IN_W, IN_W, A.in[2] + l * DM, wl + OFF_WIN / 2, DM, 1, r, scr, F.lane); return; } r -= 304;
    if (r < 48)  { tr_item(A.in[8] + (size_t)l * 256 * 768, 768, A.in[6] + l * 256, wl + OFF_WQB / 2, 256, 2, r, scr, F.lane); return; } r -= 48;
    if (r < 32)  { tr_item(A.in[9] + (size_t)l * 128 * 1024, 1024, A.in[7] + l * 128, wl + OFF_WKVB / 2, 128, 0, r, scr, F.lane); return; } r -= 32;
    if (r < 256) { const int kb = r / 16; const float* gain = (kb < 8) ? (A.in[10] + l * 512) : (A.in[11] + l * 512 - 512);
                   tr_item(A.in[12] + (size_t)l * DM * DM, DM, gain, wl + OFF_WO / 2, DM, 0, r, scr, F.lane); return; } r -= 256;
    if (r < 128) { tr_item(A.in[15] + (size_t)l * DM * 512, 512, A.in[13] + l * DM, wl + OFF_WMQ / 2, DM, 0, r, scr, F.lane); return; } r -= 128;
    if (r < 256) { tr_item(A.in[16] + (size_t)l * DM * DM, DM, A.in[14] + l * DM, wl + OFF_WMKV / 2, DM, 0, r, scr, F.lane); return; } r -= 256;
    tr_item(A.in[17] + (size_t)l * 512 * DM, DM, nullptr, wl + OFF_WMO / 2, 512, 0, r, scr, F.lane);
}
constexpr int MOE_ITEMS = 3 * 2048;
__device__ __forceinline__ void moe_weight_item(const Ctx& F, const Args& A, int l, int it, LAS float* scr) {
    bf16* wgu = WSP(bf16, (l & 1) ? WS_WGU2 : WS_WGU); bf16* wd = WSP(bf16, (l & 1) ? WS_WD2 : WS_WD);
    const int which = it >> 11, e = (it >> 7) & 15, r = it & 127;
    if (which < 2) tr_item((which == 0 ? A.in[20] : A.in[21]) + (size_t)(l * NEXP + e) * DM * EFF, EFF, A.in[18] + l * DM, wgu + (size_t)e * 1024 * 1024, DM, 3 + which, r, scr, F.lane);
    else           tr_item(A.in[22] + (size_t)(l * NEXP + e) * EFF * DM, DM, nullptr, wd + (size_t)e * 1024 * 512, EFF, 0, r, scr, F.lane);
}
__device__ __forceinline__ void convert_moe_weights(const Ctx& F, const Args& A, int l) {
    LAS float* scr = (LAS float*)(F.lds + F.wave * 16640);
    for (int it = F.gw; it < MOE_ITEMS; it += F.NGW) moe_weight_item(F, A, l, it, scr);
}

__device__ __forceinline__ void rms_row_f32(const float* xrow, bf16* xb, bf16* orow, float* rs, int lane) {
    const GAS f32x4* xr = (const GAS f32x4*)xrow + lane;
    f32x4 v[4]; float s = 0.f;
#pragma unroll
    for (int j = 0; j < 4; ++j) { v[j] = xr[64 * j]; s += (v[j].x * v[j].x + v[j].y * v[j].y) + (v[j].z * v[j].z + v[j].w * v[j].w); }
    const float rstd = __builtin_amdgcn_rsqf(wave_sum(s) * (1.f / DM) + EPS);
    if (xb) { GAS unsigned long long* x8 = (GAS unsigned long long*)xb + lane;
#pragma unroll
        for (int j = 0; j < 4; ++j) x8[64 * j] = (unsigned long long)pk2(v[j].x, v[j].y) | ((unsigned long long)pk2(v[j].z, v[j].w) << 32); }
    if (rs && lane == 0) *rs = rstd;
    if (orow) { GAS unsigned long long* o8 = (GAS unsigned long long*)orow + lane;
#pragma unroll
        for (int j = 0; j < 4; ++j) o8[64 * j] = (unsigned long long)pk2(v[j].x * rstd, v[j].y * rstd) | ((unsigned long long)pk2(v[j].z * rstd, v[j].w * rstd) << 32); }
}
__device__ __forceinline__ void phase_prologue(const Ctx& F, const Args& A) {
    LAS float* scr = (LAS float*)(F.lds + F.wave * 16640);
    for (int it = F.gw; it < DEPTH * SMALL_ITEMS; it += F.NGW) small_weight_item(F, A, it / SMALL_ITEMS, it % SMALL_ITEMS, scr);
    convert_moe_weights(F, A, 0);
    const int gt = F.vcu * (NWAVES * 64) + F.tid, NGT = F.G * NWAVES * 64;
    for (int i = gt; i < DEPTH * 12288; i += NGT) { const int l = i / 12288, r = i % 12288;
        bf16* wl = WSP(bf16, WS_WSMALL + (size_t)l * WSMALL_STRIDE);
        *(GAS v4u*)(wl + OFF_WIN / 2 + (size_t)IN_W * DM + (size_t)r * 8) = (v4u){0u, 0u, 0u, 0u}; }
    for (int i = gt; i < 1536; i += NGT) WSP(float, WS_GAINS)[i] = (i < 256) ? A.in[4][i] : (i < 512) ? A.in[5][i - 256] : A.in[23][i - 512];
    for (int i = gt; i < DEPTH * NEXP * DM; i += NGT) { const int l = i / (NEXP * DM), e = (i / DM) % NEXP, k = i % DM;
        WSP(float, WS_WR)[i] = A.in[19][(size_t)(l * DM + k) * NEXP + e] * A.in[18][l * DM + k]; }
    for (int i = gt; i < SEQ * 48; i += NGT) { const int s = i / 48, j = i % 48; const float row = (float)(s >> 6), col = (float)(s & 63);
        const bool isg = (j < 32); const int j2 = isg ? j : j - 32, half = isg ? 16 : 8, jj = j2 & (half - 1);
        const float inv = __builtin_amdgcn_exp2f(-(float)(2 * jj) / (float)(2 * half) * 13.287712379549449f);
        const float ang = ((j2 < half) ? row : col) * inv;
        double td = (double)ang * 0.15915494309189535; td -= rint(td);
        const float sn = __builtin_amdgcn_sinf((float)td), cs = __builtin_amdgcn_cosf((float)td);
        float* dst = isg ? (WSP(float, WS_TABG) + ((size_t)s * 32 + j2) * 2) : (WSP(float, WS_TABM) + ((size_t)s * 16 + j2) * 2);
        dst[0] = cs; dst[1] = sn; }
    for (int m = F.gw; m < MROWS; m += F.NGW) rms_row_f32(A.in[1] + (size_t)m * DM, nullptr, WSP(bf16, WS_MEMN) + (size_t)m * DM, nullptr, F.lane);
    for (int m = F.gw; m < MTOK; m += F.NGW) rms_row_f32(A.in[0] + (size_t)m * DM, F.x + (size_t)m * DM, nullptr, WSP(float, WS_RS1) + m, F.lane);
}

__device__ __forceinline__ void rope4(float* v, const float* tab) {
    const f32x4 t0 = *(const f32x4*)tab, t1 = *(const f32x4*)(tab + 4);
    float a, b;
    a = v[0]; b = v[1]; v[0] = a * t0[0] - b * t0[1]; v[1] = b * t0[0] + a * t0[1];
    a = v[2]; b = v[3]; v[2] = a * t0[2] - b * t0[3]; v[3] = b * t0[2] + a * t0[3];
    a = v[4]; b = v[5]; v[4] = a * t1[0] - b * t1[1]; v[5] = b * t1[0] + a * t1[1];
    a = v[6]; b = v[7]; v[6] = a * t1[2] - b * t1[3]; v[7] = b * t1[2] + a * t1[3];
}
__device__ __forceinline__ void phase_postproj(const Ctx& F, int l) {
    int lane_ = F.lane; asm volatile("" : "+v"(lane_)); const int lane = lane_;
    const float* gq = WSP(float, WS_GAINS) + l * 64; const float* gk = WSP(float, WS_GAINS) + 256 + l * 64;
    float gqv[8], gkv[8];
#pragma unroll
    for (int i = 0; i < 8; ++i) { const int p = 8 * (lane & 7) + i, d = (p >> 1) + 32 * (p & 1); gqv[i] = gq[d]; gkv[i] = gk[d]; }
    const float* tabg = WSP(float, WS_TABG); const float* tabm = WSP(float, WS_TABM);
    const float C2G = 0.125f * LOG2E;
    v4u wa_n = (v4u){0u, 0u, 0u, 0u}, wb_n = wa_n, wc_n = wa_n;
    if (F.gw < MTOK) { const bf16* pr = WSP(bf16, WS_PROJ) + (size_t)F.gw * IN_WP; wa_n = *(const GAS v4u*)(pr + 8 * lane); wb_n = *(const GAS v4u*)(pr + 512 + 8 * lane); if (lane < 20) wc_n = *(const GAS v4u*)(pr + 1024 + 8 * lane); }
    for (int m = F.gw; m < MTOK; m += F.NGW) {
        const int s = m & (SEQ - 1);
        const v4u wa = wa_n, wb = wb_n, wc = wc_n;
        if (m + F.NGW < MTOK) { const bf16* pr = WSP(bf16, WS_PROJ) + (size_t)(m + F.NGW) * IN_WP; wa_n = *(const GAS v4u*)(pr + 8 * lane); wb_n = *(const GAS v4u*)(pr + 512 + 8 * lane); if (lane < 20) wc_n = *(const GAS v4u*)(pr + 1024 + 8 * lane); }
        { const v4u w = wa; float v[8]; UNPACK8(w, v);
          float ss = 0.f;
#pragma unroll
          for (int i = 0; i < 8; ++i) ss += v[i] * v[i];
          ss += __shfl_xor(ss, 1); ss += __shfl_xor(ss, 2); ss += __shfl_xor(ss, 4);
          const float rstd = __builtin_amdgcn_rsqf(ss * (1.f / 64.f) + EPS);
#pragma unroll
          for (int i = 0; i < 8; ++i) v[i] = v[i] * rstd * gqv[i];
          rope4(v, tabg + ((size_t)s * 32 + 4 * (lane & 7)) * 2);
#pragma unroll
          for (int i = 0; i < 8; ++i) v[i] *= C2G;
          v4u o; PACK8(v, o); *(GAS v4u*)(WSP(bf16, WS_QG) + (size_t)m * 512 + 8 * lane) = o; }
        { const v4u w = wb; float v[8]; UNPACK8(w, v);
          float ss = 0.f;
#pragma unroll
          for (int i = 0; i < 8; ++i) ss += v[i] * v[i];
          ss += __shfl_xor(ss, 1); ss += __shfl_xor(ss, 2); ss += __shfl_xor(ss, 4);
          const float ss8 = ss;
          ss += __shfl_xor(ss, 8); ss += __shfl_xor(ss, 16);
          if (lane < 16) {
              const float rstd = __builtin_amdgcn_rsqf(ss8 * (1.f / 64.f) + EPS);
#pragma unroll
              for (int i = 0; i < 8; ++i) v[i] = v[i] * rstd * gkv[i];
              rope4(v, tabg + ((size_t)s * 32 + 4 * (lane & 7)) * 2);
              v4u o; PACK8(v, o); *(GAS v4u*)(WSP(bf16, WS_KG) + (size_t)m * 128 + 8 * lane) = o;
          } else if (lane < 32) {
              *(GAS v4u*)(WSP(bf16, WS_VG) + (size_t)m * 128 + 8 * (lane - 16)) = w;
          } else {
              const float rstd = __builtin_amdgcn_rsqf(ss * (1.f / 256.f) + EPS);
#pragma unroll
              for (int i = 0; i < 8; ++i) v[i] *= rstd;
              v4u o; PACK8(v, o); *(GAS v4u*)(WSP(bf16, WS_LAT) + (size_t)m * 512 + 8 * (lane - 32)) = o;
          } }
        { const v4u w = wc;
          float v[8]; UNPACK8(w, v);
          float ss = 0.f;
#pragma unroll
          for (int i = 0; i < 8; ++i) ss += v[i] * v[i];
          ss += __shfl_xor(ss, 1); ss += __shfl_xor(ss, 2); ss += __shfl_xor(ss, 4); ss += __shfl_xor(ss, 8);
          if (lane < 16) {
              const float rstd = __builtin_amdgcn_rsqf(ss * (1.f / 128.f) + EPS);
#pragma unroll
              for (int i = 0; i < 8; ++i) v[i] *= rstd;
              v4u o; PACK8(v, o); *(GAS v4u*)(WSP(bf16, WS_LAT) + (size_t)m * 512 + 256 + 8 * lane) = o;
          } else if (lane < 20) {
              rope4(v, tabm + ((size_t)s * 16 + 4 * (lane - 16)) * 2);
              v4u o; PACK8(v, o); *(GAS v4u*)(WSP(bf16, WS_KROPE) + (size_t)m * 32 + 8 * (lane - 16)) = o;
          } else if (lane < 36) {
              *(GAS v4u*)(WSP(bf16, WS_LAT) + (size_t)m * 512 + 384 + 8 * (lane - 20)) = (v4u){0u, 0u, 0u, 0u};
          } }
    }
}

__device__ __forceinline__ void phase_outnorm(const Ctx& F) {
    int lane_ = F.lane; asm volatile("" : "+v"(lane_)); const int lane = lane_;
    for (int m = F.gw; m < MTOK; m += F.NGW) {
        bf16* orow = WSP(bf16, WS_O) + (size_t)m * DM;
#pragma unroll
        for (int g = 0; g < 2; ++g) {
            v4u w = *(const GAS v4u*)(orow + g * 512 + 8 * lane); float v[8]; UNPACK8(w, v);
            float ss = 0.f;
#pragma unroll
            for (int i = 0; i < 8; ++i) ss += v[i] * v[i];
            const float rstd = __builtin_amdgcn_rsqf(wave_sum(ss) * (1.f / 512.f) + EPS);
#pragma unroll
            for (int i = 0; i < 8; ++i) v[i] *= rstd;
            v4u o; PACK8(v, o); *(GAS v4u*)(orow + g * 512 + 8 * lane) = o;
        }
    }
}

__device__ __forceinline__ void phase_router(const Ctx& F, int l) {
    int lane_ = F.lane; asm volatile("" : "+v"(lane_)); const int lane = lane_;
    LAS float* wr = (LAS float*)F.lds;
    { const GAS f32x4* src = (const GAS f32x4*)(WSP(float, WS_WR) + (size_t)l * NEXP * DM);
      for (int i = F.tid; i < NEXP * DM / 4; i += NWAVES * 64) ((LAS f32x4*)wr)[i] = src[i]; }
    __syncthreads();
    for (int mp = F.gw; mp < MTOK / 2; mp += F.NGW) {
        const int m = 2 * mp;
        asm volatile("" ::: "memory");
        typedef unsigned u32x2 __attribute__((ext_vector_type(2)));
        const GAS u32x2* xr0 = (const GAS u32x2*)(F.x + (size_t)m * DM) + lane; const GAS u32x2* xr1 = xr0 + DM / 4;
        f32x4 v0[4], v1[4]; float s0 = 0.f, s1 = 0.f;
#pragma unroll
        for (int j = 0; j < 4; ++j) { const u32x2 q0 = xr0[64 * j], q1 = xr1[64 * j];
            v0[j] = (f32x4){bflo(q0.x), bfhi(q0.x), bflo(q0.y), bfhi(q0.y)}; v1[j] = (f32x4){bflo(q1.x), bfhi(q1.x), bflo(q1.y), bfhi(q1.y)}; }
#pragma unroll
        for (int j = 0; j < 4; ++j) { s0 += (v0[j].x * v0[j].x + v0[j].y * v0[j].y) + (v0[j].z * v0[j].z + v0[j].w * v0[j].w); s1 += (v1[j].x * v1[j].x + v1[j].y * v1[j].y) + (v1[j].z * v1[j].z + v1[j].w * v1[j].w); }
        const float rstd0 = __builtin_amdgcn_rsqf(wave_sum(s0) * (1.f / DM) + EPS), rstd1 = __builtin_amdgcn_rsqf(wave_sum(s1) * (1.f / DM) + EPS);
        if (lane == 0) { WSP(float, WS_RS3)[m] = rstd0; WSP(float, WS_RS3)[m + 1] = rstd1; }
        float a0[16], a1[16];
#pragma unroll
        for (int e = 0; e < 16; ++e) { float p = 0.f, q = 0.f;
#pragma unroll
            for (int j = 0; j < 4; ++j) { const f32x4 w = *((const LAS f32x4*)(wr + e * DM) + lane + 64 * j);
                p += (v0[j].x * w.x + v0[j].y * w.y) + (v0[j].z * w.z + v0[j].w * w.w); q += (v1[j].x * w.x + v1[j].y * w.y) + (v1[j].z * w.z + v1[j].w * w.w); }
            a0[e] = p; a1[e] = q; }
        float t16[16];
#pragma unroll
        for (int e = 0; e < 16; ++e) { const float send = (lane & 32) ? a0[e] : a1[e], keep = (lane & 32) ? a1[e] : a0[e]; t16[e] = keep + __shfl_xor(send, 32); }
        float t8[8];
#pragma unroll
        for (int e = 0; e < 8; ++e) { const float send = (lane & 16) ? t16[e] : t16[e + 8], keep = (lane & 16) ? t16[e + 8] : t16[e]; t8[e] = keep + __shfl_xor(send, 16); }
        float t4[4];
#pragma unroll
        for (int e = 0; e < 4; ++e) { const float send = (lane & 8) ? t8[e] : t8[e + 4], keep = (lane & 8) ? t8[e + 4] : t8[e]; t4[e] = keep + __shfl_xor(send, 8); }
        float t2[2];
#pragma unroll
        for (int e = 0; e < 2; ++e) { const float send = (lane & 4) ? t4[e] : t4[e + 2], keep = (lane & 4) ? t4[e + 2] : t4[e]; t2[e] = keep + __shfl_xor(send, 4); }
        float lg; { const float send = (lane & 2) ? t2[0] : t2[1], keep = (lane & 2) ? t2[1] : t2[0]; lg = keep + __shfl_xor(send, 2); }
        lg += __shfl_xor(lg, 1);
        lg *= (lane & 32) ? rstd1 : rstd0;
        float mx = lg;
        mx = fmaxf(mx, __shfl_xor(mx, 2)); mx = fmaxf(mx, __shfl_xor(mx, 4)); mx = fmaxf(mx, __shfl_xor(mx, 8)); mx = fmaxf(mx, __shfl_xor(mx, 16));
        const float ex = __expf(lg - mx);
        float den = ex; den += __shfl_xor(den, 2); den += __shfl_xor(den, 4); den += __shfl_xor(den, 8); den += __shfl_xor(den, 16);
        const float mine = ex / den;
        if ((lane & 1) == 0) { const int row = m + (lane >> 5), e = (lane >> 1) & 15;
            WSP(float, WS_AFF)[(size_t)row * 16 + e] = mine;
            WSP(float, WS_AFFT)[((size_t)(row >> 12) * 16 + e) * SEQ + (row & (SEQ - 1))] = mine; }
    }
    __syncthreads();
}

__device__ __forceinline__ int block_excl_scan(int v, LAS int* red, int lane, int wave, int& total) {
    int inc = v;
#pragma unroll
    for (int o = 1; o < 64; o <<= 1) { const int t = __shfl_up(inc, o); if (lane >= o) inc += t; }
    __syncthreads();
    if (lane == 63) red[wave] = inc;
    __syncthreads();
    int base = 0, tot = 0;
#pragma unroll
    for (int w = 0; w < 8; ++w) { const int t = red[w]; if (w < wave) base += t; tot += t; }
    total = tot;
    return base + inc - v;
}
__device__ __forceinline__ void phase_select(const Ctx& F, const Args& A, int l) {
    LAS int* red = (LAS int*)F.lds;
    int tid_ = F.tid; asm volatile("" : "+v"(tid_)); const int tid = tid_, lane = tid & 63, wave = F.wave;
    for (int pair = F.vcu; pair < BATCH * NEXP; pair += F.G) {
        const int b = pair >> 4, e = pair & 15;
        const GAS v4u* src = (const GAS v4u*)(WSP(float, WS_AFFT) + (size_t)pair * SEQ) + 2 * tid;
        const v4u w0 = src[0], w1 = src[1];
        unsigned v[8] = {w0.x, w0.y, w0.z, w0.w, w1.x, w1.y, w1.z, w1.w};
        unsigned T = 0u; int par = 0;
        for (int bit = 30; bit >= 0; --bit) {
            const unsigned cand = T | (1u << bit);
            int c = 0;
#pragma unroll
            for (int i = 0; i < 8; ++i) c += (v[i] >= cand) ? 1 : 0;
            c = wave_sum_i(c);
            if (lane == 0) red[par * 8 + wave] = c;
            __syncthreads();
            int tot = 0;
#pragma unroll
            for (int w = 0; w < 8; ++w) tot += red[par * 8 + w];
            if (tot >= CAP) T = cand;
            par ^= 1;
        }
        int cgt = 0, ceq = 0;
#pragma unroll
        for (int i = 0; i < 8; ++i) { cgt += (v[i] > T) ? 1 : 0; ceq += (v[i] == T) ? 1 : 0; }
        int ngt, neq_tot;
        (void)block_excl_scan(cgt, red + 16, lane, wave, ngt);
        int eqb = block_excl_scan(ceq, red + 16, lane, wave, neq_tot);
        const int need_eq = CAP - ngt;
        int sel[8], csel = 0;
#pragma unroll
        for (int i = 0; i < 8; ++i) { const bool iseq = (v[i] == T); sel[i] = ((v[i] > T) || (iseq && eqb < need_eq)) ? 1 : 0; eqb += iseq ? 1 : 0; csel += sel[i]; }
        int nsel;
        int pos = block_excl_scan(csel, red + 16, lane, wave, nsel);
        int* idx = WSP(int, WS_IDX) + (size_t)(e * BATCH + b) * CAP; float* rg = WSP(float, WS_RG) + (size_t)(e * BATCH + b) * CAP; const float* rs3 = WSP(float, WS_RS3) + (size_t)b * SEQ;
        int* slot = WSP(int, WS_SLOT) + ((size_t)b * SEQ + (size_t)tid * 8) * NEXP + e;
#pragma unroll
        for (int i = 0; i < 8; ++i) { if (sel[i]) { if (pos < CAP) { idx[pos] = tid * 8 + i; rg[pos] = rs3[tid * 8 + i]; } slot[i * NEXP] = pos; ++pos; } else slot[i * NEXP] = -1; }
        __syncthreads();
    }
    if (l + 1 < DEPTH) {
        const bool split = F.G > BATCH * NEXP; const int nw = split ? (F.G - BATCH * NEXP) * NWAVES : F.NGW, wi = split ? (F.vcu - BATCH * NEXP) * NWAVES + F.wave : F.gw;
        LAS float* scr = (LAS float*)(F.lds + F.wave * 16640);
        if (wi >= 0) for (int it = wi; it < MOE_ITEMS; it += nw) moe_weight_item(F, A, l + 1, it, scr);
    }
}

__device__ __forceinline__ void phase_gather(const Ctx& F) {
    int lane_ = F.lane; asm volatile("" : "+v"(lane_)); const int lane = lane_;
    for (int r = F.gw; r < MOE_ROWS; r += F.NGW) {
        const int b = (r >> 9) & 7; const int t = WSP(int, WS_IDX)[r];
        const GAS v4u* src = (const GAS v4u*)(WSP(bf16, WS_H) + ((size_t)b * SEQ + t) * DM) + lane;
        GAS v4u* dst = (GAS v4u*)(WSP(bf16, WS_XG) + (size_t)r * DM) + lane;
        const v4u a = src[0], c = src[64]; dst[0] = a; dst[64] = c;
    }
}

__device__ __forceinline__ void phase_combine(const Ctx& F, const Args& A, int l, float amul) {
    int lane_ = F.lane; asm volatile("" : "+v"(lane_)); const int lane = lane_; const bool lastl = (l == DEPTH - 1);
    const float* gfin = WSP(float, WS_GAINS) + 512;
    v4u xa_n = (v4u){0u, 0u, 0u, 0u}, xc_n = xa_n; int sl_n = -1; float af_n = 0.f;
    if (F.gw < MTOK) { const GAS v4u* xp = (const GAS v4u*)(F.x + (size_t)F.gw * DM) + lane; xa_n = xp[0]; xc_n = xp[64];
        sl_n = WSP(int, WS_SLOT)[(size_t)F.gw * NEXP + (lane & 15)]; af_n = WSP(float, WS_AFF)[(size_t)F.gw * NEXP + (lane & 15)]; }
    for (int m = F.gw; m < MTOK; m += F.NGW) {
        const int b = m >> 12;
        GAS v4u* xr = (GAS v4u*)(F.x + (size_t)m * DM) + lane;
        const v4u xa = xa_n, xc = xc_n; const int sl = sl_n; const float af = amul * af_n;
        if (m + F.NGW < MTOK) { const int mn = m + F.NGW; const GAS v4u* xp = (const GAS v4u*)(F.x + (size_t)mn * DM) + lane; xa_n = xp[0]; xc_n = xp[64];
            sl_n = WSP(int, WS_SLOT)[(size_t)mn * NEXP + (lane & 15)]; af_n = WSP(float, WS_AFF)[(size_t)mn * NEXP + (lane & 15)]; }
        f32x4 x0 = (f32x4){bflo(xa.x), bfhi(xa.x), bflo(xa.y), bfhi(xa.y)}, x1 = (f32x4){bflo(xa.z), bfhi(xa.z), bflo(xa.w), bfhi(xa.w)};
        f32x4 x2 = (f32x4){bflo(xc.x), bfhi(xc.x), bflo(xc.y), bfhi(xc.y)}, x3 = (f32x4){bflo(xc.z), bfhi(xc.z), bflo(xc.w), bfhi(xc.w)};
        unsigned mask = (unsigned)(__ballot(sl >= 0 && lane < 16));
#define CMB_ACC(Y0, Y1, AE) do { x0.x += AE * bflo(Y0.x); x0.y += AE * bfhi(Y0.x); x0.z += AE * bflo(Y0.y); x0.w += AE * bfhi(Y0.y); \
            x1.x += AE * bflo(Y0.z); x1.y += AE * bfhi(Y0.z); x1.z += AE * bflo(Y0.w); x1.w += AE * bfhi(Y0.w); \
            x2.x += AE * bflo(Y1.x); x2.y += AE * bfhi(Y1.x); x2.z += AE * bflo(Y1.y); x2.w += AE * bfhi(Y1.y); \
            x3.x += AE * bflo(Y1.z); x3.y += AE * bfhi(Y1.z); x3.z += AE * bflo(Y1.w); x3.w += AE * bfhi(Y1.w); } while (0)
        while (mask) {
            const int e1 = __builtin_ctz(mask); mask &= mask - 1u;
            const bool two = mask != 0u; const int e2 = two ? __builtin_ctz(mask) : e1; if (two) mask &= mask - 1u;
            const int s1 = __shfl(sl, e1), s2 = __shfl(sl, e2); const float a1 = __shfl(af, e1), a2 = two ? __shfl(af, e2) : 0.f;
            const GAS v4u* yr1 = (const GAS v4u*)(WSP(bf16, WS_Y) + ((size_t)(e1 * BATCH + b) * CAP + s1) * DM) + lane;
            const GAS v4u* yr2 = (const GAS v4u*)(WSP(bf16, WS_Y) + ((size_t)(e2 * BATCH + b) * CAP + s2) * DM) + lane;
            const v4u y0 = yr1[0], y1 = yr1[64], z0 = yr2[0], z1 = yr2[64];
            CMB_ACC(y0, y1, a1); CMB_ACC(z0, z1, a2);
        }
#undef CMB_ACC
        float s = (x0.x * x0.x + x0.y * x0.y) + (x0.z * x0.z + x0.w * x0.w) + (x1.x * x1.x + x1.y * x1.y) + (x1.z * x1.z + x1.w * x1.w)
                + (x2.x * x2.x + x2.y * x2.y) + (x2.z * x2.z + x2.w * x2.w) + (x3.x * x3.x + x3.y * x3.y) + (x3.z * x3.z + x3.w * x3.w);
        const float rstd = __builtin_amdgcn_rsqf(wave_sum(s) * (1.f / DM) + EPS);
        if (lastl) {
            const f32x4 g0 = *(const f32x4*)(gfin + 8 * lane), g1 = *(const f32x4*)(gfin + 8 * lane + 4), g2 = *(const f32x4*)(gfin + 512 + 8 * lane), g3 = *(const f32x4*)(gfin + 512 + 8 * lane + 4);
            GAS f32x4* ow = (GAS f32x4*)(F.out + (size_t)m * DM);
            ow[2 * lane] = x0 * rstd * g0; ow[2 * lane + 1] = x1 * rstd * g1; ow[128 + 2 * lane] = x2 * rstd * g2; ow[128 + 2 * lane + 1] = x3 * rstd * g3;
        } else {
            v4u n0, n1; n0.x = pk2(x0.x, x0.y); n0.y = pk2(x0.z, x0.w); n0.z = pk2(x1.x, x1.y); n0.w = pk2(x1.z, x1.w); n1.x = pk2(x2.x, x2.y); n1.y = pk2(x2.z, x2.w); n1.z = pk2(x3.x, x3.y); n1.w = pk2(x3.z, x3.w);
            xr[0] = n0; xr[64] = n1;
            if (lane == 0) WSP(float, WS_RS1)[m] = rstd;
        }
    }
}

__device__ __forceinline__ void phase_attn_self(const Ctx& F, int l) {
    float gmq = fabsf(WSP(float, WS_GAINS)[l * 64 + F.lane]), gmk = fabsf(WSP(float, WS_GAINS)[256 + l * 64 + F.lane]);
#pragma unroll
    for (int o = 1; o < 64; o <<= 1) { gmq = fmaxf(gmq, __shfl_xor(gmq, o)); gmk = fmaxf(gmk, __shfl_xor(gmk, o)); }
    const bool bounded = (8.0f * LOG2E * gmq * gmk) < 64.0f;
    const int lane = F.lane, r32 = lane & 31, hi = lane >> 5, wid = F.wave;
#ifndef DUPATT
#define DUPATT 0
#endif
    for (int g = 0; g < 2; ++g)
      for (int rep2_ = 0; rep2_ < 1 + ((DUPATT >> g) & 1); ++rep2_)
        for (int u = F.vcu; u < 256; u += F.G) {
            const int b = u >> 5, qb = (u >> 1) & 15, hh = u & 1;
            const size_t r0 = (size_t)b * SEQ, q0 = r0 + (size_t)qb * 256;
            float ssacc[16];
#pragma unroll
            for (int r = 0; r < 16; ++r) ssacc[r] = 0.f;
            for (int hq = 0; hq < 4; ++hq) {
                const int h = hh * 4 + hq;
                if (g == 0) {
                    if (bounded) att::attn_unit<64, 0, 64, 1, true>(WSP(bf16, WS_QG) + q0 * 512 + h * 64, nullptr, 512, WSP(bf16, WS_KG) + r0 * 128 + hh * 64, 128, nullptr, 0,
                                              WSP(bf16, WS_VG) + r0 * 128 + hh * 64, 128, WSP(bf16, WS_O) + q0 * DM + h * 64, DM, SEQ, F.ldsg, ssacc);
                    else         att::attn_unit<64, 0, 64, 0, true>(WSP(bf16, WS_QG) + q0 * 512 + h * 64, nullptr, 512, WSP(bf16, WS_KG) + r0 * 128 + hh * 64, 128, nullptr, 0,
                                              WSP(bf16, WS_VG) + r0 * 128 + hh * 64, 128, WSP(bf16, WS_O) + q0 * DM + h * 64, DM, SEQ, F.ldsg, ssacc);
                } else {
                    att::attn_unit<64, 32, 64, 0, true>(WSP(bf16, WS_QM) + q0 * 768 + h * 64, WSP(bf16, WS_QM) + q0 * 768 + 512 + h * 32, 768, WSP(bf16, WS_KVM) + r0 * DM + h * 128, DM, WSP(bf16, WS_KROPE) + r0 * 32, 32,
                                               WSP(bf16, WS_KVM) + r0 * DM + h * 128 + 64, DM, WSP(bf16, WS_O) + q0 * DM + 512 + h * 64, DM, SEQ, F.ldsg, ssacc);
                }
            }
#pragma unroll
            for (int r = 0; r < 16; ++r) { float s = ssacc[r];
                s += __shfl_xor(s, 1); s += __shfl_xor(s, 2); s += __shfl_xor(s, 4); s += __shfl_xor(s, 8); s += __shfl_xor(s, 16);
                if (r32 == 0) WSP(float, WS_SSO)[(q0 + wid * 32 + att::crow(r, hi)) * 4 + g * 2 + hh] = s; }
        }
}
__device__ __forceinline__ void phase_attn_mem(const Ctx& F, int l) {
    const bf16* kv = WSP(bf16, WS_MEMKV) + (size_t)l * MROWS * DM; float dummy[16];
    for (int idx = F.vcu; idx < 256; idx += F.G) {
        const int pm = idx >> 1, pn = idx & 1, b = pm >> 4;
        const size_t q0 = (size_t)pm * 256, k0 = (size_t)b * MEM_T;
        for (int hh = 0; hh < 2; ++hh) { const int h = 2 * pn + hh;
            att::attn_unit<128, 0, 128, 0, false>(WSP(bf16, WS_QMEM) + q0 * 512 + h * 128, nullptr, 512, kv + k0 * DM + h * 128, DM, nullptr, 0,
                                        kv + k0 * DM + 512 + h * 128, DM, WSP(bf16, WS_OMEM) + q0 * 512 + h * 128, 512, MEM_T, F.ldsg, dummy); }
    }
}

__global__ void __launch_bounds__(NWAVES * 64, 2) enc_fwd(Args args) {
    extern __shared__ __attribute__((aligned(16))) unsigned char lds[];
    Ctx F;
    F.lds = (LAS unsigned char*)lds; F.ldsg = (char*)lds;
    F.tid = threadIdx.x; F.lane = F.tid & 63; F.wave = __builtin_amdgcn_readfirstlane(F.tid >> 6);
    F.G = gridDim.x; F.G0 = F.G; { const int bx = blockIdx.x; F.vcu0 = (F.G % 8 == 0) ? (bx % 8) * (F.G / 8) + bx / 8 : bx; F.vcu = F.vcu0; }
    F.gw = F.vcu * NWAVES + F.wave; F.NGW = F.G * NWAVES;
    F.out = args.out; F.ws = args.ws; F.x = (bf16*)(args.ws + WS_X);
    volatile LAS unsigned* MISC = (volatile LAS unsigned*)(F.lds + MISC_OFF);
    for (int u = F.tid; u < (LDS_BYTES - LDSCTL_OFF) / 4; u += NWAVES * 64) ((LAS unsigned*)(F.lds + LDSCTL_OFF))[u] = 0u;
    __syncthreads();
    XcdBarrier bar; bar.bar = (unsigned*)(F.ws + WS_CTL) + CW_BAR; bar.x = 0; bar.st = nullptr;
    if (MK_N_LAUNCHES == 1) bar = xcd_barrier_post((unsigned*)(F.ws + WS_CTL) + CW_BAR, MISC + 8);
    const int lo = args.ph_lo, hi = args.ph_hi;
#ifndef ONLY_SITE
#define ONLY_SITE -1
#endif
#define ON(s) (ONLY_SITE < 0 || ONLY_SITE == (s))
#ifndef DUPMASK
#define DUPMASK 0u
#endif
#define REP(s) for (int rep_ = 0; rep_ < 1 + (int)((DUPMASK >> (s)) & 1u); ++rep_)
#define IN(k) (lo <= (k) && (k) < hi)
#define SEAM(k) do { if (IN(k) && IN((k) + 1)) xcd_barrier(bar); } while (0)
#define LOCAL_SEAM() do { asm volatile("s_waitcnt vmcnt(0)" ::: "memory"); __syncthreads(); __builtin_amdgcn_fence(__ATOMIC_ACQUIRE, "agent"); asm volatile("s_waitcnt vmcnt(0)" ::: "memory"); __syncthreads(); } while (0)
#define GEMM(EpiT, epi, Ap, lda_, Bp, ldb_, K_, nM_, nN_, gdiv_, gstride_) do { const pg8::Gemm g_{(const bf16*)(Ap), (const bf16*)(Bp), lda_, ldb_, K_, gdiv_, 1 << 30, (size_t)(gstride_), nullptr, nullptr}; \
        pg8::StaticOrder S_; S_.init(nM_, nN_, F.G, (int)blockIdx.x); pg8::gemm_phase<EpiT, pg8::StaticOrder, true>(F.lds, g_, S_, epi); } while (0)

    #ifndef PRODUP
#define PRODUP 0
#endif
    if (ON(100) && IN(0)) for (int rp_ = 0; rp_ <= PRODUP; ++rp_) { refresh(F); phase_prologue(F, args); }
    SEAM(0);
    if (ON(101) && IN(1)) {
        pg8::EpiBf16 E{WSP(bf16, WS_MEMKV), DM, 1.0f, nullptr, nullptr, 0.f, 0.f};
        const pg8::Gemm g_{WSP(bf16, WS_MEMN), WSP(bf16, WS_WSMALL + OFF_WMKV), DM, DM, DM, MROWS / 256, MROWS / 256, (size_t)(WSMALL_STRIDE / 2), nullptr, nullptr};
        pg8::StaticOrder S_; S_.init(DEPTH * MROWS / 256, DM / 256, F.G, (int)blockIdx.x); pg8::gemm_phase<pg8::EpiBf16, pg8::StaticOrder, true>(F.lds, g_, S_, E); }
    SEAM(1);
    for (int l = 0; l < DEPTH; ++l) {
        const int pb = 2 + 16 * l;
        unsigned char* wl = F.ws + WS_WSMALL + (size_t)l * WSMALL_STRIDE;
        if (ON(0) && IN(pb + 0)) REP(0) if (refresh(F), true) {
            pg8::EpiInProj E{WSP(float, WS_RS1), WSP(float, WS_GAINS) + l * 64, WSP(float, WS_GAINS) + 256 + l * 64, WSP(float, WS_TABG), WSP(float, WS_TABM),
                             WSP(bf16, WS_QG), WSP(bf16, WS_KG), WSP(bf16, WS_VG), WSP(bf16, WS_LAT), WSP(bf16, WS_KROPE), WSP(float, WS_SSL), 0.125f * LOG2E, EPS};
            GEMM(pg8::EpiInProj, E, F.x, DM, wl + OFF_WIN, DM, DM, MTOK / 256, IN_WP / 256, 1, 0); }
        SEAM(pb + 0);
        if ((ON(2) || ON(16) || ON(17)) && IN(pb + 2)) REP(2) { refresh(F);
            if (ON(2) || ON(17)) { pg8::EpiQmRope E{WSP(bf16, WS_QM), 768, 0.10206207261596577f * LOG2E, WSP(float, WS_TABM), WSP(float, WS_SSL), 1.0f / 256.0f, EPS}; GEMM(pg8::EpiQmRope, E, WSP(bf16, WS_LAT), 512, wl + OFF_WQB, 256, 256, MTOK / 256, 3, 1, 0); }
            if (ON(2) || ON(16)) { pg8::EpiBf16 E{WSP(bf16, WS_KVM), DM, 1.0f, nullptr, WSP(float, WS_SSL) + 4, 1.0f / 128.0f, EPS}; GEMM(pg8::EpiBf16, E, WSP(bf16, WS_LAT) + 256, 512, wl + OFF_WKVB, 128, 128, MTOK / 256, 4, 1, 0); } }
        SEAM(pb + 2);
        if (ON(3) && IN(pb + 3)) REP(3) if (refresh(F), true) phase_attn_self(F, l);
        SEAM(pb + 3);
        if (ON(5) && IN(pb + 5)) REP(5) if (refresh(F), true) {
            pg8::EpiResidualX E{F.x, WSP(float, WS_SSX), DM, 1.0f / 512.0f, EPS, rep_ ? 0.f : 1.f};
            const pg8::Gemm g_{WSP(bf16, WS_O), (const bf16*)(wl + OFF_WO), DM, DM, DM, 1, 1 << 30, 0, nullptr, WSP(float, WS_SSO)};
            pg8::StaticOrder S_; S_.init(MTOK / 256, 4, F.G, (int)blockIdx.x); pg8::gemm_phase<pg8::EpiResidualX, pg8::StaticOrder, true, false, true>(F.lds, g_, S_, E, F.lds + STAB_OFF, 1.0f / 512.0f, EPS); }
        SEAM(pb + 5);
        if (ON(7) && IN(pb + 7)) REP(7) if (refresh(F), true) { pg8::EpiBf16RowNorm E{WSP(bf16, WS_QMEM), 512, 0.08838834764831845f * LOG2E, WSP(float, WS_SSX), 1.0f / DM, EPS}; GEMM(pg8::EpiBf16RowNorm, E, F.x, DM, wl + OFF_WMQ, DM, DM, MTOK / 256, 2, 1, 0); }
        SEAM(pb + 7);
        if (ON(8) && IN(pb + 8)) REP(8) if (refresh(F), true) phase_attn_mem(F, l);
        SEAM(pb + 8);
        if (ON(9) && IN(pb + 9)) REP(9) if (refresh(F), true) { pg8::EpiResidual E{F.x, DM, rep_ ? 0.f : 1.f}; GEMM(pg8::EpiResidual, E, WSP(bf16, WS_OMEM), 512, wl + OFF_WMO, 512, 512, MTOK / 256, 4, 1, 0); }
        SEAM(pb + 9);
        if (ON(10) && IN(pb + 10)) REP(10) if (refresh(F), true) phase_router(F, l);
        SEAM(pb + 10);
        if (ON(11) && IN(pb + 11)) REP(11) if (refresh(F), true) phase_select(F, args, l);
        SEAM(pb + 11);
        if (ON(13) && IN(pb + 13)) REP(13) if (refresh(F), true) { pg8::EpiSwiGLU E{WSP(bf16, WS_ACT), EFF, WSP(float, WS_RG)};
            const pg8::Gemm g_{F.x, WSP(bf16, (l & 1) ? WS_WGU2 : WS_WGU), DM, DM, DM, 16, 1 << 30, (size_t)(1024 * 1024), WSP(int, WS_IDX), nullptr};
            pg8::StaticOrder S_; S_.init(MOE_ROWS / 256, 4, F.G, (int)blockIdx.x); pg8::gemm_phase<pg8::EpiSwiGLU, pg8::StaticOrder, true, true>(F.lds, g_, S_, E, F.lds + GTAB_OFF); }
        SEAM(pb + 13);
        if (ON(14) && IN(pb + 14)) REP(14) if (refresh(F), true) { pg8::EpiBf16 E{WSP(bf16, WS_Y), DM, 1.0f, nullptr, nullptr, 0.f, 0.f}; GEMM(pg8::EpiBf16, E, WSP(bf16, WS_ACT), EFF, WSP(bf16, (l & 1) ? WS_WD2 : WS_WD), EFF, EFF, MOE_ROWS / 256, 4, 16, 1024 * 512); }
        SEAM(pb + 14);
        if (ON(15) && IN(pb + 15)) REP(15) if (refresh(F), true) phase_combine(F, args, l, (rep_ && l < DEPTH - 1) ? 0.f : 1.f);
        SEAM(pb + 15);
    }
#undef IN
#undef SEAM
#undef GEMM
}

extern "C" void kernel_launch(void* const* d_in, const int* in_sizes, int n_in, void* d_out, int out_size, void* d_ws, size_t ws_size, hipStream_t stream) {
    static int grid = 0;
    if (grid == 0) {
        if (n_in != 24 || out_size != MTOK * DM || ws_size < WS_END) { fprintf(stderr, "kernel_launch: unexpected shapes: n_in %d out %d ws %zu (need %zu)\n", n_in, out_size, ws_size, (size_t)WS_END); grid = -1; return; }
        int dev = 0, cus = 0, per_cu = 0;
        if (hipGetDevice(&dev) != hipSuccess || hipDeviceGetAttribute(&cus, hipDeviceAttributeMultiprocessorCount, dev) != hipSuccess) { grid = -1; return; }
        if (hipFuncSetAttribute((const void*)enc_fwd, hipFuncAttributeMaxDynamicSharedMemorySize, LDS_BYTES) != hipSuccess) { fprintf(stderr, "kernel_launch: hipFuncSetAttribute failed\n"); grid = -1; return; }
        if (hipOccupancyMaxActiveBlocksPerMultiprocessor(&per_cu, (const void*)enc_fwd, NWAVES * 64, LDS_BYTES) != hipSuccess || per_cu < 1)
            fprintf(stderr, "kernel_launch: occupancy query reports %d workgroups per CU\n", per_cu);
        (void)hipGetLastError();
        grid = cus;
        fprintf(stderr, "kernel_launch: grid %d, ws %zu bytes\n", grid, ws_size);
    }
    if (grid < 0) return;
    (void)hipMemsetAsync((char*)d_ws + WS_CTL, 0, CTL_ZERO_BYTES, stream);
    Args a{};
    for (int i = 0; i < 24; ++i) a.in[i] = (const float*)d_in[i];
    a.out = (float*)d_out; a.ws = (unsigned char*)d_ws;
#if MK_N_LAUNCHES == 1
    a.ph_lo = 0; a.ph_hi = NPH;
    hipLaunchKernelGGL(enc_fwd, dim3(grid), dim3(NWAVES * 64), LDS_BYTES, stream, a);
#else
    for (int p = 0; p < NPH; ++p) { a.ph_lo = p; a.ph_hi = p + 1; hipLaunchKernelGGL(enc_fwd, dim3(grid), dim3(NWAVES * 64), LDS_BYTES, stream, a); }
#endif
    const hipError_t le = hipPeekAtLastError();
    if (le != hipSuccess) fprintf(stderr, "kernel_launch: launch failed: %s\n", hipGetErrorName(le));
}
```

```cpp
#include <hip/hip_runtime.h>
#include <cstdio>
#include <cstdint>

namespace pg8 {
#define PG8_LAS __attribute__((address_space(3)))
typedef unsigned short bf16_t;
typedef short bf16x8 __attribute__((ext_vector_type(8)));
typedef float f32x4 __attribute__((ext_vector_type(4)));
typedef unsigned u32x4 __attribute__((ext_vector_type(4)));
constexpr int BM = 256, BK = 64, HALF = 128, HTB = HALF * BK * 2  , STAGE_BYTES = 8 * HTB, NXCD = 8, WGM = 8;

__host__ __device__ __forceinline__ int lds_byte(int r, int c) { const int st = (r >> 4) * 2 + (c >> 5), rr = r & 15, cc = c & 31, ob = rr * 64 + cc * 2; return st * 1024 + (ob ^ (((ob >> 9) & 1) << 5)); }
__host__ __device__ __forceinline__ void stage_rc(int b, int& R, int& C) { const int st = b / 1024, sb = b % 1024, swz = sb ^ (((sb >> 9) & 1) << 5); R = (st >> 1) * 16 + swz / 64; C = (st & 1) * 32 + (swz % 64) / 2; }
__host__ __device__ __forceinline__ int perm32(int rho) { const int n = rho >> 4, i = rho & 15; return 8 * (i >> 2) + 4 * n + (i & 3); }

struct Unit { int pm, pn; };
struct Gemm { const bf16_t* A; const bf16_t* Bt; int lda, ldb, K, gdiv, amod; size_t gstride; const int* idx; const float* ss; };

struct StaticOrder {
    int nM, nN, nwg, G, c;
    __host__ __device__ void init(int nM_, int nN_, int G_, int c_) { nM = nM_; nN = nN_; nwg = nM * nN; G = G_; c = c_; }
    __host__ __device__ bool next(int i, Unit& u) const {
        const long L = (long)i * G + c; if (L >= nwg) return false;
        int wgid = (int)L; { const int q = nwg / NXCD, r = nwg % NXCD, xcd = wgid % NXCD, off = wgid / NXCD; wgid = (xcd < r ? xcd * (q + 1) : r * (q + 1) + (xcd - r) * q) + off; }
        const int nig = WGM * nN, gid = wgid / nig, fm = gid * WGM, gsz = (nM - fm) < WGM ? (nM - fm) : WGM;
        u.pm = fm + ((wgid % nig) % gsz); u.pn = (wgid % nig) / gsz; return true;
    }
};

struct LinearOrder {
    int nM, nN, G, c, per;
    __host__ __device__ void init(int nM_, int nN_, int G_, int c_, int per_) { nM = nM_; nN = nN_; G = G_; c = c_; per = per_; }
    __host__ __device__ bool next(int i, Unit& u) const { const int idx = (c + (i / per) * G) * per + (i % per); if (idx >= nM * nN) return false; u.pm = idx / nN; u.pn = idx % nN; return true; }
};

__device__ __forceinline__ unsigned cvt_pk_bf16(float lo, float hi) { unsigned r; asm volatile("v_cvt_pk_bf16_f32 %0, %1, %2" : "=v"(r) : "v"(lo), "v"(hi)); return r; }

struct EpiBf16 {
    static constexpr bool PERM = true;
    bf16_t* O; int ldc; float scale; const float* rs; const float* ssl; float ssl_inv, ssl_eps;
    __device__ __forceinline__ void operator()(const f32x4 (&acc)[2][2][4][2], const Unit& u, int wr, int wc, int fr, int fq) const {
        const int row0 = u.pm * BM + wr * 64 + fr, col0 = u.pn * BM + wc * 32 + 8 * fq;
#pragma unroll
        for (int ai = 0; ai < 2; ++ai)
#pragma unroll
            for (int m = 0; m < 4; ++m) { const int row = row0 + ai * HALF + m * 16; bf16_t* rowp = O + (size_t)row * ldc + col0; float sc = rs ? scale * rs[row] : scale;
                if (ssl) { const f32x4 q_ = *(const f32x4*)(ssl + (size_t)row * 8); sc *= __builtin_amdgcn_rsqf(((q_[0] + q_[1]) + (q_[2] + q_[3])) * ssl_inv + ssl_eps); }
#pragma unroll
                for (int bj = 0; bj < 2; ++bj) { const f32x4 v0 = acc[ai][bj][m][0] * sc, v1 = acc[ai][bj][m][1] * sc;
                    u32x4 w; w.x = cvt_pk_bf16(v0[0], v0[1]); w.y = cvt_pk_bf16(v0[2], v0[3]); w.z = cvt_pk_bf16(v1[0], v1[1]); w.w = cvt_pk_bf16(v1[2], v1[3]);
                    *(u32x4*)(rowp + bj * HALF) = w; } }
    }
};
struct EpiQmRope {
    static constexpr bool PERM = true;
    bf16_t* O; int ldc; float scale; const float* tab; const float* ssl; float ssl_inv, ssl_eps;
    __device__ __forceinline__ void operator()(const f32x4 (&acc)[2][2][4][2], const Unit& u, int wr, int wc, int fr, int fq) const {
        const int row0 = u.pm * BM + wr * 64 + fr, col0 = u.pn * BM + wc * 32 + 8 * fq;
        const bool rope = (u.pn == 2);
        const int j0 = (8 * fq) >> 1;
#pragma unroll
        for (int ai = 0; ai < 2; ++ai)
#pragma unroll
            for (int m = 0; m < 4; ++m) { const int row = row0 + ai * HALF + m * 16; bf16_t* rowp = O + (size_t)row * ldc + col0; const int s = row & 4095;
                const f32x4 q_ = *(const f32x4*)(ssl + (size_t)row * 8); const float sc_ = scale * __builtin_amdgcn_rsqf(((q_[0] + q_[1]) + (q_[2] + q_[3])) * ssl_inv + ssl_eps);
                f32x4 t0 = (f32x4){1.f, 0.f, 1.f, 0.f}, t1 = (f32x4){1.f, 0.f, 1.f, 0.f};
                if (rope) { t0 = *(const f32x4*)(tab + ((size_t)s * 16 + j0) * 2); t1 = *(const f32x4*)(tab + ((size_t)s * 16 + j0 + 2) * 2); }
#pragma unroll
                for (int bj = 0; bj < 2; ++bj) { const f32x4 v0 = acc[ai][bj][m][0], v1 = acc[ai][bj][m][1];
                    f32x4 r0, r1;
                    r0[0] = v0[0] * t0[0] - v0[1] * t0[1]; r0[1] = v0[1] * t0[0] + v0[0] * t0[1];
                    r0[2] = v0[2] * t0[2] - v0[3] * t0[3]; r0[3] = v0[3] * t0[2] + v0[2] * t0[3];
                    r1[0] = v1[0] * t1[0] - v1[1] * t1[1]; r1[1] = v1[1] * t1[0] + v1[0] * t1[1];
                    r1[2] = v1[2] * t1[2] - v1[3] * t1[3]; r1[3] = v1[3] * t1[2] + v1[2] * t1[3];
                    r0 = r0 * sc_; r1 = r1 * sc_;
                    u32x4 w; w.x = cvt_pk_bf16(r0[0], r0[1]); w.y = cvt_pk_bf16(r0[2], r0[3]); w.z = cvt_pk_bf16(r1[0], r1[1]); w.w = cvt_pk_bf16(r1[2], r1[3]);
                    *(u32x4*)(rowp + bj * HALF) = w; }
                asm volatile("" ::: "memory"); }
    }
};
struct EpiBf16RowNorm {
    static constexpr bool PERM = true;
    bf16_t* O; int ldc; float scale; const float* ss; float inv_n, eps;
    __device__ __forceinline__ void operator()(const f32x4 (&acc)[2][2][4][2], const Unit& u, int wr, int wc, int fr, int fq) const {
        const int row0 = u.pm * BM + wr * 64 + fr, col0 = u.pn * BM + wc * 32 + 8 * fq;
#pragma unroll
        for (int ai = 0; ai < 2; ++ai)
#pragma unroll
            for (int m = 0; m < 4; ++m) { const int row = row0 + ai * HALF + m * 16; bf16_t* rowp = O + (size_t)row * ldc + col0;
                const f32x4 q0 = *(const f32x4*)(ss + (size_t)row * 16), q1 = *(const f32x4*)(ss + (size_t)row * 16 + 4), q2 = *(const f32x4*)(ss + (size_t)row * 16 + 8), q3 = *(const f32x4*)(ss + (size_t)row * 16 + 12);
                const float tot = ((((q0[0] + q0[1]) + (q0[2] + q0[3])) + ((q1[0] + q1[1]) + (q1[2] + q1[3]))) + (((q2[0] + q2[1]) + (q2[2] + q2[3])) + ((q3[0] + q3[1]) + (q3[2] + q3[3]))));
                const float sc = scale * __builtin_amdgcn_rsqf(tot * inv_n + eps);
#pragma unroll
                for (int bj = 0; bj < 2; ++bj) { const f32x4 v0 = acc[ai][bj][m][0] * sc, v1 = acc[ai][bj][m][1] * sc;
                    u32x4 w; w.x = cvt_pk_bf16(v0[0], v0[1]); w.y = cvt_pk_bf16(v0[2], v0[3]); w.z = cvt_pk_bf16(v1[0], v1[1]); w.w = cvt_pk_bf16(v1[2], v1[3]);
                    *(u32x4*)(rowp + bj * HALF) = w; } }
    }
};
__device__ __forceinline__ float bf_lo(unsigned w) { return __uint_as_float(w << 16); }
__device__ __forceinline__ float bf_hi(unsigned w) { return __uint_as_float(w & 0xffff0000u); }
struct EpiResidualX {
    static constexpr bool PERM = true;
    bf16_t* X; float* SSX; int ldc; float inv_n, eps, mul;
    __device__ __forceinline__ void operator()(const f32x4 (&acc)[2][2][4][2], const Unit& u, int wr, int wc, int fr, int fq, const PG8_LAS float* tab) const {
        const int rl0 = wr * 64 + fr, col0 = u.pn * BM + wc * 32 + 8 * fq;
#pragma unroll
        for (int ai = 0; ai < 2; ++ai)
#pragma unroll
            for (int m = 0; m < 4; ++m) { const int rl = rl0 + ai * HALF + m * 16, row = u.pm * BM + rl; bf16_t* rowp = X + (size_t)row * ldc + col0;
                const float rm = mul * __builtin_amdgcn_rsqf((tab[rl * 4 + 2] + tab[rl * 4 + 3]) * inv_n + eps);
                u32x4 xv[2]; float s = 0.f;
#pragma unroll
                for (int bj = 0; bj < 2; ++bj) xv[bj] = *(const u32x4*)(rowp + bj * HALF);
#pragma unroll
                for (int bj = 0; bj < 2; ++bj) { const f32x4 a0 = acc[ai][bj][m][0] * rm, a1 = acc[ai][bj][m][1] * rm; u32x4 w;
                    w.x = cvt_pk_bf16(bf_lo(xv[bj].x) + a0[0], bf_hi(xv[bj].x) + a0[1]); w.y = cvt_pk_bf16(bf_lo(xv[bj].y) + a0[2], bf_hi(xv[bj].y) + a0[3]);
                    w.z = cvt_pk_bf16(bf_lo(xv[bj].z) + a1[0], bf_hi(xv[bj].z) + a1[1]); w.w = cvt_pk_bf16(bf_lo(xv[bj].w) + a1[2], bf_hi(xv[bj].w) + a1[3]);
                    *(u32x4*)(rowp + bj * HALF) = w;
                    const float r0 = bf_lo(w.x), r1 = bf_hi(w.x), r2 = bf_lo(w.y), r3 = bf_hi(w.y), r4 = bf_lo(w.z), r5 = bf_hi(w.z), r6 = bf_lo(w.w), r7 = bf_hi(w.w);
                    s += ((r0 * r0 + r1 * r1) + (r2 * r2 + r3 * r3)) + ((r4 * r4 + r5 * r5) + (r6 * r6 + r7 * r7)); }
                s += __shfl_xor(s, 16); s += __shfl_xor(s, 32);
                if (fq == 0) SSX[(size_t)row * 16 + u.pn * 4 + wc] = s;
                if (m & 1) asm volatile("" ::: "memory"); }
    }
};
struct EpiResidual {
    static constexpr bool PERM = true;
    bf16_t* X; int ldc; float mul;
    __device__ __forceinline__ void operator()(const f32x4 (&acc)[2][2][4][2], const Unit& u, int wr, int wc, int fr, int fq) const {
        const int row0 = u.pm * BM + wr * 64 + fr, col0 = u.pn * BM + wc * 32 + 8 * fq;
#pragma unroll
        for (int ai = 0; ai < 2; ++ai)
#pragma unroll
            for (int m = 0; m < 4; ++m) { bf16_t* rowp = X + (size_t)(row0 + ai * HALF + m * 16) * ldc + col0;
                u32x4 xv[2];
#pragma unroll
                for (int bj = 0; bj < 2; ++bj) xv[bj] = *(const u32x4*)(rowp + bj * HALF);
#pragma unroll
                for (int bj = 0; bj < 2; ++bj) { const f32x4 a0 = acc[ai][bj][m][0] * mul, a1 = acc[ai][bj][m][1] * mul; u32x4 w;
                    w.x = cvt_pk_bf16(bf_lo(xv[bj].x) + a0[0], bf_hi(xv[bj].x) + a0[1]); w.y = cvt_pk_bf16(bf_lo(xv[bj].y) + a0[2], bf_hi(xv[bj].y) + a0[3]);
                    w.z = cvt_pk_bf16(bf_lo(xv[bj].z) + a1[0], bf_hi(xv[bj].z) + a1[1]); w.w = cvt_pk_bf16(bf_lo(xv[bj].w) + a1[2], bf_hi(xv[bj].w) + a1[3]);
                    *(u32x4*)(rowp + bj * HALF) = w; } }
    }
};
struct EpiInProj {
    static constexpr bool PERM = true;
    const float* rs; const float* gq; const float* gk; const float* tabg; const float* tabm;
    bf16_t* QG; bf16_t* KG; bf16_t* VG; bf16_t* LAT; bf16_t* KROPE; float* SSL; float qscale, eps;
    __device__ __forceinline__ static void rope2(f32x4& v, const f32x4 t) { const float a0 = v[0], b0 = v[1], a1 = v[2], b1 = v[3];
        v[0] = a0 * t[0] - b0 * t[1]; v[1] = b0 * t[0] + a0 * t[1]; v[2] = a1 * t[2] - b1 * t[3]; v[3] = b1 * t[2] + a1 * t[3]; }
    __device__ __forceinline__ static u32x4 pack(const f32x4 a, const f32x4 b) { u32x4 w; w.x = cvt_pk_bf16(a[0], a[1]); w.y = cvt_pk_bf16(a[2], a[3]); w.z = cvt_pk_bf16(b[0], b[1]); w.w = cvt_pk_bf16(b[2], b[3]); return w; }
    __device__ __forceinline__ void operator()(const f32x4 (&acc)[2][2][4][2], const Unit& u, int wr, int wc, int fr, int fq) const {
        const int row0 = u.pm * BM + wr * 64 + fr;
        if (u.pn < 2 || (u.pn == 2 && wc < 2)) {
            const bool isq = u.pn < 2; const float* g = isq ? gq : gk; bf16_t* dst = isq ? QG : KG; const int ld = isq ? 512 : 128, hcol = (isq ? (u.pn * 4 + wc) : wc) * 64; const float osc = isq ? qscale : 1.0f;
            f32x4 gv[2][2];
#pragma unroll
            for (int bj = 0; bj < 2; ++bj)
#pragma unroll
                for (int n = 0; n < 2; ++n)
#pragma unroll
                    for (int i = 0; i < 4; ++i) { const int p = 32 * bj + 8 * fq + 4 * n + i; gv[bj][n][i] = g[(p >> 1) + 32 * (p & 1)]; }
#pragma unroll
            for (int ai = 0; ai < 2; ++ai)
#pragma unroll
                for (int m = 0; m < 4; ++m) { const int row = row0 + ai * HALF + m * 16, s = row & 4095; const float sc = rs[row];
                    f32x4 v[2][2]; float ss = 0.f;
#pragma unroll
                    for (int bj = 0; bj < 2; ++bj)
#pragma unroll
                        for (int n = 0; n < 2; ++n) { v[bj][n] = acc[ai][bj][m][n] * sc; ss += (v[bj][n][0] * v[bj][n][0] + v[bj][n][1] * v[bj][n][1]) + (v[bj][n][2] * v[bj][n][2] + v[bj][n][3] * v[bj][n][3]); }
                    ss += __shfl_xor(ss, 16); ss += __shfl_xor(ss, 32);
                    const float rstd = __builtin_amdgcn_rsqf(ss * (1.0f / 64.0f) + eps);
#pragma unroll
                    for (int bj = 0; bj < 2; ++bj) {
#pragma unroll
                        for (int n = 0; n < 2; ++n) { v[bj][n] = v[bj][n] * rstd * gv[bj][n];
                            const f32x4 t = *(const f32x4*)(tabg + ((size_t)s * 32 + 16 * bj + 4 * fq + 2 * n) * 2); rope2(v[bj][n], t); v[bj][n] = v[bj][n] * osc; }
                        *(u32x4*)(dst + (size_t)row * ld + hcol + 32 * bj + 8 * fq) = pack(v[bj][0], v[bj][1]); }
                    if (m & 1) asm volatile("" ::: "memory"); }
        } else if (u.pn == 2) {
#pragma unroll
            for (int ai = 0; ai < 2; ++ai)
#pragma unroll
                for (int m = 0; m < 4; ++m) { const int row = row0 + ai * HALF + m * 16; const float sc = rs[row];
#pragma unroll
                    for (int bj = 0; bj < 2; ++bj) *(u32x4*)(VG + (size_t)row * 128 + (wc - 2) * 64 + 32 * bj + 8 * fq) = pack(acc[ai][bj][m][0] * sc, acc[ai][bj][m][1] * sc); }
        } else if (u.pn == 3) {
#pragma unroll
            for (int ai = 0; ai < 2; ++ai)
#pragma unroll
                for (int m = 0; m < 4; ++m) { const int row = row0 + ai * HALF + m * 16; const float sc = rs[row]; float ss = 0.f;
#pragma unroll
                    for (int bj = 0; bj < 2; ++bj) { const f32x4 a = acc[ai][bj][m][0] * sc, b = acc[ai][bj][m][1] * sc;
                        ss += ((a[0] * a[0] + a[1] * a[1]) + (a[2] * a[2] + a[3] * a[3])) + ((b[0] * b[0] + b[1] * b[1]) + (b[2] * b[2] + b[3] * b[3]));
                        *(u32x4*)(LAT + (size_t)row * 512 + 128 * bj + 32 * wc + 8 * fq) = pack(a, b); }
                    ss += __shfl_xor(ss, 16); ss += __shfl_xor(ss, 32);
                    if (fq == 0) SSL[(size_t)row * 8 + wc] = ss; }
        } else {
#pragma unroll
            for (int ai = 0; ai < 2; ++ai)
#pragma unroll
                for (int m = 0; m < 4; ++m) { const int row = row0 + ai * HALF + m * 16, s = row & 4095; const float sc = rs[row];
                    const f32x4 a = acc[ai][0][m][0] * sc, b = acc[ai][0][m][1] * sc;
                    float ss = ((a[0] * a[0] + a[1] * a[1]) + (a[2] * a[2] + a[3] * a[3])) + ((b[0] * b[0] + b[1] * b[1]) + (b[2] * b[2] + b[3] * b[3]));
                    *(u32x4*)(LAT + (size_t)row * 512 + 256 + 32 * wc + 8 * fq) = pack(a, b);
                    ss += __shfl_xor(ss, 16); ss += __shfl_xor(ss, 32);
                    if (fq == 0) SSL[(size_t)row * 8 + 4 + wc] = ss;
                    if (wc == 0) { f32x4 c = acc[ai][1][m][0] * sc, d = acc[ai][1][m][1] * sc;
                        rope2(c, *(const f32x4*)(tabm + ((size_t)s * 16 + 4 * fq) * 2)); rope2(d, *(const f32x4*)(tabm + ((size_t)s * 16 + 4 * fq + 2) * 2));
                        *(u32x4*)(KROPE + (size_t)row * 32 + 8 * fq) = pack(c, d); } }
        }
    }
};
struct EpiSwiGLU {
    static constexpr bool PERM = true;
    bf16_t* O; int ldc; const float* rs;
    __device__ __forceinline__ static float silu_mul(float g, float u) { return g * u * __builtin_amdgcn_rcpf(1.0f + __builtin_amdgcn_exp2f(-1.4426950408889634f * g)); }
    __device__ __forceinline__ void operator()(const f32x4 (&acc)[2][2][4][2], const Unit& u, int wr, int wc, int fr, int fq) const {
        const int row0 = u.pm * BM + wr * 64 + fr, col0 = u.pn * HALF + wc * 32 + 8 * fq;
#pragma unroll
        for (int ai = 0; ai < 2; ++ai)
#pragma unroll
            for (int m = 0; m < 4; ++m) { const int row = row0 + ai * HALF + m * 16; bf16_t* rowp = O + (size_t)row * ldc + col0; const float sc = rs[row];
                const f32x4 g0 = acc[ai][0][m][0] * sc, g1 = acc[ai][0][m][1] * sc, u0 = acc[ai][1][m][0] * sc, u1 = acc[ai][1][m][1] * sc;
                u32x4 w; w.x = cvt_pk_bf16(silu_mul(g0[0], u0[0]), silu_mul(g0[1], u0[1])); w.y = cvt_pk_bf16(silu_mul(g0[2], u0[2]), silu_mul(g0[3], u0[3]));
                w.z = cvt_pk_bf16(silu_mul(g1[0], u1[0]), silu_mul(g1[1], u1[1])); w.w = cvt_pk_bf16(silu_mul(g1[2], u1[2]), silu_mul(g1[3], u1[3]));
                *(u32x4*)rowp = w; }
    }
};

template <class Epi, class Sched, bool ALIGN_EPI = false, bool GATHER = false, bool MIDSCALE = false>
__device__ __forceinline__ void gemm_phase(PG8_LAS unsigned char* lds, const Gemm g, const Sched& S, const Epi& E, PG8_LAS unsigned char* gtab = nullptr, float ms_inv_n = 0.f, float ms_eps = 0.f) {
    int tid_ = threadIdx.x; asm volatile("" : "+v"(tid_));
    const int tid = tid_, wid = __builtin_amdgcn_readfirstlane(tid >> 6), lane = tid & 63, wr = wid >> 2, wc = wid & 3, fr = lane & 15, fq = lane >> 4;
    const int K = g.K, nt = K / BK;
    unsigned voffA[2], voffB[2]; int gR[2], gC[2];
#pragma unroll
    for (int i = 0; i < 2; ++i) { int R, C; stage_rc(tid * 16 + i * 8192, R, C); const int Rb = Epi::PERM ? ((R & ~31) + perm32(R & 31)) : R; gR[i] = R; gC[i] = C;
        voffA[i] = (unsigned)(R * g.lda + C) * 2u; voffB[i] = (unsigned)(Rb * g.ldb + C) * 2u; }
    unsigned goffc[2][2], goffn[2][2];
#define PG8_GISSUE(u) do { _Pragma("unroll") for (int h_ = 0; h_ < 2; ++h_) _Pragma("unroll") for (int i_ = 0; i_ < 2; ++i_) \
        __builtin_amdgcn_global_load_lds((const unsigned*)(g.idx + (u).pm * BM + h_ * HALF + gR[i_]), (PG8_LAS unsigned*)(gtab + ((h_ * 2 + i_) * 8 + wid) * 256), 4, 0, 0); } while (0)
#define PG8_GREAD(dst, u) do { asm volatile("" ::: "memory"); _Pragma("unroll") for (int h_ = 0; h_ < 2; ++h_) _Pragma("unroll") for (int i_ = 0; i_ < 2; ++i_) { \
        const int tok_ = *(const PG8_LAS int*)(gtab + ((h_ * 2 + i_) * 8 + wid) * 256 + lane * 4); \
        dst[h_][i_] = (unsigned)(((((u).pm >> 1) & 7) * 4096 + tok_) * g.lda + gC[i_]) * 2u; } } while (0)
    const size_t kstep = (size_t)(BK * 2);
    const size_t hstepA = (size_t)HALF * g.lda * 2, hstepB = (size_t)HALF * g.ldb * 2;
    const size_t tstepA = 2 * hstepA, tstepB = 2 * hstepB;
    const unsigned ldsw = (unsigned)wid * 1024u;
    const int aoff = lds_byte(wr * 64 + fr, fq * 8), boff = lds_byte(wc * 32 + fr, fq * 8);
#define PG8_SA(b, h) (((b) * 2 + (h)) * HTB)
#define PG8_SB(b, h) ((4 + (b) * 2 + (h)) * HTB)
#define PG8_STAGE(bufoff, gbase, voff) do { _Pragma("unroll") for (int _i = 0; _i < 2; ++_i) \
        __builtin_amdgcn_global_load_lds((const unsigned*)((const char*)(gbase) + (voff)[_i]), (PG8_LAS unsigned*)(lds + (bufoff) + ldsw + _i * 8192), 16, 0, 0); } while (0)
#define PG8_LDA(dst, b, h) do { _Pragma("unroll") for (int m = 0; m < 4; ++m) _Pragma("unroll") for (int k = 0; k < 2; ++k) dst[m][k] = *(const PG8_LAS bf16x8*)(lds + PG8_SA(b, h) + aoff + m * 2048 + k * 1024); } while (0)
#define PG8_LDB(dst, b, h) do { _Pragma("unroll") for (int n = 0; n < 2; ++n) _Pragma("unroll") for (int k = 0; k < 2; ++k) dst[n][k] = *(const PG8_LAS bf16x8*)(lds + PG8_SB(b, h) + boff + n * 2048 + k * 1024); } while (0)
#define PG8_MMA(ai, bj, At, Bt) do { __builtin_amdgcn_s_setprio(1); _Pragma("unroll") for (int m = 0; m < 4; ++m) _Pragma("unroll") for (int n = 0; n < 2; ++n) _Pragma("unroll") for (int k = 0; k < 2; ++k) \
        acc[ai][bj][m][n] = __builtin_amdgcn_mfma_f32_16x16x32_bf16(Bt[n][k], At[m][k], acc[ai][bj][m][n], 0, 0, 0); __builtin_amdgcn_s_setprio(0); } while (0)
#define PG8_WAIT_V(n) asm volatile("s_waitcnt vmcnt(" #n ")" ::: "memory")
#define PG8_WAIT_L(n) asm volatile("s_waitcnt lgkmcnt(" #n ")" ::: "memory")
#define PG8_BAR __builtin_amdgcn_s_barrier()
#define PG8_SCHED __builtin_amdgcn_sched_barrier(0)
#define PG8_ABASE(u) (GATHER ? (const char*)g.A : (const char*)g.A + (size_t)((u).pm % g.amod) * tstepA)
#define PG8_STA(bufoff, kptr, h, nx) do { if constexpr (GATHER) { unsigned o_[2]; o_[0] = (nx) ? goffn[h][0] : goffc[h][0]; o_[1] = (nx) ? goffn[h][1] : goffc[h][1]; PG8_STAGE(bufoff, kptr, o_); } \
        else { PG8_STAGE(bufoff, (kptr) + (h) * hstepA, voffA); } } while (0)
#define PG8_BBASE(u) ((const char*)g.Bt + ((size_t)((u).pm / g.gdiv) * g.gstride) * 2 + (size_t)(u).pn * tstepB)
    Unit cur, nxt; int ui = 0;
    if (!S.next(0, cur)) return;
    f32x4 acc[2][2][4][2];
#pragma unroll
    for (int a = 0; a < 2; ++a)
#pragma unroll
        for (int b = 0; b < 2; ++b)
#pragma unroll
            for (int m = 0; m < 4; ++m)
#pragma unroll
                for (int n = 0; n < 2; ++n) acc[a][b][m][n] = (f32x4){0.f, 0.f, 0.f, 0.f};
    bf16x8 At[4][2], B0[2][2], B1[2][2];
    const char* cA = PG8_ABASE(cur); const char* cB = PG8_BBASE(cur);
    if constexpr (GATHER) { PG8_GISSUE(cur); PG8_WAIT_V(0); PG8_GREAD(goffc, cur);
#pragma unroll
        for (int h_ = 0; h_ < 2; ++h_) { goffn[h_][0] = goffc[h_][0]; goffn[h_][1] = goffc[h_][1]; } }
    PG8_STAGE(PG8_SB(0, 0), cB, voffB); PG8_STAGE(PG8_SB(0, 1), cB + hstepB, voffB); PG8_STA(PG8_SA(0, 0), cA, 0, false); PG8_STA(PG8_SA(0, 1), cA, 1, false);
    if (wr == 1) PG8_BAR;
    PG8_WAIT_V(2); PG8_BAR;
    PG8_STAGE(PG8_SB(1, 0), cB + kstep, voffB); PG8_STA(PG8_SA(1, 0), cA + kstep, 0, false); PG8_STAGE(PG8_SB(1, 1), cB + hstepB + kstep, voffB);
    PG8_WAIT_V(6); PG8_BAR;
    for (;;) {
        const bool has_next = S.next(ui + 1, nxt);
        const char* nA = has_next ? PG8_ABASE(nxt) : cA; const char* nB = has_next ? PG8_BBASE(nxt) : cB;
        if constexpr (GATHER) { if (has_next) PG8_GISSUE(nxt); }
        if constexpr (MIDSCALE) {
#pragma unroll
            for (int q_ = 0; q_ < 2; ++q_) __builtin_amdgcn_global_load_lds((const unsigned*)(g.ss + (size_t)cur.pm * 1024 + q_ * 512 + wid * 64 + lane), (PG8_LAS unsigned*)(gtab + (ui & 1) * 4096 + q_ * 2048 + wid * 256), 4, 0, 0); }
#pragma nounroll
        for (int t = 0; t < nt; t += 2) {
            const bool last = (t == nt - 2);
            const char* a1 = cA + (size_t)(t + 1) * kstep;
            const char* a2 = last ? nA : cA + (size_t)(t + 2) * kstep; const char* b2 = last ? nB : cB + (size_t)(t + 2) * kstep;
            const char* a3 = a2 + kstep; const char* b3 = b2 + kstep;
            if constexpr (GATHER) { if (last && has_next) PG8_GREAD(goffn, nxt); }
            if constexpr (MIDSCALE) { if (t == nt / 2) { asm volatile("" ::: "memory"); const PG8_LAS float* tab = (const PG8_LAS float*)(gtab + (ui & 1) * 4096);
#pragma unroll
                for (int ai = 0; ai < 2; ++ai)
#pragma unroll
                    for (int m = 0; m < 4; ++m) { const int rl = ai * HALF + wr * 64 + m * 16 + fr; const float sg = tab[rl * 4] + tab[rl * 4 + 1], sm = tab[rl * 4 + 2] + tab[rl * 4 + 3];
                        const float ratio = __builtin_amdgcn_rsqf(sg * ms_inv_n + ms_eps) * __builtin_amdgcn_rcpf(__builtin_amdgcn_rsqf(sm * ms_inv_n + ms_eps));
#pragma unroll
                        for (int bj = 0; bj < 2; ++bj)
#pragma unroll
                            for (int n = 0; n < 2; ++n) acc[ai][bj][m][n] = acc[ai][bj][m][n] * ratio; } } }
            PG8_LDB(B0, 0, 0); PG8_LDB(B1, 0, 1); PG8_SCHED; PG8_LDA(At, 0, 0); PG8_STA(PG8_SA(1, 1), a1, 1, false);
            PG8_WAIT_V(8); PG8_WAIT_L(0); PG8_BAR; PG8_MMA(0, 0, At, B0); PG8_MMA(0, 1, At, B1); PG8_BAR; PG8_SCHED;
            PG8_LDA(At, 0, 1); PG8_STAGE(PG8_SB(0, 0), b2, voffB); PG8_STAGE(PG8_SB(0, 1), b2 + hstepB, voffB); PG8_STA(PG8_SA(0, 0), a2, 0, last);
            PG8_WAIT_V(8); PG8_WAIT_L(0); PG8_BAR; PG8_MMA(1, 0, At, B0); PG8_MMA(1, 1, At, B1); PG8_BAR; PG8_SCHED;
            PG8_LDB(B0, 1, 0); PG8_LDB(B1, 1, 1); PG8_SCHED; PG8_LDA(At, 1, 0); PG8_STA(PG8_SA(0, 1), a2, 1, last);
            PG8_WAIT_V(8); PG8_WAIT_L(0); PG8_BAR; PG8_MMA(0, 0, At, B0); PG8_MMA(0, 1, At, B1); PG8_BAR; PG8_SCHED;
            PG8_LDA(At, 1, 1); PG8_STAGE(PG8_SB(1, 0), b3, voffB); PG8_STAGE(PG8_SB(1, 1), b3 + hstepB, voffB); PG8_STA(PG8_SA(1, 0), a3, 0, last);
            PG8_WAIT_V(8); PG8_WAIT_L(0); PG8_BAR; PG8_MMA(1, 0, At, B0); PG8_MMA(1, 1, At, B1); PG8_BAR; PG8_SCHED;
        }
        if constexpr (ALIGN_EPI) { if (wr == 0) PG8_BAR; }
        if constexpr (MIDSCALE) E(acc, cur, wr, wc, fr, fq, (const PG8_LAS float*)(gtab + (ui & 1) * 4096)); else E(acc, cur, wr, wc, fr, fq);
        if (!has_next) break;
#pragma unroll
        for (int a = 0; a < 2; ++a)
#pragma unroll
            for (int b = 0; b < 2; ++b)
#pragma unroll
                for (int m = 0; m < 4; ++m)
#pragma unroll
                    for (int n = 0; n < 2; ++n) acc[a][b][m][n] = (f32x4){0.f, 0.f, 0.f, 0.f};
        cur = nxt; cA = nA; cB = nB; ++ui;
        if constexpr (GATHER) {
#pragma unroll
            for (int h_ = 0; h_ < 2; ++h_) { goffc[h_][0] = goffn[h_][0]; goffc[h_][1] = goffn[h_][1]; } }
        if constexpr (ALIGN_EPI) { if (wr == 1) PG8_BAR; }
    }
    PG8_WAIT_V(0);
    if constexpr (!ALIGN_EPI) { if (wr == 0) PG8_BAR; }
    PG8_BAR;
#undef PG8_SA
#undef PG8_SB
#undef PG8_STAGE
#undef PG8_LDA
#undef PG8_LDB
#undef PG8_MMA
#undef PG8_WAIT_V
#undef PG8_WAIT_L
#undef PG8_BAR
#undef PG8_SCHED
#undef PG8_ABASE
#undef PG8_STA
#undef PG8_GISSUE
#undef PG8_GREAD
#undef PG8_BBASE
}
}
namespace att {
typedef unsigned short bf16;
using bf16x8 = __attribute__((ext_vector_type(8))) short;
using s16x4  = __attribute__((ext_vector_type(4))) short;
using f32x16 = __attribute__((ext_vector_type(16))) float;
using u32x4  = __attribute__((ext_vector_type(4))) unsigned;
#define ATT_SBAR() __builtin_amdgcn_sched_barrier(0)
constexpr int KCH = 1040;
constexpr float THR = 8.0f;
__device__ __forceinline__ int crow(int r, int hi) { return (r & 3) + 8 * (r >> 2) + 4 * hi; }
__device__ __forceinline__ unsigned cvtpk(float lo, float hi) { unsigned r; asm volatile("v_cvt_pk_bf16_f32 %0, %1, %2" : "=v"(r) : "v"(lo), "v"(hi)); return r; }
typedef float f32x2_t __attribute__((ext_vector_type(2))); typedef __bf16 bf16x2_t __attribute__((ext_vector_type(2)));
__device__ __forceinline__ unsigned cvtpk_c(float lo, float hi) { const f32x2_t v = {lo, hi}; const bf16x2_t b = __builtin_convertvector(v, bf16x2_t); return __builtin_bit_cast(unsigned, b); }
__device__ __forceinline__ unsigned short f2bf1(float f) { unsigned u = __builtin_bit_cast(unsigned, f); return (unsigned short)((u + 0x7fffu + ((u >> 16) & 1u)) >> 16); }

#define ATT_MX3(a, b, c) __builtin_fmaxf(__builtin_fmaxf((a), (b)), (c))
template <int MODE, bool FIRST>
__device__ __forceinline__ void partialSM(f32x16& p0, f32x16& p1, float& m_run, f32x16& negm, float& alpha) {
  if constexpr (MODE == 0) {
    float a = ATT_MX3(p0[0], p0[1], p1[0]), b = ATT_MX3(p0[2], p0[3], p1[1]); a = ATT_MX3(a, p1[2], p1[3]);
#pragma unroll
    for (int r = 4; r < 16; r += 4) { a = ATT_MX3(a, p0[r], p0[r + 1]); b = ATT_MX3(b, p0[r + 2], p0[r + 3]); a = ATT_MX3(a, p1[r], p1[r + 1]); b = ATT_MX3(b, p1[r + 2], p1[r + 3]); }
    float pmax = fmaxf(a, b);
    { auto rr = __builtin_amdgcn_permlane32_swap(__float_as_uint(pmax), __float_as_uint(pmax), false, false);
      pmax = fmaxf(__uint_as_float(rr[0]), __uint_as_float(rr[1])); }
    alpha = 1.f;
    if (FIRST || __builtin_expect(__any(pmax > THR), 0)) {
      const float dl = FIRST ? pmax : fmaxf(pmax, 0.f);
      m_run += dl;
#pragma unroll
      for (int r = 0; r < 16; ++r) { p0[r] -= dl; p1[r] -= dl; }
#pragma unroll
      for (int r = 0; r < 16; ++r) negm[r] = -m_run;
      asm volatile("" : "+v"(negm));
      alpha = FIRST ? 1.f : __builtin_amdgcn_exp2f(-dl);
    }
  } else { alpha = 1.f; }
#pragma unroll
  for (int r = 0; r < 16; ++r) p0[r] = __builtin_amdgcn_exp2f(p0[r]);
}
__device__ __forceinline__ void finishSM(f32x16& p0, f32x16& p1, float alpha, float& l_reg, bf16x8& pa0, bf16x8& pa1, bf16x8& pa2, bf16x8& pa3) {
#pragma unroll
  for (int r = 0; r < 16; ++r) p1[r] = __builtin_amdgcn_exp2f(p1[r]);
  float ps = 0;
#pragma unroll
  for (int r = 0; r < 16; ++r) ps += p0[r];
#pragma unroll
  for (int r = 0; r < 16; ++r) ps += p1[r];
  { auto rr = __builtin_amdgcn_permlane32_swap(__float_as_uint(ps), __float_as_uint(ps), false, false);
    ps = __uint_as_float(rr[0]) + __uint_as_float(rr[1]); }
  l_reg = l_reg * alpha + ps;
#define ATT_PK4(P, BASE, OUT) do { const u32x4 w = {cvtpk_c(P[BASE + 0], P[BASE + 1]), cvtpk_c(P[BASE + 2], P[BASE + 3]), cvtpk_c(P[BASE + 4], P[BASE + 5]), cvtpk_c(P[BASE + 6], P[BASE + 7])}; \
    OUT = __builtin_bit_cast(bf16x8, w); } while (0)
  ATT_PK4(p0, 0, pa0); ATT_PK4(p0, 8, pa1); ATT_PK4(p1, 0, pa2); ATT_PK4(p1, 8, pa3);
#undef ATT_PK4
}
template <int ND0>
__device__ __forceinline__ void qkt(f32x16& p0, f32x16& p1, const char* Ks, const bf16x8* qr, const f32x16& negm, int r32, int hi) {
#pragma unroll
  for (int d0 = 0; d0 < ND0; ++d0) {
    const char* kb = Ks + (2 * d0 + hi) * KCH + r32 * 16;
    bf16x8 b0 = *reinterpret_cast<const bf16x8*>(kb);
    bf16x8 b1 = *reinterpret_cast<const bf16x8*>(kb + 512);
    if (d0 == 0) { p0 = __builtin_amdgcn_mfma_f32_32x32x16_bf16(b0, qr[0], negm, 0, 0, 0); p1 = __builtin_amdgcn_mfma_f32_32x32x16_bf16(b1, qr[0], negm, 0, 0, 0); }
    else { p0 = __builtin_amdgcn_mfma_f32_32x32x16_bf16(b0, qr[d0], p0, 0, 0, 0); p1 = __builtin_amdgcn_mfma_f32_32x32x16_bf16(b1, qr[d0], p1, 0, 0, 0); } }
}
template <int NB> __device__ __forceinline__ int v_st(int k, int c) { const int kk = k; return ((kk >> 3) * NB + (c >> 5)) * 512 + ((kk & 7) * 32 + (c & 31)) * 2; }
__device__ __forceinline__ int v_rd_base(int lane) { return ((lane & 3) << 3) | (((lane >> 2) & 3) << 6) | (((lane >> 4) & 1) << 5) | (((lane >> 5) & 1) << 8); }
template <int OFF> __device__ __forceinline__ s16x4 tr_read(int vb) {
  s16x4 r; asm volatile("ds_read_b64_tr_b16 %0, %1 offset:%2" : "=&v"(r) : "v"(vb), "i"(OFF) : "memory"); return r;
}
template <int NB, int D0> __device__ __forceinline__ void pv_one(f32x16& od, int vb, bf16x8 pa0, bf16x8 pa1, bf16x8 pa2, bf16x8 pa3) {
#define ATT_VO(ks, half) (D0 * 512 + (2 * (ks) + (half)) * NB * 512)
  const s16x4 l0 = tr_read<ATT_VO(0, 0)>(vb), h0 = tr_read<ATT_VO(0, 1)>(vb), l1 = tr_read<ATT_VO(1, 0)>(vb), h1 = tr_read<ATT_VO(1, 1)>(vb);
  const s16x4 l2 = tr_read<ATT_VO(2, 0)>(vb), h2 = tr_read<ATT_VO(2, 1)>(vb), l3 = tr_read<ATT_VO(3, 0)>(vb), h3 = tr_read<ATT_VO(3, 1)>(vb);
#undef ATT_VO
  asm volatile("s_waitcnt lgkmcnt(0)" ::: "memory"); ATT_SBAR();
#define ATT_PK(L, H) (bf16x8){L[0], L[1], L[2], L[3], H[0], H[1], H[2], H[3]}
  od = __builtin_amdgcn_mfma_f32_32x32x16_bf16(pa0, ATT_PK(l0, h0), od, 0, 0, 0);
  od = __builtin_amdgcn_mfma_f32_32x32x16_bf16(pa1, ATT_PK(l1, h1), od, 0, 0, 0);
  od = __builtin_amdgcn_mfma_f32_32x32x16_bf16(pa2, ATT_PK(l2, h2), od, 0, 0, 0);
  od = __builtin_amdgcn_mfma_f32_32x32x16_bf16(pa3, ATT_PK(l3, h3), od, 0, 0, 0);
#undef ATT_PK
}
template <int NB> __device__ __forceinline__ void pv_all(f32x16* o, int vb, bf16x8 pa0, bf16x8 pa1, bf16x8 pa2, bf16x8 pa3) {
  if constexpr (NB == 2) {
#define ATT_VO(d0, ks, half) ((d0) * 512 + (2 * (ks) + (half)) * NB * 512)
    const s16x4 l0 = tr_read<ATT_VO(0, 0, 0)>(vb), h0 = tr_read<ATT_VO(0, 0, 1)>(vb), l1 = tr_read<ATT_VO(0, 1, 0)>(vb), h1 = tr_read<ATT_VO(0, 1, 1)>(vb);
    const s16x4 l2 = tr_read<ATT_VO(0, 2, 0)>(vb), h2 = tr_read<ATT_VO(0, 2, 1)>(vb), l3 = tr_read<ATT_VO(0, 3, 0)>(vb), h3 = tr_read<ATT_VO(0, 3, 1)>(vb);
    const s16x4 m0 = tr_read<ATT_VO(1, 0, 0)>(vb), n0 = tr_read<ATT_VO(1, 0, 1)>(vb), m1 = tr_read<ATT_VO(1, 1, 0)>(vb), n1 = tr_read<ATT_VO(1, 1, 1)>(vb);
    const s16x4 m2 = tr_read<ATT_VO(1, 2, 0)>(vb), n2 = tr_read<ATT_VO(1, 2, 1)>(vb), m3 = tr_read<ATT_VO(1, 3, 0)>(vb), n3 = tr_read<ATT_VO(1, 3, 1)>(vb);
#undef ATT_VO
#define ATT_PK(L, H) (bf16x8){L[0], L[1], L[2], L[3], H[0], H[1], H[2], H[3]}
    asm volatile("s_waitcnt lgkmcnt(8)" ::: "memory"); ATT_SBAR();
    o[0] = __builtin_amdgcn_mfma_f32_32x32x16_bf16(pa0, ATT_PK(l0, h0), o[0], 0, 0, 0);
    o[0] = __builtin_amdgcn_mfma_f32_32x32x16_bf16(pa1, ATT_PK(l1, h1), o[0], 0, 0, 0);
    o[0] = __builtin_amdgcn_mfma_f32_32x32x16_bf16(pa2, ATT_PK(l2, h2), o[0], 0, 0, 0);
    o[0] = __builtin_amdgcn_mfma_f32_32x32x16_bf16(pa3, ATT_PK(l3, h3), o[0], 0, 0, 0);
    asm volatile("s_waitcnt lgkmcnt(0)" ::: "memory"); ATT_SBAR();
    o[1] = __builtin_amdgcn_mfma_f32_32x32x16_bf16(pa0, ATT_PK(m0, n0), o[1], 0, 0, 0);
    o[1] = __builtin_amdgcn_mfma_f32_32x32x16_bf16(pa1, ATT_PK(m1, n1), o[1], 0, 0, 0);
    o[1] = __builtin_amdgcn_mfma_f32_32x32x16_bf16(pa2, ATT_PK(m2, n2), o[1], 0, 0, 0);
    o[1] = __builtin_amdgcn_mfma_f32_32x32x16_bf16(pa3, ATT_PK(m3, n3), o[1], 0, 0, 0);
#undef ATT_PK
  } else {
    pv_one<NB, 0>(o[0], vb, pa0, pa1, pa2, pa3); pv_one<NB, 1>(o[1], vb, pa0, pa1, pa2, pa3);
    pv_one<NB, 2>(o[2], vb, pa0, pa1, pa2, pa3); pv_one<NB, 3>(o[3], vb, pa0, pa1, pa2, pa3);
  }
}

template <int W1, int W2, int DV> struct AttnCfg {
  static constexpr int DQK = W1 + W2, NCH = DQK / 8, ND0 = DQK / 16, NB = DV / 32;
  static constexpr int KT_BYTES = NCH * KCH, VT_BYTES = 64 * DV * 2;
  static constexpr int OST_BYTES = 32 * DV * 2;
  static constexpr bool OSTAGE = (DV == 64);
  static constexpr int LDS_BYTES = 3 * VT_BYTES + 3 * KT_BYTES + 8 * 64 * 4 + (OSTAGE ? 8 * OST_BYTES : 0);
  static constexpr int CW1 = W1 / 8, N1 = (64 * CW1) / 512;
  static constexpr int CWV = DV / 8, NV = (64 * CWV) / 512;
  static_assert(W1 == 64 || W1 == 128, "W1"); static_assert(W2 == 0 || W2 == 32, "W2"); static_assert(DV == 64 || DV == 128, "DV");
};

template <int W1, int W2, int DV, int MODE, bool SSQ>
__device__ __forceinline__ void attn_unit(const bf16* __restrict__ Qb, const bf16* __restrict__ Qb2, int ldq, const bf16* __restrict__ K1, int ldk1, const bf16* __restrict__ K2, int ldk2,
                                          const bf16* __restrict__ Vh, int ldv, bf16* __restrict__ Ob, int ldo, int nkeys, char* lds, float (&ssacc)[16]) {
  using C = AttnCfg<W1, W2, DV>;
  constexpr int ND0 = C::ND0, NB = C::NB, N1 = C::N1, NV = C::NV, CW1 = C::CW1, CWV = C::CWV;
  constexpr int SHM_V = C::VT_BYTES, SHM_K = C::KT_BYTES;
  int tid_ = threadIdx.x; asm volatile("" : "+v"(tid_));
  const int tid = tid_, wid = tid >> 6, lane = tid & 63, r32 = lane & 31, hi = lane >> 5;
  char* V_lds = lds; char* K_lds = lds + 3 * SHM_V;
  float* ws = (float*)(lds + 3 * SHM_V + 3 * SHM_K) + wid * 64; float* li_l = ws; float* al_l = ws + 32;
  float m_reg = 0.f, l_reg = 0; f32x16 o[NB]; bf16x8 qr[ND0]; f32x16 negm = f32x16{}; asm volatile("" : "+v"(negm));
#pragma unroll
  for (int d = 0; d < NB; ++d) o[d] = f32x16{};
  const bf16* Qw = Qb + (long)(wid * 32 + r32) * ldq + hi * 8;
#pragma unroll
  for (int d0 = 0; d0 < W1 / 16; ++d0) qr[d0] = *reinterpret_cast<const bf16x8*>(Qw + d0 * 16);
  if constexpr (W2 > 0) { const bf16* Qw2 = Qb2 + (long)(wid * 32 + r32) * ldq + hi * 8;
#pragma unroll
    for (int d0 = 0; d0 < W2 / 16; ++d0) qr[W1 / 16 + d0] = *reinterpret_cast<const bf16x8*>(Qw2 + d0 * 16); }
  int k1row[N1], k1col[N1], k1lds[N1], vrow[NV], vcol[NV], vlds[NV];
#pragma unroll
  for (int i = 0; i < N1; ++i) { const int p = tid + 512 * i; k1row[i] = p / CW1; k1col[i] = (p % CW1) * 8; k1lds[i] = (p % CW1) * KCH + (p / CW1) * 16; }
#pragma unroll
  for (int i = 0; i < NV; ++i) { const int p = tid + 512 * i; vrow[i] = p / CWV; vcol[i] = (p % CWV) * 8; vlds[i] = v_st<NB>(p / CWV, (p % CWV) * 8); }
  const int k2row = tid >> 2, k2col = (tid & 3) * 8, k2lds = (CW1 + (tid & 3)) * KCH + (tid >> 2) * 16; const bool k2on = (W2 > 0) && (tid < 256);
  const int vb0 = (int)(uintptr_t)V_lds + v_rd_base(lane);
  struct Slot { bf16x8 k1[N1]; bf16x8 k2; bf16x8 v[NV]; } sr_[2];
#define ATT_SLOAD(i, k0) do { _Pragma("unroll") for (int _j = 0; _j < N1; ++_j) sr_[i].k1[_j] = *reinterpret_cast<const bf16x8*>(&K1[(long)((k0) + k1row[_j]) * ldk1 + k1col[_j]]); \
    if constexpr (W2 > 0) { if (k2on) sr_[i].k2 = *reinterpret_cast<const bf16x8*>(&K2[(long)((k0) + k2row) * ldk2 + k2col]); } \
    _Pragma("unroll") for (int _j = 0; _j < NV; ++_j) sr_[i].v[_j] = *reinterpret_cast<const bf16x8*>(&Vh[(long)((k0) + vrow[_j]) * ldv + vcol[_j]]); } while (0)
#define ATT_SWRITE(b, i) do { _Pragma("unroll") for (int _j = 0; _j < NV; ++_j) *(bf16x8*)(V_lds + (b) * SHM_V + vlds[_j]) = sr_[i].v[_j]; \
    _Pragma("unroll") for (int _j = 0; _j < N1; ++_j) *(bf16x8*)(K_lds + (b) * SHM_K + k1lds[_j]) = sr_[i].k1[_j]; \
    if constexpr (W2 > 0) { if (k2on) *(bf16x8*)(K_lds + (b) * SHM_K + k2lds) = sr_[i].k2; } } while (0)
#define ATT_SWAIT() asm volatile("s_waitcnt vmcnt(%0)" :: "n"(N1 + NV) : "memory")
#define ATT_RESC(a) do { if (MODE == 0 && __any((a) != 1.f)) { if (hi == 0) al_l[r32] = (a); asm volatile("s_waitcnt lgkmcnt(0)" ::: "memory"); \
    _Pragma("unroll") for (int d = 0; d < NB; ++d) _Pragma("unroll") for (int r = 0; r < 16; ++r) o[d][r] *= al_l[crow(r, hi)]; } } while (0)
  f32x16 pA0, pA1, pB0, pB1; float alA, alB; bf16x8 pa0, pa1, pa2, pa3; const int NT = nkeys / 64;
  ATT_SLOAD(0, 0); asm volatile("s_waitcnt vmcnt(0)" ::: "memory"); ATT_SWRITE(0, 0); __syncthreads();
  qkt<ND0>(pA0, pA1, K_lds, qr, negm, r32, hi); partialSM<MODE, true>(pA0, pA1, m_reg, negm, alA);
  ATT_SLOAD(1, 64); if (2 < NT) ATT_SLOAD(0, 128);
  ATT_SWAIT(); ATT_SWRITE(1, 1); __syncthreads();
  int bp = 0, bc = 1, bn = 2;
  if (wid >= 4) __builtin_amdgcn_s_setprio(1);
#define ATT_ROT() do { const int t_ = bp; bp = bc; bc = bn; bn = t_; } while (0)
  for (int j = 1; j + 1 < NT; j += 2) {
    ATT_SBAR(); qkt<ND0>(pB0, pB1, K_lds + bc * SHM_K, qr, negm, r32, hi);
    finishSM(pA0, pA1, alA, l_reg, pa0, pa1, pa2, pa3); ATT_SBAR();
    ATT_SLOAD(1, (j + 2) * 64); ATT_SBAR();
    pv_all<NB>(o, vb0 + bp * SHM_V, pa0, pa1, pa2, pa3); partialSM<MODE, false>(pB0, pB1, m_reg, negm, alB);
    ATT_SWAIT(); ATT_SWRITE(bn, 0);
    ATT_RESC(alB); __syncthreads(); ATT_ROT();
    ATT_SBAR(); qkt<ND0>(pA0, pA1, K_lds + bc * SHM_K, qr, negm, r32, hi);
    finishSM(pB0, pB1, alB, l_reg, pa0, pa1, pa2, pa3); ATT_SBAR();
    if (j + 3 < NT) ATT_SLOAD(0, (j + 3) * 64); ATT_SBAR();
    pv_all<NB>(o, vb0 + bp * SHM_V, pa0, pa1, pa2, pa3); partialSM<MODE, false>(pA0, pA1, m_reg, negm, alA);
    ATT_SWAIT(); ATT_SWRITE(bn, 1);
    ATT_RESC(alA); __syncthreads(); ATT_ROT();
  }
  ATT_SBAR(); qkt<ND0>(pB0, pB1, K_lds + bc * SHM_K, qr, negm, r32, hi);
  finishSM(pA0, pA1, alA, l_reg, pa0, pa1, pa2, pa3); ATT_SBAR();
  pv_all<NB>(o, vb0 + bp * SHM_V, pa0, pa1, pa2, pa3); partialSM<MODE, false>(pB0, pB1, m_reg, negm, alB);
  ATT_RESC(alB);
  finishSM(pB0, pB1, alB, l_reg, pa0, pa1, pa2, pa3); ATT_SBAR();
  pv_all<NB>(o, vb0 + bc * SHM_V, pa0, pa1, pa2, pa3);
#undef ATT_ROT
  __builtin_amdgcn_s_setprio(0);
  if (hi == 0) li_l[r32] = l_reg; asm volatile("s_waitcnt lgkmcnt(0)" ::: "memory");
  float rli[16];
#pragma unroll
  for (int r = 0; r < 16; ++r) rli[r] = __builtin_amdgcn_rcpf(li_l[crow(r, hi)]);
  bf16* Ow = Ob + (long)(wid * 32) * ldo;
  if constexpr (C::OSTAGE) { unsigned short* stg = (unsigned short*)(lds + 3 * SHM_V + 3 * SHM_K + 8 * 64 * 4 + wid * C::OST_BYTES);
#pragma unroll
    for (int r = 0; r < 16; ++r) { const int orow = crow(r, hi);
#pragma unroll
      for (int d0 = 0; d0 < NB; ++d0) stg[orow * DV + d0 * 32 + r32] = f2bf1(o[d0][r] * rli[r]); }
    asm volatile("s_waitcnt lgkmcnt(0)" ::: "memory");
    constexpr int CPR = DV / 8;
#pragma unroll
    for (int i = 0; i < (32 * CPR) / 64; ++i) { const int p = i * 64 + lane, row = p / CPR, ch = p % CPR;
      const u32x4 v = *(const u32x4*)(stg + row * DV + ch * 8); *(u32x4*)(Ow + (long)row * ldo + ch * 8) = v; } }
  else {
#pragma unroll
    for (int r = 0; r < 16; ++r) { const int orow = crow(r, hi);
#pragma unroll
      for (int d0 = 0; d0 < NB; ++d0) Ow[(long)orow * ldo + d0 * 32 + r32] = f2bf1(o[d0][r] * rli[r]); } }
  if constexpr (SSQ) {
#pragma unroll
    for (int r = 0; r < 16; ++r) {
#pragma unroll
      for (int d0 = 0; d0 < NB; ++d0) { const float v = o[d0][r] * rli[r]; ssacc[r] += v * v; } } }
  __syncthreads();
#undef ATT_SLOAD
#undef ATT_SWRITE
#undef ATT_SWAIT
#undef ATT_RESC
}
#undef ATT_SBAR
}
constexpr int NWAVES = 8;
#ifndef MK_N_LAUNCHES
#define MK_N_LAUNCHES 1
#endif
constexpr int BATCH = 8, SEQ = 4096, DM = 1024, DEPTH = 4, MTOK = BATCH * SEQ;
constexpr int IN_W = 1184, IN_WP = 1280;
constexpr int MEM_T = 256, MROWS = BATCH * MEM_T;
constexpr int NEXP = 16, CAP = 512, EFF = 512, MOE_ROWS = NEXP * BATCH * CAP;
constexpr float EPS = 1e-6f, LOG2E = 1.4426950408889634f;
constexpr int NPH = 2 + 16 * DEPTH;
constexpr size_t MiB = 1u << 20;
constexpr size_t WS_CTL = 0, CTL_ZERO_BYTES = 1 * MiB;
constexpr size_t WS_TABG = 1 * MiB, WS_TABM = 2 * MiB, WS_WR = 2 * MiB + 512 * 1024, WS_GAINS = 3 * MiB, WS_SSO = 3 * MiB + 64 * 1024, WS_SSX = 346 * MiB, WS_RS1 = WS_SSO + 512 * 1024, WS_RS3 = WS_RS1 + 128 * 1024, WS_RG = 118 * MiB + 256 * 1024, WS_SSL = 118 * MiB + 512 * 1024;
constexpr size_t WS_WSMALL = 4 * MiB, WSMALL_STRIDE = 10 * MiB;
constexpr size_t OFF_WIN = 0, OFF_WQB = 5 * MiB / 2, OFF_WKVB = 3 * MiB, OFF_WO = 7 * MiB / 2, OFF_WMQ = 11 * MiB / 2, OFF_WMKV = 13 * MiB / 2, OFF_WMO = 17 * MiB / 2;
constexpr size_t WS_WGU = 44 * MiB, WS_WD = 76 * MiB;
constexpr size_t WS_MEMN = 92 * MiB, WS_MEMKV = 96 * MiB;
constexpr size_t WS_AFF = 112 * MiB, WS_AFFT = 114 * MiB, WS_SLOT = 116 * MiB, WS_IDX = 118 * MiB;
constexpr size_t WS_H = 120 * MiB, WS_PROJ = 184 * MiB, WS_QG = 264 * MiB, WS_KG = 296 * MiB, WS_VG = 304 * MiB, WS_LAT = 312 * MiB, WS_KROPE = 344 * MiB, WS_QM = 346 * MiB;
constexpr size_t WS_XB = 264 * MiB;
constexpr size_t WS_O = WS_H, WS_KVM = WS_PROJ, WS_QMEM = 184 * MiB, WS_OMEM = 216 * MiB, WS_XG = 184 * MiB, WS_Y = WS_XG, WS_ACT = 312 * MiB;
constexpr size_t WS_WGU2 = 394 * MiB, WS_WD2 = 426 * MiB;
constexpr size_t WS_X = 442 * MiB;
constexpr size_t WS_END = 506 * MiB;
constexpr int CW_BAR = 4096;
constexpr int RING_BYTES = 131072, LDSCTL_OFF = 135168, MISC_OFF = LDSCTL_OFF + 320, GTAB_OFF = LDSCTL_OFF + 1024, STAB_OFF = GTAB_OFF + 8192, LDS_BYTES = 163840;

#define GAS __attribute__((address_space(1)))
#define LAS __attribute__((address_space(3)))
typedef unsigned short bf16;
typedef unsigned v4u __attribute__((ext_vector_type(4)));
typedef float f32x4 __attribute__((ext_vector_type(4)));
#define LDS_WAIT() asm volatile("s_waitcnt lgkmcnt(0)" ::: "memory")
__device__ __forceinline__ unsigned pk2(float lo, float hi) { unsigned r; asm volatile("v_cvt_pk_bf16_f32 %0, %1, %2" : "=v"(r) : "v"(lo), "v"(hi)); return r; }
__device__ __forceinline__ float bflo(unsigned w) { return __uint_as_float(w << 16); }
__device__ __forceinline__ float bfhi(unsigned w) { return __uint_as_float(w & 0xffff0000u); }
#define UNPACK8(W_, V_) do { V_[0] = bflo(W_[0]); V_[1] = bfhi(W_[0]); V_[2] = bflo(W_[1]); V_[3] = bfhi(W_[1]); V_[4] = bflo(W_[2]); V_[5] = bfhi(W_[2]); V_[6] = bflo(W_[3]); V_[7] = bfhi(W_[3]); } while (0)
#define PACK8(V_, W_) do { W_[0] = pk2(V_[0], V_[1]); W_[1] = pk2(V_[2], V_[3]); W_[2] = pk2(V_[4], V_[5]); W_[3] = pk2(V_[6], V_[7]); } while (0)
__device__ __forceinline__ float wave_sum(float v) {
#pragma unroll
    for (int o = 1; o < 64; o <<= 1) v += __shfl_xor(v, o);
    return v;
}
__device__ __forceinline__ int wave_sum_i(int v) {
#pragma unroll
    for (int o = 1; o < 64; o <<= 1) v += __shfl_xor(v, o);
    return v;
}

#define XB_TMO      128
#define XB_XCNT(j)  (256  + 64 * (j))
#define XB_XSUB(j)  (1280 + 64 * (j))
#define XB_XGEN(j)  (2304 + 64 * (j))
#define XB_TOP      3328
#define XB_TOPGEN   3392
#define XCD_BAR_WORDS 3456
#define XB_SPIN_CAP (1u << 20)
__device__ __forceinline__ unsigned xb_ld(unsigned* p)              { return __hip_atomic_load(p, __ATOMIC_RELAXED, __HIP_MEMORY_SCOPE_AGENT); }
__device__ __forceinline__ unsigned xb_add(unsigned* p, unsigned v) { return __hip_atomic_fetch_add(p, v, __ATOMIC_RELAXED, __HIP_MEMORY_SCOPE_AGENT); }
__device__ __forceinline__ unsigned xb_xcc_id() { return (unsigned)__builtin_amdgcn_s_getreg((3 << 11) | 20) & 0xFu; }
#define XB_SPIN(cond, bar) do { unsigned _sp = 0; while (cond) { __builtin_amdgcn_s_sleep(1); \
    if ((++_sp & 255u) == 0u) { if (xb_ld(&(bar)[XB_TMO])) break; if (_sp > XB_SPIN_CAP) { atomicAdd(&(bar)[XB_TMO], 1u); break; } } } } while (0)
struct XcdBarrier { unsigned* bar; unsigned x; volatile LAS unsigned* st; };
__device__ __forceinline__ XcdBarrier xcd_barrier_post(unsigned* bar, volatile LAS unsigned* st) {
    XcdBarrier b; b.bar = bar; b.x = xb_xcc_id(); b.st = st;
    if (threadIdx.x == 0) (void)xb_add(&bar[XB_XCNT(b.x)], 1u);
    return b;
}
__device__ __forceinline__ void xcd_barrier_complete(unsigned* bar, unsigned x, unsigned& nloc, unsigned& nx) {
    const unsigned G = gridDim.x * gridDim.y * gridDim.z;
    unsigned sum, cnt, mine, sp = 0u;
    for (;;) {
        sum = 0u; cnt = 0u; mine = 0u;
#pragma unroll
        for (unsigned j = 0; j < 16; ++j) { const unsigned c = xb_ld(&bar[XB_XCNT(j)]); sum += c; cnt += (c > 0u) ? 1u : 0u; mine = (j == x) ? c : mine; }
        if (sum == G) break;
        __builtin_amdgcn_s_sleep(1);
        if ((++sp & 255u) == 0u) { if (xb_ld(&bar[XB_TMO])) break; if (sp > XB_SPIN_CAP) { atomicAdd(&bar[XB_TMO], 1u); break; } }
    }
    nloc = mine > 0u ? mine : 1u; nx = cnt > 0u ? cnt : 1u;
}
__device__ __forceinline__ void xcd_barrier(const XcdBarrier& b) {
    asm volatile("s_waitcnt vmcnt(0)" ::: "memory");
    __syncthreads();
    if (threadIdx.x == 0) {
        unsigned* bar = b.bar;
        __builtin_amdgcn_s_waitcnt(0);
        unsigned nloc = b.st[0], nx = b.st[1];
        if (nloc == 0u) { xcd_barrier_complete(bar, b.x, nloc, nx); b.st[0] = nloc; b.st[1] = nx; }
        const unsigned old = xb_add(&bar[XB_XSUB(b.x)], 1u);
        const unsigned gen = old / nloc;
        if (old + 1u == (gen + 1u) * nloc) {
            __builtin_amdgcn_fence(__ATOMIC_RELEASE, "agent");
            asm volatile("s_waitcnt vmcnt(0)" ::: "memory");
            const unsigned og = xb_add(&bar[XB_TOP], 1u);
            const unsigned tg = og / nx;
            if (og + 1u == (tg + 1u) * nx) xb_add(&bar[XB_TOPGEN], 1u);
            else XB_SPIN(xb_ld(&bar[XB_TOPGEN]) == tg, bar);
            __builtin_amdgcn_fence(__ATOMIC_ACQUIRE, "agent");
            xb_add(&bar[XB_XGEN(b.x)], 1u);
            asm volatile("s_waitcnt vmcnt(0)" ::: "memory");
        } else {
            XB_SPIN(xb_ld(&bar[XB_XGEN(b.x)]) == gen, bar);
            __builtin_amdgcn_fence(__ATOMIC_ACQUIRE, "agent");
            asm volatile("s_waitcnt vmcnt(0)" ::: "memory");
        }
    }
    __syncthreads();
}

struct Args { const float* in[24]; float* out; unsigned char* ws; int ph_lo, ph_hi; };
struct Ctx {
    LAS unsigned char* lds; char* ldsg;
    int tid, lane, wave, vcu, vcu0, G, G0, gw, NGW;
    bf16* x; float* out;
    unsigned char* ws;
};
#define WSP(T, off) ((T*)(F.ws + (off)))
__device__ __forceinline__ void refresh(Ctx& F) { int t = threadIdx.x; asm volatile("" : "+v"(t)); F.tid = t; F.lane = t & 63;
    int w = __builtin_amdgcn_readfirstlane(t >> 6), v = F.vcu0, g = F.G0; asm volatile("" : "+s"(w), "+s"(v), "+s"(g)); F.wave = w; F.vcu = v; F.G = g; F.gw = v * NWAVES + w; F.NGW = g * NWAVES; }

__device__ __forceinline__ int il32(int i) { return (i < 16) ? 2 * i : 2 * (i - 16) + 1; }
__device__ __forceinline__ int il64(int d) { return (d < 32) ? 2 * d : 2 * (d - 32) + 1; }
__device__ __forceinline__ int dstrow(int kind, int n) {
    if (kind == 1) {
        if (n < 512) { const int h = n >> 6, p = il64(n & 63); return 256 * (h >> 2) + 128 * (p >> 5) + 32 * (h & 3) + (p & 31); }
        if (n < 640) { const int kh = (n - 512) >> 6, p = il64(n & 63); return 512 + 128 * (p >> 5) + 32 * kh + (p & 31); }
        if (n < 768) { const int vh = (n - 640) >> 6, d = n & 63; return 512 + 128 * (d >> 5) + 32 * (2 + vh) + (d & 31); }
        if (n >= 1152) return 1152 + il32(n - 1152);
        return n; }
    if (kind == 2) { const int h = n / 96, p = n % 96; return (p < 64) ? h * 64 + p : 512 + h * 32 + il32(p - 64); }
    if (kind == 3) return (n >> 7) * 256 + (n & 127);
    if (kind == 4) return (n >> 7) * 256 + 128 + (n & 127);
    return n;
}
__device__ __forceinline__ void tr_item(const float* W, int N, const float* gain, bf16* WT, int ldk, int kind, int item, LAS float* scr, int lane) {
    const int nblk = (N + 63) / 64, kb = item / nblk, nb = item % nblk, k0 = 64 * kb, n0 = 64 * nb;
    const int lr = lane >> 4, lc = (lane & 15) * 4; const bool okc = (n0 + lc) < N;
    f32x4 v[16];
#pragma unroll
    for (int i = 0; i < 16; ++i) v[i] = okc ? *(const GAS f32x4*)(W + (size_t)(k0 + 4 * i + lr) * N + n0 + lc) : (f32x4){0.f, 0.f, 0.f, 0.f};
#pragma unroll
    for (int i = 0; i < 16; ++i) { const int kk = 4 * i + lr; const float gk = gain ? gain[k0 + kk] : 1.0f; LAS float* d = scr + kk * 65 + lc;
        d[0] = v[i].x * gk; d[1] = v[i].y * gk; d[2] = v[i].z * gk; d[3] = v[i].w * gk; }
    LDS_WAIT(); asm volatile("" ::: "memory");
    const int c = lane & 7;
#pragma unroll
    for (int j = 0; j < 8; ++j) { const int n = (lane >> 3) + 8 * j; const LAS float* s = scr + (8 * c) * 65 + n;
        v4u o; o.x = pk2(s[0 * 65], s[1 * 65]); o.y = pk2(s[2 * 65], s[3 * 65]); o.z = pk2(s[4 * 65], s[5 * 65]); o.w = pk2(s[6 * 65], s[7 * 65]);
        if (n0 + n < N) *(GAS v4u*)(WT + (size_t)dstrow(kind, n0 + n) * ldk + k0 + 8 * c) = o; }
    LDS_WAIT(); asm volatile("" ::: "memory");
}
constexpr int SMALL_ITEMS = 1152;
__device__ __forceinline__ void small_weight_item(const Ctx& F, const Args& A, int l, int r, LAS float* scr) {
    bf16* wl = WSP(bf16, WS_WSMALL + (size_t)l * WSMALL_STRIDE);
    if (r < 304) { tr_item(A.in[3] + (size_t)l * DM * IN_W, IN_W, A.in[2] + l * DM, wl + OFF_WIN / 2, DM, 1, r, scr, F.lane); return; } r -= 304;
    if (r < 48)  { tr_item(A.in[8] + (size_t)l * 256 * 768, 768, A.in[6] + l * 256, wl + OFF_WQB / 2, 256, 2, r, scr, F.lane); return; } r -= 48;
    if (r < 32)  { tr_item(A.in[9] + (size_t)l * 128 * 1024, 1024, A.in[7] + l * 128, wl + OFF_WKVB / 2, 128, 0, r, scr, F.lane); return; } r -= 32;
    if (r < 256) { const int kb = r / 16; const float* gain = (kb < 8) ? (A.in[10] + l * 512) : (A.in[11] + l * 512 - 512);
                   tr_item(A.in[12] + (size_t)l * DM * DM, DM, gain, wl + OFF_WO / 2, DM, 0, r, scr, F.lane); return; } r -= 256;
    if (r < 128) { tr_item(A.in[15] + (size_t)l * DM * 512, 512, A.in[13] + l * DM, wl + OFF_WMQ / 2, DM, 0, r, scr, F.lane); return; } r -= 128;
    if (r < 256) { tr_item(A.in[16] + (size_t)l * DM * DM, DM, A.in[14] + l * DM, wl + OFF_WMKV / 2, DM, 0, r, scr, F.lane); return; } r -= 256;
    tr_item(A.in[17] + (size_t)l * 512 * DM, DM, nullptr, wl + OFF_WMO / 2, 512, 0, r, scr, F.lane);
}
constexpr int MOE_ITEMS = 3 * 2048;
__device__ __forceinline__ void moe_weight_item(const Ctx& F, const Args& A, int l, int it, LAS float* scr) {
    bf16* wgu = WSP(bf16, (l & 1) ? WS_WGU2 : WS_WGU); bf16* wd = WSP(bf16, (l & 1) ? WS_WD2 : WS_WD);
    const int which = it >> 11, e = (it >> 7) & 15, r = it & 127;
    if (which < 2) tr_item((which == 0 ? A.in[20] : A.in[21]) + (size_t)(l * NEXP + e) * DM * EFF, EFF, A.in[18] + l * DM, wgu + (size_t)e * 1024 * 1024, DM, 3 + which, r, scr, F.lane);
    else           tr_item(A.in[22] + (size_t)(l * NEXP + e) * EFF * DM, DM, nullptr, wd + (size_t)e * 1024 * 512, EFF, 0, r, scr, F.lane);
}
__device__ __forceinline__ void convert_moe_weights(const Ctx& F, const Args& A, int l) {
    LAS float* scr = (LAS float*)(F.lds + F.wave * 16640);
    for (int it = F.gw; it < MOE_ITEMS; it += F.NGW) moe_weight_item(F, A, l, it, scr);
}

__device__ __forceinline__ void rms_row_f32(const float* xrow, bf16* xb, bf16* orow, float* rs, int lane) {
    const GAS f32x4* xr = (const GAS f32x4*)xrow + lane;
    f32x4 v[4]; float s = 0.f;
#pragma unroll
    for (int j = 0; j < 4; ++j) { v[j] = xr[64 * j]; s += (v[j].x * v[j].x + v[j].y * v[j].y) + (v[j].z * v[j].z + v[j].w * v[j].w); }
    const float rstd = __builtin_amdgcn_rsqf(wave_sum(s) * (1.f / DM) + EPS);
    if (xb) { GAS unsigned long long* x8 = (GAS unsigned long long*)xb + lane;
#pragma unroll
        for (int j = 0; j < 4; ++j) x8[64 * j] = (unsigned long long)pk2(v[j].x, v[j].y) | ((unsigned long long)pk2(v[j].z, v[j].w) << 32); }
    if (rs && lane == 0) *rs = rstd;
    if (orow) { GAS unsigned long long* o8 = (GAS unsigned long long*)orow + lane;
#pragma unroll
        for (int j = 0; j < 4; ++j) o8[64 * j] = (unsigned long long)pk2(v[j].x * rstd, v[j].y * rstd) | ((unsigned long long)pk2(v[j].z * rstd, v[j].w * rstd) << 32); }
}
__device__ __forceinline__ void phase_prologue(const Ctx& F, const Args& A) {
    LAS float* scr = (LAS float*)(F.lds + F.wave * 16640);
    for (int it = F.gw; it < DEPTH * SMALL_ITEMS; it += F.NGW) small_weight_item(F, A, it / SMALL_ITEMS, it % SMALL_ITEMS, scr);
    convert_moe_weights(F, A, 0);
    const int gt = F.vcu * (NWAVES * 64) + F.tid, NGT = F.G * NWAVES * 64;
    for (int i = gt; i < DEPTH * 12288; i += NGT) { const int l = i / 12288, r = i % 12288;
        bf16* wl = WSP(bf16, WS_WSMALL + (size_t)l * WSMALL_STRIDE);
        *(GAS v4u*)(wl + OFF_WIN / 2 + (size_t)IN_W * DM + (size_t)r * 8) = (v4u){0u, 0u, 0u, 0u}; }
    for (int i = gt; i < 1536; i += NGT) WSP(float, WS_GAINS)[i] = (i < 256) ? A.in[4][i] : (i < 512) ? A.in[5][i - 256] : A.in[23][i - 512];
    for (int i = gt; i < DEPTH * NEXP * DM; i += NGT) { const int l = i / (NEXP * DM), e = (i / DM) % NEXP, k = i % DM;
        WSP(float, WS_WR)[i] = A.in[19][(size_t)(l * DM + k) * NEXP + e] * A.in[18][l * DM + k]; }
    for (int i = gt; i < SEQ * 48; i += NGT) { const int s = i / 48, j = i % 48; const float row = (float)(s >> 6), col = (float)(s & 63);
        const bool isg = (j < 32); const int j2 = isg ? j : j - 32, half = isg ? 16 : 8, jj = j2 & (half - 1);
        const float inv = __builtin_amdgcn_exp2f(-(float)(2 * jj) / (float)(2 * half) * 13.287712379549449f);
        const float ang = ((j2 < half) ? row : col) * inv;
        double td = (double)ang * 0.15915494309189535; td -= rint(td);
        const float sn = __builtin_amdgcn_sinf((float)td), cs = __builtin_amdgcn_cosf((float)td);
        float* dst = isg ? (WSP(float, WS_TABG) + ((size_t)s * 32 + j2) * 2) : (WSP(float, WS_TABM) + ((size_t)s * 16 + j2) * 2);
        dst[0] = cs; dst[1] = sn; }
    for (int m = F.gw; m < MROWS; m += F.NGW) rms_row_f32(A.in[1] + (size_t)m * DM, nullptr, WSP(bf16, WS_MEMN) + (size_t)m * DM, nullptr, F.lane);
    for (int m = F.gw; m < MTOK; m += F.NGW) rms_row_f32(A.in[0] + (size_t)m * DM, F.x + (size_t)m * DM, nullptr, WSP(float, WS_RS1) + m, F.lane);
}

__device__ __forceinline__ void rope4(float* v, const float* tab) {
    const f32x4 t0 = *(const f32x4*)tab, t1 = *(const f32x4*)(tab + 4);
    float a, b;
    a = v[0]; b = v[1]; v[0] = a * t0[0] - b * t0[1]; v[1] = b * t0[0] + a * t0[1];
    a = v[2]; b = v[3]; v[2] = a * t0[2] - b * t0[3]; v[3] = b * t0[2] + a * t0[3];
    a = v[4]; b = v[5]; v[4] = a * t1[0] - b * t1[1]; v[5] = b * t1[0] + a * t1[1];
    a = v[6]; b = v[7]; v[6] = a * t1[2] - b * t1[3]; v[7] = b * t1[2] + a * t1[3];
}
__device__ __forceinline__ void phase_postproj(const Ctx& F, int l) {
    int lane_ = F.lane; asm volatile("" : "+v"(lane_)); const int lane = lane_;
    const float* gq = WSP(float, WS_GAINS) + l * 64; const float* gk = WSP(float, WS_GAINS) + 256 + l * 64;
    float gqv[8], gkv[8];
#pragma unroll
    for (int i = 0; i < 8; ++i) { const int p = 8 * (lane & 7) + i, d = (p >> 1) + 32 * (p & 1); gqv[i] = gq[d]; gkv[i] = gk[d]; }
    const float* tabg = WSP(float, WS_TABG); const float* tabm = WSP(float, WS_TABM);
    const float C2G = 0.125f * LOG2E;
    v4u wa_n = (v4u){0u, 0u, 0u, 0u}, wb_n = wa_n, wc_n = wa_n;
    if (F.gw < MTOK) { const bf16* pr = WSP(bf16, WS_PROJ) + (size_t)F.gw * IN_WP; wa_n = *(const GAS v4u*)(pr + 8 * lane); wb_n = *(const GAS v4u*)(pr + 512 + 8 * lane); if (lane < 20) wc_n = *(const GAS v4u*)(pr + 1024 + 8 * lane); }
    for (int m = F.gw; m < MTOK; m += F.NGW) {
        const int s = m & (SEQ - 1);
        const v4u wa = wa_n, wb = wb_n, wc = wc_n;
        if (m + F.NGW < MTOK) { const bf16* pr = WSP(bf16, WS_PROJ) + (size_t)(m + F.NGW) * IN_WP; wa_n = *(const GAS v4u*)(pr + 8 * lane); wb_n = *(const GAS v4u*)(pr + 512 + 8 * lane); if (lane < 20) wc_n = *(const GAS v4u*)(pr + 1024 + 8 * lane); }
        { const v4u w = wa; float v[8]; UNPACK8(w, v);
          float ss = 0.f;
#pragma unroll
          for (int i = 0; i < 8; ++i) ss += v[i] * v[i];
          ss += __shfl_xor(ss, 1); ss += __shfl_xor(ss, 2); ss += __shfl_xor(ss, 4);
          const float rstd = __builtin_amdgcn_rsqf(ss * (1.f / 64.f) + EPS);
#pragma unroll
          for (int i = 0; i < 8; ++i) v[i] = v[i] * rstd * gqv[i];
          rope4(v, tabg + ((size_t)s * 32 + 4 * (lane & 7)) * 2);
#pragma unroll
          for (int i = 0; i < 8; ++i) v[i] *= C2G;
          v4u o; PACK8(v, o); *(GAS v4u*)(WSP(bf16, WS_QG) + (size_t)m * 512 + 8 * lane) = o; }
        { const v4u w = wb; float v[8]; UNPACK8(w, v);
          float ss = 0.f;
#pragma unroll
          for (int i = 0; i < 8; ++i) ss += v[i] * v[i];
          ss += __shfl_xor(ss, 1); ss += __shfl_xor(ss, 2); ss += __shfl_xor(ss, 4);
          const float ss8 = ss;
          ss += __shfl_xor(ss, 8); ss += __shfl_xor(ss, 16);
          if (lane < 16) {
              const float rstd = __builtin_amdgcn_rsqf(ss8 * (1.f / 64.f) + EPS);
#pragma unroll
              for (int i = 0; i < 8; ++i) v[i] = v[i] * rstd * gkv[i];
              rope4(v, tabg + ((size_t)s * 32 + 4 * (lane & 7)) * 2);
              v4u o; PACK8(v, o); *(GAS v4u*)(WSP(bf16, WS_KG) + (size_t)m * 128 + 8 * lane) = o;
          } else if (lane < 32) {
              *(GAS v4u*)(WSP(bf16, WS_VG) + (size_t)m * 128 + 8 * (lane - 16)) = w;
          } else {
              const float rstd = __builtin_amdgcn_rsqf(ss * (1.f / 256.f) + EPS);
#pragma unroll
              for (int i = 0; i < 8; ++i) v[i] *= rstd;
              v4u o; PACK8(v, o); *(GAS v4u*)(WSP(bf16, WS_LAT) + (size_t)m * 512 + 8 * (lane - 32)) = o;
          } }
        { const v4u w = wc;
          float v[8]; UNPACK8(w, v);
          float ss = 0.f;
#pragma unroll
          for (int i = 0; i < 8; ++i) ss += v[i] * v[i];
          ss += __shfl_xor(ss, 1); ss += __shfl_xor(ss, 2); ss += __shfl_xor(ss, 4); ss += __shfl_xor(ss, 8);
          if (lane < 16) {
              const float rstd = __builtin_amdgcn_rsqf(ss * (1.f / 128.f) + EPS);
#pragma unroll
              for (int i = 0; i < 8; ++i) v[i] *= rstd;
              v4u o; PACK8(v, o); *(GAS v4u*)(WSP(bf16, WS_LAT) + (size_t)m * 512 + 256 + 8 * lane) = o;
          } else if (lane < 20) {
              rope4(v, tabm + ((size_t)s * 16 + 4 * (lane - 16)) * 2);
              v4u o; PACK8(v, o); *(GAS v4u*)(WSP(bf16, WS_KROPE) + (size_t)m * 32 + 8 * (lane - 16)) = o;
          } else if (lane < 36) {
              *(GAS v4u*)(WSP(bf16, WS_LAT) + (size_t)m * 512 + 384 + 8 * (lane - 20)) = (v4u){0u, 0u, 0u, 0u};
          } }
    }
}

__device__ __forceinline__ void phase_outnorm(const Ctx& F) {
    int lane_ = F.lane; asm volatile("" : "+v"(lane_)); const int lane = lane_;
    for (int m = F.gw; m < MTOK; m += F.NGW) {
        bf16* orow = WSP(bf16, WS_O) + (size_t)m * DM;
#pragma unroll
        for (int g = 0; g < 2; ++g) {
            v4u w = *(const GAS v4u*)(orow + g * 512 + 8 * lane); float v[8]; UNPACK8(w, v);
            float ss = 0.f;
#pragma unroll
            for (int i = 0; i < 8; ++i) ss += v[i] * v[i];
            const float rstd = __builtin_amdgcn_rsqf(wave_sum(ss) * (1.f / 512.f) + EPS);
#pragma unroll
            for (int i = 0; i < 8; ++i) v[i] *= rstd;
            v4u o; PACK8(v, o); *(GAS v4u*)(orow + g * 512 + 8 * lane) = o;
        }
    }
}

__device__ __forceinline__ void phase_router(const Ctx& F, int l) {
    int lane_ = F.lane; asm volatile("" : "+v"(lane_)); const int lane = lane_;
    LAS float* wr = (LAS float*)F.lds;
    { const GAS f32x4* src = (const GAS f32x4*)(WSP(float, WS_WR) + (size_t)l * NEXP * DM);
      for (int i = F.tid; i < NEXP * DM / 4; i += NWAVES * 64) ((LAS f32x4*)wr)[i] = src[i]; }
    __syncthreads();
    for (int mp = F.gw; mp < MTOK / 2; mp += F.NGW) {
        const int m = 2 * mp;
        asm volatile("" ::: "memory");
        typedef unsigned u32x2 __attribute__((ext_vector_type(2)));
        const GAS u32x2* xr0 = (const GAS u32x2*)(F.x + (size_t)m * DM) + lane; const GAS u32x2* xr1 = xr0 + DM / 4;
        f32x4 v0[4], v1[4]; float s0 = 0.f, s1 = 0.f;
#pragma unroll
        for (int j = 0; j < 4; ++j) { const u32x2 q0 = xr0[64 * j], q1 = xr1[64 * j];
            v0[j] = (f32x4){bflo(q0.x), bfhi(q0.x), bflo(q0.y), bfhi(q0.y)}; v1[j] = (f32x4){bflo(q1.x), bfhi(q1.x), bflo(q1.y), bfhi(q1.y)}; }
#pragma unroll
        for (int j = 0; j < 4; ++j) { s0 += (v0[j].x * v0[j].x + v0[j].y * v0[j].y) + (v0[j].z * v0[j].z + v0[j].w * v0[j].w); s1 += (v1[j].x * v1[j].x + v1[j].y * v1[j].y) + (v1[j].z * v1[j].z + v1[j].w * v1[j].w); }
        const float rstd0 = __builtin_amdgcn_rsqf(wave_sum(s0) * (1.f / DM) + EPS), rstd1 = __builtin_amdgcn_rsqf(wave_sum(s1) * (1.f / DM) + EPS);
        if (lane == 0) { WSP(float, WS_RS3)[m] = rstd0; WSP(float, WS_RS3)[m + 1] = rstd1; }
        float a0[16], a1[16];
#pragma unroll
        for (int e = 0; e < 16; ++e) { float p = 0.f, q = 0.f;
#pragma unroll
            for (int j = 0; j < 4; ++j) { const f32x4 w = *((const LAS f32x4*)(wr + e * DM) + lane + 64 * j);
                p += (v0[j].x * w.x + v0[j].y * w.y) + (v0[j].z * w.z + v0[j].w * w.w); q += (v1[j].x * w.x + v1[j].y * w.y) + (v1[j].z * w.z + v1[j].w * w.w); }
            a0[e] = p; a1[e] = q; }
        float t16[16];
#pragma unroll
        for (int e = 0; e < 16; ++e) { const float send = (lane & 32) ? a0[e] : a1[e], keep = (lane & 32) ? a1[e] : a0[e]; t16[e] = keep + __shfl_xor(send, 32); }
        float t8[8];
#pragma unroll
        for (int e = 0; e < 8; ++e) { const float send = (lane & 16) ? t16[e] : t16[e + 8], keep = (lane & 16) ? t16[e + 8] : t16[e]; t8[e] = keep + __shfl_xor(send, 16); }
        float t4[4];
#pragma unroll
        for (int e = 0; e < 4; ++e) { const float send = (lane & 8) ? t8[e] : t8[e + 4], keep = (lane & 8) ? t8[e + 4] : t8[e]; t4[e] = keep + __shfl_xor(send, 8); }
        float t2[2];
#pragma unroll
        for (int e = 0; e < 2; ++e) { const float send = (lane & 4) ? t4[e] : t4[e + 2], keep = (lane & 4) ? t4[e + 2] : t4[e]; t2[e] = keep + __shfl_xor(send, 4); }
        float lg; { const float send = (lane & 2) ? t2[0] : t2[1], keep = (lane & 2) ? t2[1] : t2[0]; lg = keep + __shfl_xor(send, 2); }
        lg += __shfl_xor(lg, 1);
        lg *= (lane & 32) ? rstd1 : rstd0;
        float mx = lg;
        mx = fmaxf(mx, __shfl_xor(mx, 2)); mx = fmaxf(mx, __shfl_xor(mx, 4)); mx = fmaxf(mx, __shfl_xor(mx, 8)); mx = fmaxf(mx, __shfl_xor(mx, 16));
        const float ex = __expf(lg - mx);
        float den = ex; den += __shfl_xor(den, 2); den += __shfl_xor(den, 4); den += __shfl_xor(den, 8); den += __shfl_xor(den, 16);
        const float mine = ex / den;
        if ((lane & 1) == 0) { const int row = m + (lane >> 5), e = (lane >> 1) & 15;
            WSP(float, WS_AFF)[(size_t)row * 16 + e] = mine;
            WSP(float, WS_AFFT)[((size_t)(row >> 12) * 16 + e) * SEQ + (row & (SEQ - 1))] = mine; }
    }
    __syncthreads();
}

__device__ __forceinline__ int block_excl_scan(int v, LAS int* red, int lane, int wave, int& total) {
    int inc = v;
#pragma unroll
    for (int o = 1; o < 64; o <<= 1) { const int t = __shfl_up(inc, o); if (lane >= o) inc += t; }
    __syncthreads();
    if (lane == 63) red[wave] = inc;
    __syncthreads();
    int base = 0, tot = 0;
#pragma unroll
    for (int w = 0; w < 8; ++w) { const int t = red[w]; if (w < wave) base += t; tot += t; }
    total = tot;
    return base + inc - v;
}
__device__ __forceinline__ void phase_select(const Ctx& F, const Args& A, int l) {
    LAS int* red = (LAS int*)F.lds;
    int tid_ = F.tid; asm volatile("" : "+v"(tid_)); const int tid = tid_, lane = tid & 63, wave = F.wave;
    for (int pair = F.vcu; pair < BATCH * NEXP; pair += F.G) {
        const int b = pair >> 4, e = pair & 15;
        const GAS v4u* src = (const GAS v4u*)(WSP(float, WS_AFFT) + (size_t)pair * SEQ) + 2 * tid;
        const v4u w0 = src[0], w1 = src[1];
        unsigned v[8] = {w0.x, w0.y, w0.z, w0.w, w1.x, w1.y, w1.z, w1.w};
        unsigned T = 0u; int par = 0;
        for (int bit = 30; bit >= 0; --bit) {
            const unsigned cand = T | (1u << bit);
            int c = 0;
#pragma unroll
            for (int i = 0; i < 8; ++i) c += (v[i] >= cand) ? 1 : 0;
            c = wave_sum_i(c);
            if (lane == 0) red[par * 8 + wave] = c;
            __syncthreads();
            int tot = 0;
#pragma unroll
            for (int w = 0; w < 8; ++w) tot += red[par * 8 + w];
            if (tot >= CAP) T = cand;
            par ^= 1;
        }
        int cgt = 0, ceq = 0;
#pragma unroll
        for (int i = 0; i < 8; ++i) { cgt += (v[i] > T) ? 1 : 0; ceq += (v[i] == T) ? 1 : 0; }
        int ngt, neq_tot;
        (void)block_excl_scan(cgt, red + 16, lane, wave, ngt);
        int eqb = block_excl_scan(ceq, red + 16, lane, wave, neq_tot);
        const int need_eq = CAP - ngt;
        int sel[8], csel = 0;
#pragma unroll
        for (int i = 0; i < 8; ++i) { const bool iseq = (v[i] == T); sel[i] = ((v[i] > T) || (iseq && eqb < need_eq)) ? 1 : 0; eqb += iseq ? 1 : 0; csel += sel[i]; }
        int nsel;
        int pos = block_excl_scan(csel, red + 16, lane, wave, nsel);
        int* idx = WSP(int, WS_IDX) + (size_t)(e * BATCH + b) * CAP; float* rg = WSP(float, WS_RG) + (size_t)(e * BATCH + b) * CAP; const float* rs3 = WSP(float, WS_RS3) + (size_t)b * SEQ;
        int* slot = WSP(int, WS_SLOT) + ((size_t)b * SEQ + (size_t)tid * 8) * NEXP + e;
#pragma unroll
        for (int i = 0; i < 8; ++i) { if (sel[i]) { if (pos < CAP) { idx[pos] = tid * 8 + i; rg[pos] = rs3[tid * 8 + i]; } slot[i * NEXP] = pos; ++pos; } else slot[i * NEXP] = -1; }
        __syncthreads();
    }
    if (l + 1 < DEPTH) {
        const bool split = F.G > BATCH * NEXP; const int nw = split ? (F.G - BATCH * NEXP) * NWAVES : F.NGW, wi = split ? (F.vcu - BATCH * NEXP) * NWAVES + F.wave : F.gw;
        LAS float* scr = (LAS float*)(F.lds + F.wave * 16640);
        if (wi >= 0) for (int it = wi; it < MOE_ITEMS; it += nw) moe_weight_item(F, A, l + 1, it, scr);
    }
}

__device__ __forceinline__ void phase_gather(const Ctx& F) {
    int lane_ = F.lane; asm volatile("" : "+v"(lane_)); const int lane = lane_;
    for (int r = F.gw; r < MOE_ROWS; r += F.NGW) {
        const int b = (r >> 9) & 7; const int t = WSP(int, WS_IDX)[r];
        const GAS v4u* src = (const GAS v4u*)(WSP(bf16, WS_H) + ((size_t)b * SEQ + t) * DM) + lane;
        GAS v4u* dst = (GAS v4u*)(WSP(bf16, WS_XG) + (size_t)r * DM) + lane;
        const v4u a = src[0], c = src[64]; dst[0] = a; dst[64] = c;
    }
}

__device__ __forceinline__ void phase_combine(const Ctx& F, const Args& A, int l, float amul) {
    int lane_ = F.lane; asm volatile("" : "+v"(lane_)); const int lane = lane_; const bool lastl = (l == DEPTH - 1);
    const float* gfin = WSP(float, WS_GAINS) + 512;
    v4u xa_n = (v4u){0u, 0u, 0u, 0u}, xc_n = xa_n; int sl_n = -1; float af_n = 0.f;
    if (F.gw < MTOK) { const GAS v4u* xp = (const GAS v4u*)(F.x + (size_t)F.gw * DM) + lane; xa_n = xp[0]; xc_n = xp[64];
        sl_n = WSP(int, WS_SLOT)[(size_t)F.gw * NEXP + (lane & 15)]; af_n = WSP(float, WS_AFF)[(size_t)F.gw * NEXP + (lane & 15)]; }
    for (int m = F.gw; m < MTOK; m += F.NGW) {
        const int b = m >> 12;
        GAS v4u* xr = (GAS v4u*)(F.x + (size_t)m * DM) + lane;
        const v4u xa = xa_n, xc = xc_n; const int sl = sl_n; const float af = amul * af_n;
        if (m + F.NGW < MTOK) { const int mn = m + F.NGW; const GAS v4u* xp = (const GAS v4u*)(F.x + (size_t)mn * DM) + lane; xa_n = xp[0]; xc_n = xp[64];
            sl_n = WSP(int, WS_SLOT)[(size_t)mn * NEXP + (lane & 15)]; af_n = WSP(float, WS_AFF)[(size_t)mn * NEXP + (lane & 15)]; }
        f32x4 x0 = (f32x4){bflo(xa.x), bfhi(xa.x), bflo(xa.y), bfhi(xa.y)}, x1 = (f32x4){bflo(xa.z), bfhi(xa.z), bflo(xa.w), bfhi(xa.w)};
        f32x4 x2 = (f32x4){bflo(xc.x), bfhi(xc.x), bflo(xc.y), bfhi(xc.y)}, x3 = (f32x4){bflo(xc.z), bfhi(xc.z), bflo(xc.w), bfhi(xc.w)};
        unsigned mask = (unsigned)(__ballot(sl >= 0 && lane < 16));
#define CMB_ACC(Y0, Y1, AE) do { x0.x += AE * bflo(Y0.x); x0.y += AE * bfhi(Y0.x); x0.z += AE * bflo(Y0.y); x0.w += AE * bfhi(Y0.y); \
            x1.x += AE * bflo(Y0.z); x1.y += AE * bfhi(Y0.z); x1.z += AE * bflo(Y0.w); x1.w += AE * bfhi(Y0.w); \
            x2.x += AE * bflo(Y1.x); x2.y += AE * bfhi(Y1.x); x2.z += AE * bflo(Y1.y); x2.w += AE * bfhi(Y1.y); \
            x3.x += AE * bflo(Y1.z); x3.y += AE * bfhi(Y1.z); x3.z += AE * bflo(Y1.w); x3.w += AE * bfhi(Y1.w); } while (0)
        while (mask) {
            const int e1 = __builtin_ctz(mask); mask &= mask - 1u;
            const bool two = mask != 0u; const int e2 = two ? __builtin_ctz(mask) : e1; if (two) mask &= mask - 1u;
            const int s1 = __shfl(sl, e1), s2 = __shfl(sl, e2); const float a1 = __shfl(af, e1), a2 = two ? __shfl(af, e2) : 0.f;
            const GAS v4u* yr1 = (const GAS v4u*)(WSP(bf16, WS_Y) + ((size_t)(e1 * BATCH + b) * CAP + s1) * DM) + lane;
            const GAS v4u* yr2 = (const GAS v4u*)(WSP(bf16, WS_Y) + ((size_t)(e2 * BATCH + b) * CAP + s2) * DM) + lane;
            const v4u y0 = yr1[0], y1 = yr1[64], z0 = yr2[0], z1 = yr2[64];
            CMB_ACC(y0, y1, a1); CMB_ACC(z0, z1, a2);
        }
#undef CMB_ACC
        float s = (x0.x * x0.x + x0.y * x0.y) + (x0.z * x0.z + x0.w * x0.w) + (x1.x * x1.x + x1.y * x1.y) + (x1.z * x1.z + x1.w * x1.w)
                + (x2.x * x2.x + x2.y * x2.y) + (x2.z * x2.z + x2.w * x2.w) + (x3.x * x3.x + x3.y * x3.y) + (x3.z * x3.z + x3.w * x3.w);
        const float rstd = __builtin_amdgcn_rsqf(wave_sum(s) * (1.f / DM) + EPS);
        if (lastl) {
            const f32x4 g0 = *(const f32x4*)(gfin + 8 * lane), g1 = *(const f32x4*)(gfin + 8 * lane + 4), g2 = *(const f32x4*)(gfin + 512 + 8 * lane), g3 = *(const f32x4*)(gfin + 512 + 8 * lane + 4);
            GAS f32x4* ow = (GAS f32x4*)(F.out + (size_t)m * DM);
            ow[2 * lane] = x0 * rstd * g0; ow[2 * lane + 1] = x1 * rstd * g1; ow[128 + 2 * lane] = x2 * rstd * g2; ow[128 + 2 * lane + 1] = x3 * rstd * g3;
        } else {
            v4u n0, n1; n0.x = pk2(x0.x, x0.y); n0.y = pk2(x0.z, x0.w); n0.z = pk2(x1.x, x1.y); n0.w = pk2(x1.z, x1.w); n1.x = pk2(x2.x, x2.y); n1.y = pk2(x2.z, x2.w); n1.z = pk2(x3.x, x3.y); n1.w = pk2(x3.z, x3.w);
            xr[0] = n0; xr[64] = n1;
            if (lane == 0) WSP(float, WS_RS1)[m] = rstd;
        }
    }
}

__device__ __forceinline__ void phase_attn_self(const Ctx& F, int l) {
    float gmq = fabsf(WSP(float, WS_GAINS)[l * 64 + F.lane]), gmk = fabsf(WSP(float, WS_GAINS)[256 + l * 64 + F.lane]);
#pragma unroll
    for (int o = 1; o < 64; o <<= 1) { gmq = fmaxf(gmq, __shfl_xor(gmq, o)); gmk = fmaxf(gmk, __shfl_xor(gmk, o)); }
    const bool bounded = (8.0f * LOG2E * gmq * gmk) < 64.0f;
    const int lane = F.lane, r32 = lane & 31, hi = lane >> 5, wid = F.wave;
#ifndef DUPATT
#define DUPATT 0
#endif
    for (int g = 0; g < 2; ++g)
      for (int rep2_ = 0; rep2_ < 1 + ((DUPATT >> g) & 1); ++rep2_)
        for (int u = F.vcu; u < 256; u += F.G) {
            const int b = u >> 5, qb = (u >> 1) & 15, hh = u & 1;
            const size_t r0 = (size_t)b * SEQ, q0 = r0 + (size_t)qb * 256;
            float ssacc[16];
#pragma unroll
            for (int r = 0; r < 16; ++r) ssacc[r] = 0.f;
            for (int hq = 0; hq < 4; ++hq) {
                const int h = hh * 4 + hq;
                if (g == 0) {
                    if (bounded) att::attn_unit<64, 0, 64, 1, true>(WSP(bf16, WS_QG) + q0 * 512 + h * 64, nullptr, 512, WSP(bf16, WS_KG) + r0 * 128 + hh * 64, 128, nullptr, 0,
                                              WSP(bf16, WS_VG) + r0 * 128 + hh * 64, 128, WSP(bf16, WS_O) + q0 * DM + h * 64, DM, SEQ, F.ldsg, ssacc);
                    else         att::attn_unit<64, 0, 64, 0, true>(WSP(bf16, WS_QG) + q0 * 512 + h * 64, nullptr, 512, WSP(bf16, WS_KG) + r0 * 128 + hh * 64, 128, nullptr, 0,
                                              WSP(bf16, WS_VG) + r0 * 128 + hh * 64, 128, WSP(bf16, WS_O) + q0 * DM + h * 64, DM, SEQ, F.ldsg, ssacc);
                } else {
                    att::attn_unit<64, 32, 64, 0, true>(WSP(bf16, WS_QM) + q0 * 768 + h * 64, WSP(bf16, WS_QM) + q0 * 768 + 512 + h * 32, 768, WSP(bf16, WS_KVM) + r0 * DM + h * 128, DM, WSP(bf16, WS_KROPE) + r0 * 32, 32,
                                               WSP(bf16, WS_KVM) + r0 * DM + h * 128 + 64, DM, WSP(bf16, WS_O) + q0 * DM + 512 + h * 64, DM, SEQ, F.ldsg, ssacc);
                }
            }
#pragma unroll
            for (int r = 0; r < 16; ++r) { float s = ssacc[r];
                s += __shfl_xor(s, 1); s += __shfl_xor(s, 2); s += __shfl_xor(s, 4); s += __shfl_xor(s, 8); s += __shfl_xor(s, 16);
                if (r32 == 0) WSP(float, WS_SSO)[(q0 + wid * 32 + att::crow(r, hi)) * 4 + g * 2 + hh] = s; }
        }
}
__device__ __forceinline__ void phase_attn_mem(const Ctx& F, int l) {
    const bf16* kv = WSP(bf16, WS_MEMKV) + (size_t)l * MROWS * DM; float dummy[16];
    for (int idx = F.vcu; idx < 256; idx += F.G) {
        const int pm = idx >> 1, pn = idx & 1, b = pm >> 4;
        const size_t q0 = (size_t)pm * 256, k0 = (size_t)b * MEM_T;
        for (int hh = 0; hh < 2; ++hh) { const int h = 2 * pn + hh;
            att::attn_unit<128, 0, 128, 0, false>(WSP(bf16, WS_QMEM) + q0 * 512 + h * 128, nullptr, 512, kv + k0 * DM + h * 128, DM, nullptr, 0,
                                        kv + k0 * DM + 512 + h * 128, DM, WSP(bf16, WS_OMEM) + q0 * 512 + h * 128, 512, MEM_T, F.ldsg, dummy); }
    }
}

__global__ void __launch_bounds__(NWAVES * 64, 2) enc_fwd(Args args) {
    extern __shared__ __attribute__((aligned(16))) unsigned char lds[];
    Ctx F;
    F.lds = (LAS unsigned char*)lds; F.ldsg = (char*)lds;
    F.tid = threadIdx.x; F.lane = F.tid & 63; F.wave = __builtin_amdgcn_readfirstlane(F.tid >> 6);
    F.G = gridDim.x; F.G0 = F.G; { const int bx = blockIdx.x; F.vcu0 = (F.G % 8 == 0) ? (bx % 8) * (F.G / 8) + bx / 8 : bx; F.vcu = F.vcu0; }
    F.gw = F.vcu * NWAVES + F.wave; F.NGW = F.G * NWAVES;
    F.out = args.out; F.ws = args.ws; F.x = (bf16*)(args.ws + WS_X);
    volatile LAS unsigned* MISC = (volatile LAS unsigned*)(F.lds + MISC_OFF);
    for (int u = F.tid; u < (LDS_BYTES - LDSCTL_OFF) / 4; u += NWAVES * 64) ((LAS unsigned*)(F.lds + LDSCTL_OFF))[u] = 0u;
    __syncthreads();
    XcdBarrier bar; bar.bar = (unsigned*)(F.ws + WS_CTL) + CW_BAR; bar.x = 0; bar.st = nullptr;
    if (MK_N_LAUNCHES == 1) bar = xcd_barrier_post((unsigned*)(F.ws + WS_CTL) + CW_BAR, MISC + 8);
    const int lo = args.ph_lo, hi = args.ph_hi;
#ifndef ONLY_SITE
#define ONLY_SITE -1
#endif
#define ON(s) (ONLY_SITE < 0 || ONLY_SITE == (s))
#ifndef DUPMASK
#define DUPMASK 0u
#endif
#define REP(s) for (int rep_ = 0; rep_ < 1 + (int)((DUPMASK >> (s)) & 1u); ++rep_)
#define IN(k) (lo <= (k) && (k) < hi)
#define SEAM(k) do { if (IN(k) && IN((k) + 1)) xcd_barrier(bar); } while (0)
#define LOCAL_SEAM() do { asm volatile("s_waitcnt vmcnt(0)" ::: "memory"); __syncthreads(); __builtin_amdgcn_fence(__ATOMIC_ACQUIRE, "agent"); asm volatile("s_waitcnt vmcnt(0)" ::: "memory"); __syncthreads(); } while (0)
#define GEMM(EpiT, epi, Ap, lda_, Bp, ldb_, K_, nM_, nN_, gdiv_, gstride_) do { const pg8::Gemm g_{(const bf16*)(Ap), (const bf16*)(Bp), lda_, ldb_, K_, gdiv_, 1 << 30, (size_t)(gstride_), nullptr, nullptr}; \
        pg8::StaticOrder S_; S_.init(nM_, nN_, F.G, (int)blockIdx.x); pg8::gemm_phase<EpiT, pg8::StaticOrder, true>(F.lds, g_, S_, epi); } while (0)

    #ifndef PRODUP
#define PRODUP 0
#endif
    if (ON(100) && IN(0)) for (int rp_ = 0; rp_ <= PRODUP; ++rp_) { refresh(F); phase_prologue(F, args); }
    SEAM(0);
    if (ON(101) && IN(1)) {
        pg8::EpiBf16 E{WSP(bf16, WS_MEMKV), DM, 1.0f, nullptr, nullptr, 0.f, 0.f};
        const pg8::Gemm g_{WSP(bf16, WS_MEMN), WSP(bf16, WS_WSMALL + OFF_WMKV), DM, DM, DM, MROWS / 256, MROWS / 256, (size_t)(WSMALL_STRIDE / 2), nullptr, nullptr};
        pg8::StaticOrder S_; S_.init(DEPTH * MROWS / 256, DM / 256, F.G, (int)blockIdx.x); pg8::gemm_phase<pg8::EpiBf16, pg8::StaticOrder, true>(F.lds, g_, S_, E); }
    SEAM(1);
    for (int l = 0; l < DEPTH; ++l) {
        const int pb = 2 + 16 * l;
        unsigned char* wl = F.ws + WS_WSMALL + (size_t)l * WSMALL_STRIDE;
        if (ON(0) && IN(pb + 0)) REP(0) if (refresh(F), true) {
            pg8::EpiInProj E{WSP(float, WS_RS1), WSP(float, WS_GAINS) + l * 64, WSP(float, WS_GAINS) + 256 + l * 64, WSP(float, WS_TABG), WSP(float, WS_TABM),
                             WSP(bf16, WS_QG), WSP(bf16, WS_KG), WSP(bf16, WS_VG), WSP(bf16, WS_LAT), WSP(bf16, WS_KROPE), WSP(float, WS_SSL), 0.125f * LOG2E, EPS};
            GEMM(pg8::EpiInProj, E, F.x, DM, wl + OFF_WIN, DM, DM, MTOK / 256, IN_WP / 256, 1, 0); }
        SEAM(pb + 0);
        if ((ON(2) || ON(16) || ON(17)) && IN(pb + 2)) REP(2) { refresh(F);
            if (ON(2) || ON(17)) { pg8::EpiQmRope E{WSP(bf16, WS_QM), 768, 0.10206207261596577f * LOG2E, WSP(float, WS_TABM), WSP(float, WS_SSL), 1.0f / 256.0f, EPS}; GEMM(pg8::EpiQmRope, E, WSP(bf16, WS_LAT), 512, wl + OFF_WQB, 256, 256, MTOK / 256, 3, 1, 0); }
            if (ON(2) || ON(16)) { pg8::EpiBf16 E{WSP(bf16, WS_KVM), DM, 1.0f, nullptr, WSP(float, WS_SSL) + 4, 1.0f / 128.0f, EPS}; GEMM(pg8::EpiBf16, E, WSP(bf16, WS_LAT) + 256, 512, wl + OFF_WKVB, 128, 128, MTOK / 256, 4, 1, 0); } }
        SEAM(pb + 2);
        if (ON(3) && IN(pb + 3)) REP(3) if (refresh(F), true) phase_attn_self(F, l);
        SEAM(pb + 3);
        if (ON(5) && IN(pb + 5)) REP(5) if (refresh(F), true) {
            pg8::EpiResidualX E{F.x, WSP(float, WS_SSX), DM, 1.0f / 512.0f, EPS, rep_ ? 0.f : 1.f};
            const pg8::Gemm g_{WSP(bf16, WS_O), (const bf16*)(wl + OFF_WO), DM, DM, DM, 1, 1 << 30, 0, nullptr, WSP(float, WS_SSO)};
            pg8::StaticOrder S_; S_.init(MTOK / 256, 4, F.G, (int)blockIdx.x); pg8::gemm_phase<pg8::EpiResidualX, pg8::StaticOrder, true, false, true>(F.lds, g_, S_, E, F.lds + STAB_OFF, 1.0f / 512.0f, EPS); }
        SEAM(pb + 5);
        if (ON(7) && IN(pb + 7)) REP(7) if (refresh(F), true) { pg8::EpiBf16RowNorm E{WSP(bf16, WS_QMEM), 512, 0.08838834764831845f * LOG2E, WSP(float, WS_SSX), 1.0f / DM, EPS}; GEMM(pg8::EpiBf16RowNorm, E, F.x, DM, wl + OFF_WMQ, DM, DM, MTOK / 256, 2, 1, 0); }
        SEAM(pb + 7);
        if (ON(8) && IN(pb + 8)) REP(8) if (refresh(F), true) phase_attn_mem(F, l);
        SEAM(pb + 8);
        if (ON(9) && IN(pb + 9)) REP(9) if (refresh(F), true) { pg8::EpiResidual E{F.x, DM, rep_ ? 0.f : 1.f}; GEMM(pg8::EpiResidual, E, WSP(bf16, WS_OMEM), 512, wl + OFF_WMO, 512, 512, MTOK / 256, 4, 1, 0); }
        SEAM(pb + 9);
        if (ON(10) && IN(pb + 10)) REP(10) if (refresh(F), true) phase_router(F, l);
        SEAM(pb + 10);
        if (ON(11) && IN(pb + 11)) REP(11) if (refresh(F), true) phase_select(F, args, l);
        SEAM(pb + 11);
        if (ON(13) && IN(pb + 13)) REP(13) if (refresh(F), true) { pg8::EpiSwiGLU E{WSP(bf16, WS_ACT), EFF, WSP(float, WS_RG)};
            const pg8::Gemm g_{F.x, WSP(bf16, (l & 1) ? WS_WGU2 : WS_WGU), DM, DM, DM, 16, 1 << 30, (size_t)(1024 * 1024), WSP(int, WS_IDX), nullptr};
            pg8::StaticOrder S_; S_.init(MOE_ROWS / 256, 4, F.G, (int)blockIdx.x); pg8::gemm_phase<pg8::EpiSwiGLU, pg8::StaticOrder, true, true>(F.lds, g_, S_, E, F.lds + GTAB_OFF); }
        SEAM(pb + 13);
        if (ON(14) && IN(pb + 14)) REP(14) if (refresh(F), true) { pg8::EpiBf16 E{WSP(bf16, WS_Y), DM, 1.0f, nullptr, nullptr, 0.f, 0.f}; GEMM(pg8::EpiBf16, E, WSP(bf16, WS_ACT), EFF, WSP(bf16, (l & 1) ? WS_WD2 : WS_WD), EFF, EFF, MOE_ROWS / 256, 4, 16, 1024 * 512); }
        SEAM(pb + 14);
        if (ON(15) && IN(pb + 15)) REP(15) if (refresh(F), true) phase_combine(F, args, l, (rep_ && l < DEPTH - 1) ? 0.f : 1.f);
        SEAM(pb + 15);
    }
#undef IN
#undef SEAM
#undef GEMM
}

extern "C" void kernel_launch(void* const* d_in, const int* in_sizes, int n_in, void* d_out, int out_size, void* d_ws, size_t ws_size, hipStream_t stream) {
    static int grid = 0;
    if (grid == 0) {
        if (n_in != 24 || out_size != MTOK * DM || ws_size < WS_END) { fprintf(stderr, "kernel_launch: unexpected shapes: n_in %d out %d ws %zu (need %zu)\n", n_in, out_size, ws_size, (size_t)WS_END); grid = -1; return; }
        int dev = 0, cus = 0, per_cu = 0;
        if (hipGetDevice(&dev) != hipSuccess || hipDeviceGetAttribute(&cus, hipDeviceAttributeMultiprocessorCount, dev) != hipSuccess) { grid = -1; return; }
        if (hipFuncSetAttribute((const void*)enc_fwd, hipFuncAttributeMaxDynamicSharedMemorySize, LDS_BYTES) != hipSuccess) { fprintf(stderr, "kernel_launch: hipFuncSetAttribute failed\n"); grid = -1; return; }
        if (hipOccupancyMaxActiveBlocksPerMultiprocessor(&per_cu, (const void*)enc_fwd, NWAVES * 64, LDS_BYTES) != hipSuccess || per_cu < 1)
            fprintf(stderr, "kernel_launch: occupancy query reports %d workgroups per CU\n", per_cu);
        (void)hipGetLastError();
        grid = cus;
        fprintf(stderr, "kernel_launch: grid %d, ws %zu bytes\n", grid, ws_size);
    }
    if (grid < 0) return;
    (void)hipMemsetAsync((char*)d_ws + WS_CTL, 0, CTL_ZERO_BYTES, stream);
    Args a{};
    for (int i = 0; i < 24; ++i) a.in[i] = (const float*)d_in[i];
    a.out = (float*)d_out; a.ws = (unsigned char*)d_ws;
#if MK_N_LAUNCHES == 1
    a.ph_lo = 0; a.ph_hi = NPH;
    hipLaunchKernelGGL(enc_fwd, dim3(grid), dim3(NWAVES * 64), LDS_BYTES, stream, a);
#else
    for (int p = 0; p < NPH; ++p) { a.ph_lo = p; a.ph_hi = p + 1; hipLaunchKernelGGL(enc_fwd, dim3(grid), dim3(NWAVES * 64), LDS_BYTES, stream, a); }
#endif
    const hipError_t le = hipPeekAtLastError();
    if (le != hipSuccess) fprintf(stderr, "kernel_launch: launch failed: %s\n", hipGetErrorName(le));
}
```

```cpp
#include <hip/hip_runtime.h>
#include <cstdio>
#include <cstdint>

namespace pg8 {
#define PG8_LAS __attribute__((address_space(3)))
typedef unsigned short bf16_t;
typedef short bf16x8 __attribute__((ext_vector_type(8)));
typedef float f32x4 __attribute__((ext_vector_type(4)));
typedef unsigned u32x4 __attribute__((ext_vector_type(4)));
constexpr int BM = 256, BK = 64, HALF = 128, HTB = HALF * BK * 2  , STAGE_BYTES = 8 * HTB, NXCD = 8, WGM = 8;

__host__ __device__ __forceinline__ int lds_byte(int r, int c) { const int st = (r >> 4) * 2 + (c >> 5), rr = r & 15, cc = c & 31, ob = rr * 64 + cc * 2; return st * 1024 + (ob ^ (((ob >> 9) & 1) << 5)); }
__host__ __device__ __forceinline__ void stage_rc(int b, int& R, int& C) { const int st = b / 1024, sb = b % 1024, swz = sb ^ (((sb >> 9) & 1) << 5); R = (st >> 1) * 16 + swz / 64; C = (st & 1) * 32 + (swz % 64) / 2; }
__host__ __device__ __forceinline__ int perm32(int rho) { const int n = rho >> 4, i = rho & 15; return 8 * (i >> 2) + 4 * n + (i & 3); }

struct Unit { int pm, pn; };
struct Gemm { const bf16_t* A; const bf16_t* Bt; int lda, ldb, K, gdiv, amod; size_t gstride; const int* idx; const float* ss; };

struct StaticOrder {
    int nM, nN, nwg, G, c;
    __host__ __device__ void init(int nM_, int nN_, int G_, int c_) { nM = nM_; nN = nN_; nwg = nM * nN; G = G_; c = c_; }
    __host__ __device__ bool next(int i, Unit& u) const {
        const long L = (long)i * G + c; if (L >= nwg) return false;
        int wgid = (int)L; { const int q = nwg / NXCD, r = nwg % NXCD, xcd = wgid % NXCD, off = wgid / NXCD; wgid = (xcd < r ? xcd * (q + 1) : r * (q + 1) + (xcd - r) * q) + off; }
        const int nig = WGM * nN, gid = wgid / nig, fm = gid * WGM, gsz = (nM - fm) < WGM ? (nM - fm) : WGM;
        u.pm = fm + ((wgid % nig) % gsz); u.pn = (wgid % nig) / gsz; return true;
    }
};

struct LinearOrder {
    int nM, nN, G, c, per;
    __host__ __device__ void init(int nM_, int nN_, int G_, int c_, int per_) { nM = nM_; nN = nN_; G = G_; c = c_; per = per_; }
    __host__ __device__ bool next(int i, Unit& u) const { const int idx = (c + (i / per) * G) * per + (i % per); if (idx >= nM * nN) return false; u.pm = idx / nN; u.pn = idx % nN; return true; }
};

__device__ __forceinline__ unsigned cvt_pk_bf16(float lo, float hi) { unsigned r; asm volatile("v_cvt_pk_bf16_f32 %0, %1, %2" : "=v"(r) : "v"(lo), "v"(hi)); return r; }

struct EpiBf16 {
    static constexpr bool PERM = true;
    bf16_t* O; int ldc; float scale; const float* rs; const float* ssl; float ssl_inv, ssl_eps;
    __device__ __forceinline__ void operator()(const f32x4 (&acc)[2][2][4][2], const Unit& u, int wr, int wc, int fr, int fq) const {
        const int row0 = u.pm * BM + wr * 64 + fr, col0 = u.pn * BM + wc * 32 + 8 * fq;
#pragma unroll
        for (int ai = 0; ai < 2; ++ai)
#pragma unroll
            for (int m = 0; m < 4; ++m) { const int row = row0 + ai * HALF + m * 16; bf16_t* rowp = O + (size_t)row * ldc + col0; float sc = rs ? scale * rs[row] : scale;
                if (ssl) { const f32x4 q_ = *(const f32x4*)(ssl + (size_t)row * 8); sc *= __builtin_amdgcn_rsqf(((q_[0] + q_[1]) + (q_[2] + q_[3])) * ssl_inv + ssl_eps); }
#pragma unroll
                for (int bj = 0; bj < 2; ++bj) { const f32x4 v0 = acc[ai][bj][m][0] * sc, v1 = acc[ai][bj][m][1] * sc;
                    u32x4 w; w.x = cvt_pk_bf16(v0[0], v0[1]); w.y = cvt_pk_bf16(v0[2], v0[3]); w.z = cvt_pk_bf16(v1[0], v1[1]); w.w = cvt_pk_bf16(v1[2], v1[3]);
                    *(u32x4*)(rowp + bj * HALF) = w; } }
    }
};
struct EpiQmRope {
    static constexpr bool PERM = true;
    bf16_t* O; int ldc; float scale; const float* tab; const float* ssl; float ssl_inv, ssl_eps;
    __device__ __forceinline__ void operator()(const f32x4 (&acc)[2][2][4][2], const Unit& u, int wr, int wc, int fr, int fq) const {
        const int row0 = u.pm * BM + wr * 64 + fr, col0 = u.pn * BM + wc * 32 + 8 * fq;
        const bool rope = (u.pn == 2);
        const int j0 = (8 * fq) >> 1;
#pragma unroll
        for (int ai = 0; ai < 2; ++ai)
#pragma unroll
            for (int m = 0; m < 4; ++m) { const int row = row0 + ai * HALF + m * 16; bf16_t* rowp = O + (size_t)row * ldc + col0; const int s = row & 4095;
                const f32x4 q_ = *(const f32x4*)(ssl + (size_t)row * 8); const float sc_ = scale * __builtin_amdgcn_rsqf(((q_[0] + q_[1]) + (q_[2] + q_[3])) * ssl_inv + ssl_eps);
                f32x4 t0 = (f32x4){1.f, 0.f, 1.f, 0.f}, t1 = (f32x4){1.f, 0.f, 1.f, 0.f};
                if (rope) { t0 = *(const f32x4*)(tab + ((size_t)s * 16 + j0) * 2); t1 = *(const f32x4*)(tab + ((size_t)s * 16 + j0 + 2) * 2); }
#pragma unroll
                for (int bj = 0; bj < 2; ++bj) { const f32x4 v0 = acc[ai][bj][m][0], v1 = acc[ai][bj][m][1];
                    f32x4 r0, r1;
                    r0[0] = v0[0] * t0[0] - v0[1] * t0[1]; r0[1] = v0[1] * t0[0] + v0[0] * t0[1];
                    r0[2] = v0[2] * t0[2] - v0[3] * t0[3]; r0[3] = v0[3] * t0[2] + v0[2] * t0[3];
                    r1[0] = v1[0] * t1[0] - v1[1] * t1[1]; r1[1] = v1[1] * t1[0] + v1[0] * t1[1];
                    r1[2] = v1[2] * t1[2] - v1[3] * t1[3]; r1[3] = v1[3] * t1[2] + v1[2] * t1[3];
                    r0 = r0 * sc_; r1 = r1 * sc_;
                    u32x4 w; w.x = cvt_pk_bf16(r0[0], r0[1]); w.y = cvt_pk_bf16(r0[2], r0[3]); w.z = cvt_pk_bf16(r1[0], r1[1]); w.w = cvt_pk_bf16(r1[2], r1[3]);
                    *(u32x4*)(rowp + bj * HALF) = w; }
                asm volatile("" ::: "memory"); }
    }
};
struct EpiBf16RowNorm {
    static constexpr bool PERM = true;
    bf16_t* O; int ldc; float scale; const float* ss; float inv_n, eps;
    __device__ __forceinline__ void operator()(const f32x4 (&acc)[2][2][4][2], const Unit& u, int wr, int wc, int fr, int fq) const {
        const int row0 = u.pm * BM + wr * 64 + fr, col0 = u.pn * BM + wc * 32 + 8 * fq;
#pragma unroll
        for (int ai = 0; ai < 2; ++ai)
#pragma unroll
            for (int m = 0; m < 4; ++m) { const int row = row0 + ai * HALF + m * 16; bf16_t* rowp = O + (size_t)row * ldc + col0;
                const f32x4 q0 = *(const f32x4*)(ss + (size_t)row * 16), q1 = *(const f32x4*)(ss + (size_t)row * 16 + 4), q2 = *(const f32x4*)(ss + (size_t)row * 16 + 8), q3 = *(const f32x4*)(ss + (size_t)row * 16 + 12);
                const float tot = ((((q0[0] + q0[1]) + (q0[2] + q0[3])) + ((q1[0] + q1[1]) + (q1[2] + q1[3]))) + (((q2[0] + q2[1]) + (q2[2] + q2[3])) + ((q3[0] + q3[1]) + (q3[2] + q3[3]))));
                const float sc = scale * __builtin_amdgcn_rsqf(tot * inv_n + eps);
#pragma unroll
                for (int bj = 0; bj < 2; ++bj) { const f32x4 v0 = acc[ai][bj][m][0] * sc, v1 = acc[ai][bj][m][1] * sc;
                    u32x4 w; w.x = cvt_pk_bf16(v0[0], v0[1]); w.y = cvt_pk_bf16(v0[2], v0[3]); w.z = cvt_pk_bf16(v1[0], v1[1]); w.w = cvt_pk_bf16(v1[2], v1[3]);
                    *(u32x4*)(rowp + bj * HALF) = w; } }
    }
};
__device__ __forceinline__ float bf_lo(unsigned w) { return __uint_as_float(w << 16); }
__device__ __forceinline__ float bf_hi(unsigned w) { return __uint_as_float(w & 0xffff0000u); }
struct EpiResidualX {
    static constexpr bool PERM = true;
    bf16_t* X; float* SSX; int ldc; float inv_n, eps, mul;
    __device__ __forceinline__ void operator()(const f32x4 (&acc)[2][2][4][2], const Unit& u, int wr, int wc, int fr, int fq, const PG8_LAS float* tab) const {
        const int rl0 = wr * 64 + fr, col0 = u.pn * BM + wc * 32 + 8 * fq;
#pragma unroll
        for (int ai = 0; ai < 2; ++ai)
#pragma unroll
            for (int m = 0; m < 4; ++m) { const int rl = rl0 + ai * HALF + m * 16, row = u.pm * BM + rl; bf16_t* rowp = X + (size_t)row * ldc + col0;
                const float rm = mul * __builtin_amdgcn_rsqf((tab[rl * 4 + 2] + tab[rl * 4 + 3]) * inv_n + eps);
                u32x4 xv[2]; float s = 0.f;
#pragma unroll
                for (int bj = 0; bj < 2; ++bj) xv[bj] = *(const u32x4*)(rowp + bj * HALF);
#pragma unroll
                for (int bj = 0; bj < 2; ++bj) { const f32x4 a0 = acc[ai][bj][m][0] * rm, a1 = acc[ai][bj][m][1] * rm; u32x4 w;
                    w.x = cvt_pk_bf16(bf_lo(xv[bj].x) + a0[0], bf_hi(xv[bj].x) + a0[1]); w.y = cvt_pk_bf16(bf_lo(xv[bj].y) + a0[2], bf_hi(xv[bj].y) + a0[3]);
                    w.z = cvt_pk_bf16(bf_lo(xv[bj].z) + a1[0], bf_hi(xv[bj].z) + a1[1]); w.w = cvt_pk_bf16(bf_lo(xv[bj].w) + a1[2], bf_hi(xv[bj].w) + a1[3]);
                    *(u32x4*)(rowp + bj * HALF) = w;
                    const float r0 = bf_lo(w.x), r1 = bf_hi(w.x), r2 = bf_lo(w.y), r3 = bf_hi(w.y), r4 = bf_lo(w.z), r5 = bf_hi(w.z), r6 = bf_lo(w.w), r7 = bf_hi(w.w);
                    s += ((r0 * r0 + r1 * r1) + (r2 * r2 + r3 * r3)) + ((r4 * r4 + r5 * r5) + (r6 * r6 + r7 * r7)); }
                s += __shfl_xor(s, 16); s += __shfl_xor(s, 32);
                if (fq == 0) SSX[(size_t)row * 16 + u.pn * 4 + wc] = s;
                if (m & 1) asm volatile("" ::: "memory"); }
    }
};
struct EpiResidual {
    static constexpr bool PERM = true;
    bf16_t* X; int ldc; float mul;
    __device__ __forceinline__ void operator()(const f32x4 (&acc)[2][2][4][2], const Unit& u, int wr, int wc, int fr, int fq) const {
        const int row0 = u.pm * BM + wr * 64 + fr, col0 = u.pn * BM + wc * 32 + 8 * fq;
#pragma unroll
        for (int ai = 0; ai < 2; ++ai)
#pragma unroll
            for (int m = 0; m < 4; ++m) { bf16_t* rowp = X + (size_t)(row0 + ai * HALF + m * 16) * ldc + col0;
                u32x4 xv[2];
#pragma unroll
                for (int bj = 0; bj < 2; ++bj) xv[bj] = *(const u32x4*)(rowp + bj * HALF);
#pragma unroll
                for (int bj = 0; bj < 2; ++bj) { const f32x4 a0 = acc[ai][bj][m][0] * mul, a1 = acc[ai][bj][m][1] * mul; u32x4 w;
                    w.x = cvt_pk_bf16(bf_lo(xv[bj].x) + a0[0], bf_hi(xv[bj].x) + a0[1]); w.y = cvt_pk_bf16(bf_lo(xv[bj].y) + a0[2], bf_hi(xv[bj].y) + a0[3]);
                    w.z = cvt_pk_bf16(bf_lo(xv[bj].z) + a1[0], bf_hi(xv[bj].z) + a1[1]); w.w = cvt_pk_bf16(bf_lo(xv[bj].w) + a1[2], bf_hi(xv[bj].w) + a1[3]);
                    *(u32x4*)(rowp + bj * HALF) = w; } }
    }
};
struct EpiInProj {
    static constexpr bool PERM = true;
    const float* rs; const float* gq; const float* gk; const float* tabg; const float* tabm;
    bf16_t* QG; bf16_t* KG; bf16_t* VG; bf16_t* LAT; bf16_t* KROPE; float* SSL; float qscale, eps;
    __device__ __forceinline__ static void rope2(f32x4& v, const f32x4 t) { const float a0 = v[0], b0 = v[1], a1 = v[2], b1 = v[3];
        v[0] = a0 * t[0] - b0 * t[1]; v[1] = b0 * t[0] + a0 * t[1]; v[2] = a1 * t[2] - b1 * t[3]; v[3] = b1 * t[2] + a1 * t[3]; }
    __device__ __forceinline__ static u32x4 pack(const f32x4 a, const f32x4 b) { u32x4 w; w.x = cvt_pk_bf16(a[0], a[1]); w.y = cvt_pk_bf16(a[2], a[3]); w.z = cvt_pk_bf16(b[0], b[1]); w.w = cvt_pk_bf16(b[2], b[3]); return w; }
    __device__ __forceinline__ void operator()(const f32x4 (&acc)[2][2][4][2], const Unit& u, int wr, int wc, int fr, int fq) const {
        const int row0 = u.pm * BM + wr * 64 + fr;
        if (u.pn < 2 || (u.pn == 2 && wc < 2)) {
            const bool isq = u.pn < 2; const float* g = isq ? gq : gk; bf16_t* dst = isq ? QG : KG; const int ld = isq ? 512 : 128, hcol = (isq ? (u.pn * 4 + wc) : wc) * 64; const float osc = isq ? qscale : 1.0f;
            f32x4 gv[2][2];
#pragma unroll
            for (int bj = 0; bj < 2; ++bj)
#pragma unroll
                for (int n = 0; n < 2; ++n)
#pragma unroll
                    for (int i = 0; i < 4; ++i) { const int p = 32 * bj + 8 * fq + 4 * n + i; gv[bj][n][i] = g[(p >> 1) + 32 * (p & 1)]; }
#pragma unroll
            for (int ai = 0; ai < 2; ++ai)
#pragma unroll
                for (int m = 0; m < 4; ++m) { const int row = row0 + ai * HALF + m * 16, s = row & 4095; const float sc = rs[row];
                    f32x4 v[2][2]; float ss = 0.f;
#pragma unroll
                    for (int bj = 0; bj < 2; ++bj)
#pragma unroll
                        for (int n = 0; n < 2; ++n) { v[bj][n] = acc[ai][bj][m][n] * sc; ss += (v[bj][n][0] * v[bj][n][0] + v[bj][n][1] * v[bj][n][1]) + (v[bj][n][2] * v[bj][n][2] + v[bj][n][3] * v[bj][n][3]); }
                    ss += __shfl_xor(ss, 16); ss += __shfl_xor(ss, 32);
                    const float rstd = __builtin_amdgcn_rsqf(ss * (1.0f / 64.0f) + eps);
#pragma unroll
                    for (int bj = 0; bj < 2; ++bj) {
#pragma unroll
                        for (int n = 0; n < 2; ++n) { v[bj][n] = v[bj][n] * rstd * gv[bj][n];
                            const f32x4 t = *(const f32x4*)(tabg + ((size_t)s * 32 + 16 * bj + 4 * fq + 2 * n) * 2); rope2(v[bj][n], t); v[bj][n] = v[bj][n] * osc; }
                        *(u32x4*)(dst + (size_t)row * ld + hcol + 32 * bj + 8 * fq) = pack(v[bj][0], v[bj][1]); }
                    if (m & 1) asm volatile("" ::: "memory"); }
        } else if (u.pn == 2) {
#pragma unroll
            for (int ai = 0; ai < 2; ++ai)
#pragma unroll
                for (int m = 0; m < 4; ++m) { const int row = row0 + ai * HALF + m * 16; const float sc = rs[row];
#pragma unroll
                    for (int bj = 0; bj < 2; ++bj) *(u32x4*)(VG + (size_t)row * 128 + (wc - 2) * 64 + 32 * bj + 8 * fq) = pack(acc[ai][bj][m][0] * sc, acc[ai][bj][m][1] * sc); }
        } else if (u.pn == 3) {
#pragma unroll
            for (int ai = 0; ai < 2; ++ai)
#pragma unroll
                for (int m = 0; m < 4; ++m) { const int row = row0 + ai * HALF + m * 16; const float sc = rs[row]; float ss = 0.f;
#pragma unroll
                    for (int bj = 0; bj < 2; ++bj) { const f32x4 a = acc[ai][bj][m][0] * sc, b = acc[ai][bj][m][1] * sc;
                        ss += ((a[0] * a[0] + a[1] * a[1]) + (a[2] * a[2] + a[3] * a[3])) + ((b[0] * b[0] + b[1] * b[1]) + (b[2] * b[2] + b[3] * b[3]));
                        *(u32x4*)(LAT + (size_t)row * 512 + 128 * bj + 32 * wc + 8 * fq) = pack(a, b); }
                    ss += __shfl_xor(ss, 16); ss += __shfl_xor(ss, 32);
                    if (fq == 0) SSL[(size_t)row * 8 + wc] = ss; }
        } else {
#pragma unroll
            for (int ai = 0; ai < 2; ++ai)
#pragma unroll
                for (int m = 0; m < 4; ++m) { const int row = row0 + ai * HALF + m * 16, s = row & 4095; const float sc = rs[row];
                    const f32x4 a = acc[ai][0][m][0] * sc, b = acc[ai][0][m][1] * sc;
                    float ss = ((a[0] * a[0] + a[1] * a[1]) + (a[2] * a[2] + a[3] * a[3])) + ((b[0] * b[0] + b[1] * b[1]) + (b[2] * b[2] + b[3] * b[3]));
                    *(u32x4*)(LAT + (size_t)row * 512 + 256 + 32 * wc + 8 * fq) = pack(a, b);
                    ss += __shfl_xor(ss, 16); ss += __shfl_xor(ss, 32);
                    if (fq == 0) SSL[(size_t)row * 8 + 4 + wc] = ss;
                    if (wc == 0) { f32x4 c = acc[ai][1][m][0] * sc, d = acc[ai][1][m][1] * sc;
                        rope2(c, *(const f32x4*)(tabm + ((size_t)s * 16 + 4 * fq) * 2)); rope2(d, *(const f32x4*)(tabm + ((size_t)s * 16 + 4 * fq + 2) * 2));
                        *(u32x4*)(KROPE + (size_t)row * 32 + 8 * fq) = pack(c, d); } }
        }
    }
};
struct EpiSwiGLU {
    static constexpr bool PERM = true;
    bf16_t* O; int ldc; const float* rs;
    __device__ __forceinline__ static float silu_mul(float g, float u) { return g * u * __builtin_amdgcn_rcpf(1.0f + __builtin_amdgcn_exp2f(-1.4426950408889634f * g)); }
    __device__ __forceinline__ void operator()(const f32x4 (&acc)[2][2][4][2], const Unit& u, int wr, int wc, int fr, int fq) const {
        const int row0 = u.pm * BM + wr * 64 + fr, col0 = u.pn * HALF + wc * 32 + 8 * fq;
#pragma unroll
        for (int ai = 0; ai < 2; ++ai)
#pragma unroll
            for (int m = 0; m < 4; ++m) { const int row = row0 + ai * HALF + m * 16; bf16_t* rowp = O + (size_t)row * ldc + col0; const float sc = rs[row];
                const f32x4 g0 = acc[ai][0][m][0] * sc, g1 = acc[ai][0][m][1] * sc, u0 = acc[ai][1][m][0] * sc, u1 = acc[ai][1][m][1] * sc;
                u32x4 w; w.x = cvt_pk_bf16(silu_mul(g0[0], u0[0]), silu_mul(g0[1], u0[1])); w.y = cvt_pk_bf16(silu_mul(g0[2], u0[2]), silu_mul(g0[3], u0[3]));
                w.z = cvt_pk_bf16(silu_mul(g1[0], u1[0]), silu_mul(g1[1], u1[1])); w.w = cvt_pk_bf16(silu_mul(g1[2], u1[2]), silu_mul(g1[3], u1[3]));
                *(u32x4*)rowp = w; }
    }
};

template <class Epi, class Sched, bool ALIGN_EPI = false, bool GATHER = false, bool MIDSCALE = false>
__device__ __forceinline__ void gemm_phase(PG8_LAS unsigned char* lds, const Gemm g, const Sched& S, const Epi& E, PG8_LAS unsigned char* gtab = nullptr, float ms_inv_n = 0.f, float ms_eps = 0.f) {
    int tid_ = threadIdx.x; asm volatile("" : "+v"(tid_));
    const int tid = tid_, wid = __builtin_amdgcn_readfirstlane(tid >> 6), lane = tid & 63, wr = wid >> 2, wc = wid & 3, fr = lane & 15, fq = lane >> 4;
    const int K = g.K, nt = K / BK;
    unsigned voffA[2], voffB[2]; int gR[2], gC[2];
#pragma unroll
    for (int i = 0; i < 2; ++i) { int R, C; stage_rc(tid * 16 + i * 8192, R, C); const int Rb = Epi::PERM ? ((R & ~31) + perm32(R & 31)) : R; gR[i] = R; gC[i] = C;
        voffA[i] = (unsigned)(R * g.lda + C) * 2u; voffB[i] = (unsigned)(Rb * g.ldb + C) * 2u; }
    unsigned goffc[2][2], goffn[2][2];
#define PG8_GISSUE(u) do { _Pragma("unroll") for (int h_ = 0; h_ < 2; ++h_) _Pragma("unroll") for (int i_ = 0; i_ < 2; ++i_) \
        __builtin_amdgcn_global_load_lds((const unsigned*)(g.idx + (u).pm * BM + h_ * HALF + gR[i_]), (PG8_LAS unsigned*)(gtab + ((h_ * 2 + i_) * 8 + wid) * 256), 4, 0, 0); } while (0)
#define PG8_GREAD(dst, u) do { asm volatile("" ::: "memory"); _Pragma("unroll") for (int h_ = 0; h_ < 2; ++h_) _Pragma("unroll") for (int i_ = 0; i_ < 2; ++i_) { \
        const int tok_ = *(const PG8_LAS int*)(gtab + ((h_ * 2 + i_) * 8 + wid) * 256 + lane * 4); \
        dst[h_][i_] = (unsigned)(((((u).pm >> 1) & 7) * 4096 + tok_) * g.lda + gC[i_]) * 2u; } } while (0)
    const size_t kstep = (size_t)(BK * 2);
    const size_t hstepA = (size_t)HALF * g.lda * 2, hstepB = (size_t)HALF * g.ldb * 2;
    const size_t tstepA = 2 * hstepA, tstepB = 2 * hstepB;
    const unsigned ldsw = (unsigned)wid * 1024u;
    const int aoff = lds_byte(wr * 64 + fr, fq * 8), boff = lds_byte(wc * 32 + fr, fq * 8);
#define PG8_SA(b, h) (((b) * 2 + (h)) * HTB)
#define PG8_SB(b, h) ((4 + (b) * 2 + (h)) * HTB)
#define PG8_STAGE(bufoff, gbase, voff) do { _Pragma("unroll") for (int _i = 0; _i < 2; ++_i) \
        __builtin_amdgcn_global_load_lds((const unsigned*)((const char*)(gbase) + (voff)[_i]), (PG8_LAS unsigned*)(lds + (bufoff) + ldsw + _i * 8192), 16, 0, 0); } while (0)
#define PG8_LDA(dst, b, h) do { _Pragma("unroll") for (int m = 0; m < 4; ++m) _Pragma("unroll") for (int k = 0; k < 2; ++k) dst[m][k] = *(const PG8_LAS bf16x8*)(lds + PG8_SA(b, h) + aoff + m * 2048 + k * 1024); } while (0)
#define PG8_LDB(dst, b, h) do { _Pragma("unroll") for (int n = 0; n < 2; ++n) _Pragma("unroll") for (int k = 0; k < 2; ++k) dst[n][k] = *(const PG8_LAS bf16x8*)(lds + PG8_SB(b, h) + boff + n * 2048 + k * 1024); } while (0)
#define PG8_MMA(ai, bj, At, Bt) do { __builtin_amdgcn_s_setprio(1); _Pragma("unroll") for (int m = 0; m < 4; ++m) _Pragma("unroll") for (int n = 0; n < 2; ++n) _Pragma("unroll") for (int k = 0; k < 2; ++k) \
        acc[ai][bj][m][n] = __builtin_amdgcn_mfma_f32_16x16x32_bf16(Bt[n][k], At[m][k], acc[ai][bj][m][n], 0, 0, 0); __builtin_amdgcn_s_setprio(0); } while (0)
#define PG8_WAIT_V(n) asm volatile("s_waitcnt vmcnt(" #n ")" ::: "memory")
#define PG8_WAIT_L(n) asm volatile("s_waitcnt lgkmcnt(" #n ")" ::: "memory")
#define PG8_BAR __builtin_amdgcn_s_barrier()
#define PG8_SCHED __builtin_amdgcn_sched_barrier(0)
#define PG8_ABASE(u) (GATHER ? (const char*)g.A : (const char*)g.A + (size_t)((u).pm % g.amod) * tstepA)
#define PG8_STA(bufoff, kptr, h, nx) do { if constexpr (GATHER) { unsigned o_[2]; o_[0] = (nx) ? goffn[h][0] : goffc[h][0]; o_[1] = (nx) ? goffn[h][1] : goffc[h][1]; PG8_STAGE(bufoff, kptr, o_); } \
        else { PG8_STAGE(bufoff, (kptr) + (h) * hstepA, voffA); } } while (0)
#define PG8_BBASE(u) ((const char*)g.Bt + ((size_t)((u).pm / g.gdiv) * g.gstride) * 2 + (size_t)(u).pn * tstepB)
    Unit cur, nxt; int ui = 0;
    if (!S.next(0, cur)) return;
    f32x4 acc[2][2][4][2];
#pragma unroll
    for (int a = 0; a < 2; ++a)
#pragma unroll
        for (int b = 0; b < 2; ++b)
#pragma unroll
            for (int m = 0; m < 4; ++m)
#pragma unroll
                for (int n = 0; n < 2; ++n) acc[a][b][m][n] = (f32x4){0.f, 0.f, 0.f, 0.f};
    bf16x8 At[4][2], B0[2][2], B1[2][2];
    const char* cA = PG8_ABASE(cur); const char* cB = PG8_BBASE(cur);
    if constexpr (GATHER) { PG8_GISSUE(cur); PG8_WAIT_V(0); PG8_GREAD(goffc, cur);
#pragma unroll
        for (int h_ = 0; h_ < 2; ++h_) { goffn[h_][0] = goffc[h_][0]; goffn[h_][1] = goffc[h_][1]; } }
    PG8_STAGE(PG8_SB(0, 0), cB, voffB); PG8_STAGE(PG8_SB(0, 1), cB + hstepB, voffB); PG8_STA(PG8_SA(0, 0), cA, 0, false); PG8_STA(PG8_SA(0, 1), cA, 1, false);
    if (wr == 1) PG8_BAR;
    PG8_WAIT_V(2); PG8_BAR;
    PG8_STAGE(PG8_SB(1, 0), cB + kstep, voffB); PG8_STA(PG8_SA(1, 0), cA + kstep, 0, false); PG8_STAGE(PG8_SB(1, 1), cB + hstepB + kstep, voffB);
    PG8_WAIT_V(6); PG8_BAR;
    for (;;) {
        const bool has_next = S.next(ui + 1, nxt);
        const char* nA = has_next ? PG8_ABASE(nxt) : cA; const char* nB = has_next ? PG8_BBASE(nxt) : cB;
        if constexpr (GATHER) { if (has_next) PG8_GISSUE(nxt); }
        if constexpr (MIDSCALE) {
#pragma unroll
            for (int q_ = 0; q_ < 2; ++q_) __builtin_amdgcn_global_load_lds((const unsigned*)(g.ss + (size_t)cur.pm * 1024 + q_ * 512 + wid * 64 + lane), (PG8_LAS unsigned*)(gtab + (ui & 1) * 4096 + q_ * 2048 + wid * 256), 4, 0, 0); }
#pragma nounroll
        for (int t = 0; t < nt; t += 2) {
            const bool last = (t == nt - 2);
            const char* a1 = cA + (size_t)(t + 1) * kstep;
            const char* a2 = last ? nA : cA + (size_t)(t + 2) * kstep; const char* b2 = last ? nB : cB + (size_t)(t + 2) * kstep;
            const char* a3 = a2 + kstep; const char* b3 = b2 + kstep;
            if constexpr (GATHER) { if (last && has_next) PG8_GREAD(goffn, nxt); }
            if constexpr (MIDSCALE) { if (t == nt / 2) { asm volatile("" ::: "memory"); const PG8_LAS float* tab = (const PG8_LAS float*)(gtab + (ui & 1) * 4096);
#pragma unroll
                for (int ai = 0; ai < 2; ++ai)
#pragma unroll
                    for (int m = 0; m < 4; ++m) { const int rl = ai * HALF + wr * 64 + m * 16 + fr; const float sg = tab[rl * 4] + tab[rl * 4 + 1], sm = tab[rl * 4 + 2] + tab[rl * 4 + 3];
                        const float ratio = __builtin_amdgcn_rsqf(sg * ms_inv_n + ms_eps) * __builtin_amdgcn_rcpf(__builtin_amdgcn_rsqf(sm * ms_inv_n + ms_eps));
#pragma unroll
                        for (int bj = 0; bj < 2; ++bj)
#pragma unroll
                            for (int n = 0; n < 2; ++n) acc[ai][bj][m][n] = acc[ai][bj][m][n] * ratio; } } }
            PG8_LDB(B0, 0, 0); PG8_LDB(B1, 0, 1); PG8_SCHED; PG8_LDA(At, 0, 0); PG8_STA(PG8_SA(1, 1), a1, 1, false);
            PG8_WAIT_V(8); PG8_WAIT_L(0); PG8_BAR; PG8_MMA(0, 0, At, B0); PG8_MMA(0, 1, At, B1); PG8_BAR; PG8_SCHED;
            PG8_LDA(At, 0, 1); PG8_STAGE(PG8_SB(0, 0), b2, voffB); PG8_STAGE(PG8_SB(0, 1), b2 + hstepB, voffB); PG8_STA(PG8_SA(0, 0), a2, 0, last);
            PG8_WAIT_V(8); PG8_WAIT_L(0); PG8_BAR; PG8_MMA(1, 0, At, B0); PG8_MMA(1, 1, At, B1); PG8_BAR; PG8_SCHED;
            PG8_LDB(B0, 1, 0); PG8_LDB(B1, 1, 1); PG8_SCHED; PG8_LDA(At, 1, 0); PG8_STA(PG8_SA(0, 1), a2, 1, last);
            PG8_WAIT_V(8); PG8_WAIT_L(0); PG8_BAR; PG8_MMA(0, 0, At, B0); PG8_MMA(0, 1, At, B1); PG8_BAR; PG8_SCHED;
            PG8_LDA(At, 1, 1); PG8_STAGE(PG8_SB(1, 0), b3, voffB); PG8_STAGE(PG8_SB(1, 1), b3 + hstepB, voffB); PG8_STA(PG8_SA(1, 0), a3, 0, last);
            PG8_WAIT_V(8); PG8_WAIT_L(0); PG8_BAR; PG8_MMA(1, 0, At, B0); PG8_MMA(1, 1, At, B1); PG8_BAR; PG8_SCHED;
        }
        if constexpr (ALIGN_EPI) { if (wr == 0) PG8_BAR; }
        if constexpr (MIDSCALE) E(acc, cur, wr, wc, fr, fq, (const PG8_LAS float*)(gtab + (ui & 1) * 4096)); else E(acc, cur, wr, wc, fr, fq);
        if (!has_next) break;
#pragma unroll
        for (int a = 0; a < 2; ++a)
#pragma unroll
            for (int b = 0; b < 2; ++b)
#pragma unroll
                for (int m = 0; m < 4; ++m)
#pragma unroll
                    for (int n = 0; n < 2; ++n) acc[a][b][m][n] = (f32x4){0.f, 0.f, 0.f, 0.f};
        cur = nxt; cA = nA; cB = nB; ++ui;
        if constexpr (GATHER) {
#pragma unroll
            for (int h_ = 0; h_ < 2; ++h_) { goffc[h_][0] = goffn[h_][0]; goffc[h_][1] = goffn[h_][1]; } }
        if constexpr (ALIGN_EPI) { if (wr == 1) PG8_BAR; }
    }
    PG8_WAIT_V(0);
    if constexpr (!ALIGN_EPI) { if (wr == 0) PG8_BAR; }
    PG8_BAR;
#undef PG8_SA
#undef PG8_SB
#undef PG8_STAGE
#undef PG8_LDA
#undef PG8_LDB
#undef PG8_MMA
#undef PG8_WAIT_V
#undef PG8_WAIT_L
#undef PG8_BAR
#undef PG8_SCHED
#undef PG8_ABASE
#undef PG8_STA
#undef PG8_GISSUE
#undef PG8_GREAD
#undef PG8_BBASE
}
}
namespace att {
typedef unsigned short bf16;
using bf16x8 = __attribute__((ext_vector_type(8))) short;
using s16x4  = __attribute__((ext_vector_type(4))) short;
using f32x16 = __attribute__((ext_vector_type(16))) float;
using u32x4  = __attribute__((ext_vector_type(4))) unsigned;
#define ATT_SBAR() __builtin_amdgcn_sched_barrier(0)
constexpr int KCH = 1040;
constexpr float THR = 8.0f;
__device__ __forceinline__ int crow(int r, int hi) { return (r & 3) + 8 * (r >> 2) + 4 * hi; }
__device__ __forceinline__ unsigned cvtpk(float lo, float hi) { unsigned r; asm volatile("v_cvt_pk_bf16_f32 %0, %1, %2" : "=v"(r) : "v"(lo), "v"(hi)); return r; }
typedef float f32x2_t __attribute__((ext_vector_type(2))); typedef __bf16 bf16x2_t __attribute__((ext_vector_type(2)));
__device__ __forceinline__ unsigned cvtpk_c(float lo, float hi) { const f32x2_t v = {lo, hi}; const bf16x2_t b = __builtin_convertvector(v, bf16x2_t); return __builtin_bit_cast(unsigned, b); }
__device__ __forceinline__ unsigned short f2bf1(float f) { unsigned u = __builtin_bit_cast(unsigned, f); return (unsigned short)((u + 0x7fffu + ((u >> 16) & 1u)) >> 16); }

#define ATT_MX3(a, b, c) __builtin_fmaxf(__builtin_fmaxf((a), (b)), (c))
template <int MODE, bool FIRST>
__device__ __forceinline__ void partialSM(f32x16& p0, f32x16& p1, float& m_run, f32x16& negm, float& alpha) {
  if constexpr (MODE == 0) {
    float a = ATT_MX3(p0[0], p0[1], p1[0]), b = ATT_MX3(p0[2], p0[3], p1[1]); a = ATT_MX3(a, p1[2], p1[3]);
#pragma unroll
    for (int r = 4; r < 16; r += 4) { a = ATT_MX3(a, p0[r], p0[r + 1]); b = ATT_MX3(b, p0[r + 2], p0[r + 3]); a = ATT_MX3(a, p1[r], p1[r + 1]); b = ATT_MX3(b, p1[r + 2], p1[r + 3]); }
    float pmax = fmaxf(a, b);
    { auto rr = __builtin_amdgcn_permlane32_swap(__float_as_uint(pmax), __float_as_uint(pmax), false, false);
      pmax = fmaxf(__uint_as_float(rr[0]), __uint_as_float(rr[1])); }
    alpha = 1.f;
    if (FIRST || __builtin_expect(__any(pmax > THR), 0)) {
      const float dl = FIRST ? pmax : fmaxf(pmax, 0.f);
      m_run += dl;
#pragma unroll
      for (int r = 0; r < 16; ++r) { p0[r] -= dl; p1[r] -= dl; }
#pragma unroll
      for (int r = 0; r < 16; ++r) negm[r] = -m_run;
      asm volatile("" : "+v"(negm));
      alpha = FIRST ? 1.f : __builtin_amdgcn_exp2f(-dl);
    }
  } else { alpha = 1.f; }
#pragma unroll
  for (int r = 0; r < 16; ++r) p0[r] = __builtin_amdgcn_exp2f(p0[r]);
}
__device__ __forceinline__ void finishSM(f32x16& p0, f32x16& p1, float alpha, float& l_reg, bf16x8& pa0, bf16x8& pa1, bf16x8& pa2, bf16x8& pa3) {
#pragma unroll
  for (int r = 0; r < 16; ++r) p1[r] = __builtin_amdgcn_exp2f(p1[r]);
  float ps = 0;
#pragma unroll
  for (int r = 0; r < 16; ++r) ps += p0[r];
#pragma unroll
  for (int r = 0; r < 16; ++r) ps += p1[r];
  { auto rr = __builtin_amdgcn_permlane32_swap(__float_as_uint(ps), __float_as_uint(ps), false, false);
    ps = __uint_as_float(rr[0]) + __uint_as_float(rr[1]); }
  l_reg = l_reg * alpha + ps;
#define ATT_PK4(P, BASE, OUT) do { const u32x4 w = {cvtpk_c(P[BASE + 0], P[BASE + 1]), cvtpk_c(P[BASE + 2], P[BASE + 3]), cvtpk_c(P[BASE + 4], P[BASE + 5]), cvtpk_c(P[BASE + 6], P[BASE + 7])}; \
    OUT = __builtin_bit_cast(bf16x8, w); } while (0)
  ATT_PK4(p0, 0, pa0); ATT_PK4(p0, 8, pa1); ATT_PK4(p1, 0, pa2); ATT_PK4(p1, 8, pa3);
#undef ATT_PK4
}
template <int ND0, int MODE = 0>
__device__ __forceinline__ void qkt(f32x16& p0, f32x16& p1, const char* Ks, const bf16x8* qr, const f32x16& negm, int r32, int hi) {
#pragma unroll
  for (int d0 = 0; d0 < ND0; ++d0) {
    const char* kb = Ks + (2 * d0 + hi) * KCH + r32 * 16;
    bf16x8 b0 = *reinterpret_cast<const bf16x8*>(kb);
    bf16x8 b1 = *reinterpret_cast<const bf16x8*>(kb + 512);
    if (d0 == 0) { if constexpr (MODE == 1) { p0 = __builtin_amdgcn_mfma_f32_32x32x16_bf16(b0, qr[0], f32x16{}, 0, 0, 0); p1 = __builtin_amdgcn_mfma_f32_32x32x16_bf16(b1, qr[0], f32x16{}, 0, 0, 0); }
                   else { p0 = __builtin_amdgcn_mfma_f32_32x32x16_bf16(b0, qr[0], negm, 0, 0, 0); p1 = __builtin_amdgcn_mfma_f32_32x32x16_bf16(b1, qr[0], negm, 0, 0, 0); } }
    else { p0 = __builtin_amdgcn_mfma_f32_32x32x16_bf16(b0, qr[d0], p0, 0, 0, 0); p1 = __builtin_amdgcn_mfma_f32_32x32x16_bf16(b1, qr[d0], p1, 0, 0, 0); } }
}
template <int NB> __device__ __forceinline__ int v_st(int k, int c) { const int kk = k; return ((kk >> 3) * NB + (c >> 5)) * 512 + ((kk & 7) * 32 + (c & 31)) * 2; }
__device__ __forceinline__ int v_rd_base(int lane) { return ((lane & 3) << 3) | (((lane >> 2) & 3) << 6) | (((lane >> 4) & 1) << 5) | (((lane >> 5) & 1) << 8); }
template <int OFF> __device__ __forceinline__ s16x4 tr_read(int vb) {
  s16x4 r; asm volatile("ds_read_b64_tr_b16 %0, %1 offset:%2" : "=&v"(r) : "v"(vb), "i"(OFF) : "memory"); return r;
}
template <int NB, int D0> __device__ __forceinline__ void pv_one(f32x16& od, int vb, bf16x8 pa0, bf16x8 pa1, bf16x8 pa2, bf16x8 pa3) {
#define ATT_VO(ks, half) (D0 * 512 + (2 * (ks) + (half)) * NB * 512)
  const s16x4 l0 = tr_read<ATT_VO(0, 0)>(vb), h0 = tr_read<ATT_VO(0, 1)>(vb), l1 = tr_read<ATT_VO(1, 0)>(vb), h1 = tr_read<ATT_VO(1, 1)>(vb);
  const s16x4 l2 = tr_read<ATT_VO(2, 0)>(vb), h2 = tr_read<ATT_VO(2, 1)>(vb), l3 = tr_read<ATT_VO(3, 0)>(vb), h3 = tr_read<ATT_VO(3, 1)>(vb);
#undef ATT_VO
  asm volatile("s_waitcnt lgkmcnt(0)" ::: "memory"); ATT_SBAR();
#define ATT_PK(L, H) (bf16x8){L[0], L[1], L[2], L[3], H[0], H[1], H[2], H[3]}
  od = __builtin_amdgcn_mfma_f32_32x32x16_bf16(pa0, ATT_PK(l0, h0), od, 0, 0, 0);
  od = __builtin_amdgcn_mfma_f32_32x32x16_bf16(pa1, ATT_PK(l1, h1), od, 0, 0, 0);
  od = __builtin_amdgcn_mfma_f32_32x32x16_bf16(pa2, ATT_PK(l2, h2), od, 0, 0, 0);
  od = __builtin_amdgcn_mfma_f32_32x32x16_bf16(pa3, ATT_PK(l3, h3), od, 0, 0, 0);
#undef ATT_PK
}
template <int NB> __device__ __forceinline__ void pv_all(f32x16* o, int vb, bf16x8 pa0, bf16x8 pa1, bf16x8 pa2, bf16x8 pa3) {
  if constexpr (NB == 2) {
#define ATT_VO(d0, ks, half) ((d0) * 512 + (2 * (ks) + (half)) * NB * 512)
    const s16x4 l0 = tr_read<ATT_VO(0, 0, 0)>(vb), h0 = tr_read<ATT_VO(0, 0, 1)>(vb), l1 = tr_read<ATT_VO(0, 1, 0)>(vb), h1 = tr_read<ATT_VO(0, 1, 1)>(vb);
    const s16x4 l2 = tr_read<ATT_VO(0, 2, 0)>(vb), h2 = tr_read<ATT_VO(0, 2, 1)>(vb), l3 = tr_read<ATT_VO(0, 3, 0)>(vb), h3 = tr_read<ATT_VO(0, 3, 1)>(vb);
    const s16x4 m0 = tr_read<ATT_VO(1, 0, 0)>(vb), n0 = tr_read<ATT_VO(1, 0, 1)>(vb), m1 = tr_read<ATT_VO(1, 1, 0)>(vb), n1 = tr_read<ATT_VO(1, 1, 1)>(vb);
    const s16x4 m2 = tr_read<ATT_VO(1, 2, 0)>(vb), n2 = tr_read<ATT_VO(1, 2, 1)>(vb), m3 = tr_read<ATT_VO(1, 3, 0)>(vb), n3 = tr_read<ATT_VO(1, 3, 1)>(vb);
#undef ATT_VO
#define ATT_PK(L, H) (bf16x8){L[0], L[1], L[2], L[3], H[0], H[1], H[2], H[3]}
    asm volatile("s_waitcnt lgkmcnt(8)" ::: "memory"); ATT_SBAR();
    o[0] = __builtin_amdgcn_mfma_f32_32x32x16_bf16(pa0, ATT_PK(l0, h0), o[0], 0, 0, 0);
    o[0] = __builtin_amdgcn_mfma_f32_32x32x16_bf16(pa1, ATT_PK(l1, h1), o[0], 0, 0, 0);
    o[0] = __builtin_amdgcn_mfma_f32_32x32x16_bf16(pa2, ATT_PK(l2, h2), o[0], 0, 0, 0);
    o[0] = __builtin_amdgcn_mfma_f32_32x32x16_bf16(pa3, ATT_PK(l3, h3), o[0], 0, 0, 0);
    asm volatile("s_waitcnt lgkmcnt(0)" ::: "memory"); ATT_SBAR();
    o[1] = __builtin_amdgcn_mfma_f32_32x32x16_bf16(pa0, ATT_PK(m0, n0), o[1], 0, 0, 0);
    o[1] = __builtin_amdgcn_mfma_f32_32x32x16_bf16(pa1, ATT_PK(m1, n1), o[1], 0, 0, 0);
    o[1] = __builtin_amdgcn_mfma_f32_32x32x16_bf16(pa2, ATT_PK(m2, n2), o[1], 0, 0, 0);
    o[1] = __builtin_amdgcn_mfma_f32_32x32x16_bf16(pa3, ATT_PK(m3, n3), o[1], 0, 0, 0);
#undef ATT_PK
  } else {
    pv_one<NB, 0>(o[0], vb, pa0, pa1, pa2, pa3); pv_one<NB, 1>(o[1], vb, pa0, pa1, pa2, pa3);
    pv_one<NB, 2>(o[2], vb, pa0, pa1, pa2, pa3); pv_one<NB, 3>(o[3], vb, pa0, pa1, pa2, pa3);
  }
}

template <int W1, int W2, int DV> struct AttnCfg {
  static constexpr int DQK = W1 + W2, NCH = DQK / 8, ND0 = DQK / 16, NB = DV / 32;
  static constexpr int KT_BYTES = NCH * KCH, VT_BYTES = 64 * DV * 2;
  static constexpr int OST_BYTES = 32 * DV * 2;
  static constexpr bool OSTAGE = (DV == 64);
  static constexpr int LDS_BYTES = 3 * VT_BYTES + 3 * KT_BYTES + 8 * 64 * 4 + (OSTAGE ? 8 * OST_BYTES : 0);
  static constexpr int CW1 = W1 / 8, N1 = (64 * CW1) / 512;
  static constexpr int CWV = DV / 8, NV = (64 * CWV) / 512;
  static_assert(W1 == 64 || W1 == 128, "W1"); static_assert(W2 == 0 || W2 == 32, "W2"); static_assert(DV == 64 || DV == 128, "DV");
};

template <int W1, int W2, int DV, int MODE, bool SSQ>
__device__ __forceinline__ void attn_unit(const bf16* __restrict__ Qb, const bf16* __restrict__ Qb2, int ldq, const bf16* __restrict__ K1, int ldk1, const bf16* __restrict__ K2, int ldk2,
                                          const bf16* __restrict__ Vh, int ldv, bf16* __restrict__ Ob, int ldo, int nkeys, char* lds, float (&ssacc)[16]) {
  using C = AttnCfg<W1, W2, DV>;
  constexpr int ND0 = C::ND0, NB = C::NB, N1 = C::N1, NV = C::NV, CW1 = C::CW1, CWV = C::CWV;
  constexpr int SHM_V = C::VT_BYTES, SHM_K = C::KT_BYTES;
  int tid_ = threadIdx.x; asm volatile("" : "+v"(tid_));
  const int tid = tid_, wid = tid >> 6, lane = tid & 63, r32 = lane & 31, hi = lane >> 5;
  char* V_lds = lds; char* K_lds = lds + 3 * SHM_V;
  float* ws = (float*)(lds + 3 * SHM_V + 3 * SHM_K) + wid * 64; float* li_l = ws; float* al_l = ws + 32;
  float m_reg = 0.f, l_reg = 0; f32x16 o[NB]; bf16x8 qr[ND0]; f32x16 negm = f32x16{}; if constexpr (MODE == 0) asm volatile("" : "+v"(negm));
#pragma unroll
  for (int d = 0; d < NB; ++d) o[d] = f32x16{};
  const bf16* Qw = Qb + (long)(wid * 32 + r32) * ldq + hi * 8;
#pragma unroll
  for (int d0 = 0; d0 < W1 / 16; ++d0) qr[d0] = *reinterpret_cast<const bf16x8*>(Qw + d0 * 16);
  if constexpr (W2 > 0) { const bf16* Qw2 = Qb2 + (long)(wid * 32 + r32) * ldq + hi * 8;
#pragma unroll
    for (int d0 = 0; d0 < W2 / 16; ++d0) qr[W1 / 16 + d0] = *reinterpret_cast<const bf16x8*>(Qw2 + d0 * 16); }
  int k1row[N1], k1col[N1], k1lds[N1], vrow[NV], vcol[NV], vlds[NV];
#pragma unroll
  for (int i = 0; i < N1; ++i) { const int p = tid + 512 * i; k1row[i] = p / CW1; k1col[i] = (p % CW1) * 8; k1lds[i] = (p % CW1) * KCH + (p / CW1) * 16; }
#pragma unroll
  for (int i = 0; i < NV; ++i) { const int p = tid + 512 * i; vrow[i] = p / CWV; vcol[i] = (p % CWV) * 8; vlds[i] = v_st<NB>(p / CWV, (p % CWV) * 8); }
  const int k2row = tid >> 2, k2col = (tid & 3) * 8, k2lds = (CW1 + (tid & 3)) * KCH + (tid >> 2) * 16; const bool k2on = (W2 > 0) && (tid < 256);
  const int vb0 = (int)(uintptr_t)V_lds + v_rd_base(lane);
  struct Slot { bf16x8 k1[N1]; bf16x8 k2; bf16x8 v[NV]; } sr_[2];
#define ATT_SLOAD(i, k0) do { _Pragma("unroll") for (int _j = 0; _j < N1; ++_j) sr_[i].k1[_j] = *reinterpret_cast<const bf16x8*>(&K1[(long)((k0) + k1row[_j]) * ldk1 + k1col[_j]]); \
    if constexpr (W2 > 0) { if (k2on) sr_[i].k2 = *reinterpret_cast<const bf16x8*>(&K2[(long)((k0) + k2row) * ldk2 + k2col]); } \
    _Pragma("unroll") for (int _j = 0; _j < NV; ++_j) sr_[i].v[_j] = *reinterpret_cast<const bf16x8*>(&Vh[(long)((k0) + vrow[_j]) * ldv + vcol[_j]]); } while (0)
#define ATT_SWRITE(b, i) do { _Pragma("unroll") for (int _j = 0; _j < NV; ++_j) *(bf16x8*)(V_lds + (b) * SHM_V + vlds[_j]) = sr_[i].v[_j]; \
    _Pragma("unroll") for (int _j = 0; _j < N1; ++_j) *(bf16x8*)(K_lds + (b) * SHM_K + k1lds[_j]) = sr_[i].k1[_j]; \
    if constexpr (W2 > 0) { if (k2on) *(bf16x8*)(K_lds + (b) * SHM_K + k2lds) = sr_[i].k2; } } while (0)
#define ATT_SWAIT() asm volatile("s_waitcnt vmcnt(%0)" :: "n"(N1 + NV) : "memory")
#define ATT_RESC(a) do { if (MODE == 0 && __any((a) != 1.f)) { if (hi == 0) al_l[r32] = (a); asm volatile("s_waitcnt lgkmcnt(0)" ::: "memory"); \
    _Pragma("unroll") for (int d = 0; d < NB; ++d) _Pragma("unroll") for (int r = 0; r < 16; ++r) o[d][r] *= al_l[crow(r, hi)]; } } while (0)
  f32x16 pA0, pA1, pB0, pB1; float alA, alB; bf16x8 pa0, pa1, pa2, pa3; const int NT = nkeys / 64;
  ATT_SLOAD(0, 0); asm volatile("s_waitcnt vmcnt(0)" ::: "memory"); ATT_SWRITE(0, 0); __syncthreads();
  qkt<ND0, MODE>(pA0, pA1, K_lds, qr, negm, r32, hi); partialSM<MODE, true>(pA0, pA1, m_reg, negm, alA);
  ATT_SLOAD(1, 64); if (2 < NT) ATT_SLOAD(0, 128);
  ATT_SWAIT(); ATT_SWRITE(1, 1); __syncthreads();
  int bp = 0, bc = 1, bn = 2;
  if (wid >= 4) __builtin_amdgcn_s_setprio(1);
#define ATT_ROT() do { const int t_ = bp; bp = bc; bc = bn; bn = t_; } while (0)
  for (int j = 1; j + 1 < NT; j += 2) {
    ATT_SBAR(); qkt<ND0, MODE>(pB0, pB1, K_lds + bc * SHM_K, qr, negm, r32, hi);
    finishSM(pA0, pA1, alA, l_reg, pa0, pa1, pa2, pa3); ATT_SBAR();
    ATT_SLOAD(1, (j + 2) * 64); ATT_SBAR();
    pv_all<NB>(o, vb0 + bp * SHM_V, pa0, pa1, pa2, pa3); partialSM<MODE, false>(pB0, pB1, m_reg, negm, alB);
    ATT_SWAIT(); ATT_SWRITE(bn, 0);
    ATT_RESC(alB); __syncthreads(); ATT_ROT();
    ATT_SBAR(); qkt<ND0, MODE>(pA0, pA1, K_lds + bc * SHM_K, qr, negm, r32, hi);
    finishSM(pB0, pB1, alB, l_reg, pa0, pa1, pa2, pa3); ATT_SBAR();
    if (j + 3 < NT) ATT_SLOAD(0, (j + 3) * 64); ATT_SBAR();
    pv_all<NB>(o, vb0 + bp * SHM_V, pa0, pa1, pa2, pa3); partialSM<MODE, false>(pA0, pA1, m_reg, negm, alA);
    ATT_SWAIT(); ATT_SWRITE(bn, 1);
    ATT_RESC(alA); __syncthreads(); ATT_ROT();
  }
  ATT_SBAR(); qkt<ND0, MODE>(pB0, pB1, K_lds + bc * SHM_K, qr, negm, r32, hi);
  finishSM(pA0, pA1, alA, l_reg, pa0, pa1, pa2, pa3); ATT_SBAR();
  pv_all<NB>(o, vb0 + bp * SHM_V, pa0, pa1, pa2, pa3); partialSM<MODE, false>(pB0, pB1, m_reg, negm, alB);
  ATT_RESC(alB);
  finishSM(pB0, pB1, alB, l_reg, pa0, pa1, pa2, pa3); ATT_SBAR();
  pv_all<NB>(o, vb0 + bc * SHM_V, pa0, pa1, pa2, pa3);
#undef ATT_ROT
  __builtin_amdgcn_s_setprio(0);
  if (hi == 0) li_l[r32] = l_reg; asm volatile("s_waitcnt lgkmcnt(0)" ::: "memory");
  float rli[16];
#pragma unroll
  for (int r = 0; r < 16; ++r) rli[r] = __builtin_amdgcn_rcpf(li_l[crow(r, hi)]);
  bf16* Ow = Ob + (long)(wid * 32) * ldo;
  if constexpr (C::OSTAGE) { unsigned short* stg = (unsigned short*)(lds + 3 * SHM_V + 3 * SHM_K + 8 * 64 * 4 + wid * C::OST_BYTES);
#pragma unroll
    for (int r = 0; r < 16; ++r) { const int orow = crow(r, hi);
#pragma unroll
      for (int d0 = 0; d0 < NB; ++d0) stg[orow * DV + d0 * 32 + r32] = f2bf1(o[d0][r] * rli[r]); }
    asm volatile("s_waitcnt lgkmcnt(0)" ::: "memory");
    constexpr int CPR = DV / 8;
#pragma unroll
    for (int i = 0; i < (32 * CPR) / 64; ++i) { const int p = i * 64 + lane, row = p / CPR, ch = p % CPR;
      const u32x4 v = *(const u32x4*)(stg + row * DV + ch * 8); *(u32x4*)(Ow + (long)row * ldo + ch * 8) = v; } }
  else {
#pragma unroll
    for (int r = 0; r < 16; ++r) { const int orow = crow(r, hi);
#pragma unroll
      for (int d0 = 0; d0 < NB; ++d0) Ow[(long)orow * ldo + d0 * 32 + r32] = f2bf1(o[d0][r] * rli[r]); } }
  if constexpr (SSQ) {
#pragma unroll
    for (int r = 0; r < 16; ++r) {
#pragma unroll
      for (int d0 = 0; d0 < NB; ++d0) { const float v = o[d0][r] * rli[r]; ssacc[r] += v * v; } } }
  __syncthreads();
#undef ATT_SLOAD
#undef ATT_SWRITE
#undef ATT_SWAIT
#undef ATT_RESC
}
#undef ATT_SBAR
}
constexpr int NWAVES = 8;
#ifndef MK_N_LAUNCHES
#define MK_N_LAUNCHES 1
#endif
constexpr int BATCH = 8, SEQ = 4096, DM = 1024, DEPTH = 4, MTOK = BATCH * SEQ;
constexpr int IN_W = 1184, IN_WP = 1280;
constexpr int MEM_T = 256, MROWS = BATCH * MEM_T;
constexpr int NEXP = 16, CAP = 512, EFF = 512, MOE_ROWS = NEXP * BATCH * CAP;
constexpr float EPS = 1e-6f, LOG2E = 1.4426950408889634f;
constexpr int NPH = 2 + 16 * DEPTH;
constexpr size_t MiB = 1u << 20;
constexpr size_t WS_CTL = 0, CTL_ZERO_BYTES = 1 * MiB;
constexpr size_t WS_TABG = 1 * MiB, WS_TABM = 2 * MiB, WS_WR = 2 * MiB + 512 * 1024, WS_GAINS = 3 * MiB, WS_SSO = 3 * MiB + 64 * 1024, WS_SSX = 346 * MiB, WS_RS1 = WS_SSO + 512 * 1024, WS_RS3 = WS_RS1 + 128 * 1024, WS_RG = 118 * MiB + 256 * 1024, WS_SSL = 118 * MiB + 512 * 1024;
constexpr size_t WS_WSMALL = 4 * MiB, WSMALL_STRIDE = 10 * MiB;
constexpr size_t OFF_WIN = 0, OFF_WQB = 5 * MiB / 2, OFF_WKVB = 3 * MiB, OFF_WO = 7 * MiB / 2, OFF_WMQ = 11 * MiB / 2, OFF_WMKV = 13 * MiB / 2, OFF_WMO = 17 * MiB / 2;
constexpr size_t WS_WGU = 44 * MiB, WS_WD = 76 * MiB;
constexpr size_t WS_MEMN = 92 * MiB, WS_MEMKV = 96 * MiB;
constexpr size_t WS_AFF = 112 * MiB, WS_AFFT = 114 * MiB, WS_SLOT = 116 * MiB, WS_IDX = 118 * MiB;
constexpr size_t WS_H = 120 * MiB, WS_PROJ = 184 * MiB, WS_QG = 264 * MiB, WS_KG = 296 * MiB, WS_VG = 304 * MiB, WS_LAT = 312 * MiB, WS_KROPE = 344 * MiB, WS_QM = 346 * MiB;
constexpr size_t WS_XB = 264 * MiB;
constexpr size_t WS_O = WS_H, WS_KVM = WS_PROJ, WS_QMEM = 184 * MiB, WS_OMEM = 216 * MiB, WS_XG = 184 * MiB, WS_Y = WS_XG, WS_ACT = 312 * MiB;
constexpr size_t WS_WGU2 = 394 * MiB, WS_WD2 = 426 * MiB;
constexpr size_t WS_X = 442 * MiB;
constexpr size_t WS_END = 506 * MiB;
constexpr int CW_BAR = 4096;
constexpr int RING_BYTES = 131072, LDSCTL_OFF = 135168, MISC_OFF = LDSCTL_OFF + 320, GTAB_OFF = LDSCTL_OFF + 1024, STAB_OFF = GTAB_OFF + 8192, LDS_BYTES = 163840;

#define GAS __attribute__((address_space(1)))
#define LAS __attribute__((address_space(3)))
typedef unsigned short bf16;
typedef unsigned v4u __attribute__((ext_vector_type(4)));
typedef float f32x4 __attribute__((ext_vector_type(4)));
#define LDS_WAIT() asm volatile("s_waitcnt lgkmcnt(0)" ::: "memory")
__device__ __forceinline__ unsigned pk2(float lo, float hi) { unsigned r; asm volatile("v_cvt_pk_bf16_f32 %0, %1, %2" : "=v"(r) : "v"(lo), "v"(hi)); return r; }
__device__ __forceinline__ float bflo(unsigned w) { return __uint_as_float(w << 16); }
__device__ __forceinline__ float bfhi(unsigned w) { return __uint_as_float(w & 0xffff0000u); }
#define UNPACK8(W_, V_) do { V_[0] = bflo(W_[0]); V_[1] = bfhi(W_[0]); V_[2] = bflo(W_[1]); V_[3] = bfhi(W_[1]); V_[4] = bflo(W_[2]); V_[5] = bfhi(W_[2]); V_[6] = bflo(W_[3]); V_[7] = bfhi(W_[3]); } while (0)
#define PACK8(V_, W_) do { W_[0] = pk2(V_[0], V_[1]); W_[1] = pk2(V_[2], V_[3]); W_[2] = pk2(V_[4], V_[5]); W_[3] = pk2(V_[6], V_[7]); } while (0)
__device__ __forceinline__ float wave_sum(float v) {
#pragma unroll
    for (int o = 1; o < 64; o <<= 1) v += __shfl_xor(v, o);
    return v;
}
__device__ __forceinline__ int wave_sum_i(int v) {
#pragma unroll
    for (int o = 1; o < 64; o <<= 1) v += __shfl_xor(v, o);
    return v;
}

#define XB_TMO      128
#define XB_XCNT(j)  (256  + 64 * (j))
#define XB_XSUB(j)  (1280 + 64 * (j))
#define XB_XGEN(j)  (2304 + 64 * (j))
#define XB_TOP      3328
#define XB_TOPGEN   3392
#define XCD_BAR_WORDS 3456
#define XB_SPIN_CAP (1u << 20)
__device__ __forceinline__ unsigned xb_ld(unsigned* p)              { return __hip_atomic_load(p, __ATOMIC_RELAXED, __HIP_MEMORY_SCOPE_AGENT); }
__device__ __forceinline__ unsigned xb_add(unsigned* p, unsigned v) { return __hip_atomic_fetch_add(p, v, __ATOMIC_RELAXED, __HIP_MEMORY_SCOPE_AGENT); }
__device__ __forceinline__ unsigned xb_xcc_id() { return (unsigned)__builtin_amdgcn_s_getreg((3 << 11) | 20) & 0xFu; }
#define XB_SPIN(cond, bar) do { unsigned _sp = 0; while (cond) { __builtin_amdgcn_s_sleep(1); \
    if ((++_sp & 255u) == 0u) { if (xb_ld(&(bar)[XB_TMO])) break; if (_sp > XB_SPIN_CAP) { atomicAdd(&(bar)[XB_TMO], 1u); break; } } } } while (0)
struct XcdBarrier { unsigned* bar; unsigned x; volatile LAS unsigned* st; };
__device__ __forceinline__ XcdBarrier xcd_barrier_post(unsigned* bar, volatile LAS unsigned* st) {
    XcdBarrier b; b.bar = bar; b.x = xb_xcc_id(); b.st = st;
    if (threadIdx.x == 0) (void)xb_add(&bar[XB_XCNT(b.x)], 1u);
    return b;
}
__device__ __forceinline__ void xcd_barrier_complete(unsigned* bar, unsigned x, unsigned& nloc, unsigned& nx) {
    const unsigned G = gridDim.x * gridDim.y * gridDim.z;
    unsigned sum, cnt, mine, sp = 0u;
    for (;;) {
        sum = 0u; cnt = 0u; mine = 0u;
#pragma unroll
        for (unsigned j = 0; j < 16; ++j) { const unsigned c = xb_ld(&bar[XB_XCNT(j)]); sum += c; cnt += (c > 0u) ? 1u : 0u; mine = (j == x) ? c : mine; }
        if (sum == G) break;
        __builtin_amdgcn_s_sleep(1);
        if ((++sp & 255u) == 0u) { if (xb_ld(&bar[XB_TMO])) break; if (sp > XB_SPIN_CAP) { atomicAdd(&bar[XB_TMO], 1u); break; } }
    }
    nloc = mine > 0u ? mine : 1u; nx = cnt > 0u ? cnt : 1u;
}
__device__ __forceinline__ void xcd_barrier(const XcdBarrier& b) {
    asm volatile("s_waitcnt vmcnt(0)" ::: "memory");
    __syncthreads();
    if (threadIdx.x == 0) {
        unsigned* bar = b.bar;
        __builtin_amdgcn_s_waitcnt(0);
        unsigned nloc = b.st[0], nx = b.st[1];
        if (nloc == 0u) { xcd_barrier_complete(bar, b.x, nloc, nx); b.st[0] = nloc; b.st[1] = nx; }
        const unsigned old = xb_add(&bar[XB_XSUB(b.x)], 1u);
        const unsigned gen = old / nloc;
        if (old + 1u == (gen + 1u) * nloc) {
            __builtin_amdgcn_fence(__ATOMIC_RELEASE, "agent");
            asm volatile("s_waitcnt vmcnt(0)" ::: "memory");
            const unsigned og = xb_add(&bar[XB_TOP], 1u);
            const unsigned tg = og / nx;
            if (og + 1u == (tg + 1u) * nx) xb_add(&bar[XB_TOPGEN], 1u);
            else XB_SPIN(xb_ld(&bar[XB_TOPGEN]) == tg, bar);
            __builtin_amdgcn_fence(__ATOMIC_ACQUIRE, "agent");
            xb_add(&bar[XB_XGEN(b.x)], 1u);
            asm volatile("s_waitcnt vmcnt(0)" ::: "memory");
        } else {
            XB_SPIN(xb_ld(&bar[XB_XGEN(b.x)]) == gen, bar);
            __builtin_amdgcn_fence(__ATOMIC_ACQUIRE, "agent");
            asm volatile("s_waitcnt vmcnt(0)" ::: "memory");
        }
    }
    __syncthreads();
}

struct Args { const float* in[24]; float* out; unsigned char* ws; int ph_lo, ph_hi; };
struct Ctx {
    LAS unsigned char* lds; char* ldsg;
    int tid, lane, wave, vcu, vcu0, G, G0, gw, NGW;
    bf16* x; float* out;
    unsigned char* ws;
};
#define WSP(T, off) ((T*)(F.ws + (off)))
__device__ __forceinline__ void refresh(Ctx& F) { int t = threadIdx.x; asm volatile("" : "+v"(t)); F.tid = t; F.lane = t & 63;
    int w = __builtin_amdgcn_readfirstlane(t >> 6), v = F.vcu0, g = F.G0; asm volatile("" : "+s"(w), "+s"(v), "+s"(g)); F.wave = w; F.vcu = v; F.G = g; F.gw = v * NWAVES + w; F.NGW = g * NWAVES; }

__device__ __forceinline__ int il32(int i) { return (i < 16) ? 2 * i : 2 * (i - 16) + 1; }
__device__ __forceinline__ int il64(int d) { return (d < 32) ? 2 * d : 2 * (d - 32) + 1; }
__device__ __forceinline__ int dstrow(int kind, int n) {
    if (kind == 1) {
        if (n < 512) { const int h = n >> 6, p = il64(n & 63); return 256 * (h >> 2) + 128 * (p >> 5) + 32 * (h & 3) + (p & 31); }
        if (n < 640) { const int kh = (n - 512) >> 6, p = il64(n & 63); return 512 + 128 * (p >> 5) + 32 * kh + (p & 31); }
        if (n < 768) { const int vh = (n - 640) >> 6, d = n & 63; return 512 + 128 * (d >> 5) + 32 * (2 + vh) + (d & 31); }
        if (n >= 1152) return 1152 + il32(n - 1152);
        return n; }
    if (kind == 2) { const int h = n / 96, p = n % 96; return (p < 64) ? h * 64 + p : 512 + h * 32 + il32(p - 64); }
    if (kind == 3) return (n >> 7) * 256 + (n & 127);
    if (kind == 4) return (n >> 7) * 256 + 128 + (n & 127);
    return n;
}
__device__ __forceinline__ void tr_item(const float* W, int N, const float* gain, bf16* WT, int ldk, int kind, int item, LAS float* scr, int lane) {
    const int nblk = (N + 63) / 64, kb = item / nblk, nb = item % nblk, k0 = 64 * kb, n0 = 64 * nb;
    const int lr = lane >> 4, lc = (lane & 15) * 4; const bool okc = (n0 + lc) < N;
    f32x4 v[16];
#pragma unroll
    for (int i = 0; i < 16; ++i) v[i] = okc ? *(const GAS f32x4*)(W + (size_t)(k0 + 4 * i + lr) * N + n0 + lc) : (f32x4){0.f, 0.f, 0.f, 0.f};
#pragma unroll
    for (int i = 0; i < 16; ++i) { const int kk = 4 * i + lr; const float gk = gain ? gain[k0 + kk] : 1.0f; LAS float* d = scr + kk * 65 + lc;
        d[0] = v[i].x * gk; d[1] = v[i].y * gk; d[2] = v[i].z * gk; d[3] = v[i].w * gk; }
    LDS_WAIT(); asm volatile("" ::: "memory");
    const int c = lane & 7;
#pragma unroll
    for (int j = 0; j < 8; ++j) { const int n = (lane >> 3) + 8 * j; const LAS float* s = scr + (8 * c) * 65 + n;
        v4u o; o.x = pk2(s[0 * 65], s[1 * 65]); o.y = pk2(s[2 * 65], s[3 * 65]); o.z = pk2(s[4 * 65], s[5 * 65]); o.w = pk2(s[6 * 65], s[7 * 65]);
        if (n0 + n < N) *(GAS v4u*)(WT + (size_t)dstrow(kind, n0 + n) * ldk + k0 + 8 * c) = o; }
    LDS_WAIT(); asm volatile("" ::: "memory");
}
constexpr int SMALL_ITEMS = 1152;
__device__ __forceinline__ void small_weight_item(const Ctx& F, const Args& A, int l, int r, LAS float* scr) {
    bf16* wl = WSP(bf16, WS_WSMALL + (size_t)l * WSMALL_STRIDE);
    if (r < 304) { tr_item(A.in[3] + (size_t)l * DM * IN_W, IN_W, A.in[2] + l * DM, wl + OFF_WIN / 2, DM, 1, r, scr, F.lane); return; } r -= 304;
    if (r < 48)  { tr_item(A.in[8] + (size_t)l * 256 * 768, 768, A.in[6] + l * 256, wl + OFF_WQB / 2, 256, 2, r, scr, F.lane); return; } r -= 48;
    if (r < 32)  { tr_item(A.in[9] + (size_t)l * 128 * 1024, 1024, A.in[7] + l * 128, wl + OFF_WKVB / 2, 128, 0, r, scr, F.lane); return; } r -= 32;
    if (r < 256) { const int kb = r / 16; const float* gain = (kb < 8) ? (A.in[10] + l * 512) : (A.in[11] + l * 512 - 512);
                   tr_item(A.in[12] + (size_t)l * DM * DM, DM, gain, wl + OFF_WO / 2, DM, 0, r, scr, F.lane); return; } r -= 256;
    if (r < 128) { tr_item(A.in[15] + (size_t)l * DM * 512, 512, A.in[13] + l * DM, wl + OFF_WMQ / 2, DM, 0, r, scr, F.lane); return; } r -= 128;
    if (r < 256) { tr_item(A.in[16] + (size_t)l * DM * DM, DM, A.in[14] + l * DM, wl + OFF_WMKV / 2, DM, 0, r, scr, F.lane); return; } r -= 256;
    tr_item(A.in[17] + (size_t)l * 512 * DM, DM, nullptr, wl + OFF_WMO / 2, 512, 0, r, scr, F.lane);
}
constexpr int MOE_ITEMS = 3 * 2048;
__device__ __forceinline__ void moe_weight_item(const Ctx& F, const Args& A, int l, int it, LAS float* scr) {
    bf16* wgu = WSP(bf16, (l & 1) ? WS_WGU2 : WS_WGU); bf16* wd = WSP(bf16, (l & 1) ? WS_WD2 : WS_WD);
    const int which = it >> 11, e = (it >> 7) & 15, r = it & 127;
    if (which < 2) tr_item((which == 0 ? A.in[20] : A.in[21]) + (size_t)(l * NEXP + e) * DM * EFF, EFF, A.in[18] + l * DM, wgu + (size_t)e * 1024 * 1024, DM, 3 + which, r, scr, F.lane);
    else           tr_item(A.in[22] + (size_t)(l * NEXP + e) * EFF * DM, DM, nullptr, wd + (size_t)e * 1024 * 512, EFF, 0, r, scr, F.lane);
}
__device__ __forceinline__ void convert_moe_weights(const Ctx& F, const Args& A, int l) {
    LAS float* scr = (LAS float*)(F.lds + F.wave * 16640);
    for (int it = F.gw; it < MOE_ITEMS; it += F.NGW) moe_weight_item(F, A, l, it, scr);
}

__device__ __forceinline__ void rms_row_f32(const float* xrow, bf16* xb, bf16* orow, float* rs, int lane) {
    const GAS f32x4* xr = (const GAS f32x4*)xrow + lane;
    f32x4 v[4]; float s = 0.f;
#pragma unroll
    for (int j = 0; j < 4; ++j) { v[j] = xr[64 * j]; s += (v[j].x * v[j].x + v[j].y * v[j].y) + (v[j].z * v[j].z + v[j].w * v[j].w); }
    const float rstd = __builtin_amdgcn_rsqf(wave_sum(s) * (1.f / DM) + EPS);
    if (xb) { GAS unsigned long long* x8 = (GAS unsigned long long*)xb + lane;
#pragma unroll
        for (int j = 0; j < 4; ++j) x8[64 * j] = (unsigned long long)pk2(v[j].x, v[j].y) | ((unsigned long long)pk2(v[j].z, v[j].w) << 32); }
    if (rs && lane == 0) *rs = rstd;
    if (orow) { GAS unsigned long long* o8 = (GAS unsigned long long*)orow + lane;
#pragma unroll
        for (int j = 0; j < 4; ++j) o8[64 * j] = (unsigned long long)pk2(v[j].x * rstd, v[j].y * rstd) | ((unsigned long long)pk2(v[j].z * rstd, v[j].w * rstd) << 32); }
}
__device__ __forceinline__ void phase_prologue(const Ctx& F, const Args& A) {
    LAS float* scr = (LAS float*)(F.lds + F.wave * 16640);
    for (int it = F.gw; it < DEPTH * SMALL_ITEMS; it += F.NGW) small_weight_item(F, A, it / SMALL_ITEMS, it % SMALL_ITEMS, scr);
    convert_moe_weights(F, A, 0);
    const int gt = F.vcu * (NWAVES * 64) + F.tid, NGT = F.G * NWAVES * 64;
    for (int i = gt; i < DEPTH * 12288; i += NGT) { const int l = i / 12288, r = i % 12288;
        bf16* wl = WSP(bf16, WS_WSMALL + (size_t)l * WSMALL_STRIDE);
        *(GAS v4u*)(wl + OFF_WIN / 2 + (size_t)IN_W * DM + (size_t)r * 8) = (v4u){0u, 0u, 0u, 0u}; }
    for (int i = gt; i < 1536; i += NGT) WSP(float, WS_GAINS)[i] = (i < 256) ? A.in[4][i] : (i < 512) ? A.in[5][i - 256] : A.in[23][i - 512];
    for (int i = gt; i < DEPTH * NEXP * DM; i += NGT) { const int l = i / (NEXP * DM), e = (i / DM) % NEXP, k = i % DM;
        WSP(float, WS_WR)[i] = A.in[19][(size_t)(l * DM + k) * NEXP + e] * A.in[18][l * DM + k]; }
    for (int i = gt; i < SEQ * 48; i += NGT) { const int s = i / 48, j = i % 48; const float row = (float)(s >> 6), col = (float)(s & 63);
        const bool isg = (j < 32); const int j2 = isg ? j : j - 32, half = isg ? 16 : 8, jj = j2 & (half - 1);
        const float inv = __builtin_amdgcn_exp2f(-(float)(2 * jj) / (float)(2 * half) * 13.287712379549449f);
        const float ang = ((j2 < half) ? row : col) * inv;
        double td = (double)ang * 0.15915494309189535; td -= rint(td);
        const float sn = __builtin_amdgcn_sinf((float)td), cs = __builtin_amdgcn_cosf((float)td);
        float* dst = isg ? (WSP(float, WS_TABG) + ((size_t)s * 32 + j2) * 2) : (WSP(float, WS_TABM) + ((size_t)s * 16 + j2) * 2);
        dst[0] = cs; dst[1] = sn; }
    for (int m = F.gw; m < MROWS; m += F.NGW) rms_row_f32(A.in[1] + (size_t)m * DM, nullptr, WSP(bf16, WS_MEMN) + (size_t)m * DM, nullptr, F.lane);
    {
        const int lane = F.lane; f32x4 vn[4];
#pragma unroll
        for (int j = 0; j < 4; ++j) vn[j] = (f32x4){0.f, 0.f, 0.f, 0.f};
        if (F.gw < MTOK) { const GAS f32x4* xr = (const GAS f32x4*)(A.in[0] + (size_t)F.gw * DM) + lane;
#pragma unroll
            for (int j = 0; j < 4; ++j) vn[j] = xr[64 * j]; }
        for (int m = F.gw; m < MTOK; m += F.NGW) {
            f32x4 v[4]; float s = 0.f;
#pragma unroll
            for (int j = 0; j < 4; ++j) { v[j] = vn[j]; s += (v[j].x * v[j].x + v[j].y * v[j].y) + (v[j].z * v[j].z + v[j].w * v[j].w); }
            if (m + F.NGW < MTOK) { const GAS f32x4* xr = (const GAS f32x4*)(A.in[0] + (size_t)(m + F.NGW) * DM) + lane;
#pragma unroll
                for (int j = 0; j < 4; ++j) vn[j] = xr[64 * j]; }
            const float rstd = __builtin_amdgcn_rsqf(wave_sum(s) * (1.f / DM) + EPS);
            GAS unsigned long long* x8 = (GAS unsigned long long*)(F.x + (size_t)m * DM) + lane;
#pragma unroll
            for (int j = 0; j < 4; ++j) x8[64 * j] = (unsigned long long)pk2(v[j].x, v[j].y) | ((unsigned long long)pk2(v[j].z, v[j].w) << 32);
            if (lane == 0) WSP(float, WS_RS1)[m] = rstd;
        } }
}

__device__ __forceinline__ void rope4(float* v, const float* tab) {
    const f32x4 t0 = *(const f32x4*)tab, t1 = *(const f32x4*)(tab + 4);
    float a, b;
    a = v[0]; b = v[1]; v[0] = a * t0[0] - b * t0[1]; v[1] = b * t0[0] + a * t0[1];
    a = v[2]; b = v[3]; v[2] = a * t0[2] - b * t0[3]; v[3] = b * t0[2] + a * t0[3];
    a = v[4]; b = v[5]; v[4] = a * t1[0] - b * t1[1]; v[5] = b * t1[0] + a * t1[1];
    a = v[6]; b = v[7]; v[6] = a * t1[2] - b * t1[3]; v[7] = b * t1[2] + a * t1[3];
}
__device__ __forceinline__ void phase_postproj(const Ctx& F, int l) {
    int lane_ = F.lane; asm volatile("" : "+v"(lane_)); const int lane = lane_;
    const float* gq = WSP(float, WS_GAINS) + l * 64; const float* gk = WSP(float, WS_GAINS) + 256 + l * 64;
    float gqv[8], gkv[8];
#pragma unroll
    for (int i = 0; i < 8; ++i) { const int p = 8 * (lane & 7) + i, d = (p >> 1) + 32 * (p & 1); gqv[i] = gq[d]; gkv[i] = gk[d]; }
    const float* tabg = WSP(float, WS_TABG); const float* tabm = WSP(float, WS_TABM);
    const float C2G = 0.125f * LOG2E;
    v4u wa_n = (v4u){0u, 0u, 0u, 0u}, wb_n = wa_n, wc_n = wa_n;
    if (F.gw < MTOK) { const bf16* pr = WSP(bf16, WS_PROJ) + (size_t)F.gw * IN_WP; wa_n = *(const GAS v4u*)(pr + 8 * lane); wb_n = *(const GAS v4u*)(pr + 512 + 8 * lane); if (lane < 20) wc_n = *(const GAS v4u*)(pr + 1024 + 8 * lane); }
    for (int m = F.gw; m < MTOK; m += F.NGW) {
        const int s = m & (SEQ - 1);
        const v4u wa = wa_n, wb = wb_n, wc = wc_n;
        if (m + F.NGW < MTOK) { const bf16* pr = WSP(bf16, WS_PROJ) + (size_t)(m + F.NGW) * IN_WP; wa_n = *(const GAS v4u*)(pr + 8 * lane); wb_n = *(const GAS v4u*)(pr + 512 + 8 * lane); if (lane < 20) wc_n = *(const GAS v4u*)(pr + 1024 + 8 * lane); }
        { const v4u w = wa; float v[8]; UNPACK8(w, v);
          float ss = 0.f;
#pragma unroll
          for (int i = 0; i < 8; ++i) ss += v[i] * v[i];
          ss += __shfl_xor(ss, 1); ss += __shfl_xor(ss, 2); ss += __shfl_xor(ss, 4);
          const float rstd = __builtin_amdgcn_rsqf(ss * (1.f / 64.f) + EPS);
#pragma unroll
          for (int i = 0; i < 8; ++i) v[i] = v[i] * rstd * gqv[i];
          rope4(v, tabg + ((size_t)s * 32 + 4 * (lane & 7)) * 2);
#pragma unroll
          for (int i = 0; i < 8; ++i) v[i] *= C2G;
          v4u o; PACK8(v, o); *(GAS v4u*)(WSP(bf16, WS_QG) + (size_t)m * 512 + 8 * lane) = o; }
        { const v4u w = wb; float v[8]; UNPACK8(w, v);
          float ss = 0.f;
#pragma unroll
          for (int i = 0; i < 8; ++i) ss += v[i] * v[i];
          ss += __shfl_xor(ss, 1); ss += __shfl_xor(ss, 2); ss += __shfl_xor(ss, 4);
          const float ss8 = ss;
          ss += __shfl_xor(ss, 8); ss += __shfl_xor(ss, 16);
          if (lane < 16) {
              const float rstd = __builtin_amdgcn_rsqf(ss8 * (1.f / 64.f) + EPS);
#pragma unroll
              for (int i = 0; i < 8; ++i) v[i] = v[i] * rstd * gkv[i];
              rope4(v, tabg + ((size_t)s * 32 + 4 * (lane & 7)) * 2);
              v4u o; PACK8(v, o); *(GAS v4u*)(WSP(bf16, WS_KG) + (size_t)m * 128 + 8 * lane) = o;
          } else if (lane < 32) {
              *(GAS v4u*)(WSP(bf16, WS_VG) + (size_t)m * 128 + 8 * (lane - 16)) = w;
          } else {
              const float rstd = __builtin_amdgcn_rsqf(ss * (1.f / 256.f) + EPS);
#pragma unroll
              for (int i = 0; i < 8; ++i) v[i] *= rstd;
              v4u o; PACK8(v, o); *(GAS v4u*)(WSP(bf16, WS_LAT) + (size_t)m * 512 + 8 * (lane - 32)) = o;
          } }
        { const v4u w = wc;
          float v[8]; UNPACK8(w, v);
          float ss = 0.f;
#pragma unroll
          for (int i = 0; i < 8; ++i) ss += v[i] * v[i];
          ss += __shfl_xor(ss, 1); ss += __shfl_xor(ss, 2); ss += __shfl_xor(ss, 4); ss += __shfl_xor(ss, 8);
          if (lane < 16) {
              const float rstd = __builtin_amdgcn_rsqf(ss * (1.f / 128.f) + EPS);
#pragma unroll
              for (int i = 0; i < 8; ++i) v[i] *= rstd;
              v4u o; PACK8(v, o); *(GAS v4u*)(WSP(bf16, WS_LAT) + (size_t)m * 512 + 256 + 8 * lane) = o;
          } else if (lane < 20) {
              rope4(v, tabm + ((size_t)s * 16 + 4 * (lane - 16)) * 2);
              v4u o; PACK8(v, o); *(GAS v4u*)(WSP(bf16, WS_KROPE) + (size_t)m * 32 + 8 * (lane - 16)) = o;
          } else if (lane < 36) {
              *(GAS v4u*)(WSP(bf16, WS_LAT) + (size_t)m * 512 + 384 + 8 * (lane - 20)) = (v4u){0u, 0u, 0u, 0u};
          } }
    }
}

__device__ __forceinline__ void phase_outnorm(const Ctx& F) {
    int lane_ = F.lane; asm volatile("" : "+v"(lane_)); const int lane = lane_;
    for (int m = F.gw; m < MTOK; m += F.NGW) {
        bf16* orow = WSP(bf16, WS_O) + (size_t)m * DM;
#pragma unroll
        for (int g = 0; g < 2; ++g) {
            v4u w = *(const GAS v4u*)(orow + g * 512 + 8 * lane); float v[8]; UNPACK8(w, v);
            float ss = 0.f;
#pragma unroll
            for (int i = 0; i < 8; ++i) ss += v[i] * v[i];
            const float rstd = __builtin_amdgcn_rsqf(wave_sum(ss) * (1.f / 512.f) + EPS);
#pragma unroll
            for (int i = 0; i < 8; ++i) v[i] *= rstd;
            v4u o; PACK8(v, o); *(GAS v4u*)(orow + g * 512 + 8 * lane) = o;
        }
    }
}

__device__ __forceinline__ void phase_router(const Ctx& F, int l) {
    int lane_ = F.lane; asm volatile("" : "+v"(lane_)); const int lane = lane_;
    LAS float* wr = (LAS float*)F.lds;
    { const GAS f32x4* src = (const GAS f32x4*)(WSP(float, WS_WR) + (size_t)l * NEXP * DM);
      for (int i = F.tid; i < NEXP * DM / 4; i += NWAVES * 64) ((LAS f32x4*)wr)[i] = src[i]; }
    __syncthreads();
    for (int mp = F.gw; mp < MTOK / 2; mp += F.NGW) {
        const int m = 2 * mp;
        asm volatile("" ::: "memory");
        typedef unsigned u32x2 __attribute__((ext_vector_type(2)));
        const GAS u32x2* xr0 = (const GAS u32x2*)(F.x + (size_t)m * DM) + lane; const GAS u32x2* xr1 = xr0 + DM / 4;
        f32x4 v0[4], v1[4]; float s0 = 0.f, s1 = 0.f;
#pragma unroll
        for (int j = 0; j < 4; ++j) { const u32x2 q0 = xr0[64 * j], q1 = xr1[64 * j];
            v0[j] = (f32x4){bflo(q0.x), bfhi(q0.x), bflo(q0.y), bfhi(q0.y)}; v1[j] = (f32x4){bflo(q1.x), bfhi(q1.x), bflo(q1.y), bfhi(q1.y)}; }
#pragma unroll
        for (int j = 0; j < 4; ++j) { s0 += (v0[j].x * v0[j].x + v0[j].y * v0[j].y) + (v0[j].z * v0[j].z + v0[j].w * v0[j].w); s1 += (v1[j].x * v1[j].x + v1[j].y * v1[j].y) + (v1[j].z * v1[j].z + v1[j].w * v1[j].w); }
        const float rstd0 = __builtin_amdgcn_rsqf(wave_sum(s0) * (1.f / DM) + EPS), rstd1 = __builtin_amdgcn_rsqf(wave_sum(s1) * (1.f / DM) + EPS);
        if (lane == 0) { WSP(float, WS_RS3)[m] = rstd0; WSP(float, WS_RS3)[m + 1] = rstd1; }
        float a0[16], a1[16];
#pragma unroll
        for (int e = 0; e < 16; ++e) { float p = 0.f, q = 0.f;
#pragma unroll
            for (int j = 0; j < 4; ++j) { const f32x4 w = *((const LAS f32x4*)(wr + e * DM) + lane + 64 * j);
                p += (v0[j].x * w.x + v0[j].y * w.y) + (v0[j].z * w.z + v0[j].w * w.w); q += (v1[j].x * w.x + v1[j].y * w.y) + (v1[j].z * w.z + v1[j].w * w.w); }
            a0[e] = p; a1[e] = q; }
        float t16[16];
#pragma unroll
        for (int e = 0; e < 16; ++e) { const float send = (lane & 32) ? a0[e] : a1[e], keep = (lane & 32) ? a1[e] : a0[e]; t16[e] = keep + __shfl_xor(send, 32); }
        float t8[8];
#pragma unroll
        for (int e = 0; e < 8; ++e) { const float send = (lane & 16) ? t16[e] : t16[e + 8], keep = (lane & 16) ? t16[e + 8] : t16[e]; t8[e] = keep + __shfl_xor(send, 16); }
        float t4[4];
#pragma unroll
        for (int e = 0; e < 4; ++e) { const float send = (lane & 8) ? t8[e] : t8[e + 4], keep = (lane & 8) ? t8[e + 4] : t8[e]; t4[e] = keep + __shfl_xor(send, 8); }
        float t2[2];
#pragma unroll
        for (int e = 0; e < 2; ++e) { const float send = (lane & 4) ? t4[e] : t4[e + 2], keep = (lane & 4) ? t4[e + 2] : t4[e]; t2[e] = keep + __shfl_xor(send, 4); }
        float lg; { const float send = (lane & 2) ? t2[0] : t2[1], keep = (lane & 2) ? t2[1] : t2[0]; lg = keep + __shfl_xor(send, 2); }
        lg += __shfl_xor(lg, 1);
        lg *= (lane & 32) ? rstd1 : rstd0;
        float mx = lg;
        mx = fmaxf(mx, __shfl_xor(mx, 2)); mx = fmaxf(mx, __shfl_xor(mx, 4)); mx = fmaxf(mx, __shfl_xor(mx, 8)); mx = fmaxf(mx, __shfl_xor(mx, 16));
        const float ex = __expf(lg - mx);
        float den = ex; den += __shfl_xor(den, 2); den += __shfl_xor(den, 4); den += __shfl_xor(den, 8); den += __shfl_xor(den, 16);
        const float mine = ex / den;
        if ((lane & 1) == 0) { const int row = m + (lane >> 5), e = (lane >> 1) & 15;
            WSP(float, WS_AFF)[(size_t)row * 16 + e] = mine;
            WSP(float, WS_AFFT)[((size_t)(row >> 12) * 16 + e) * SEQ + (row & (SEQ - 1))] = mine; }
    }
    __syncthreads();
}

__device__ __forceinline__ int block_excl_scan(int v, LAS int* red, int lane, int wave, int& total) {
    int inc = v;
#pragma unroll
    for (int o = 1; o < 64; o <<= 1) { const int t = __shfl_up(inc, o); if (lane >= o) inc += t; }
    __syncthreads();
    if (lane == 63) red[wave] = inc;
    __syncthreads();
    int base = 0, tot = 0;
#pragma unroll
    for (int w = 0; w < 8; ++w) { const int t = red[w]; if (w < wave) base += t; tot += t; }
    total = tot;
    return base + inc - v;
}
__device__ __forceinline__ void phase_select(const Ctx& F, const Args& A, int l) {
    LAS int* red = (LAS int*)F.lds;
    int tid_ = F.tid; asm volatile("" : "+v"(tid_)); const int tid = tid_, lane = tid & 63, wave = F.wave;
    for (int pair = F.vcu; pair < BATCH * NEXP; pair += F.G) {
        const int b = pair >> 4, e = pair & 15;
        const GAS v4u* src = (const GAS v4u*)(WSP(float, WS_AFFT) + (size_t)pair * SEQ) + 2 * tid;
        const v4u w0 = src[0], w1 = src[1];
        unsigned v[8] = {w0.x, w0.y, w0.z, w0.w, w1.x, w1.y, w1.z, w1.w};
        unsigned T = 0u; int par = 0;
        for (int bit = 30; bit >= 0; --bit) {
            const unsigned cand = T | (1u << bit);
            int c = 0;
#pragma unroll
            for (int i = 0; i < 8; ++i) c += (v[i] >= cand) ? 1 : 0;
            c = wave_sum_i(c);
            if (lane == 0) red[par * 8 + wave] = c;
            __syncthreads();
            int tot = 0;
#pragma unroll
            for (int w = 0; w < 8; ++w) tot += red[par * 8 + w];
            if (tot >= CAP) T = cand;
            par ^= 1;
        }
        int cgt = 0, ceq = 0;
#pragma unroll
        for (int i = 0; i < 8; ++i) { cgt += (v[i] > T) ? 1 : 0; ceq += (v[i] == T) ? 1 : 0; }
        int ngt, neq_tot;
        (void)block_excl_scan(cgt, red + 16, lane, wave, ngt);
        int eqb = block_excl_scan(ceq, red + 16, lane, wave, neq_tot);
        const int need_eq = CAP - ngt;
        int sel[8], csel = 0;
#pragma unroll
        for (int i = 0; i < 8; ++i) { const bool iseq = (v[i] == T); sel[i] = ((v[i] > T) || (iseq && eqb < need_eq)) ? 1 : 0; eqb += iseq ? 1 : 0; csel += sel[i]; }
        int nsel;
        int pos = block_excl_scan(csel, red + 16, lane, wave, nsel);
        int* idx = WSP(int, WS_IDX) + (size_t)(e * BATCH + b) * CAP; float* rg = WSP(float, WS_RG) + (size_t)(e * BATCH + b) * CAP; const float* rs3 = WSP(float, WS_RS3) + (size_t)b * SEQ;
        int* slot = WSP(int, WS_SLOT) + ((size_t)b * SEQ + (size_t)tid * 8) * NEXP + e;
#pragma unroll
        for (int i = 0; i < 8; ++i) { if (sel[i]) { if (pos < CAP) { idx[pos] = tid * 8 + i; rg[pos] = rs3[tid * 8 + i]; } slot[i * NEXP] = pos; ++pos; } else slot[i * NEXP] = -1; }
        __syncthreads();
    }
    if (l + 1 < DEPTH) {
        const bool split = F.G > BATCH * NEXP; const int nw = split ? (F.G - BATCH * NEXP) * NWAVES : F.NGW, wi = split ? (F.vcu - BATCH * NEXP) * NWAVES + F.wave : F.gw;
        LAS float* scr = (LAS float*)(F.lds + F.wave * 16640);
        if (wi >= 0) for (int it = wi; it < MOE_ITEMS; it += nw) moe_weight_item(F, A, l + 1, it, scr);
    }
}

__device__ __forceinline__ void phase_gather(const Ctx& F) {
    int lane_ = F.lane; asm volatile("" : "+v"(lane_)); const int lane = lane_;
    for (int r = F.gw; r < MOE_ROWS; r += F.NGW) {
        const int b = (r >> 9) & 7; const int t = WSP(int, WS_IDX)[r];
        const GAS v4u* src = (const GAS v4u*)(WSP(bf16, WS_H) + ((size_t)b * SEQ + t) * DM) + lane;
        GAS v4u* dst = (GAS v4u*)(WSP(bf16, WS_XG) + (size_t)r * DM) + lane;
        const v4u a = src[0], c = src[64]; dst[0] = a; dst[64] = c;
    }
}

__device__ __forceinline__ void phase_combine(const Ctx& F, const Args& A, int l, float amul) {
    int lane_ = F.lane; asm volatile("" : "+v"(lane_)); const int lane = lane_; const bool lastl = (l == DEPTH - 1);
    const float* gfin = WSP(float, WS_GAINS) + 512;
    v4u xa_n = (v4u){0u, 0u, 0u, 0u}, xc_n = xa_n; int sl_n = -1; float af_n = 0.f;
    if (F.gw < MTOK) { const GAS v4u* xp = (const GAS v4u*)(F.x + (size_t)F.gw * DM) + lane; xa_n = xp[0]; xc_n = xp[64];
        sl_n = WSP(int, WS_SLOT)[(size_t)F.gw * NEXP + (lane & 15)]; af_n = WSP(float, WS_AFF)[(size_t)F.gw * NEXP + (lane & 15)]; }
    for (int m = F.gw; m < MTOK; m += F.NGW) {
        const int b = m >> 12;
        GAS v4u* xr = (GAS v4u*)(F.x + (size_t)m * DM) + lane;
        const v4u xa = xa_n, xc = xc_n; const int sl = sl_n; const float af = amul * af_n;
        if (m + F.NGW < MTOK) { const int mn = m + F.NGW; const GAS v4u* xp = (const GAS v4u*)(F.x + (size_t)mn * DM) + lane; xa_n = xp[0]; xc_n = xp[64];
            sl_n = WSP(int, WS_SLOT)[(size_t)mn * NEXP + (lane & 15)]; af_n = WSP(float, WS_AFF)[(size_t)mn * NEXP + (lane & 15)]; }
        f32x4 x0 = (f32x4){bflo(xa.x), bfhi(xa.x), bflo(xa.y), bfhi(xa.y)}, x1 = (f32x4){bflo(xa.z), bfhi(xa.z), bflo(xa.w), bfhi(xa.w)};
        f32x4 x2 = (f32x4){bflo(xc.x), bfhi(xc.x), bflo(xc.y), bfhi(xc.y)}, x3 = (f32x4){bflo(xc.z), bfhi(xc.z), bflo(xc.w), bfhi(xc.w)};
        unsigned mask = (unsigned)(__ballot(sl >= 0 && lane < 16));
#define CMB_ACC(Y0, Y1, AE) do { x0.x += AE * bflo(Y0.x); x0.y += AE * bfhi(Y0.x); x0.z += AE * bflo(Y0.y); x0.w += AE * bfhi(Y0.y); \
            x1.x += AE * bflo(Y0.z); x1.y += AE * bfhi(Y0.z); x1.z += AE * bflo(Y0.w); x1.w += AE * bfhi(Y0.w); \
            x2.x += AE * bflo(Y1.x); x2.y += AE * bfhi(Y1.x); x2.z += AE * bflo(Y1.y); x2.w += AE * bfhi(Y1.y); \
            x3.x += AE * bflo(Y1.z); x3.y += AE * bfhi(Y1.z); x3.z += AE * bflo(Y1.w); x3.w += AE * bfhi(Y1.w); } while (0)
        while (mask) {
            const int e1 = __builtin_ctz(mask); mask &= mask - 1u;
            const bool two = mask != 0u; const int e2 = two ? __builtin_ctz(mask) : e1; if (two) mask &= mask - 1u;
            const int s1 = __shfl(sl, e1), s2 = __shfl(sl, e2); const float a1 = __shfl(af, e1), a2 = two ? __shfl(af, e2) : 0.f;
            const GAS v4u* yr1 = (const GAS v4u*)(WSP(bf16, WS_Y) + ((size_t)(e1 * BATCH + b) * CAP + s1) * DM) + lane;
            const GAS v4u* yr2 = (const GAS v4u*)(WSP(bf16, WS_Y) + ((size_t)(e2 * BATCH + b) * CAP + s2) * DM) + lane;
            const v4u y0 = yr1[0], y1 = yr1[64], z0 = yr2[0], z1 = yr2[64];
            CMB_ACC(y0, y1, a1); CMB_ACC(z0, z1, a2);
        }
#undef CMB_ACC
        float s = (x0.x * x0.x + x0.y * x0.y) + (x0.z * x0.z + x0.w * x0.w) + (x1.x * x1.x + x1.y * x1.y) + (x1.z * x1.z + x1.w * x1.w)
                + (x2.x * x2.x + x2.y * x2.y) + (x2.z * x2.z + x2.w * x2.w) + (x3.x * x3.x + x3.y * x3.y) + (x3.z * x3.z + x3.w * x3.w);
        const float rstd = __builtin_amdgcn_rsqf(wave_sum(s) * (1.f / DM) + EPS);
        if (lastl) {
            const f32x4 g0 = *(const f32x4*)(gfin + 8 * lane), g1 = *(const f32x4*)(gfin + 8 * lane + 4), g2 = *(const f32x4*)(gfin + 512 + 8 * lane), g3 = *(const f32x4*)(gfin + 512 + 8 * lane + 4);
            GAS f32x4* ow = (GAS f32x4*)(F.out + (size_t)m * DM);
            ow[2 * lane] = x0 * rstd * g0; ow[2 * lane + 1] = x1 * rstd * g1; ow[128 + 2 * lane] = x2 * rstd * g2; ow[128 + 2 * lane + 1] = x3 * rstd * g3;
        } else {
            v4u n0, n1; n0.x = pk2(x0.x, x0.y); n0.y = pk2(x0.z, x0.w); n0.z = pk2(x1.x, x1.y); n0.w = pk2(x1.z, x1.w); n1.x = pk2(x2.x, x2.y); n1.y = pk2(x2.z, x2.w); n1.z = pk2(x3.x, x3.y); n1.w = pk2(x3.z, x3.w);
            xr[0] = n0; xr[64] = n1;
            if (lane == 0) WSP(float, WS_RS1)[m] = rstd;
        }
    }
}

__device__ __forceinline__ void phase_attn_self(const Ctx& F, int l) {
    float gmq = fabsf(WSP(float, WS_GAINS)[l * 64 + F.lane]), gmk = fabsf(WSP(float, WS_GAINS)[256 + l * 64 + F.lane]);
#pragma unroll
    for (int o = 1; o < 64; o <<= 1) { gmq = fmaxf(gmq, __shfl_xor(gmq, o)); gmk = fmaxf(gmk, __shfl_xor(gmk, o)); }
    const bool bounded = (8.0f * LOG2E * gmq * gmk) < 64.0f;
    const int lane = F.lane, r32 = lane & 31, hi = lane >> 5, wid = F.wave;
#ifndef DUPATT
#define DUPATT 0
#endif
    for (int g = 0; g < 2; ++g)
      for (int rep2_ = 0; rep2_ < 1 + ((DUPATT >> g) & 1); ++rep2_)
        for (int u = F.vcu; u < 256; u += F.G) {
            const int b = u >> 5, qb = (u >> 1) & 15, hh = u & 1;
            const size_t r0 = (size_t)b * SEQ, q0 = r0 + (size_t)qb * 256;
            float ssacc[16];
#pragma unroll
            for (int r = 0; r < 16; ++r) ssacc[r] = 0.f;
            for (int hq = 0; hq < 4; ++hq) {
                const int h = hh * 4 + hq;
                if (g == 0) {
                    if (bounded) att::attn_unit<64, 0, 64, 1, true>(WSP(bf16, WS_QG) + q0 * 512 + h * 64, nullptr, 512, WSP(bf16, WS_KG) + r0 * 128 + hh * 64, 128, nullptr, 0,
                                              WSP(bf16, WS_VG) + r0 * 128 + hh * 64, 128, WSP(bf16, WS_O) + q0 * DM + h * 64, DM, SEQ, F.ldsg, ssacc);
                    else         att::attn_unit<64, 0, 64, 0, true>(WSP(bf16, WS_QG) + q0 * 512 + h * 64, nullptr, 512, WSP(bf16, WS_KG) + r0 * 128 + hh * 64, 128, nullptr, 0,
                                              WSP(bf16, WS_VG) + r0 * 128 + hh * 64, 128, WSP(bf16, WS_O) + q0 * DM + h * 64, DM, SEQ, F.ldsg, ssacc);
                } else {
                    att::attn_unit<64, 32, 64, 0, true>(WSP(bf16, WS_QM) + q0 * 768 + h * 64, WSP(bf16, WS_QM) + q0 * 768 + 512 + h * 32, 768, WSP(bf16, WS_KVM) + r0 * DM + h * 128, DM, WSP(bf16, WS_KROPE) + r0 * 32, 32,
                                               WSP(bf16, WS_KVM) + r0 * DM + h * 128 + 64, DM, WSP(bf16, WS_O) + q0 * DM + 512 + h * 64, DM, SEQ, F.ldsg, ssacc);
                }
            }
#pragma unroll
            for (int r = 0; r < 16; ++r) { float s = ssacc[r];
                s += __shfl_xor(s, 1); s += __shfl_xor(s, 2); s += __shfl_xor(s, 4); s += __shfl_xor(s, 8); s += __shfl_xor(s, 16);
                if (r32 == 0) WSP(float, WS_SSO)[(q0 + wid * 32 + att::crow(r, hi)) * 4 + g * 2 + hh] = s; }
        }
}
__device__ __forceinline__ void phase_attn_mem(const Ctx& F, int l) {
    const bf16* kv = WSP(bf16, WS_MEMKV) + (size_t)l * MROWS * DM; float dummy[16];
    for (int idx = F.vcu; idx < 256; idx += F.G) {
        const int pm = idx >> 1, pn = idx & 1, b = pm >> 4;
        const size_t q0 = (size_t)pm * 256, k0 = (size_t)b * MEM_T;
        for (int hh = 0; hh < 2; ++hh) { const int h = 2 * pn + hh;
            att::attn_unit<128, 0, 128, 0, false>(WSP(bf16, WS_QMEM) + q0 * 512 + h * 128, nullptr, 512, kv + k0 * DM + h * 128, DM, nullptr, 0,
                                        kv + k0 * DM + 512 + h * 128, DM, WSP(bf16, WS_OMEM) + q0 * 512 + h * 128, 512, MEM_T, F.ldsg, dummy); }
    }
}

__global__ void __launch_bounds__(NWAVES * 64, 2) enc_fwd(Args args) {
    extern __shared__ __attribute__((aligned(16))) unsigned char lds[];
    Ctx F;
    F.lds = (LAS unsigned char*)lds; F.ldsg = (char*)lds;
    F.tid = threadIdx.x; F.lane = F.tid & 63; F.wave = __builtin_amdgcn_readfirstlane(F.tid >> 6);
    F.G = gridDim.x; F.G0 = F.G; { const int bx = blockIdx.x; F.vcu0 = (F.G % 8 == 0) ? (bx % 8) * (F.G / 8) + bx / 8 : bx; F.vcu = F.vcu0; }
    F.gw = F.vcu * NWAVES + F.wave; F.NGW = F.G * NWAVES;
    F.out = args.out; F.ws = args.ws; F.x = (bf16*)(args.ws + WS_X);
    volatile LAS unsigned* MISC = (volatile LAS unsigned*)(F.lds + MISC_OFF);
    for (int u = F.tid; u < (LDS_BYTES - LDSCTL_OFF) / 4; u += NWAVES * 64) ((LAS unsigned*)(F.lds + LDSCTL_OFF))[u] = 0u;
    __syncthreads();
    XcdBarrier bar; bar.bar = (unsigned*)(F.ws + WS_CTL) + CW_BAR; bar.x = 0; bar.st = nullptr;
    if (MK_N_LAUNCHES == 1) bar = xcd_barrier_post((unsigned*)(F.ws + WS_CTL) + CW_BAR, MISC + 8);
    const int lo = args.ph_lo, hi = args.ph_hi;
#ifndef ONLY_SITE
#define ONLY_SITE -1
#endif
#define ON(s) (ONLY_SITE < 0 || ONLY_SITE == (s))
#ifndef DUPMASK
#define DUPMASK 0u
#endif
#define REP(s) for (int rep_ = 0; rep_ < 1 + (int)((DUPMASK >> (s)) & 1u); ++rep_)
#define IN(k) (lo <= (k) && (k) < hi)
#define SEAM(k) do { if (IN(k) && IN((k) + 1)) xcd_barrier(bar); } while (0)
#define LOCAL_SEAM() do { asm volatile("s_waitcnt vmcnt(0)" ::: "memory"); __syncthreads(); __builtin_amdgcn_fence(__ATOMIC_ACQUIRE, "agent"); asm volatile("s_waitcnt vmcnt(0)" ::: "memory"); __syncthreads(); } while (0)
#define GEMM(EpiT, epi, Ap, lda_, Bp, ldb_, K_, nM_, nN_, gdiv_, gstride_) do { const pg8::Gemm g_{(const bf16*)(Ap), (const bf16*)(Bp), lda_, ldb_, K_, gdiv_, 1 << 30, (size_t)(gstride_), nullptr, nullptr}; \
        pg8::StaticOrder S_; S_.init(nM_, nN_, F.G, (int)blockIdx.x); pg8::gemm_phase<EpiT, pg8::StaticOrder, true>(F.lds, g_, S_, epi); } while (0)

    #ifndef PRODUP
#define PRODUP 0
#endif
    if (ON(100) && IN(0)) for (int rp_ = 0; rp_ <= PRODUP; ++rp_) { refresh(F); phase_prologue(F, args); }
    SEAM(0);
    if (ON(101) && IN(1)) {
        pg8::EpiBf16 E{WSP(bf16, WS_MEMKV), DM, 1.0f, nullptr, nullptr, 0.f, 0.f};
        const pg8::Gemm g_{WSP(bf16, WS_MEMN), WSP(bf16, WS_WSMALL + OFF_WMKV), DM, DM, DM, MROWS / 256, MROWS / 256, (size_t)(WSMALL_STRIDE / 2), nullptr, nullptr};
        pg8::StaticOrder S_; S_.init(DEPTH * MROWS / 256, DM / 256, F.G, (int)blockIdx.x); pg8::gemm_phase<pg8::EpiBf16, pg8::StaticOrder, true>(F.lds, g_, S_, E); }
    SEAM(1);
    for (int l = 0; l < DEPTH; ++l) {
        const int pb = 2 + 16 * l;
        unsigned char* wl = F.ws + WS_WSMALL + (size_t)l * WSMALL_STRIDE;
        if (ON(0) && IN(pb + 0)) REP(0) if (refresh(F), true) {
            pg8::EpiInProj E{WSP(float, WS_RS1), WSP(float, WS_GAINS) + l * 64, WSP(float, WS_GAINS) + 256 + l * 64, WSP(float, WS_TABG), WSP(float, WS_TABM),
                             WSP(bf16, WS_QG), WSP(bf16, WS_KG), WSP(bf16, WS_VG), WSP(bf16, WS_LAT), WSP(bf16, WS_KROPE), WSP(float, WS_SSL), 0.125f * LOG2E, EPS};
            GEMM(pg8::EpiInProj, E, F.x, DM, wl + OFF_WIN, DM, DM, MTOK / 256, IN_WP / 256, 1, 0); }
        SEAM(pb + 0);
        if ((ON(2) || ON(16) || ON(17)) && IN(pb + 2)) REP(2) { refresh(F);
            if (ON(2) || ON(17)) { pg8::EpiQmRope E{WSP(bf16, WS_QM), 768, 0.10206207261596577f * LOG2E, WSP(float, WS_TABM), WSP(float, WS_SSL), 1.0f / 256.0f, EPS}; GEMM(pg8::EpiQmRope, E, WSP(bf16, WS_LAT), 512, wl + OFF_WQB, 256, 256, MTOK / 256, 3, 1, 0); }
            if (ON(2) || ON(16)) { pg8::EpiBf16 E{WSP(bf16, WS_KVM), DM, 1.0f, nullptr, WSP(float, WS_SSL) + 4, 1.0f / 128.0f, EPS}; GEMM(pg8::EpiBf16, E, WSP(bf16, WS_LAT) + 256, 512, wl + OFF_WKVB, 128, 128, MTOK / 256, 4, 1, 0); } }
        SEAM(pb + 2);
        if (ON(3) && IN(pb + 3)) REP(3) if (refresh(F), true) phase_attn_self(F, l);
        SEAM(pb + 3);
        if (ON(5) && IN(pb + 5)) REP(5) if (refresh(F), true) {
            pg8::EpiResidualX E{F.x, WSP(float, WS_SSX), DM, 1.0f / 512.0f, EPS, rep_ ? 0.f : 1.f};
            const pg8::Gemm g_{WSP(bf16, WS_O), (const bf16*)(wl + OFF_WO), DM, DM, DM, 1, 1 << 30, 0, nullptr, WSP(float, WS_SSO)};
            pg8::StaticOrder S_; S_.init(MTOK / 256, 4, F.G, (int)blockIdx.x); pg8::gemm_phase<pg8::EpiResidualX, pg8::StaticOrder, true, false, true>(F.lds, g_, S_, E, F.lds + STAB_OFF, 1.0f / 512.0f, EPS); }
        SEAM(pb + 5);
        if (ON(7) && IN(pb + 7)) REP(7) if (refresh(F), true) { pg8::EpiBf16RowNorm E{WSP(bf16, WS_QMEM), 512, 0.08838834764831845f * LOG2E, WSP(float, WS_SSX), 1.0f / DM, EPS}; GEMM(pg8::EpiBf16RowNorm, E, F.x, DM, wl + OFF_WMQ, DM, DM, MTOK / 256, 2, 1, 0); }
        SEAM(pb + 7);
        if (ON(8) && IN(pb + 8)) REP(8) if (refresh(F), true) phase_attn_mem(F, l);
        SEAM(pb + 8);
        if (ON(9) && IN(pb + 9)) REP(9) if (refresh(F), true) { pg8::EpiResidual E{F.x, DM, rep_ ? 0.f : 1.f}; GEMM(pg8::EpiResidual, E, WSP(bf16, WS_OMEM), 512, wl + OFF_WMO, 512, 512, MTOK / 256, 4, 1, 0); }
        SEAM(pb + 9);
        if (ON(10) && IN(pb + 10)) REP(10) if (refresh(F), true) phase_router(F, l);
        SEAM(pb + 10);
        if (ON(11) && IN(pb + 11)) REP(11) if (refresh(F), true) phase_select(F, args, l);
        SEAM(pb + 11);
        if (ON(13) && IN(pb + 13)) REP(13) if (refresh(F), true) { pg8::EpiSwiGLU E{WSP(bf16, WS_ACT), EFF, WSP(float, WS_RG)};
            const pg8::Gemm g_{F.x, WSP(bf16, (l & 1) ? WS_WGU2 : WS_WGU), DM, DM, DM, 16, 1 << 30, (size_t)(1024 * 1024), WSP(int, WS_IDX), nullptr};
            pg8::StaticOrder S_; S_.init(MOE_ROWS / 256, 4, F.G, (int)blockIdx.x); pg8::gemm_phase<pg8::EpiSwiGLU, pg8::StaticOrder, true, true>(F.lds, g_, S_, E, F.lds + GTAB_OFF); }
        SEAM(pb + 13);
        if (ON(14) && IN(pb + 14)) REP(14) if (refresh(F), true) { pg8::EpiBf16 E{WSP(bf16, WS_Y), DM, 1.0f, nullptr, nullptr, 0.f, 0.f}; GEMM(pg8::EpiBf16, E, WSP(bf16, WS_ACT), EFF, WSP(bf16, (l & 1) ? WS_WD2 : WS_WD), EFF, EFF, MOE_ROWS / 256, 4, 16, 1024 * 512); }
        SEAM(pb + 14);
        if (ON(15) && IN(pb + 15)) REP(15) if (refresh(F), true) phase_combine(F, args, l, (rep_ && l < DEPTH - 1) ? 0.f : 1.f);
        SEAM(pb + 15);
    }
#undef IN
#undef SEAM
#undef GEMM
}

extern "C" void kernel_launch(void* const* d_in, const int* in_sizes, int n_in, void* d_out, int out_size, void* d_ws, size_t ws_size, hipStream_t stream) {
    static int grid = 0;
    if (grid == 0) {
        if (n_in != 24 || out_size != MTOK * DM || ws_size < WS_END) { fprintf(stderr, "kernel_launch: unexpected shapes: n_in %d out %d ws %zu (need %zu)\n", n_in, out_size, ws_size, (size_t)WS_END); grid = -1; return; }
        int dev = 0, cus = 0, per_cu = 0;
        if (hipGetDevice(&dev) != hipSuccess || hipDeviceGetAttribute(&cus, hipDeviceAttributeMultiprocessorCount, dev) != hipSuccess) { grid = -1; return; }
        if (hipFuncSetAttribute((const void*)enc_fwd, hipFuncAttributeMaxDynamicSharedMemorySize, LDS_BYTES) != hipSuccess) { fprintf(stderr, "kernel_launch: hipFuncSetAttribute failed\n"); grid = -1; return; }
        if (hipOccupancyMaxActiveBlocksPerMultiprocessor(&per_cu, (const void*)enc_fwd, NWAVES * 64, LDS_BYTES) != hipSuccess || per_cu < 1)
            fprintf(stderr, "kernel_launch: occupancy query reports %d workgroups per CU\n", per_cu);
        (void)hipGetLastError();
        grid = cus;
        fprintf(stderr, "kernel_launch: grid %d, ws %zu bytes\n", grid, ws_size);
    }
    if (grid < 0) return;
    (void)hipMemsetAsync((char*)d_ws + WS_CTL, 0, CTL_ZERO_BYTES, stream);
    Args a{};
    for (int i = 0; i < 24; ++i) a.in[i] = (const float*)d_in[i];
    a.out = (float*)d_out; a.ws = (unsigned char*)d_ws;
#if MK_N_LAUNCHES == 1
    a.ph_lo = 0; a.ph_hi = NPH;
    hipLaunchKernelGGL(enc_fwd, dim3(grid), dim3(NWAVES * 64), LDS_BYTES, stream, a);
#else
    for (int p = 0; p < NPH; ++p) { a.ph_lo = p; a.ph_hi = p + 1; hipLaunchKernelGGL(enc_fwd, dim3(grid), dim3(NWAVES * 64), LDS_BYTES, stream, a); }
#endif
    const hipError_t le = hipPeekAtLastError();
    if (le != hipSuccess) fprintf(stderr, "kernel_launch: launch failed: %s\n", hipGetErrorName(le));
}
```

```cpp
#include <hip/hip_runtime.h>
#include <cstdio>
#include <cstdint>

namespace pg8 {
#define PG8_LAS __attribute__((address_space(3)))
typedef unsigned short bf16_t;
typedef short bf16x8 __attribute__((ext_vector_type(8)));
typedef float f32x4 __attribute__((ext_vector_type(4)));
typedef unsigned u32x4 __attribute__((ext_vector_type(4)));
constexpr int BM = 256, BK = 64, HALF = 128, HTB = HALF * BK * 2  , STAGE_BYTES = 8 * HTB, NXCD = 8, WGM = 8;

__host__ __device__ __forceinline__ int lds_byte(int r, int c) { const int st = (r >> 4) * 2 + (c >> 5), rr = r & 15, cc = c & 31, ob = rr * 64 + cc * 2; return st * 1024 + (ob ^ (((ob >> 9) & 1) << 5)); }
__host__ __device__ __forceinline__ void stage_rc(int b, int& R, int& C) { const int st = b / 1024, sb = b % 1024, swz = sb ^ (((sb >> 9) & 1) << 5); R = (st >> 1) * 16 + swz / 64; C = (st & 1) * 32 + (swz % 64) / 2; }
__host__ __device__ __forceinline__ int perm32(int rho) { const int n = rho >> 4, i = rho & 15; return 8 * (i >> 2) + 4 * n + (i & 3); }

struct Unit { int pm, pn; };
struct Gemm { const bf16_t* A; const bf16_t* Bt; int lda, ldb, K, gdiv, amod; size_t gstride; const int* idx; const float* ss; };

struct StaticOrder {
    int nM, nN, nwg, G, c;
    __host__ __device__ void init(int nM_, int nN_, int G_, int c_) { nM = nM_; nN = nN_; nwg = nM * nN; G = G_; c = c_; }
    __host__ __device__ bool next(int i, Unit& u) const {
        const long L = (long)i * G + c; if (L >= nwg) return false;
        int wgid = (int)L; { const int q = nwg / NXCD, r = nwg % NXCD, xcd = wgid % NXCD, off = wgid / NXCD; wgid = (xcd < r ? xcd * (q + 1) : r * (q + 1) + (xcd - r) * q) + off; }
        const int nig = WGM * nN, gid = wgid / nig, fm = gid * WGM, gsz = (nM - fm) < WGM ? (nM - fm) : WGM;
        u.pm = fm + ((wgid % nig) % gsz); u.pn = (wgid % nig) / gsz; return true;
    }
};

struct LinearOrder {
    int nM, nN, G, c, per;
    __host__ __device__ void init(int nM_, int nN_, int G_, int c_, int per_) { nM = nM_; nN = nN_; G = G_; c = c_; per = per_; }
    __host__ __device__ bool next(int i, Unit& u) const { const int idx = (c + (i / per) * G) * per + (i % per); if (idx >= nM * nN) return false; u.pm = idx / nN; u.pn = idx % nN; return true; }
};

__device__ __forceinline__ unsigned cvt_pk_bf16(float lo, float hi) { unsigned r; asm volatile("v_cvt_pk_bf16_f32 %0, %1, %2" : "=v"(r) : "v"(lo), "v"(hi)); return r; }

struct EpiBf16 {
    static constexpr bool PERM = true;
    bf16_t* O; int ldc; float scale; const float* rs; const float* ssl; float ssl_inv, ssl_eps;
    __device__ __forceinline__ void operator()(const f32x4 (&acc)[2][2][4][2], const Unit& u, int wr, int wc, int fr, int fq) const {
        const int row0 = u.pm * BM + wr * 64 + fr, col0 = u.pn * BM + wc * 32 + 8 * fq;
#pragma unroll
        for (int ai = 0; ai < 2; ++ai)
#pragma unroll
            for (int m = 0; m < 4; ++m) { const int row = row0 + ai * HALF + m * 16; bf16_t* rowp = O + (size_t)row * ldc + col0; float sc = rs ? scale * rs[row] : scale;
                if (ssl) { const f32x4 q_ = *(const f32x4*)(ssl + (size_t)row * 8); sc *= __builtin_amdgcn_rsqf(((q_[0] + q_[1]) + (q_[2] + q_[3])) * ssl_inv + ssl_eps); }
#pragma unroll
                for (int bj = 0; bj < 2; ++bj) { const f32x4 v0 = acc[ai][bj][m][0] * sc, v1 = acc[ai][bj][m][1] * sc;
                    u32x4 w; w.x = cvt_pk_bf16(v0[0], v0[1]); w.y = cvt_pk_bf16(v0[2], v0[3]); w.z = cvt_pk_bf16(v1[0], v1[1]); w.w = cvt_pk_bf16(v1[2], v1[3]);
                    *(u32x4*)(rowp + bj * HALF) = w; } }
    }
};
struct EpiQmRope {
    static constexpr bool PERM = true;
    bf16_t* O; int ldc; float scale; const float* tab; const float* ssl; float ssl_inv, ssl_eps;
    __device__ __forceinline__ void operator()(const f32x4 (&acc)[2][2][4][2], const Unit& u, int wr, int wc, int fr, int fq) const {
        const int row0 = u.pm * BM + wr * 64 + fr, col0 = u.pn * BM + wc * 32 + 8 * fq;
        const bool rope = (u.pn == 2);
        const int j0 = (8 * fq) >> 1;
#pragma unroll
        for (int ai = 0; ai < 2; ++ai)
#pragma unroll
            for (int m = 0; m < 4; ++m) { const int row = row0 + ai * HALF + m * 16; bf16_t* rowp = O + (size_t)row * ldc + col0; const int s = row & 4095;
                const f32x4 q_ = *(const f32x4*)(ssl + (size_t)row * 8); const float sc_ = scale * __builtin_amdgcn_rsqf(((q_[0] + q_[1]) + (q_[2] + q_[3])) * ssl_inv + ssl_eps);
                f32x4 t0 = (f32x4){1.f, 0.f, 1.f, 0.f}, t1 = (f32x4){1.f, 0.f, 1.f, 0.f};
                if (rope) { t0 = *(const f32x4*)(tab + ((size_t)s * 16 + j0) * 2); t1 = *(const f32x4*)(tab + ((size_t)s * 16 + j0 + 2) * 2); }
#pragma unroll
                for (int bj = 0; bj < 2; ++bj) { const f32x4 v0 = acc[ai][bj][m][0], v1 = acc[ai][bj][m][1];
                    f32x4 r0, r1;
                    r0[0] = v0[0] * t0[0] - v0[1] * t0[1]; r0[1] = v0[1] * t0[0] + v0[0] * t0[1];
                    r0[2] = v0[2] * t0[2] - v0[3] * t0[3]; r0[3] = v0[3] * t0[2] + v0[2] * t0[3];
                    r1[0] = v1[0] * t1[0] - v1[1] * t1[1]; r1[1] = v1[1] * t1[0] + v1[0] * t1[1];
                    r1[2] = v1[2] * t1[2] - v1[3] * t1[3]; r1[3] = v1[3] * t1[2] + v1[2] * t1[3];
                    r0 = r0 * sc_; r1 = r1 * sc_;
                    u32x4 w; w.x = cvt_pk_bf16(r0[0], r0[1]); w.y = cvt_pk_bf16(r0[2], r0[3]); w.z = cvt_pk_bf16(r1[0], r1[1]); w.w = cvt_pk_bf16(r1[2], r1[3]);
                    *(u32x4*)(rowp + bj * HALF) = w; }
                asm volatile("" ::: "memory"); }
    }
};
struct EpiBf16RowNorm {
    static constexpr bool PERM = true;
    bf16_t* O; int ldc; float scale; const float* ss; float inv_n, eps;
    __device__ __forceinline__ void operator()(const f32x4 (&acc)[2][2][4][2], const Unit& u, int wr, int wc, int fr, int fq) const {
        const int row0 = u.pm * BM + wr * 64 + fr, col0 = u.pn * BM + wc * 32 + 8 * fq;
#pragma unroll
        for (int ai = 0; ai < 2; ++ai)
#pragma unroll
            for (int m = 0; m < 4; ++m) { const int row = row0 + ai * HALF + m * 16; bf16_t* rowp = O + (size_t)row * ldc + col0;
                const f32x4 q0 = *(const f32x4*)(ss + (size_t)row * 16), q1 = *(const f32x4*)(ss + (size_t)row * 16 + 4), q2 = *(const f32x4*)(ss + (size_t)row * 16 + 8), q3 = *(const f32x4*)(ss + (size_t)row * 16 + 12);
                const float tot = ((((q0[0] + q0[1]) + (q0[2] + q0[3])) + ((q1[0] + q1[1]) + (q1[2] + q1[3]))) + (((q2[0] + q2[1]) + (q2[2] + q2[3])) + ((q3[0] + q3[1]) + (q3[2] + q3[3]))));
                const float sc = scale * __builtin_amdgcn_rsqf(tot * inv_n + eps);
#pragma unroll
                for (int bj = 0; bj < 2; ++bj) { const f32x4 v0 = acc[ai][bj][m][0] * sc, v1 = acc[ai][bj][m][1] * sc;
                    u32x4 w; w.x = cvt_pk_bf16(v0[0], v0[1]); w.y = cvt_pk_bf16(v0[2], v0[3]); w.z = cvt_pk_bf16(v1[0], v1[1]); w.w = cvt_pk_bf16(v1[2], v1[3]);
                    *(u32x4*)(rowp + bj * HALF) = w; } }
    }
};
__device__ __forceinline__ float bf_lo(unsigned w) { return __uint_as_float(w << 16); }
__device__ __forceinline__ float bf_hi(unsigned w) { return __uint_as_float(w & 0xffff0000u); }
struct EpiResidualX {
    static constexpr bool PERM = true;
    bf16_t* X; float* SSX; int ldc; float inv_n, eps, mul;
    __device__ __forceinline__ void operator()(const f32x4 (&acc)[2][2][4][2], const Unit& u, int wr, int wc, int fr, int fq, const PG8_LAS float* tab) const {
        const int rl0 = wr * 64 + fr, col0 = u.pn * BM + wc * 32 + 8 * fq;
#pragma unroll
        for (int ai = 0; ai < 2; ++ai)
#pragma unroll
            for (int m = 0; m < 4; ++m) { const int rl = rl0 + ai * HALF + m * 16, row = u.pm * BM + rl; bf16_t* rowp = X + (size_t)row * ldc + col0;
                const float rm = mul * __builtin_amdgcn_rsqf((tab[rl * 4 + 2] + tab[rl * 4 + 3]) * inv_n + eps);
                u32x4 xv[2]; float s = 0.f;
#pragma unroll
                for (int bj = 0; bj < 2; ++bj) xv[bj] = *(const u32x4*)(rowp + bj * HALF);
#pragma unroll
                for (int bj = 0; bj < 2; ++bj) { const f32x4 a0 = acc[ai][bj][m][0] * rm, a1 = acc[ai][bj][m][1] * rm; u32x4 w;
                    w.x = cvt_pk_bf16(bf_lo(xv[bj].x) + a0[0], bf_hi(xv[bj].x) + a0[1]); w.y = cvt_pk_bf16(bf_lo(xv[bj].y) + a0[2], bf_hi(xv[bj].y) + a0[3]);
                    w.z = cvt_pk_bf16(bf_lo(xv[bj].z) + a1[0], bf_hi(xv[bj].z) + a1[1]); w.w = cvt_pk_bf16(bf_lo(xv[bj].w) + a1[2], bf_hi(xv[bj].w) + a1[3]);
                    *(u32x4*)(rowp + bj * HALF) = w;
                    const float r0 = bf_lo(w.x), r1 = bf_hi(w.x), r2 = bf_lo(w.y), r3 = bf_hi(w.y), r4 = bf_lo(w.z), r5 = bf_hi(w.z), r6 = bf_lo(w.w), r7 = bf_hi(w.w);
                    s += ((r0 * r0 + r1 * r1) + (r2 * r2 + r3 * r3)) + ((r4 * r4 + r5 * r5) + (r6 * r6 + r7 * r7)); }
                s += __shfl_xor(s, 16); s += __shfl_xor(s, 32);
                if (fq == 0) SSX[(size_t)row * 16 + u.pn * 4 + wc] = s;
                if (m & 1) asm volatile("" ::: "memory"); }
    }
};
struct EpiResidual {
    static constexpr bool PERM = true;
    bf16_t* X; int ldc; float mul;
    __device__ __forceinline__ void operator()(const f32x4 (&acc)[2][2][4][2], const Unit& u, int wr, int wc, int fr, int fq) const {
        const int row0 = u.pm * BM + wr * 64 + fr, col0 = u.pn * BM + wc * 32 + 8 * fq;
#pragma unroll
        for (int ai = 0; ai < 2; ++ai)
#pragma unroll
            for (int m = 0; m < 4; ++m) { bf16_t* rowp = X + (size_t)(row0 + ai * HALF + m * 16) * ldc + col0;
                u32x4 xv[2];
#pragma unroll
                for (int bj = 0; bj < 2; ++bj) xv[bj] = *(const u32x4*)(rowp + bj * HALF);
#pragma unroll
                for (int bj = 0; bj < 2; ++bj) { const f32x4 a0 = acc[ai][bj][m][0] * mul, a1 = acc[ai][bj][m][1] * mul; u32x4 w;
                    w.x = cvt_pk_bf16(bf_lo(xv[bj].x) + a0[0], bf_hi(xv[bj].x) + a0[1]); w.y = cvt_pk_bf16(bf_lo(xv[bj].y) + a0[2], bf_hi(xv[bj].y) + a0[3]);
                    w.z = cvt_pk_bf16(bf_lo(xv[bj].z) + a1[0], bf_hi(xv[bj].z) + a1[1]); w.w = cvt_pk_bf16(bf_lo(xv[bj].w) + a1[2], bf_hi(xv[bj].w) + a1[3]);
                    *(u32x4*)(rowp + bj * HALF) = w; } }
    }
};
struct EpiInProj {
    static constexpr bool PERM = true;
    const float* rs; const float* gq; const float* gk; const float* tabg; const float* tabm;
    bf16_t* QG; bf16_t* KG; bf16_t* VG; bf16_t* LAT; bf16_t* KROPE; float* SSL; float qscale, eps;
    __device__ __forceinline__ static void rope2(f32x4& v, const f32x4 t) { const float a0 = v[0], b0 = v[1], a1 = v[2], b1 = v[3];
        v[0] = a0 * t[0] - b0 * t[1]; v[1] = b0 * t[0] + a0 * t[1]; v[2] = a1 * t[2] - b1 * t[3]; v[3] = b1 * t[2] + a1 * t[3]; }
    __device__ __forceinline__ static u32x4 pack(const f32x4 a, const f32x4 b) { u32x4 w; w.x = cvt_pk_bf16(a[0], a[1]); w.y = cvt_pk_bf16(a[2], a[3]); w.z = cvt_pk_bf16(b[0], b[1]); w.w = cvt_pk_bf16(b[2], b[3]); return w; }
    __device__ __forceinline__ void operator()(const f32x4 (&acc)[2][2][4][2], const Unit& u, int wr, int wc, int fr, int fq) const {
        const int row0 = u.pm * BM + wr * 64 + fr;
        if (u.pn < 2 || (u.pn == 2 && wc < 2)) {
            const bool isq = u.pn < 2; const float* g = isq ? gq : gk; bf16_t* dst = isq ? QG : KG; const int ld = isq ? 512 : 128, hcol = (isq ? (u.pn * 4 + wc) : wc) * 64; const float osc = isq ? qscale : 1.0f;
            f32x4 gv[2][2];
#pragma unroll
            for (int bj = 0; bj < 2; ++bj)
#pragma unroll
                for (int n = 0; n < 2; ++n)
#pragma unroll
                    for (int i = 0; i < 4; ++i) { const int p = 32 * bj + 8 * fq + 4 * n + i; gv[bj][n][i] = g[(p >> 1) + 32 * (p & 1)]; }
#pragma unroll
            for (int ai = 0; ai < 2; ++ai)
#pragma unroll
                for (int m = 0; m < 4; ++m) { const int row = row0 + ai * HALF + m * 16, s = row & 4095; const float sc = rs[row];
                    f32x4 v[2][2]; float ss = 0.f;
#pragma unroll
                    for (int bj = 0; bj < 2; ++bj)
#pragma unroll
                        for (int n = 0; n < 2; ++n) { v[bj][n] = acc[ai][bj][m][n] * sc; ss += (v[bj][n][0] * v[bj][n][0] + v[bj][n][1] * v[bj][n][1]) + (v[bj][n][2] * v[bj][n][2] + v[bj][n][3] * v[bj][n][3]); }
                    ss += __shfl_xor(ss, 16); ss += __shfl_xor(ss, 32);
                    const float rstd = __builtin_amdgcn_rsqf(ss * (1.0f / 64.0f) + eps);
#pragma unroll
                    for (int bj = 0; bj < 2; ++bj) {
#pragma unroll
                        for (int n = 0; n < 2; ++n) { v[bj][n] = v[bj][n] * rstd * gv[bj][n];
                            const f32x4 t = *(const f32x4*)(tabg + ((size_t)s * 32 + 16 * bj + 4 * fq + 2 * n) * 2); rope2(v[bj][n], t); v[bj][n] = v[bj][n] * osc; }
                        *(u32x4*)(dst + (size_t)row * ld + hcol + 32 * bj + 8 * fq) = pack(v[bj][0], v[bj][1]); } }
        } else if (u.pn == 2) {
#pragma unroll
            for (int ai = 0; ai < 2; ++ai)
#pragma unroll
                for (int m = 0; m < 4; ++m) { const int row = row0 + ai * HALF + m * 16; const float sc = rs[row];
#pragma unroll
                    for (int bj = 0; bj < 2; ++bj) *(u32x4*)(VG + (size_t)row * 128 + (wc - 2) * 64 + 32 * bj + 8 * fq) = pack(acc[ai][bj][m][0] * sc, acc[ai][bj][m][1] * sc); }
        } else if (u.pn == 3) {
#pragma unroll
            for (int ai = 0; ai < 2; ++ai)
#pragma unroll
                for (int m = 0; m < 4; ++m) { const int row = row0 + ai * HALF + m * 16; const float sc = rs[row]; float ss = 0.f;
#pragma unroll
                    for (int bj = 0; bj < 2; ++bj) { const f32x4 a = acc[ai][bj][m][0] * sc, b = acc[ai][bj][m][1] * sc;
                        ss += ((a[0] * a[0] + a[1] * a[1]) + (a[2] * a[2] + a[3] * a[3])) + ((b[0] * b[0] + b[1] * b[1]) + (b[2] * b[2] + b[3] * b[3]));
                        *(u32x4*)(LAT + (size_t)row * 512 + 128 * bj + 32 * wc + 8 * fq) = pack(a, b); }
                    ss += __shfl_xor(ss, 16); ss += __shfl_xor(ss, 32);
                    if (fq == 0) SSL[(size_t)row * 8 + wc] = ss; }
        } else {
#pragma unroll
            for (int ai = 0; ai < 2; ++ai)
#pragma unroll
                for (int m = 0; m < 4; ++m) { const int row = row0 + ai * HALF + m * 16, s = row & 4095; const float sc = rs[row];
                    const f32x4 a = acc[ai][0][m][0] * sc, b = acc[ai][0][m][1] * sc;
                    float ss = ((a[0] * a[0] + a[1] * a[1]) + (a[2] * a[2] + a[3] * a[3])) + ((b[0] * b[0] + b[1] * b[1]) + (b[2] * b[2] + b[3] * b[3]));
                    *(u32x4*)(LAT + (size_t)row * 512 + 256 + 32 * wc + 8 * fq) = pack(a, b);
                    ss += __shfl_xor(ss, 16); ss += __shfl_xor(ss, 32);
                    if (fq == 0) SSL[(size_t)row * 8 + 4 + wc] = ss;
                    if (wc == 0) { f32x4 c = acc[ai][1][m][0] * sc, d = acc[ai][1][m][1] * sc;
                        rope2(c, *(const f32x4*)(tabm + ((size_t)s * 16 + 4 * fq) * 2)); rope2(d, *(const f32x4*)(tabm + ((size_t)s * 16 + 4 * fq + 2) * 2));
                        *(u32x4*)(KROPE + (size_t)row * 32 + 8 * fq) = pack(c, d); } }
        }
    }
};
struct EpiSwiGLU {
    static constexpr bool PERM = true;
    bf16_t* O; int ldc; const float* rs;
    __device__ __forceinline__ static float silu_mul(float g, float u) { return g * u * __builtin_amdgcn_rcpf(1.0f + __builtin_amdgcn_exp2f(-1.4426950408889634f * g)); }
    __device__ __forceinline__ void operator()(const f32x4 (&acc)[2][2][4][2], const Unit& u, int wr, int wc, int fr, int fq) const {
        const int row0 = u.pm * BM + wr * 64 + fr, col0 = u.pn * HALF + wc * 32 + 8 * fq;
#pragma unroll
        for (int ai = 0; ai < 2; ++ai)
#pragma unroll
            for (int m = 0; m < 4; ++m) { const int row = row0 + ai * HALF + m * 16; bf16_t* rowp = O + (size_t)row * ldc + col0; const float sc = rs[row];
                const f32x4 g0 = acc[ai][0][m][0] * sc, g1 = acc[ai][0][m][1] * sc, u0 = acc[ai][1][m][0] * sc, u1 = acc[ai][1][m][1] * sc;
                u32x4 w; w.x = cvt_pk_bf16(silu_mul(g0[0], u0[0]), silu_mul(g0[1], u0[1])); w.y = cvt_pk_bf16(silu_mul(g0[2], u0[2]), silu_mul(g0[3], u0[3]));
                w.z = cvt_pk_bf16(silu_mul(g1[0], u1[0]), silu_mul(g1[1], u1[1])); w.w = cvt_pk_bf16(silu_mul(g1[2], u1[2]), silu_mul(g1[3], u1[3]));
                *(u32x4*)rowp = w; }
    }
};

template <class Epi, class Sched, bool ALIGN_EPI = false, bool GATHER = false, bool MIDSCALE = false>
__device__ __forceinline__ void gemm_phase(PG8_LAS unsigned char* lds, const Gemm g, const Sched& S, const Epi& E, PG8_LAS unsigned char* gtab = nullptr, float ms_inv_n = 0.f, float ms_eps = 0.f) {
    int tid_ = threadIdx.x; asm volatile("" : "+v"(tid_));
    const int tid = tid_, wid = __builtin_amdgcn_readfirstlane(tid >> 6), lane = tid & 63, wr = wid >> 2, wc = wid & 3, fr = lane & 15, fq = lane >> 4;
    const int K = g.K, nt = K / BK;
    unsigned voffA[2], voffB[2]; int gR[2], gC[2];
#pragma unroll
    for (int i = 0; i < 2; ++i) { int R, C; stage_rc(tid * 16 + i * 8192, R, C); const int Rb = Epi::PERM ? ((R & ~31) + perm32(R & 31)) : R; gR[i] = R; gC[i] = C;
        voffA[i] = (unsigned)(R * g.lda + C) * 2u; voffB[i] = (unsigned)(Rb * g.ldb + C) * 2u; }
    unsigned goffc[2][2], goffn[2][2];
#define PG8_GISSUE(u) do { _Pragma("unroll") for (int h_ = 0; h_ < 2; ++h_) _Pragma("unroll") for (int i_ = 0; i_ < 2; ++i_) \
        __builtin_amdgcn_global_load_lds((const unsigned*)(g.idx + (u).pm * BM + h_ * HALF + gR[i_]), (PG8_LAS unsigned*)(gtab + ((h_ * 2 + i_) * 8 + wid) * 256), 4, 0, 0); } while (0)
#define PG8_GREAD(dst, u) do { asm volatile("" ::: "memory"); _Pragma("unroll") for (int h_ = 0; h_ < 2; ++h_) _Pragma("unroll") for (int i_ = 0; i_ < 2; ++i_) { \
        const int tok_ = *(const PG8_LAS int*)(gtab + ((h_ * 2 + i_) * 8 + wid) * 256 + lane * 4); \
        dst[h_][i_] = (unsigned)(((((u).pm >> 1) & 7) * 4096 + tok_) * g.lda + gC[i_]) * 2u; } } while (0)
    const size_t kstep = (size_t)(BK * 2);
    const size_t hstepA = (size_t)HALF * g.lda * 2, hstepB = (size_t)HALF * g.ldb * 2;
    const size_t tstepA = 2 * hstepA, tstepB = 2 * hstepB;
    const unsigned ldsw = (unsigned)wid * 1024u;
    const int aoff = lds_byte(wr * 64 + fr, fq * 8), boff = lds_byte(wc * 32 + fr, fq * 8);
#define PG8_SA(b, h) (((b) * 2 + (h)) * HTB)
#define PG8_SB(b, h) ((4 + (b) * 2 + (h)) * HTB)
#define PG8_STAGE(bufoff, gbase, voff) do { _Pragma("unroll") for (int _i = 0; _i < 2; ++_i) \
        __builtin_amdgcn_global_load_lds((const unsigned*)((const char*)(gbase) + (voff)[_i]), (PG8_LAS unsigned*)(lds + (bufoff) + ldsw + _i * 8192), 16, 0, 0); } while (0)
#define PG8_LDA(dst, b, h) do { _Pragma("unroll") for (int m = 0; m < 4; ++m) _Pragma("unroll") for (int k = 0; k < 2; ++k) dst[m][k] = *(const PG8_LAS bf16x8*)(lds + PG8_SA(b, h) + aoff + m * 2048 + k * 1024); } while (0)
#define PG8_LDB(dst, b, h) do { _Pragma("unroll") for (int n = 0; n < 2; ++n) _Pragma("unroll") for (int k = 0; k < 2; ++k) dst[n][k] = *(const PG8_LAS bf16x8*)(lds + PG8_SB(b, h) + boff + n * 2048 + k * 1024); } while (0)
#define PG8_MMA(ai, bj, At, Bt) do { __builtin_amdgcn_s_setprio(1); _Pragma("unroll") for (int m = 0; m < 4; ++m) _Pragma("unroll") for (int n = 0; n < 2; ++n) _Pragma("unroll") for (int k = 0; k < 2; ++k) \
        acc[ai][bj][m][n] = __builtin_amdgcn_mfma_f32_16x16x32_bf16(Bt[n][k], At[m][k], acc[ai][bj][m][n], 0, 0, 0); __builtin_amdgcn_s_setprio(0); } while (0)
#define PG8_WAIT_V(n) asm volatile("s_waitcnt vmcnt(" #n ")" ::: "memory")
#define PG8_WAIT_L(n) asm volatile("s_waitcnt lgkmcnt(" #n ")" ::: "memory")
#define PG8_BAR __builtin_amdgcn_s_barrier()
#define PG8_SCHED __builtin_amdgcn_sched_barrier(0)
#define PG8_ABASE(u) (GATHER ? (const char*)g.A : (const char*)g.A + (size_t)((u).pm % g.amod) * tstepA)
#define PG8_STA(bufoff, kptr, h, nx) do { if constexpr (GATHER) { unsigned o_[2]; o_[0] = (nx) ? goffn[h][0] : goffc[h][0]; o_[1] = (nx) ? goffn[h][1] : goffc[h][1]; PG8_STAGE(bufoff, kptr, o_); } \
        else { PG8_STAGE(bufoff, (kptr) + (h) * hstepA, voffA); } } while (0)
#define PG8_BBASE(u) ((const char*)g.Bt + ((size_t)((u).pm / g.gdiv) * g.gstride) * 2 + (size_t)(u).pn * tstepB)
    Unit cur, nxt; int ui = 0;
    if (!S.next(0, cur)) return;
    f32x4 acc[2][2][4][2];
#pragma unroll
    for (int a = 0; a < 2; ++a)
#pragma unroll
        for (int b = 0; b < 2; ++b)
#pragma unroll
            for (int m = 0; m < 4; ++m)
#pragma unroll
                for (int n = 0; n < 2; ++n) acc[a][b][m][n] = (f32x4){0.f, 0.f, 0.f, 0.f};
    bf16x8 At[4][2], B0[2][2], B1[2][2];
    const char* cA = PG8_ABASE(cur); const char* cB = PG8_BBASE(cur);
    if constexpr (GATHER) { PG8_GISSUE(cur); PG8_WAIT_V(0); PG8_GREAD(goffc, cur);
#pragma unroll
        for (int h_ = 0; h_ < 2; ++h_) { goffn[h_][0] = goffc[h_][0]; goffn[h_][1] = goffc[h_][1]; } }
    PG8_STAGE(PG8_SB(0, 0), cB, voffB); PG8_STAGE(PG8_SB(0, 1), cB + hstepB, voffB); PG8_STA(PG8_SA(0, 0), cA, 0, false); PG8_STA(PG8_SA(0, 1), cA, 1, false);
    if (wr == 1) PG8_BAR;
    PG8_WAIT_V(2); PG8_BAR;
    PG8_STAGE(PG8_SB(1, 0), cB + kstep, voffB); PG8_STA(PG8_SA(1, 0), cA + kstep, 0, false); PG8_STAGE(PG8_SB(1, 1), cB + hstepB + kstep, voffB);
    PG8_WAIT_V(6); PG8_BAR;
    for (;;) {
        const bool has_next = S.next(ui + 1, nxt);
        const char* nA = has_next ? PG8_ABASE(nxt) : cA; const char* nB = has_next ? PG8_BBASE(nxt) : cB;
        if constexpr (GATHER) { if (has_next) PG8_GISSUE(nxt); }
        if constexpr (MIDSCALE) {
#pragma unroll
            for (int q_ = 0; q_ < 2; ++q_) __builtin_amdgcn_global_load_lds((const unsigned*)(g.ss + (size_t)cur.pm * 1024 + q_ * 512 + wid * 64 + lane), (PG8_LAS unsigned*)(gtab + (ui & 1) * 4096 + q_ * 2048 + wid * 256), 4, 0, 0); }
#pragma nounroll
        for (int t = 0; t < nt; t += 2) {
            const bool last = (t == nt - 2);
            const char* a1 = cA + (size_t)(t + 1) * kstep;
            const char* a2 = last ? nA : cA + (size_t)(t + 2) * kstep; const char* b2 = last ? nB : cB + (size_t)(t + 2) * kstep;
            const char* a3 = a2 + kstep; const char* b3 = b2 + kstep;
            if constexpr (GATHER) { if (last && has_next) PG8_GREAD(goffn, nxt); }
            if constexpr (MIDSCALE) { if (t == nt / 2) { asm volatile("" ::: "memory"); const PG8_LAS float* tab = (const PG8_LAS float*)(gtab + (ui & 1) * 4096);
#pragma unroll
                for (int ai = 0; ai < 2; ++ai)
#pragma unroll
                    for (int m = 0; m < 4; ++m) { const int rl = ai * HALF + wr * 64 + m * 16 + fr; const float sg = tab[rl * 4] + tab[rl * 4 + 1], sm = tab[rl * 4 + 2] + tab[rl * 4 + 3];
                        const float ratio = __builtin_amdgcn_rsqf(sg * ms_inv_n + ms_eps) * __builtin_amdgcn_rcpf(__builtin_amdgcn_rsqf(sm * ms_inv_n + ms_eps));
#pragma unroll
                        for (int bj = 0; bj < 2; ++bj)
#pragma unroll
                            for (int n = 0; n < 2; ++n) acc[ai][bj][m][n] = acc[ai][bj][m][n] * ratio; } } }
            PG8_LDB(B0, 0, 0); PG8_LDB(B1, 0, 1); PG8_SCHED; PG8_LDA(At, 0, 0); PG8_STA(PG8_SA(1, 1), a1, 1, false);
            PG8_WAIT_V(8); PG8_WAIT_L(0); PG8_BAR; PG8_MMA(0, 0, At, B0); PG8_MMA(0, 1, At, B1); PG8_BAR; PG8_SCHED;
            PG8_LDA(At, 0, 1); PG8_STAGE(PG8_SB(0, 0), b2, voffB); PG8_STAGE(PG8_SB(0, 1), b2 + hstepB, voffB); PG8_STA(PG8_SA(0, 0), a2, 0, last);
            PG8_WAIT_V(8); PG8_WAIT_L(0); PG8_BAR; PG8_MMA(1, 0, At, B0); PG8_MMA(1, 1, At, B1); PG8_BAR; PG8_SCHED;
            PG8_LDB(B0, 1, 0); PG8_LDB(B1, 1, 1); PG8_SCHED; PG8_LDA(At, 1, 0); PG8_STA(PG8_SA(0, 1), a2, 1, last);
            PG8_WAIT_V(8); PG8_WAIT_L(0); PG8_BAR; PG8_MMA(0, 0, At, B0); PG8_MMA(0, 1, At, B1); PG8_BAR; PG8_SCHED;
            PG8_LDA(At, 1, 1); PG8_STAGE(PG8_SB(1, 0), b3, voffB); PG8_STAGE(PG8_SB(1, 1), b3 + hstepB, voffB); PG8_STA(PG8_SA(1, 0), a3, 0, last);
            PG8_WAIT_V(8); PG8_WAIT_L(0); PG8_BAR; PG8_MMA(1, 0, At, B0); PG8_MMA(1, 1, At, B1); PG8_BAR; PG8_SCHED;
        }
        if constexpr (ALIGN_EPI) { if (wr == 0) PG8_BAR; }
        if constexpr (MIDSCALE) E(acc, cur, wr, wc, fr, fq, (const PG8_LAS float*)(gtab + (ui & 1) * 4096)); else E(acc, cur, wr, wc, fr, fq);
        if (!has_next) break;
#pragma unroll
        for (int a = 0; a < 2; ++a)
#pragma unroll
            for (int b = 0; b < 2; ++b)
#pragma unroll
                for (int m = 0; m < 4; ++m)
#pragma unroll
                    for (int n = 0; n < 2; ++n) acc[a][b][m][n] = (f32x4){0.f, 0.f, 0.f, 0.f};
        cur = nxt; cA = nA; cB = nB; ++ui;
        if constexpr (GATHER) {
#pragma unroll
            for (int h_ = 0; h_ < 2; ++h_) { goffc[h_][0] = goffn[h_][0]; goffc[h_][1] = goffn[h_][1]; } }
        if constexpr (ALIGN_EPI) { if (wr == 1) PG8_BAR; }
    }
    PG8_WAIT_V(0);
    if constexpr (!ALIGN_EPI) { if (wr == 0) PG8_BAR; }
    PG8_BAR;
#undef PG8_SA
#undef PG8_SB
#undef PG8_STAGE
#undef PG8_LDA
#undef PG8_LDB
#undef PG8_MMA
#undef PG8_WAIT_V
#undef PG8_WAIT_L
#undef PG8_BAR
#undef PG8_SCHED
#undef PG8_ABASE
#undef PG8_STA
#undef PG8_GISSUE
#undef PG8_GREAD
#undef PG8_BBASE
}
}
namespace att {
typedef unsigned short bf16;
using bf16x8 = __attribute__((ext_vector_type(8))) short;
using s16x4  = __attribute__((ext_vector_type(4))) short;
using f32x16 = __attribute__((ext_vector_type(16))) float;
using u32x4  = __attribute__((ext_vector_type(4))) unsigned;
#define ATT_SBAR() __builtin_amdgcn_sched_barrier(0)
constexpr int KCH = 1040;
constexpr float THR = 8.0f;
__device__ __forceinline__ int crow(int r, int hi) { return (r & 3) + 8 * (r >> 2) + 4 * hi; }
__device__ __forceinline__ unsigned cvtpk(float lo, float hi) { unsigned r; asm volatile("v_cvt_pk_bf16_f32 %0, %1, %2" : "=v"(r) : "v"(lo), "v"(hi)); return r; }
typedef float f32x2_t __attribute__((ext_vector_type(2))); typedef __bf16 bf16x2_t __attribute__((ext_vector_type(2)));
__device__ __forceinline__ unsigned cvtpk_c(float lo, float hi) { const f32x2_t v = {lo, hi}; const bf16x2_t b = __builtin_convertvector(v, bf16x2_t); return __builtin_bit_cast(unsigned, b); }
__device__ __forceinline__ unsigned short f2bf1(float f) { unsigned u = __builtin_bit_cast(unsigned, f); return (unsigned short)((u + 0x7fffu + ((u >> 16) & 1u)) >> 16); }

#define ATT_MX3(a, b, c) __builtin_fmaxf(__builtin_fmaxf((a), (b)), (c))
template <int MODE, bool FIRST>
__device__ __forceinline__ void partialSM(f32x16& p0, f32x16& p1, float& m_run, f32x16& negm, float& alpha) {
  if constexpr (MODE == 0) {
    float a = ATT_MX3(p0[0], p0[1], p1[0]), b = ATT_MX3(p0[2], p0[3], p1[1]); a = ATT_MX3(a, p1[2], p1[3]);
#pragma unroll
    for (int r = 4; r < 16; r += 4) { a = ATT_MX3(a, p0[r], p0[r + 1]); b = ATT_MX3(b, p0[r + 2], p0[r + 3]); a = ATT_MX3(a, p1[r], p1[r + 1]); b = ATT_MX3(b, p1[r + 2], p1[r + 3]); }
    float pmax = fmaxf(a, b);
    { auto rr = __builtin_amdgcn_permlane32_swap(__float_as_uint(pmax), __float_as_uint(pmax), false, false);
      pmax = fmaxf(__uint_as_float(rr[0]), __uint_as_float(rr[1])); }
    alpha = 1.f;
    if (FIRST || __builtin_expect(__any(pmax > THR), 0)) {
      const float dl = FIRST ? pmax : fmaxf(pmax, 0.f);
      m_run += dl;
#pragma unroll
      for (int r = 0; r < 16; ++r) { p0[r] -= dl; p1[r] -= dl; }
#pragma unroll
      for (int r = 0; r < 16; ++r) negm[r] = -m_run;
      asm volatile("" : "+v"(negm));
      alpha = FIRST ? 1.f : __builtin_amdgcn_exp2f(-dl);
    }
  } else { alpha = 1.f; }
#pragma unroll
  for (int r = 0; r < 16; ++r) p0[r] = __builtin_amdgcn_exp2f(p0[r]);
}
__device__ __forceinline__ void finishSM(f32x16& p0, f32x16& p1, float alpha, float& l_reg, bf16x8& pa0, bf16x8& pa1, bf16x8& pa2, bf16x8& pa3) {
#pragma unroll
  for (int r = 0; r < 16; ++r) p1[r] = __builtin_amdgcn_exp2f(p1[r]);
  float ps = 0;
#pragma unroll
  for (int r = 0; r < 16; ++r) ps += p0[r];
#pragma unroll
  for (int r = 0; r < 16; ++r) ps += p1[r];
  { auto rr = __builtin_amdgcn_permlane32_swap(__float_as_uint(ps), __float_as_uint(ps), false, false);
    ps = __uint_as_float(rr[0]) + __uint_as_float(rr[1]); }
  l_reg = l_reg * alpha + ps;
#define ATT_PK4(P, BASE, OUT) do { const u32x4 w = {cvtpk_c(P[BASE + 0], P[BASE + 1]), cvtpk_c(P[BASE + 2], P[BASE + 3]), cvtpk_c(P[BASE + 4], P[BASE + 5]), cvtpk_c(P[BASE + 6], P[BASE + 7])}; \
    OUT = __builtin_bit_cast(bf16x8, w); } while (0)
  ATT_PK4(p0, 0, pa0); ATT_PK4(p0, 8, pa1); ATT_PK4(p1, 0, pa2); ATT_PK4(p1, 8, pa3);
#undef ATT_PK4
}
template <int ND0, int MODE = 0>
__device__ __forceinline__ void qkt(f32x16& p0, f32x16& p1, const char* Ks, const bf16x8* qr, const f32x16& negm, int r32, int hi) {
#pragma unroll
  for (int d0 = 0; d0 < ND0; ++d0) {
    const char* kb = Ks + (2 * d0 + hi) * KCH + r32 * 16;
    bf16x8 b0 = *reinterpret_cast<const bf16x8*>(kb);
    bf16x8 b1 = *reinterpret_cast<const bf16x8*>(kb + 512);
    if (d0 == 0) { if constexpr (MODE == 1) { p0 = __builtin_amdgcn_mfma_f32_32x32x16_bf16(b0, qr[0], f32x16{}, 0, 0, 0); p1 = __builtin_amdgcn_mfma_f32_32x32x16_bf16(b1, qr[0], f32x16{}, 0, 0, 0); }
                   else { p0 = __builtin_amdgcn_mfma_f32_32x32x16_bf16(b0, qr[0], negm, 0, 0, 0); p1 = __builtin_amdgcn_mfma_f32_32x32x16_bf16(b1, qr[0], negm, 0, 0, 0); } }
    else { p0 = __builtin_amdgcn_mfma_f32_32x32x16_bf16(b0, qr[d0], p0, 0, 0, 0); p1 = __builtin_amdgcn_mfma_f32_32x32x16_bf16(b1, qr[d0], p1, 0, 0, 0); } }
}
template <int NB> __device__ __forceinline__ int v_st(int k, int c) { const int kk = k; return ((kk >> 3) * NB + (c >> 5)) * 512 + ((kk & 7) * 32 + (c & 31)) * 2; }
__device__ __forceinline__ int v_rd_base(int lane) { return ((lane & 3) << 3) | (((lane >> 2) & 3) << 6) | (((lane >> 4) & 1) << 5) | (((lane >> 5) & 1) << 8); }
template <int OFF> __device__ __forceinline__ s16x4 tr_read(int vb) {
  s16x4 r; asm volatile("ds_read_b64_tr_b16 %0, %1 offset:%2" : "=&v"(r) : "v"(vb), "i"(OFF) : "memory"); return r;
}
template <int NB, int D0> __device__ __forceinline__ void pv_one(f32x16& od, int vb, bf16x8 pa0, bf16x8 pa1, bf16x8 pa2, bf16x8 pa3) {
#define ATT_VO(ks, half) (D0 * 512 + (2 * (ks) + (half)) * NB * 512)
  const s16x4 l0 = tr_read<ATT_VO(0, 0)>(vb), h0 = tr_read<ATT_VO(0, 1)>(vb), l1 = tr_read<ATT_VO(1, 0)>(vb), h1 = tr_read<ATT_VO(1, 1)>(vb);
  const s16x4 l2 = tr_read<ATT_VO(2, 0)>(vb), h2 = tr_read<ATT_VO(2, 1)>(vb), l3 = tr_read<ATT_VO(3, 0)>(vb), h3 = tr_read<ATT_VO(3, 1)>(vb);
#undef ATT_VO
  asm volatile("s_waitcnt lgkmcnt(0)" ::: "memory"); ATT_SBAR();
#define ATT_PK(L, H) (bf16x8){L[0], L[1], L[2], L[3], H[0], H[1], H[2], H[3]}
  od = __builtin_amdgcn_mfma_f32_32x32x16_bf16(pa0, ATT_PK(l0, h0), od, 0, 0, 0);
  od = __builtin_amdgcn_mfma_f32_32x32x16_bf16(pa1, ATT_PK(l1, h1), od, 0, 0, 0);
  od = __builtin_amdgcn_mfma_f32_32x32x16_bf16(pa2, ATT_PK(l2, h2), od, 0, 0, 0);
  od = __builtin_amdgcn_mfma_f32_32x32x16_bf16(pa3, ATT_PK(l3, h3), od, 0, 0, 0);
#undef ATT_PK
}
template <int NB> __device__ __forceinline__ void pv_all(f32x16* o, int vb, bf16x8 pa0, bf16x8 pa1, bf16x8 pa2, bf16x8 pa3) {
  if constexpr (NB == 2) {
#define ATT_VO(d0, ks, half) ((d0) * 512 + (2 * (ks) + (half)) * NB * 512)
    const s16x4 l0 = tr_read<ATT_VO(0, 0, 0)>(vb), h0 = tr_read<ATT_VO(0, 0, 1)>(vb), l1 = tr_read<ATT_VO(0, 1, 0)>(vb), h1 = tr_read<ATT_VO(0, 1, 1)>(vb);
    const s16x4 l2 = tr_read<ATT_VO(0, 2, 0)>(vb), h2 = tr_read<ATT_VO(0, 2, 1)>(vb), l3 = tr_read<ATT_VO(0, 3, 0)>(vb), h3 = tr_read<ATT_VO(0, 3, 1)>(vb);
    const s16x4 m0 = tr_read<ATT_VO(1, 0, 0)>(vb), n0 = tr_read<ATT_VO(1, 0, 1)>(vb), m1 = tr_read<ATT_VO(1, 1, 0)>(vb), n1 = tr_read<ATT_VO(1, 1, 1)>(vb);
    const s16x4 m2 = tr_read<ATT_VO(1, 2, 0)>(vb), n2 = tr_read<ATT_VO(1, 2, 1)>(vb), m3 = tr_read<ATT_VO(1, 3, 0)>(vb), n3 = tr_read<ATT_VO(1, 3, 1)>(vb);
#undef ATT_VO
#define ATT_PK(L, H) (bf16x8){L[0], L[1], L[2], L[3], H[0], H[1], H[2], H[3]}
    asm volatile("s_waitcnt lgkmcnt(8)" ::: "memory"); ATT_SBAR();
    o[0] = __builtin_amdgcn_mfma_f32_32x32x16_bf16(pa0, ATT_PK(l0, h0), o[0], 0, 0, 0);
    o[0] = __builtin_amdgcn_mfma_f32_32x32x16_bf16(pa1, ATT_PK(l1, h1), o[0], 0, 0, 0);
    o[0] = __builtin_amdgcn_mfma_f32_32x32x16_bf16(pa2, ATT_PK(l2, h2), o[0], 0, 0, 0);
    o[0] = __builtin_amdgcn_mfma_f32_32x32x16_bf16(pa3, ATT_PK(l3, h3), o[0], 0, 0, 0);
    asm volatile("s_waitcnt lgkmcnt(0)" ::: "memory"); ATT_SBAR();
    o[1] = __builtin_amdgcn_mfma_f32_32x32x16_bf16(pa0, ATT_PK(m0, n0), o[1], 0, 0, 0);
    o[1] = __builtin_amdgcn_mfma_f32_32x32x16_bf16(pa1, ATT_PK(m1, n1), o[1], 0, 0, 0);
    o[1] = __builtin_amdgcn_mfma_f32_32x32x16_bf16(pa2, ATT_PK(m2, n2), o[1], 0, 0, 0);
    o[1] = __builtin_amdgcn_mfma_f32_32x32x16_bf16(pa3, ATT_PK(m3, n3), o[1], 0, 0, 0);
#undef ATT_PK
  } else {
    pv_one<NB, 0>(o[0], vb, pa0, pa1, pa2, pa3); pv_one<NB, 1>(o[1], vb, pa0, pa1, pa2, pa3);
    pv_one<NB, 2>(o[2], vb, pa0, pa1, pa2, pa3); pv_one<NB, 3>(o[3], vb, pa0, pa1, pa2, pa3);
  }
}

template <int W1, int W2, int DV> struct AttnCfg {
  static constexpr int DQK = W1 + W2, NCH = DQK / 8, ND0 = DQK / 16, NB = DV / 32;
  static constexpr int KT_BYTES = NCH * KCH, VT_BYTES = 64 * DV * 2;
  static constexpr int OST_BYTES = 32 * DV * 2;
  static constexpr bool OSTAGE = (DV == 64);
  static constexpr int LDS_BYTES = 3 * VT_BYTES + 3 * KT_BYTES + 8 * 64 * 4 + (OSTAGE ? 8 * OST_BYTES : 0);
  static constexpr int CW1 = W1 / 8, N1 = (64 * CW1) / 512;
  static constexpr int CWV = DV / 8, NV = (64 * CWV) / 512;
  static_assert(W1 == 64 || W1 == 128, "W1"); static_assert(W2 == 0 || W2 == 32, "W2"); static_assert(DV == 64 || DV == 128, "DV");
};

template <int W1, int W2, int DV, int MODE, bool SSQ>
__device__ __forceinline__ void attn_unit(const bf16* __restrict__ Qb, const bf16* __restrict__ Qb2, int ldq, const bf16* __restrict__ K1, int ldk1, const bf16* __restrict__ K2, int ldk2,
                                          const bf16* __restrict__ Vh, int ldv, bf16* __restrict__ Ob, int ldo, int nkeys, char* lds, float (&ssacc)[16]) {
  using C = AttnCfg<W1, W2, DV>;
  constexpr int ND0 = C::ND0, NB = C::NB, N1 = C::N1, NV = C::NV, CW1 = C::CW1, CWV = C::CWV;
  constexpr int SHM_V = C::VT_BYTES, SHM_K = C::KT_BYTES;
  int tid_ = threadIdx.x; asm volatile("" : "+v"(tid_));
  const int tid = tid_, wid = tid >> 6, lane = tid & 63, r32 = lane & 31, hi = lane >> 5;
  char* V_lds = lds; char* K_lds = lds + 3 * SHM_V;
  float* ws = (float*)(lds + 3 * SHM_V + 3 * SHM_K) + wid * 64; float* li_l = ws; float* al_l = ws + 32;
  float m_reg = 0.f, l_reg = 0; f32x16 o[NB]; bf16x8 qr[ND0]; f32x16 negm = f32x16{}; if constexpr (MODE == 0) asm volatile("" : "+v"(negm));
#pragma unroll
  for (int d = 0; d < NB; ++d) o[d] = f32x16{};
  const bf16* Qw = Qb + (long)(wid * 32 + r32) * ldq + hi * 8;
#pragma unroll
  for (int d0 = 0; d0 < W1 / 16; ++d0) qr[d0] = *reinterpret_cast<const bf16x8*>(Qw + d0 * 16);
  if constexpr (W2 > 0) { const bf16* Qw2 = Qb2 + (long)(wid * 32 + r32) * ldq + hi * 8;
#pragma unroll
    for (int d0 = 0; d0 < W2 / 16; ++d0) qr[W1 / 16 + d0] = *reinterpret_cast<const bf16x8*>(Qw2 + d0 * 16); }
  int k1row[N1], k1col[N1], k1lds[N1], vrow[NV], vcol[NV], vlds[NV];
#pragma unroll
  for (int i = 0; i < N1; ++i) { const int p = tid + 512 * i; k1row[i] = p / CW1; k1col[i] = (p % CW1) * 8; k1lds[i] = (p % CW1) * KCH + (p / CW1) * 16; }
#pragma unroll
  for (int i = 0; i < NV; ++i) { const int p = tid + 512 * i; vrow[i] = p / CWV; vcol[i] = (p % CWV) * 8; vlds[i] = v_st<NB>(p / CWV, (p % CWV) * 8); }
  const int k2row = tid >> 2, k2col = (tid & 3) * 8, k2lds = (CW1 + (tid & 3)) * KCH + (tid >> 2) * 16; const bool k2on = (W2 > 0) && (tid < 256);
  const int vb0 = (int)(uintptr_t)V_lds + v_rd_base(lane);
  struct Slot { bf16x8 k1[N1]; bf16x8 k2; bf16x8 v[NV]; } sr_[2];
#define ATT_SLOAD(i, k0) do { _Pragma("unroll") for (int _j = 0; _j < N1; ++_j) sr_[i].k1[_j] = *reinterpret_cast<const bf16x8*>(&K1[(long)((k0) + k1row[_j]) * ldk1 + k1col[_j]]); \
    if constexpr (W2 > 0) { if (k2on) sr_[i].k2 = *reinterpret_cast<const bf16x8*>(&K2[(long)((k0) + k2row) * ldk2 + k2col]); } \
    _Pragma("unroll") for (int _j = 0; _j < NV; ++_j) sr_[i].v[_j] = *reinterpret_cast<const bf16x8*>(&Vh[(long)((k0) + vrow[_j]) * ldv + vcol[_j]]); } while (0)
#define ATT_SWRITE(b, i) do { _Pragma("unroll") for (int _j = 0; _j < NV; ++_j) *(bf16x8*)(V_lds + (b) * SHM_V + vlds[_j]) = sr_[i].v[_j]; \
    _Pragma("unroll") for (int _j = 0; _j < N1; ++_j) *(bf16x8*)(K_lds + (b) * SHM_K + k1lds[_j]) = sr_[i].k1[_j]; \
    if constexpr (W2 > 0) { if (k2on) *(bf16x8*)(K_lds + (b) * SHM_K + k2lds) = sr_[i].k2; } } while (0)
#define ATT_SWAIT() asm volatile("s_waitcnt vmcnt(%0)" :: "n"(N1 + NV) : "memory")
#define ATT_RESC(a) do { if (MODE == 0 && __any((a) != 1.f)) { if (hi == 0) al_l[r32] = (a); asm volatile("s_waitcnt lgkmcnt(0)" ::: "memory"); \
    _Pragma("unroll") for (int d = 0; d < NB; ++d) _Pragma("unroll") for (int r = 0; r < 16; ++r) o[d][r] *= al_l[crow(r, hi)]; } } while (0)
  f32x16 pA0, pA1, pB0, pB1; float alA, alB; bf16x8 pa0, pa1, pa2, pa3; const int NT = nkeys / 64;
  ATT_SLOAD(0, 0); asm volatile("s_waitcnt vmcnt(0)" ::: "memory"); ATT_SWRITE(0, 0); __syncthreads();
  qkt<ND0, MODE>(pA0, pA1, K_lds, qr, negm, r32, hi); partialSM<MODE, true>(pA0, pA1, m_reg, negm, alA);
  ATT_SLOAD(1, 64); if (2 < NT) ATT_SLOAD(0, 128);
  ATT_SWAIT(); ATT_SWRITE(1, 1); __syncthreads();
  int bp = 0, bc = 1, bn = 2;
  if (wid >= 4) __builtin_amdgcn_s_setprio(1);
#define ATT_ROT() do { const int t_ = bp; bp = bc; bc = bn; bn = t_; } while (0)
  for (int j = 1; j + 1 < NT; j += 2) {
    ATT_SBAR(); qkt<ND0, MODE>(pB0, pB1, K_lds + bc * SHM_K, qr, negm, r32, hi);
    finishSM(pA0, pA1, alA, l_reg, pa0, pa1, pa2, pa3); ATT_SBAR();
    ATT_SLOAD(1, (j + 2) * 64); ATT_SBAR();
    pv_all<NB>(o, vb0 + bp * SHM_V, pa0, pa1, pa2, pa3); partialSM<MODE, false>(pB0, pB1, m_reg, negm, alB);
    ATT_SWAIT(); ATT_SWRITE(bn, 0);
    ATT_RESC(alB); __syncthreads(); ATT_ROT();
    ATT_SBAR(); qkt<ND0, MODE>(pA0, pA1, K_lds + bc * SHM_K, qr, negm, r32, hi);
    finishSM(pB0, pB1, alB, l_reg, pa0, pa1, pa2, pa3); ATT_SBAR();
    if (j + 3 < NT) ATT_SLOAD(0, (j + 3) * 64); ATT_SBAR();
    pv_all<NB>(o, vb0 + bp * SHM_V, pa0, pa1, pa2, pa3); partialSM<MODE, false>(pA0, pA1, m_reg, negm, alA);
    ATT_SWAIT(); ATT_SWRITE(bn, 1);
    ATT_RESC(alA); __syncthreads(); ATT_ROT();
  }
  ATT_SBAR(); qkt<ND0, MODE>(pB0, pB1, K_lds + bc * SHM_K, qr, negm, r32, hi);
  finishSM(pA0, pA1, alA, l_reg, pa0, pa1, pa2, pa3); ATT_SBAR();
  pv_all<NB>(o, vb0 + bp * SHM_V, pa0, pa1, pa2, pa3); partialSM<MODE, false>(pB0, pB1, m_reg, negm, alB);
  ATT_RESC(alB);
  finishSM(pB0, pB1, alB, l_reg, pa0, pa1, pa2, pa3); ATT_SBAR();
  pv_all<NB>(o, vb0 + bc * SHM_V, pa0, pa1, pa2, pa3);
#undef ATT_ROT
  __builtin_amdgcn_s_setprio(0);
  if (hi == 0) li_l[r32] = l_reg; asm volatile("s_waitcnt lgkmcnt(0)" ::: "memory");
  float rli[16];
#pragma unroll
  for (int r = 0; r < 16; ++r) rli[r] = __builtin_amdgcn_rcpf(li_l[crow(r, hi)]);
  bf16* Ow = Ob + (long)(wid * 32) * ldo;
  if constexpr (C::OSTAGE) { unsigned short* stg = (unsigned short*)(lds + 3 * SHM_V + 3 * SHM_K + 8 * 64 * 4 + wid * C::OST_BYTES);
#pragma unroll
    for (int r = 0; r < 16; ++r) { const int orow = crow(r, hi);
#pragma unroll
      for (int d0 = 0; d0 < NB; ++d0) stg[orow * DV + d0 * 32 + r32] = f2bf1(o[d0][r] * rli[r]); }
    asm volatile("s_waitcnt lgkmcnt(0)" ::: "memory");
    constexpr int CPR = DV / 8;
#pragma unroll
    for (int i = 0; i < (32 * CPR) / 64; ++i) { const int p = i * 64 + lane, row = p / CPR, ch = p % CPR;
      const u32x4 v = *(const u32x4*)(stg + row * DV + ch * 8); *(u32x4*)(Ow + (long)row * ldo + ch * 8) = v; } }
  else {
#pragma unroll
    for (int r = 0; r < 16; ++r) { const int orow = crow(r, hi);
#pragma unroll
      for (int d0 = 0; d0 < NB; ++d0) Ow[(long)orow * ldo + d0 * 32 + r32] = f2bf1(o[d0][r] * rli[r]); } }
  if constexpr (SSQ) {
#pragma unroll
    for (int r = 0; r < 16; ++r) {
#pragma unroll
      for (int d0 = 0; d0 < NB; ++d0) { const float v = o[d0][r] * rli[r]; ssacc[r] += v * v; } } }
  __syncthreads();
#undef ATT_SLOAD
#undef ATT_SWRITE
#undef ATT_SWAIT
#undef ATT_RESC
}
#undef ATT_SBAR
}
constexpr int NWAVES = 8;
#ifndef MK_N_LAUNCHES
#define MK_N_LAUNCHES 1
#endif
constexpr int BATCH = 8, SEQ = 4096, DM = 1024, DEPTH = 4, MTOK = BATCH * SEQ;
constexpr int IN_W = 1184, IN_WP = 1280;
constexpr int MEM_T = 256, MROWS = BATCH * MEM_T;
constexpr int NEXP = 16, CAP = 512, EFF = 512, MOE_ROWS = NEXP * BATCH * CAP;
constexpr float EPS = 1e-6f, LOG2E = 1.4426950408889634f;
constexpr int NPH = 2 + 16 * DEPTH;
constexpr size_t MiB = 1u << 20;
constexpr size_t WS_CTL = 0, CTL_ZERO_BYTES = 1 * MiB;
constexpr size_t WS_TABG = 1 * MiB, WS_TABM = 2 * MiB, WS_WR = 2 * MiB + 512 * 1024, WS_GAINS = 3 * MiB, WS_SSO = 3 * MiB + 64 * 1024, WS_SSX = 346 * MiB, WS_RS1 = WS_SSO + 512 * 1024, WS_RS3 = WS_RS1 + 128 * 1024, WS_RG = 118 * MiB + 256 * 1024, WS_SSL = 118 * MiB + 512 * 1024;
constexpr size_t WS_WSMALL = 4 * MiB, WSMALL_STRIDE = 10 * MiB;
constexpr size_t OFF_WIN = 0, OFF_WQB = 5 * MiB / 2, OFF_WKVB = 3 * MiB, OFF_WO = 7 * MiB / 2, OFF_WMQ = 11 * MiB / 2, OFF_WMKV = 13 * MiB / 2, OFF_WMO = 17 * MiB / 2;
constexpr size_t WS_WGU = 44 * MiB, WS_WD = 76 * MiB;
constexpr size_t WS_MEMN = 92 * MiB, WS_MEMKV = 96 * MiB;
constexpr size_t WS_AFF = 112 * MiB, WS_AFFT = 114 * MiB, WS_SLOT = 116 * MiB, WS_IDX = 118 * MiB;
constexpr size_t WS_H = 120 * MiB, WS_PROJ = 184 * MiB, WS_QG = 264 * MiB, WS_KG = 296 * MiB, WS_VG = 304 * MiB, WS_LAT = 312 * MiB, WS_KROPE = 344 * MiB, WS_QM = 346 * MiB;
constexpr size_t WS_XB = 264 * MiB;
constexpr size_t WS_O = WS_H, WS_KVM = WS_PROJ, WS_QMEM = 184 * MiB, WS_OMEM = 216 * MiB, WS_XG = 184 * MiB, WS_Y = WS_XG, WS_ACT = 312 * MiB;
constexpr size_t WS_WGU2 = 394 * MiB, WS_WD2 = 426 * MiB;
constexpr size_t WS_X = 442 * MiB;
constexpr size_t WS_END = 506 * MiB;
constexpr int CW_BAR = 4096;
constexpr int RING_BYTES = 131072, LDSCTL_OFF = 135168, MISC_OFF = LDSCTL_OFF + 320, GTAB_OFF = LDSCTL_OFF + 1024, STAB_OFF = GTAB_OFF + 8192, LDS_BYTES = 163840;

#define GAS __attribute__((address_space(1)))
#define LAS __attribute__((address_space(3)))
typedef unsigned short bf16;
typedef unsigned v4u __attribute__((ext_vector_type(4)));
typedef float f32x4 __attribute__((ext_vector_type(4)));
#define LDS_WAIT() asm volatile("s_waitcnt lgkmcnt(0)" ::: "memory")
__device__ __forceinline__ unsigned pk2(float lo, float hi) { unsigned r; asm volatile("v_cvt_pk_bf16_f32 %0, %1, %2" : "=v"(r) : "v"(lo), "v"(hi)); return r; }
__device__ __forceinline__ float bflo(unsigned w) { return __uint_as_float(w << 16); }
__device__ __forceinline__ float bfhi(unsigned w) { return __uint_as_float(w & 0xffff0000u); }
#define UNPACK8(W_, V_) do { V_[0] = bflo(W_[0]); V_[1] = bfhi(W_[0]); V_[2] = bflo(W_[1]); V_[3] = bfhi(W_[1]); V_[4] = bflo(W_[2]); V_[5] = bfhi(W_[2]); V_[6] = bflo(W_[3]); V_[7] = bfhi(W_[3]); } while (0)
#define PACK8(V_, W_) do { W_[0] = pk2(V_[0], V_[1]); W_[1] = pk2(V_[2], V_[3]); W_[2] = pk2(V_[4], V_[5]); W_[3] = pk2(V_[6], V_[7]); } while (0)
__device__ __forceinline__ float wave_sum(float v) {
#pragma unroll
    for (int o = 1; o < 64; o <<= 1) v += __shfl_xor(v, o);
    return v;
}
__device__ __forceinline__ int wave_sum_i(int v) {
#pragma unroll
    for (int o = 1; o < 64; o <<= 1) v += __shfl_xor(v, o);
    return v;
}

#define XB_TMO      128
#define XB_XCNT(j)  (256  + 64 * (j))
#define XB_XSUB(j)  (1280 + 64 * (j))
#define XB_XGEN(j)  (2304 + 64 * (j))
#define XB_TOP      3328
#define XB_TOPGEN   3392
#define XCD_BAR_WORDS 3456
#define XB_SPIN_CAP (1u << 20)
__device__ __forceinline__ unsigned xb_ld(unsigned* p)              { return __hip_atomic_load(p, __ATOMIC_RELAXED, __HIP_MEMORY_SCOPE_AGENT); }
__device__ __forceinline__ unsigned xb_add(unsigned* p, unsigned v) { return __hip_atomic_fetch_add(p, v, __ATOMIC_RELAXED, __HIP_MEMORY_SCOPE_AGENT); }
__device__ __forceinline__ unsigned xb_xcc_id() { return (unsigned)__builtin_amdgcn_s_getreg((3 << 11) | 20) & 0xFu; }
#define XB_SPIN(cond, bar) do { unsigned _sp = 0; while (cond) { __builtin_amdgcn_s_sleep(1); \
    if ((++_sp & 255u) == 0u) { if (xb_ld(&(bar)[XB_TMO])) break; if (_sp > XB_SPIN_CAP) { atomicAdd(&(bar)[XB_TMO], 1u); break; } } } } while (0)
struct XcdBarrier { unsigned* bar; unsigned x; volatile LAS unsigned* st; };
__device__ __forceinline__ XcdBarrier xcd_barrier_post(unsigned* bar, volatile LAS unsigned* st) {
    XcdBarrier b; b.bar = bar; b.x = xb_xcc_id(); b.st = st;
    if (threadIdx.x == 0) (void)xb_add(&bar[XB_XCNT(b.x)], 1u);
    return b;
}
__device__ __forceinline__ void xcd_barrier_complete(unsigned* bar, unsigned x, unsigned& nloc, unsigned& nx) {
    const unsigned G = gridDim.x * gridDim.y * gridDim.z;
    unsigned sum, cnt, mine, sp = 0u;
    for (;;) {
        sum = 0u; cnt = 0u; mine = 0u;
#pragma unroll
        for (unsigned j = 0; j < 16; ++j) { const unsigned c = xb_ld(&bar[XB_XCNT(j)]); sum += c; cnt += (c > 0u) ? 1u : 0u; mine = (j == x) ? c : mine; }
        if (sum == G) break;
        __builtin_amdgcn_s_sleep(1);
        if ((++sp & 255u) == 0u) { if (xb_ld(&bar[XB_TMO])) break; if (sp > XB_SPIN_CAP) { atomicAdd(&bar[XB_TMO], 1u); break; } }
    }
    nloc = mine > 0u ? mine : 1u; nx = cnt > 0u ? cnt : 1u;
}
__device__ __forceinline__ void xcd_barrier(const XcdBarrier& b) {
    asm volatile("s_waitcnt vmcnt(0)" ::: "memory");
    __syncthreads();
    if (threadIdx.x == 0) {
        unsigned* bar = b.bar;
        __builtin_amdgcn_s_waitcnt(0);
        unsigned nloc = b.st[0], nx = b.st[1];
        if (nloc == 0u) { xcd_barrier_complete(bar, b.x, nloc, nx); b.st[0] = nloc; b.st[1] = nx; }
        const unsigned old = xb_add(&bar[XB_XSUB(b.x)], 1u);
        const unsigned gen = old / nloc;
        if (old + 1u == (gen + 1u) * nloc) {
            __builtin_amdgcn_fence(__ATOMIC_RELEASE, "agent");
            asm volatile("s_waitcnt vmcnt(0)" ::: "memory");
            const unsigned og = xb_add(&bar[XB_TOP], 1u);
            const unsigned tg = og / nx;
            if (og + 1u == (tg + 1u) * nx) xb_add(&bar[XB_TOPGEN], 1u);
            else XB_SPIN(xb_ld(&bar[XB_TOPGEN]) == tg, bar);
            __builtin_amdgcn_fence(__ATOMIC_ACQUIRE, "agent");
            xb_add(&bar[XB_XGEN(b.x)], 1u);
            asm volatile("s_waitcnt vmcnt(0)" ::: "memory");
        } else {
            XB_SPIN(xb_ld(&bar[XB_XGEN(b.x)]) == gen, bar);
            __builtin_amdgcn_fence(__ATOMIC_ACQUIRE, "agent");
            asm volatile("s_waitcnt vmcnt(0)" ::: "memory");
        }
    }
    __syncthreads();
}

struct Args { const float* in[24]; float* out; unsigned char* ws; int ph_lo, ph_hi; };
struct Ctx {
    LAS unsigned char* lds; char* ldsg;
    int tid, lane, wave, vcu, vcu0, G, G0, gw, NGW;
    bf16* x; float* out;
    unsigned char* ws;
};
#define WSP(T, off) ((T*)(F.ws + (off)))
__device__ __forceinline__ void refresh(Ctx& F) { int t = threadIdx.x; asm volatile("" : "+v"(t)); F.tid = t; F.lane = t & 63;
    int w = __builtin_amdgcn_readfirstlane(t >> 6), v = F.vcu0, g = F.G0; asm volatile("" : "+s"(w), "+s"(v), "+s"(g)); F.wave = w; F.vcu = v; F.G = g; F.gw = v * NWAVES + w; F.NGW = g * NWAVES; }

__device__ __forceinline__ int il32(int i) { return (i < 16) ? 2 * i : 2 * (i - 16) + 1; }
__device__ __forceinline__ int il64(int d) { return (d < 32) ? 2 * d : 2 * (d - 32) + 1; }
__device__ __forceinline__ int dstrow(int kind, int n) {
    if (kind == 1) {
        if (n < 512) { const int h = n >> 6, p = il64(n & 63); return 256 * (h >> 2) + 128 * (p >> 5) + 32 * (h & 3) + (p & 31); }
        if (n < 640) { const int kh = (n - 512) >> 6, p = il64(n & 63); return 512 + 128 * (p >> 5) + 32 * kh + (p & 31); }
        if (n < 768) { const int vh = (n - 640) >> 6, d = n & 63; return 512 + 128 * (d >> 5) + 32 * (2 + vh) + (d & 31); }
        if (n >= 1152) return 1152 + il32(n - 1152);
        return n; }
    if (kind == 2) { const int h = n / 96, p = n % 96; return (p < 64) ? h * 64 + p : 512 + h * 32 + il32(p - 64); }
    if (kind == 3) return (n >> 7) * 256 + (n & 127);
    if (kind == 4) return (n >> 7) * 256 + 128 + (n & 127);
    return n;
}
__device__ __forceinline__ void tr_item(const float* W, int N, const float* gain, bf16* WT, int ldk, int kind, int item, LAS float* scr, int lane) {
    const int nblk = (N + 63) / 64, kb = item / nblk, nb = item % nblk, k0 = 64 * kb, n0 = 64 * nb;
    const int lr = lane >> 4, lc = (lane & 15) * 4; const bool okc = (n0 + lc) < N;
    f32x4 v[16];
#pragma unroll
    for (int i = 0; i < 16; ++i) v[i] = okc ? *(const GAS f32x4*)(W + (size_t)(k0 + 4 * i + lr) * N + n0 + lc) : (f32x4){0.f, 0.f, 0.f, 0.f};
#pragma unroll
    for (int i = 0; i < 16; ++i) { const int kk = 4 * i + lr; const float gk = gain ? gain[k0 + kk] : 1.0f; LAS float* d = scr + kk * 65 + lc;
        d[0] = v[i].x * gk; d[1] = v[i].y * gk; d[2] = v[i].z * gk; d[3] = v[i].w * gk; }
    LDS_WAIT(); asm volatile("" ::: "memory");
    const int c = lane & 7;
#pragma unroll
    for (int j = 0; j < 8; ++j) { const int n = (lane >> 3) + 8 * j; const LAS float* s = scr + (8 * c) * 65 + n;
        v4u o; o.x = pk2(s[0 * 65], s[1 * 65]); o.y = pk2(s[2 * 65], s[3 * 65]); o.z = pk2(s[4 * 65], s[5 * 65]); o.w = pk2(s[6 * 65], s[7 * 65]);
        if (n0 + n < N) *(GAS v4u*)(WT + (size_t)dstrow(kind, n0 + n) * ldk + k0 + 8 * c) = o; }
    LDS_WAIT(); asm volatile("" ::: "memory");
}
constexpr int SMALL_ITEMS = 1152;
__device__ __forceinline__ void small_weight_item(const Ctx& F, const Args& A, int l, int r, LAS float* scr) {
    bf16* wl = WSP(bf16, WS_WSMALL + (size_t)l * WSMALL_STRIDE);
    if (r < 304) { tr_item(A.in[3] + (size_t)l * DM * IN_W, IN_W, A.in[2] + l * DM, wl + OFF_WIN / 2, DM, 1, r, scr, F.lane); return; } r -= 304;
    if (r < 48)  { tr_item(A.in[8] + (size_t)l * 256 * 768, 768, A.in[6] + l * 256, wl + OFF_WQB / 2, 256, 2, r, scr, F.lane); return; } r -= 48;
    if (r < 32)  { tr_item(A.in[9] + (size_t)l * 128 * 1024, 1024, A.in[7] + l * 128, wl + OFF_WKVB / 2, 128, 0, r, scr, F.lane); return; } r -= 32;
    if (r < 256) { const int kb = r / 16; const float* gain = (kb < 8) ? (A.in[10] + l * 512) : (A.in[11] + l * 512 - 512);
                   tr_item(A.in[12] + (size_t)l * DM * DM, DM, gain, wl + OFF_WO / 2, DM, 0, r, scr, F.lane); return; } r -= 256;
    if (r < 128) { tr_item(A.in[15] + (size_t)l * DM * 512, 512, A.in[13] + l * DM, wl + OFF_WMQ / 2, DM, 0, r, scr, F.lane); return; } r -= 128;
    if (r < 256) { tr_item(A.in[16] + (size_t)l * DM * DM, DM, A.in[14] + l * DM, wl + OFF_WMKV / 2, DM, 0, r, scr, F.lane); return; } r -= 256;
    tr_item(A.in[17] + (size_t)l * 512 * DM, DM, nullptr, wl + OFF_WMO / 2, 512, 0, r, scr, F.lane);
}
constexpr int MOE_ITEMS = 3 * 2048;
__device__ __forceinline__ void moe_weight_item(const Ctx& F, const Args& A, int l, int it, LAS float* scr) {
    bf16* wgu = WSP(bf16, (l & 1) ? WS_WGU2 : WS_WGU); bf16* wd = WSP(bf16, (l & 1) ? WS_WD2 : WS_WD);
    const int which = it >> 11, e = (it >> 7) & 15, r = it & 127;
    if (which < 2) tr_item((which == 0 ? A.in[20] : A.in[21]) + (size_t)(l * NEXP + e) * DM * EFF, EFF, A.in[18] + l * DM, wgu + (size_t)e * 1024 * 1024, DM, 3 + which, r, scr, F.lane);
    else           tr_item(A.in[22] + (size_t)(l * NEXP + e) * EFF * DM, DM, nullptr, wd + (size_t)e * 1024 * 512, EFF, 0, r, scr, F.lane);
}
__device__ __forceinline__ void convert_moe_weights(const Ctx& F, const Args& A, int l) {
    LAS float* scr = (LAS float*)(F.lds + F.wave * 16640);
    for (int it = F.gw; it < MOE_ITEMS; it += F.NGW) moe_weight_item(F, A, l, it, scr);
}

__device__ __forceinline__ void rms_row_f32(const float* xrow, bf16* xb, bf16* orow, float* rs, int lane) {
    const GAS f32x4* xr = (const GAS f32x4*)xrow + lane;
    f32x4 v[4]; float s = 0.f;
#pragma unroll
    for (int j = 0; j < 4; ++j) { v[j] = xr[64 * j]; s += (v[j].x * v[j].x + v[j].y * v[j].y) + (v[j].z * v[j].z + v[j].w * v[j].w); }
    const float rstd = __builtin_amdgcn_rsqf(wave_sum(s) * (1.f / DM) + EPS);
    if (xb) { GAS unsigned long long* x8 = (GAS unsigned long long*)xb + lane;
#pragma unroll
        for (int j = 0; j < 4; ++j) x8[64 * j] = (unsigned long long)pk2(v[j].x, v[j].y) | ((unsigned long long)pk2(v[j].z, v[j].w) << 32); }
    if (rs && lane == 0) *rs = rstd;
    if (orow) { GAS unsigned long long* o8 = (GAS unsigned long long*)orow + lane;
#pragma unroll
        for (int j = 0; j < 4; ++j) o8[64 * j] = (unsigned long long)pk2(v[j].x * rstd, v[j].y * rstd) | ((unsigned long long)pk2(v[j].z * rstd, v[j].w * rstd) << 32); }
}
__device__ __forceinline__ void phase_prologue(const Ctx& F, const Args& A) {
    LAS float* scr = (LAS float*)(F.lds + F.wave * 16640);
    for (int it = F.gw; it < DEPTH * SMALL_ITEMS; it += F.NGW) small_weight_item(F, A, it / SMALL_ITEMS, it % SMALL_ITEMS, scr);
    convert_moe_weights(F, A, 0);
    const int gt = F.vcu * (NWAVES * 64) + F.tid, NGT = F.G * NWAVES * 64;
    for (int i = gt; i < DEPTH * 12288; i += NGT) { const int l = i / 12288, r = i % 12288;
        bf16* wl = WSP(bf16, WS_WSMALL + (size_t)l * WSMALL_STRIDE);
        *(GAS v4u*)(wl + OFF_WIN / 2 + (size_t)IN_W * DM + (size_t)r * 8) = (v4u){0u, 0u, 0u, 0u}; }
    for (int i = gt; i < 1536; i += NGT) WSP(float, WS_GAINS)[i] = (i < 256) ? A.in[4][i] : (i < 512) ? A.in[5][i - 256] : A.in[23][i - 512];
    for (int i = gt; i < DEPTH * NEXP * DM; i += NGT) { const int l = i / (NEXP * DM), e = (i / DM) % NEXP, k = i % DM;
        WSP(float, WS_WR)[i] = A.in[19][(size_t)(l * DM + k) * NEXP + e] * A.in[18][l * DM + k]; }
    for (int i = gt; i < SEQ * 48; i += NGT) { const int s = i / 48, j = i % 48; const float row = (float)(s >> 6), col = (float)(s & 63);
        const bool isg = (j < 32); const int j2 = isg ? j : j - 32, half = isg ? 16 : 8, jj = j2 & (half - 1);
        const float inv = __builtin_amdgcn_exp2f(-(float)(2 * jj) / (float)(2 * half) * 13.287712379549449f);
        const float ang = ((j2 < half) ? row : col) * inv;
        double td = (double)ang * 0.15915494309189535; td -= rint(td);
        const float sn = __builtin_amdgcn_sinf((float)td), cs = __builtin_amdgcn_cosf((float)td);
        float* dst = isg ? (WSP(float, WS_TABG) + ((size_t)s * 32 + j2) * 2) : (WSP(float, WS_TABM) + ((size_t)s * 16 + j2) * 2);
        dst[0] = cs; dst[1] = sn; }
    for (int m = F.gw; m < MROWS; m += F.NGW) rms_row_f32(A.in[1] + (size_t)m * DM, nullptr, WSP(bf16, WS_MEMN) + (size_t)m * DM, nullptr, F.lane);
    {
        const int lane = F.lane; f32x4 vn[4];
#pragma unroll
        for (int j = 0; j < 4; ++j) vn[j] = (f32x4){0.f, 0.f, 0.f, 0.f};
        if (F.gw < MTOK) { const GAS f32x4* xr = (const GAS f32x4*)(A.in[0] + (size_t)F.gw * DM) + lane;
#pragma unroll
            for (int j = 0; j < 4; ++j) vn[j] = xr[64 * j]; }
        for (int m = F.gw; m < MTOK; m += F.NGW) {
            f32x4 v[4]; float s = 0.f;
#pragma unroll
            for (int j = 0; j < 4; ++j) { v[j] = vn[j]; s += (v[j].x * v[j].x + v[j].y * v[j].y) + (v[j].z * v[j].z + v[j].w * v[j].w); }
            if (m + F.NGW < MTOK) { const GAS f32x4* xr = (const GAS f32x4*)(A.in[0] + (size_t)(m + F.NGW) * DM) + lane;
#pragma unroll
                for (int j = 0; j < 4; ++j) vn[j] = xr[64 * j]; }
            const float rstd = __builtin_amdgcn_rsqf(wave_sum(s) * (1.f / DM) + EPS);
            GAS unsigned long long* x8 = (GAS unsigned long long*)(F.x + (size_t)m * DM) + lane;
#pragma unroll
            for (int j = 0; j < 4; ++j) x8[64 * j] = (unsigned long long)pk2(v[j].x, v[j].y) | ((unsigned long long)pk2(v[j].z, v[j].w) << 32);
            if (lane == 0) WSP(float, WS_RS1)[m] = rstd;
        } }
}

__device__ __forceinline__ void rope4(float* v, const float* tab) {
    const f32x4 t0 = *(const f32x4*)tab, t1 = *(const f32x4*)(tab + 4);
    float a, b;
    a = v[0]; b = v[1]; v[0] = a * t0[0] - b * t0[1]; v[1] = b * t0[0] + a * t0[1];
    a = v[2]; b = v[3]; v[2] = a * t0[2] - b * t0[3]; v[3] = b * t0[2] + a * t0[3];
    a = v[4]; b = v[5]; v[4] = a * t1[0] - b * t1[1]; v[5] = b * t1[0] + a * t1[1];
    a = v[6]; b = v[7]; v[6] = a * t1[2] - b * t1[3]; v[7] = b * t1[2] + a * t1[3];
}
__device__ __forceinline__ void phase_postproj(const Ctx& F, int l) {
    int lane_ = F.lane; asm volatile("" : "+v"(lane_)); const int lane = lane_;
    const float* gq = WSP(float, WS_GAINS) + l * 64; const float* gk = WSP(float, WS_GAINS) + 256 + l * 64;
    float gqv[8], gkv[8];
#pragma unroll
    for (int i = 0; i < 8; ++i) { const int p = 8 * (lane & 7) + i, d = (p >> 1) + 32 * (p & 1); gqv[i] = gq[d]; gkv[i] = gk[d]; }
    const float* tabg = WSP(float, WS_TABG); const float* tabm = WSP(float, WS_TABM);
    const float C2G = 0.125f * LOG2E;
    v4u wa_n = (v4u){0u, 0u, 0u, 0u}, wb_n = wa_n, wc_n = wa_n;
    if (F.gw < MTOK) { const bf16* pr = WSP(bf16, WS_PROJ) + (size_t)F.gw * IN_WP; wa_n = *(const GAS v4u*)(pr + 8 * lane); wb_n = *(const GAS v4u*)(pr + 512 + 8 * lane); if (lane < 20) wc_n = *(const GAS v4u*)(pr + 1024 + 8 * lane); }
    for (int m = F.gw; m < MTOK; m += F.NGW) {
        const int s = m & (SEQ - 1);
        const v4u wa = wa_n, wb = wb_n, wc = wc_n;
        if (m + F.NGW < MTOK) { const bf16* pr = WSP(bf16, WS_PROJ) + (size_t)(m + F.NGW) * IN_WP; wa_n = *(const GAS v4u*)(pr + 8 * lane); wb_n = *(const GAS v4u*)(pr + 512 + 8 * lane); if (lane < 20) wc_n = *(const GAS v4u*)(pr + 1024 + 8 * lane); }
        { const v4u w = wa; float v[8]; UNPACK8(w, v);
          float ss = 0.f;
#pragma unroll
          for (int i = 0; i < 8; ++i) ss += v[i] * v[i];
          ss += __shfl_xor(ss, 1); ss += __shfl_xor(ss, 2); ss += __shfl_xor(ss, 4);
          const float rstd = __builtin_amdgcn_rsqf(ss * (1.f / 64.f) + EPS);
#pragma unroll
          for (int i = 0; i < 8; ++i) v[i] = v[i] * rstd * gqv[i];
          rope4(v, tabg + ((size_t)s * 32 + 4 * (lane & 7)) * 2);
#pragma unroll
          for (int i = 0; i < 8; ++i) v[i] *= C2G;
          v4u o; PACK8(v, o); *(GAS v4u*)(WSP(bf16, WS_QG) + (size_t)m * 512 + 8 * lane) = o; }
        { const v4u w = wb; float v[8]; UNPACK8(w, v);
          float ss = 0.f;
#pragma unroll
          for (int i = 0; i < 8; ++i) ss += v[i] * v[i];
          ss += __shfl_xor(ss, 1); ss += __shfl_xor(ss, 2); ss += __shfl_xor(ss, 4);
          const float ss8 = ss;
          ss += __shfl_xor(ss, 8); ss += __shfl_xor(ss, 16);
          if (lane < 16) {
              const float rstd = __builtin_amdgcn_rsqf(ss8 * (1.f / 64.f) + EPS);
#pragma unroll
              for (int i = 0; i < 8; ++i) v[i] = v[i] * rstd * gkv[i];
              rope4(v, tabg + ((size_t)s * 32 + 4 * (lane & 7)) * 2);
              v4u o; PACK8(v, o); *(GAS v4u*)(WSP(bf16, WS_KG) + (size_t)m * 128 + 8 * lane) = o;
          } else if (lane < 32) {
              *(GAS v4u*)(WSP(bf16, WS_VG) + (size_t)m * 128 + 8 * (lane - 16)) = w;
          } else {
              const float rstd = __builtin_amdgcn_rsqf(ss * (1.f / 256.f) + EPS);
#pragma unroll
              for (int i = 0; i < 8; ++i) v[i] *= rstd;
              v4u o; PACK8(v, o); *(GAS v4u*)(WSP(bf16, WS_LAT) + (size_t)m * 512 + 8 * (lane - 32)) = o;
          } }
        { const v4u w = wc;
          float v[8]; UNPACK8(w, v);
          float ss = 0.f;
#pragma unroll
          for (int i = 0; i < 8; ++i) ss += v[i] * v[i];
          ss += __shfl_xor(ss, 1); ss += __shfl_xor(ss, 2); ss += __shfl_xor(ss, 4); ss += __shfl_xor(ss, 8);
          if (lane < 16) {
              const float rstd = __builtin_amdgcn_rsqf(ss * (1.f / 128.f) + EPS);
#pragma unroll
              for (int i = 0; i < 8; ++i) v[i] *= rstd;
              v4u o; PACK8(v, o); *(GAS v4u*)(WSP(bf16, WS_LAT) + (size_t)m * 512 + 256 + 8 * lane) = o;
          } else if (lane < 20) {
              rope4(v, tabm + ((size_t)s * 16 + 4 * (lane - 16)) * 2);
              v4u o; PACK8(v, o); *(GAS v4u*)(WSP(bf16, WS_KROPE) + (size_t)m * 32 + 8 * (lane - 16)) = o;
          } else if (lane < 36) {
              *(GAS v4u*)(WSP(bf16, WS_LAT) + (size_t)m * 512 + 384 + 8 * (lane - 20)) = (v4u){0u, 0u, 0u, 0u};
          } }
    }
}

__device__ __forceinline__ void phase_outnorm(const Ctx& F) {
    int lane_ = F.lane; asm volatile("" : "+v"(lane_)); const int lane = lane_;
    for (int m = F.gw; m < MTOK; m += F.NGW) {
        bf16* orow = WSP(bf16, WS_O) + (size_t)m * DM;
#pragma unroll
        for (int g = 0; g < 2; ++g) {
            v4u w = *(const GAS v4u*)(orow + g * 512 + 8 * lane); float v[8]; UNPACK8(w, v);
            float ss = 0.f;
#pragma unroll
            for (int i = 0; i < 8; ++i) ss += v[i] * v[i];
            const float rstd = __builtin_amdgcn_rsqf(wave_sum(ss) * (1.f / 512.f) + EPS);
#pragma unroll
            for (int i = 0; i < 8; ++i) v[i] *= rstd;
            v4u o; PACK8(v, o); *(GAS v4u*)(orow + g * 512 + 8 * lane) = o;
        }
    }
}

__device__ __forceinline__ void phase_router(const Ctx& F, int l) {
    int lane_ = F.lane; asm volatile("" : "+v"(lane_)); const int lane = lane_;
    int tid_ = F.tid; asm volatile("" : "+v"(tid_)); const int tid = tid_;
    typedef short rbf16x8 __attribute__((ext_vector_type(8)));
    const int NB = MTOK / 16, tok = lane & 15, kq = lane >> 4;
    int tb = F.gw;
    v4u xf[32];
#define RT_LOAD() do { const GAS v4u* xr_ = (const GAS v4u*)(F.x + ((size_t)tb * 16 + tok) * DM) + kq; _Pragma("unroll") for (int s_ = 0; s_ < 32; ++s_) xf[s_] = xr_[4 * s_]; } while (0)
    if (tb < NB) RT_LOAD();
    {
        const GAS f32x4* src = (const GAS f32x4*)(WSP(float, WS_WR) + (size_t)l * NEXP * DM);
        for (int it = tid; it < NEXP * DM / 8; it += NWAVES * 64) { const int e = it & 15, k8 = it >> 4;
            const f32x4 a = src[(e * DM + 8 * k8) / 4], b = src[(e * DM + 8 * k8) / 4 + 1];
            v4u hi, lo; hi.x = pk2(a.x, a.y); hi.y = pk2(a.z, a.w); hi.z = pk2(b.x, b.y); hi.w = pk2(b.z, b.w);
            lo.x = pk2(a.x - bflo(hi.x), a.y - bfhi(hi.x)); lo.y = pk2(a.z - bflo(hi.y), a.w - bfhi(hi.y)); lo.z = pk2(b.x - bflo(hi.z), b.y - bfhi(hi.z)); lo.w = pk2(b.z - bflo(hi.w), b.w - bfhi(hi.w));
            const int s = k8 >> 2, ln = (k8 & 3) * 16 + e;
            *(LAS v4u*)(F.lds + ((s * 2 + 0) * 64 + ln) * 16) = hi; *(LAS v4u*)(F.lds + ((s * 2 + 1) * 64 + ln) * 16) = lo; }
    }
    __syncthreads();
    while (tb < NB) {
        asm volatile("" ::: "memory");
        f32x4 ah = {0.f, 0.f, 0.f, 0.f}, al = {0.f, 0.f, 0.f, 0.f}; float ss0 = 0.f, ss1 = 0.f;
#pragma unroll
        for (int s = 0; s < 32; ++s) {
            const rbf16x8 wh = *(const LAS rbf16x8*)(F.lds + ((s * 2 + 0) * 64 + lane) * 16), wl = *(const LAS rbf16x8*)(F.lds + ((s * 2 + 1) * 64 + lane) * 16);
            const rbf16x8 xb = __builtin_bit_cast(rbf16x8, xf[s]);
            ah = __builtin_amdgcn_mfma_f32_16x16x32_bf16(wh, xb, ah, 0, 0, 0);
            al = __builtin_amdgcn_mfma_f32_16x16x32_bf16(wl, xb, al, 0, 0, 0);
            const v4u q = xf[s];
            ss0 += (bflo(q.x) * bflo(q.x) + bfhi(q.x) * bfhi(q.x)) + (bflo(q.y) * bflo(q.y) + bfhi(q.y) * bfhi(q.y));
            ss1 += (bflo(q.z) * bflo(q.z) + bfhi(q.z) * bfhi(q.z)) + (bflo(q.w) * bflo(q.w) + bfhi(q.w) * bfhi(q.w));
        }
        float ss = ss0 + ss1; ss += __shfl_xor(ss, 16); ss += __shfl_xor(ss, 32);
        const float rstd = __builtin_amdgcn_rsqf(ss * (1.f / DM) + EPS);
        const int row = tb * 16 + tok;
        if (lane < 16) WSP(float, WS_RS3)[row] = rstd;
        f32x4 lg = (ah + al) * rstd;
        float mx = fmaxf(fmaxf(lg.x, lg.y), fmaxf(lg.z, lg.w)); mx = fmaxf(mx, __shfl_xor(mx, 16)); mx = fmaxf(mx, __shfl_xor(mx, 32));
        f32x4 ex = {__expf(lg.x - mx), __expf(lg.y - mx), __expf(lg.z - mx), __expf(lg.w - mx)};
        float den = (ex.x + ex.y) + (ex.z + ex.w); den += __shfl_xor(den, 16); den += __shfl_xor(den, 32);
        ex = {ex.x / den, ex.y / den, ex.z / den, ex.w / den};
        *(f32x4*)(WSP(float, WS_AFF) + (size_t)row * 16 + 4 * kq) = ex;
        float* at = WSP(float, WS_AFFT) + ((size_t)(row >> 12) * 16 + 4 * kq) * SEQ + (row & (SEQ - 1));
        at[0] = ex.x; at[SEQ] = ex.y; at[2 * SEQ] = ex.z; at[3 * SEQ] = ex.w;
        tb += F.NGW; if (tb < NB) RT_LOAD();
    }
#undef RT_LOAD
    __syncthreads();
}

__device__ __forceinline__ int block_excl_scan(int v, LAS int* red, int lane, int wave, int& total) {
    int inc = v;
#pragma unroll
    for (int o = 1; o < 64; o <<= 1) { const int t = __shfl_up(inc, o); if (lane >= o) inc += t; }
    __syncthreads();
    if (lane == 63) red[wave] = inc;
    __syncthreads();
    int base = 0, tot = 0;
#pragma unroll
    for (int w = 0; w < 8; ++w) { const int t = red[w]; if (w < wave) base += t; tot += t; }
    total = tot;
    return base + inc - v;
}
__device__ __forceinline__ void phase_select(const Ctx& F, const Args& A, int l) {
    LAS int* red = (LAS int*)F.lds;
    int tid_ = F.tid; asm volatile("" : "+v"(tid_)); const int tid = tid_, lane = tid & 63, wave = F.wave;
    for (int pair = F.vcu; pair < BATCH * NEXP; pair += F.G) {
        const int b = pair >> 4, e = pair & 15;
        const GAS v4u* src = (const GAS v4u*)(WSP(float, WS_AFFT) + (size_t)pair * SEQ) + 2 * tid;
        const v4u w0 = src[0], w1 = src[1];
        unsigned v[8] = {w0.x, w0.y, w0.z, w0.w, w1.x, w1.y, w1.z, w1.w};
        unsigned T = 0u; int par = 0;
        for (int bit = 30; bit >= 0; --bit) {
            const unsigned cand = T | (1u << bit);
            int c = 0;
#pragma unroll
            for (int i = 0; i < 8; ++i) c += (v[i] >= cand) ? 1 : 0;
            c = wave_sum_i(c);
            if (lane == 0) red[par * 8 + wave] = c;
            __syncthreads();
            int tot = 0;
#pragma unroll
            for (int w = 0; w < 8; ++w) tot += red[par * 8 + w];
            if (tot >= CAP) T = cand;
            par ^= 1;
        }
        int cgt = 0, ceq = 0;
#pragma unroll
        for (int i = 0; i < 8; ++i) { cgt += (v[i] > T) ? 1 : 0; ceq += (v[i] == T) ? 1 : 0; }
        int ngt, neq_tot;
        (void)block_excl_scan(cgt, red + 16, lane, wave, ngt);
        int eqb = block_excl_scan(ceq, red + 16, lane, wave, neq_tot);
        const int need_eq = CAP - ngt;
        int sel[8], csel = 0;
#pragma unroll
        for (int i = 0; i < 8; ++i) { const bool iseq = (v[i] == T); sel[i] = ((v[i] > T) || (iseq && eqb < need_eq)) ? 1 : 0; eqb += iseq ? 1 : 0; csel += sel[i]; }
        int nsel;
        int pos = block_excl_scan(csel, red + 16, lane, wave, nsel);
        int* idx = WSP(int, WS_IDX) + (size_t)(e * BATCH + b) * CAP; float* rg = WSP(float, WS_RG) + (size_t)(e * BATCH + b) * CAP; const float* rs3 = WSP(float, WS_RS3) + (size_t)b * SEQ;
        int* slot = WSP(int, WS_SLOT) + ((size_t)b * SEQ + (size_t)tid * 8) * NEXP + e;
#pragma unroll
        for (int i = 0; i < 8; ++i) { if (sel[i]) { if (pos < CAP) { idx[pos] = tid * 8 + i; rg[pos] = rs3[tid * 8 + i]; } slot[i * NEXP] = pos; ++pos; } else slot[i * NEXP] = -1; }
        __syncthreads();
    }
    if (l + 1 < DEPTH) {
        const bool split = F.G > BATCH * NEXP; const int nw = split ? (F.G - BATCH * NEXP) * NWAVES : F.NGW, wi = split ? (F.vcu - BATCH * NEXP) * NWAVES + F.wave : F.gw;
        LAS float* scr = (LAS float*)(F.lds + F.wave * 16640);
        if (wi >= 0) for (int it = wi; it < MOE_ITEMS; it += nw) moe_weight_item(F, A, l + 1, it, scr);
    }
}

__device__ __forceinline__ void phase_gather(const Ctx& F) {
    int lane_ = F.lane; asm volatile("" : "+v"(lane_)); const int lane = lane_;
    for (int r = F.gw; r < MOE_ROWS; r += F.NGW) {
        const int b = (r >> 9) & 7; const int t = WSP(int, WS_IDX)[r];
        const GAS v4u* src = (const GAS v4u*)(WSP(bf16, WS_H) + ((size_t)b * SEQ + t) * DM) + lane;
        GAS v4u* dst = (GAS v4u*)(WSP(bf16, WS_XG) + (size_t)r * DM) + lane;
        const v4u a = src[0], c = src[64]; dst[0] = a; dst[64] = c;
    }
}

__device__ __forceinline__ void phase_combine(const Ctx& F, const Args& A, int l, float amul) {
    int lane_ = F.lane; asm volatile("" : "+v"(lane_)); const int lane = lane_; const bool lastl = (l == DEPTH - 1);
    const float* gfin = WSP(float, WS_GAINS) + 512;
    v4u xa_n = (v4u){0u, 0u, 0u, 0u}, xc_n = xa_n; int sl_n = -1; float af_n = 0.f;
    if (F.gw < MTOK) { const GAS v4u* xp = (const GAS v4u*)(F.x + (size_t)F.gw * DM) + lane; xa_n = xp[0]; xc_n = xp[64];
        sl_n = WSP(int, WS_SLOT)[(size_t)F.gw * NEXP + (lane & 15)]; af_n = WSP(float, WS_AFF)[(size_t)F.gw * NEXP + (lane & 15)]; }
    for (int m = F.gw; m < MTOK; m += F.NGW) {
        const int b = m >> 12;
        GAS v4u* xr = (GAS v4u*)(F.x + (size_t)m * DM) + lane;
        const v4u xa = xa_n, xc = xc_n; const int sl = sl_n; const float af = amul * af_n;
        if (m + F.NGW < MTOK) { const int mn = m + F.NGW; const GAS v4u* xp = (const GAS v4u*)(F.x + (size_t)mn * DM) + lane; xa_n = xp[0]; xc_n = xp[64];
            sl_n = WSP(int, WS_SLOT)[(size_t)mn * NEXP + (lane & 15)]; af_n = WSP(float, WS_AFF)[(size_t)mn * NEXP + (lane & 15)]; }
        f32x4 x0 = (f32x4){bflo(xa.x), bfhi(xa.x), bflo(xa.y), bfhi(xa.y)}, x1 = (f32x4){bflo(xa.z), bfhi(xa.z), bflo(xa.w), bfhi(xa.w)};
        f32x4 x2 = (f32x4){bflo(xc.x), bfhi(xc.x), bflo(xc.y), bfhi(xc.y)}, x3 = (f32x4){bflo(xc.z), bfhi(xc.z), bflo(xc.w), bfhi(xc.w)};
        unsigned mask = (unsigned)(__ballot(sl >= 0 && lane < 16));
#define CMB_ACC(Y0, Y1, AE) do { x0.x += AE * bflo(Y0.x); x0.y += AE * bfhi(Y0.x); x0.z += AE * bflo(Y0.y); x0.w += AE * bfhi(Y0.y); \
            x1.x += AE * bflo(Y0.z); x1.y += AE * bfhi(Y0.z); x1.z += AE * bflo(Y0.w); x1.w += AE * bfhi(Y0.w); \
            x2.x += AE * bflo(Y1.x); x2.y += AE * bfhi(Y1.x); x2.z += AE * bflo(Y1.y); x2.w += AE * bfhi(Y1.y); \
            x3.x += AE * bflo(Y1.z); x3.y += AE * bfhi(Y1.z); x3.z += AE * bflo(Y1.w); x3.w += AE * bfhi(Y1.w); } while (0)
        while (mask) {
            const int e1 = __builtin_ctz(mask); mask &= mask - 1u;
            const bool two = mask != 0u; const int e2 = two ? __builtin_ctz(mask) : e1; if (two) mask &= mask - 1u;
            const int s1 = __shfl(sl, e1), s2 = __shfl(sl, e2); const float a1 = __shfl(af, e1), a2 = two ? __shfl(af, e2) : 0.f;
            const GAS v4u* yr1 = (const GAS v4u*)(WSP(bf16, WS_Y) + ((size_t)(e1 * BATCH + b) * CAP + s1) * DM) + lane;
            const GAS v4u* yr2 = (const GAS v4u*)(WSP(bf16, WS_Y) + ((size_t)(e2 * BATCH + b) * CAP + s2) * DM) + lane;
            const v4u y0 = yr1[0], y1 = yr1[64], z0 = yr2[0], z1 = yr2[64];
            CMB_ACC(y0, y1, a1); CMB_ACC(z0, z1, a2);
        }
#undef CMB_ACC
        float s = (x0.x * x0.x + x0.y * x0.y) + (x0.z * x0.z + x0.w * x0.w) + (x1.x * x1.x + x1.y * x1.y) + (x1.z * x1.z + x1.w * x1.w)
                + (x2.x * x2.x + x2.y * x2.y) + (x2.z * x2.z + x2.w * x2.w) + (x3.x * x3.x + x3.y * x3.y) + (x3.z * x3.z + x3.w * x3.w);
        const float rstd = __builtin_amdgcn_rsqf(wave_sum(s) * (1.f / DM) + EPS);
        if (lastl) {
            const f32x4 g0 = *(const f32x4*)(gfin + 8 * lane), g1 = *(const f32x4*)(gfin + 8 * lane + 4), g2 = *(const f32x4*)(gfin + 512 + 8 * lane), g3 = *(const f32x4*)(gfin + 512 + 8 * lane + 4);
            GAS f32x4* ow = (GAS f32x4*)(F.out + (size_t)m * DM);
            ow[2 * lane] = x0 * rstd * g0; ow[2 * lane + 1] = x1 * rstd * g1; ow[128 + 2 * lane] = x2 * rstd * g2; ow[128 + 2 * lane + 1] = x3 * rstd * g3;
        } else {
            v4u n0, n1; n0.x = pk2(x0.x, x0.y); n0.y = pk2(x0.z, x0.w); n0.z = pk2(x1.x, x1.y); n0.w = pk2(x1.z, x1.w); n1.x = pk2(x2.x, x2.y); n1.y = pk2(x2.z, x2.w); n1.z = pk2(x3.x, x3.y); n1.w = pk2(x3.z, x3.w);
            xr[0] = n0; xr[64] = n1;
            if (lane == 0) WSP(float, WS_RS1)[m] = rstd;
        }
    }
}

__device__ __forceinline__ void phase_attn_self(const Ctx& F, int l) {
    float gmq = fabsf(WSP(float, WS_GAINS)[l * 64 + F.lane]), gmk = fabsf(WSP(float, WS_GAINS)[256 + l * 64 + F.lane]);
#pragma unroll
    for (int o = 1; o < 64; o <<= 1) { gmq = fmaxf(gmq, __shfl_xor(gmq, o)); gmk = fmaxf(gmk, __shfl_xor(gmk, o)); }
    const bool bounded = (8.0f * LOG2E * gmq * gmk) < 64.0f;
    const int lane = F.lane, r32 = lane & 31, hi = lane >> 5, wid = F.wave;
#ifndef DUPATT
#define DUPATT 0
#endif
    for (int g = 0; g < 2; ++g)
      for (int rep2_ = 0; rep2_ < 1 + ((DUPATT >> g) & 1); ++rep2_)
        for (int u = F.vcu; u < 256; u += F.G) {
            const int b = u >> 5, qb = (u >> 1) & 15, hh = u & 1;
            const size_t r0 = (size_t)b * SEQ, q0 = r0 + (size_t)qb * 256;
            float ssacc[16];
#pragma unroll
            for (int r = 0; r < 16; ++r) ssacc[r] = 0.f;
            for (int hq = 0; hq < 4; ++hq) {
                const int h = hh * 4 + hq;
                if (g == 0) {
                    if (bounded) att::attn_unit<64, 0, 64, 1, true>(WSP(bf16, WS_QG) + q0 * 512 + h * 64, nullptr, 512, WSP(bf16, WS_KG) + r0 * 128 + hh * 64, 128, nullptr, 0,
                                              WSP(bf16, WS_VG) + r0 * 128 + hh * 64, 128, WSP(bf16, WS_O) + q0 * DM + h * 64, DM, SEQ, F.ldsg, ssacc);
                    else         att::attn_unit<64, 0, 64, 0, true>(WSP(bf16, WS_QG) + q0 * 512 + h * 64, nullptr, 512, WSP(bf16, WS_KG) + r0 * 128 + hh * 64, 128, nullptr, 0,
                                              WSP(bf16, WS_VG) + r0 * 128 + hh * 64, 128, WSP(bf16, WS_O) + q0 * DM + h * 64, DM, SEQ, F.ldsg, ssacc);
                } else {
                    att::attn_unit<64, 32, 64, 0, true>(WSP(bf16, WS_QM) + q0 * 768 + h * 64, WSP(bf16, WS_QM) + q0 * 768 + 512 + h * 32, 768, WSP(bf16, WS_KVM) + r0 * DM + h * 128, DM, WSP(bf16, WS_KROPE) + r0 * 32, 32,
                                               WSP(bf16, WS_KVM) + r0 * DM + h * 128 + 64, DM, WSP(bf16, WS_O) + q0 * DM + 512 + h * 64, DM, SEQ, F.ldsg, ssacc);
                }
            }
#pragma unroll
            for (int r = 0; r < 16; ++r) { float s = ssacc[r];
                s += __shfl_xor(s, 1); s += __shfl_xor(s, 2); s += __shfl_xor(s, 4); s += __shfl_xor(s, 8); s += __shfl_xor(s, 16);
                if (r32 == 0) WSP(float, WS_SSO)[(q0 + wid * 32 + att::crow(r, hi)) * 4 + g * 2 + hh] = s; }
        }
}
__device__ __forceinline__ void phase_attn_mem(const Ctx& F, int l) {
    const bf16* kv = WSP(bf16, WS_MEMKV) + (size_t)l * MROWS * DM; float dummy[16];
    for (int idx = F.vcu; idx < 256; idx += F.G) {
        const int pm = idx >> 1, pn = idx & 1, b = pm >> 4;
        const size_t q0 = (size_t)pm * 256, k0 = (size_t)b * MEM_T;
        for (int hh = 0; hh < 2; ++hh) { const int h = 2 * pn + hh;
            att::attn_unit<128, 0, 128, 0, false>(WSP(bf16, WS_QMEM) + q0 * 512 + h * 128, nullptr, 512, kv + k0 * DM + h * 128, DM, nullptr, 0,
                                        kv + k0 * DM + 512 + h * 128, DM, WSP(bf16, WS_OMEM) + q0 * 512 + h * 128, 512, MEM_T, F.ldsg, dummy); }
    }
}

__global__ void __launch_bounds__(NWAVES * 64, 2) enc_fwd(Args args) {
    extern __shared__ __attribute__((aligned(16))) unsigned char lds[];
    Ctx F;
    F.lds = (LAS unsigned char*)lds; F.ldsg = (char*)lds;
    F.tid = threadIdx.x; F.lane = F.tid & 63; F.wave = __builtin_amdgcn_readfirstlane(F.tid >> 6);
    F.G = gridDim.x; F.G0 = F.G; { const int bx = blockIdx.x; F.vcu0 = (F.G % 8 == 0) ? (bx % 8) * (F.G / 8) + bx / 8 : bx; F.vcu = F.vcu0; }
    F.gw = F.vcu * NWAVES + F.wave; F.NGW = F.G * NWAVES;
    F.out = args.out; F.ws = args.ws; F.x = (bf16*)(args.ws + WS_X);
    volatile LAS unsigned* MISC = (volatile LAS unsigned*)(F.lds + MISC_OFF);
    for (int u = F.tid; u < (LDS_BYTES - LDSCTL_OFF) / 4; u += NWAVES * 64) ((LAS unsigned*)(F.lds + LDSCTL_OFF))[u] = 0u;
    __syncthreads();
    XcdBarrier bar; bar.bar = (unsigned*)(F.ws + WS_CTL) + CW_BAR; bar.x = 0; bar.st = nullptr;
    if (MK_N_LAUNCHES == 1) bar = xcd_barrier_post((unsigned*)(F.ws + WS_CTL) + CW_BAR, MISC + 8);
    const int lo = args.ph_lo, hi = args.ph_hi;
#ifndef ONLY_SITE
#define ONLY_SITE -1
#endif
#define ON(s) (ONLY_SITE < 0 || ONLY_SITE == (s))
#ifndef DUPMASK
#define DUPMASK 0u
#endif
#define REP(s) for (int rep_ = 0; rep_ < 1 + (int)((DUPMASK >> (s)) & 1u); ++rep_)
#define IN(k) (lo <= (k) && (k) < hi)
#define SEAM(k) do { if (IN(k) && IN((k) + 1)) xcd_barrier(bar); } while (0)
#define LOCAL_SEAM() do { asm volatile("s_waitcnt vmcnt(0)" ::: "memory"); __syncthreads(); __builtin_amdgcn_fence(__ATOMIC_ACQUIRE, "agent"); asm volatile("s_waitcnt vmcnt(0)" ::: "memory"); __syncthreads(); } while (0)
#define GEMM(EpiT, epi, Ap, lda_, Bp, ldb_, K_, nM_, nN_, gdiv_, gstride_) do { const pg8::Gemm g_{(const bf16*)(Ap), (const bf16*)(Bp), lda_, ldb_, K_, gdiv_, 1 << 30, (size_t)(gstride_), nullptr, nullptr}; \
        pg8::StaticOrder S_; S_.init(nM_, nN_, F.G, (int)blockIdx.x); pg8::gemm_phase<EpiT, pg8::StaticOrder, true>(F.lds, g_, S_, epi); } while (0)

    #ifndef PRODUP
#define PRODUP 0
#endif
    if (ON(100) && IN(0)) for (int rp_ = 0; rp_ <= PRODUP; ++rp_) { refresh(F); phase_prologue(F, args); }
    SEAM(0);
    if (ON(101) && IN(1)) {
        pg8::EpiBf16 E{WSP(bf16, WS_MEMKV), DM, 1.0f, nullptr, nullptr, 0.f, 0.f};
        const pg8::Gemm g_{WSP(bf16, WS_MEMN), WSP(bf16, WS_WSMALL + OFF_WMKV), DM, DM, DM, MROWS / 256, MROWS / 256, (size_t)(WSMALL_STRIDE / 2), nullptr, nullptr};
        pg8::StaticOrder S_; S_.init(DEPTH * MROWS / 256, DM / 256, F.G, (int)blockIdx.x); pg8::gemm_phase<pg8::EpiBf16, pg8::StaticOrder, true>(F.lds, g_, S_, E); }
    SEAM(1);
    for (int l = 0; l < DEPTH; ++l) {
        const int pb = 2 + 16 * l;
        unsigned char* wl = F.ws + WS_WSMALL + (size_t)l * WSMALL_STRIDE;
        if (ON(0) && IN(pb + 0)) REP(0) if (refresh(F), true) {
            pg8::EpiInProj E{WSP(float, WS_RS1), WSP(float, WS_GAINS) + l * 64, WSP(float, WS_GAINS) + 256 + l * 64, WSP(float, WS_TABG), WSP(float, WS_TABM),
                             WSP(bf16, WS_QG), WSP(bf16, WS_KG), WSP(bf16, WS_VG), WSP(bf16, WS_LAT), WSP(bf16, WS_KROPE), WSP(float, WS_SSL), 0.125f * LOG2E, EPS};
            GEMM(pg8::EpiInProj, E, F.x, DM, wl + OFF_WIN, DM, DM, MTOK / 256, IN_WP / 256, 1, 0); }
        SEAM(pb + 0);
        if ((ON(2) || ON(16) || ON(17)) && IN(pb + 2)) REP(2) { refresh(F);
            if (ON(2) || ON(17)) { pg8::EpiQmRope E{WSP(bf16, WS_QM), 768, 0.10206207261596577f * LOG2E, WSP(float, WS_TABM), WSP(float, WS_SSL), 1.0f / 256.0f, EPS}; GEMM(pg8::EpiQmRope, E, WSP(bf16, WS_LAT), 512, wl + OFF_WQB, 256, 256, MTOK / 256, 3, 1, 0); }
            if (ON(2) || ON(16)) { pg8::EpiBf16 E{WSP(bf16, WS_KVM), DM, 1.0f, nullptr, WSP(float, WS_SSL) + 4, 1.0f / 128.0f, EPS}; GEMM(pg8::EpiBf16, E, WSP(bf16, WS_LAT) + 256, 512, wl + OFF_WKVB, 128, 128, MTOK / 256, 4, 1, 0); } }
        SEAM(pb + 2);
        if (ON(3) && IN(pb + 3)) REP(3) if (refresh(F), true) phase_attn_self(F, l);
        SEAM(pb + 3);
        if (ON(5) && IN(pb + 5)) REP(5) if (refresh(F), true) {
            pg8::EpiResidualX E{F.x, WSP(float, WS_SSX), DM, 1.0f / 512.0f, EPS, rep_ ? 0.f : 1.f};
            const pg8::Gemm g_{WSP(bf16, WS_O), (const bf16*)(wl + OFF_WO), DM, DM, DM, 1, 1 << 30, 0, nullptr, WSP(float, WS_SSO)};
            pg8::StaticOrder S_; S_.init(MTOK / 256, 4, F.G, (int)blockIdx.x); pg8::gemm_phase<pg8::EpiResidualX, pg8::StaticOrder, true, false, true>(F.lds, g_, S_, E, F.lds + STAB_OFF, 1.0f / 512.0f, EPS); }
        SEAM(pb + 5);
        if (ON(7) && IN(pb + 7)) REP(7) if (refresh(F), true) { pg8::EpiBf16RowNorm E{WSP(bf16, WS_QMEM), 512, 0.08838834764831845f * LOG2E, WSP(float, WS_SSX), 1.0f / DM, EPS}; GEMM(pg8::EpiBf16RowNorm, E, F.x, DM, wl + OFF_WMQ, DM, DM, MTOK / 256, 2, 1, 0); }
        SEAM(pb + 7);
        if (ON(8) && IN(pb + 8)) REP(8) if (refresh(F), true) phase_attn_mem(F, l);
        SEAM(pb + 8);
        if (ON(9) && IN(pb + 9)) REP(9) if (refresh(F), true) { pg8::EpiResidual E{F.x, DM, rep_ ? 0.f : 1.f}; GEMM(pg8::EpiResidual, E, WSP(bf16, WS_OMEM), 512, wl + OFF_WMO, 512, 512, MTOK / 256, 4, 1, 0); }
        SEAM(pb + 9);
        if (ON(10) && IN(pb + 10)) REP(10) if (refresh(F), true) phase_router(F, l);
        SEAM(pb + 10);
        if (ON(11) && IN(pb + 11)) REP(11) if (refresh(F), true) phase_select(F, args, l);
        SEAM(pb + 11);
        if (ON(13) && IN(pb + 13)) REP(13) if (refresh(F), true) { pg8::EpiSwiGLU E{WSP(bf16, WS_ACT), EFF, WSP(float, WS_RG)};
            const pg8::Gemm g_{F.x, WSP(bf16, (l & 1) ? WS_WGU2 : WS_WGU), DM, DM, DM, 16, 1 << 30, (size_t)(1024 * 1024), WSP(int, WS_IDX), nullptr};
            pg8::StaticOrder S_; S_.init(MOE_ROWS / 256, 4, F.G, (int)blockIdx.x); pg8::gemm_phase<pg8::EpiSwiGLU, pg8::StaticOrder, true, true>(F.lds, g_, S_, E, F.lds + GTAB_OFF); }
        SEAM(pb + 13);
        if (ON(14) && IN(pb + 14)) REP(14) if (refresh(F), true) { pg8::EpiBf16 E{WSP(bf16, WS_Y), DM, 1.0f, nullptr, nullptr, 0.f, 0.f}; GEMM(pg8::EpiBf16, E, WSP(bf16, WS_ACT), EFF, WSP(bf16, (l & 1) ? WS_WD2 : WS_WD), EFF, EFF, MOE_ROWS / 256, 4, 16, 1024 * 512); }
        SEAM(pb + 14);
        if (ON(15) && IN(pb + 15)) REP(15) if (refresh(F), true) phase_combine(F, args, l, (rep_ && l < DEPTH - 1) ? 0.f : 1.f);
        SEAM(pb + 15);
    }
#undef IN
#undef SEAM
#undef GEMM
}

extern "C" void kernel_launch(void* const* d_in, const int* in_sizes, int n_in, void* d_out, int out_size, void* d_ws, size_t ws_size, hipStream_t stream) {
    static int grid = 0;
    if (grid == 0) {
        if (n_in != 24 || out_size != MTOK * DM || ws_size < WS_END) { fprintf(stderr, "kernel_launch: unexpected shapes: n_in %d out %d ws %zu (need %zu)\n", n_in, out_size, ws_size, (size_t)WS_END); grid = -1; return; }
        int dev = 0, cus = 0, per_cu = 0;
        if (hipGetDevice(&dev) != hipSuccess || hipDeviceGetAttribute(&cus, hipDeviceAttributeMultiprocessorCount, dev) != hipSuccess) { grid = -1; return; }
        if (hipFuncSetAttribute((const void*)enc_fwd, hipFuncAttributeMaxDynamicSharedMemorySize, LDS_BYTES) != hipSuccess) { fprintf(stderr, "kernel_launch: hipFuncSetAttribute failed\n"); grid = -1; return; }
        if (hipOccupancyMaxActiveBlocksPerMultiprocessor(&per_cu, (const void*)enc_fwd, NWAVES * 64, LDS_BYTES) != hipSuccess || per_cu < 1)
            fprintf(stderr, "kernel_launch: occupancy query reports %d workgroups per CU\n", per_cu);
        (void)hipGetLastError();
        grid = cus;
        fprintf(stderr, "kernel_launch: grid %d, ws %zu bytes\n", grid, ws_size);
    }
    if (grid < 0) return;
    (void)hipMemsetAsync((char*)d_ws + WS_CTL, 0, CTL_ZERO_BYTES, stream);
    Args a{};
    for (int i = 0; i < 24; ++i) a.in[i] = (const float*)d_in[i];
    a.out = (float*)d_out; a.ws = (unsigned char*)d_ws;
#if MK_N_LAUNCHES == 1
    a.ph_lo = 0; a.ph_hi = NPH;
    hipLaunchKernelGGL(enc_fwd, dim3(grid), dim3(NWAVES * 64), LDS_BYTES, stream, a);
#else
    for (int p = 0; p < NPH; ++p) { a.ph_lo = p; a.ph_hi = p + 1; hipLaunchKernelGGL(enc_fwd, dim3(grid), dim3(NWAVES * 64), LDS_BYTES, stream, a); }
#endif
    const hipError_t le = hipPeekAtLastError();
    if (le != hipSuccess) fprintf(stderr, "kernel_launch: launch failed: %s\n", hipGetErrorName(le));
}
```

```cpp
#include <hip/hip_runtime.h>
#include <cstdio>
#include <cstdint>

namespace pg8 {
#define PG8_LAS __attribute__((address_space(3)))
typedef unsigned short bf16_t;
typedef short bf16x8 __attribute__((ext_vector_type(8)));
typedef float f32x4 __attribute__((ext_vector_type(4)));
typedef unsigned u32x4 __attribute__((ext_vector_type(4)));
constexpr int BM = 256, BK = 64, HALF = 128, HTB = HALF * BK * 2  , STAGE_BYTES = 8 * HTB, NXCD = 8, WGM = 8;

__host__ __device__ __forceinline__ int lds_byte(int r, int c) { const int st = (r >> 4) * 2 + (c >> 5), rr = r & 15, cc = c & 31, ob = rr * 64 + cc * 2; return st * 1024 + (ob ^ (((ob >> 9) & 1) << 5)); }
__host__ __device__ __forceinline__ void stage_rc(int b, int& R, int& C) { const int st = b / 1024, sb = b % 1024, swz = sb ^ (((sb >> 9) & 1) << 5); R = (st >> 1) * 16 + swz / 64; C = (st & 1) * 32 + (swz % 64) / 2; }
__host__ __device__ __forceinline__ int perm32(int rho) { const int n = rho >> 4, i = rho & 15; return 8 * (i >> 2) + 4 * n + (i & 3); }

struct Unit { int pm, pn; };
struct Gemm { const bf16_t* A; const bf16_t* Bt; int lda, ldb, K, gdiv, amod; size_t gstride; const int* idx; const float* ss; };

struct StaticOrder {
    int nM, nN, nwg, G, c;
    __host__ __device__ void init(int nM_, int nN_, int G_, int c_) { nM = nM_; nN = nN_; nwg = nM * nN; G = G_; c = c_; }
    __host__ __device__ bool next(int i, Unit& u) const {
        const long L = (long)i * G + c; if (L >= nwg) return false;
        int wgid = (int)L; { const int q = nwg / NXCD, r = nwg % NXCD, xcd = wgid % NXCD, off = wgid / NXCD; wgid = (xcd < r ? xcd * (q + 1) : r * (q + 1) + (xcd - r) * q) + off; }
        const int nig = WGM * nN, gid = wgid / nig, fm = gid * WGM, gsz = (nM - fm) < WGM ? (nM - fm) : WGM;
        u.pm = fm + ((wgid % nig) % gsz); u.pn = (wgid % nig) / gsz; return true;
    }
};

template <int NN, int PN0, int KH, int KL> struct SplitOrder {
    int nM, G, c;
    __host__ __device__ void init(int nM_, int G_, int c_) { nM = nM_; G = G_; c = c_; }
    __host__ __device__ bool next(int i, Unit& u) const {
        const int nwg = nM * NN; long L;
        if (KH == 0 || G != 256) L = (long)i * G + c;
        else if (c < 128) { if (i >= KH) return false; L = (long)i * 128 + c; }
        else { if (i >= KL) return false; L = 128L * KH + (long)i * 128 + (c - 128); }
        if (L >= nwg) return false;
        int wgid = (int)L; { const int q = nwg / NXCD, r = nwg % NXCD, xcd = wgid % NXCD, off = wgid / NXCD; wgid = (xcd < r ? xcd * (q + 1) : r * (q + 1) + (xcd - r) * q) + off; }
        const int nig = WGM * NN, gid = wgid / nig, fm = gid * WGM, gsz = (nM - fm) < WGM ? (nM - fm) : WGM;
        u.pm = fm + ((wgid % nig) % gsz); u.pn = PN0 + (wgid % nig) / gsz; return true;
    }
};

struct LinearOrder {
    int nM, nN, G, c, per;
    __host__ __device__ void init(int nM_, int nN_, int G_, int c_, int per_) { nM = nM_; nN = nN_; G = G_; c = c_; per = per_; }
    __host__ __device__ bool next(int i, Unit& u) const { const int idx = (c + (i / per) * G) * per + (i % per); if (idx >= nM * nN) return false; u.pm = idx / nN; u.pn = idx % nN; return true; }
};

__device__ __forceinline__ unsigned cvt_pk_bf16(float lo, float hi) { unsigned r; asm volatile("v_cvt_pk_bf16_f32 %0, %1, %2" : "=v"(r) : "v"(lo), "v"(hi)); return r; }

struct EpiBf16 {
    static constexpr bool PERM = true;
    bf16_t* O; int ldc; float scale; const float* rs; const float* ssl; float ssl_inv, ssl_eps;
    __device__ __forceinline__ void operator()(const f32x4 (&acc)[2][2][4][2], const Unit& u, int wr, int wc, int fr, int fq) const {
        const int row0 = u.pm * BM + wr * 64 + fr, col0 = u.pn * BM + wc * 32 + 8 * fq;
#pragma unroll
        for (int ai = 0; ai < 2; ++ai)
#pragma unroll
            for (int m = 0; m < 4; ++m) { const int row = row0 + ai * HALF + m * 16; bf16_t* rowp = O + (size_t)row * ldc + col0; float sc = rs ? scale * rs[row] : scale;
                if (ssl) { const f32x4 q_ = *(const f32x4*)(ssl + (size_t)row * 8); sc *= __builtin_amdgcn_rsqf(((q_[0] + q_[1]) + (q_[2] + q_[3])) * ssl_inv + ssl_eps); }
#pragma unroll
                for (int bj = 0; bj < 2; ++bj) { const f32x4 v0 = acc[ai][bj][m][0] * sc, v1 = acc[ai][bj][m][1] * sc;
                    u32x4 w; w.x = cvt_pk_bf16(v0[0], v0[1]); w.y = cvt_pk_bf16(v0[2], v0[3]); w.z = cvt_pk_bf16(v1[0], v1[1]); w.w = cvt_pk_bf16(v1[2], v1[3]);
                    *(u32x4*)(rowp + bj * HALF) = w; } }
    }
};
struct EpiQmRope {
    static constexpr bool PERM = true;
    bf16_t* O; int ldc; float scale; const float* tab; const float* ssl; float ssl_inv, ssl_eps;
    __device__ __forceinline__ void operator()(const f32x4 (&acc)[2][2][4][2], const Unit& u, int wr, int wc, int fr, int fq) const {
        const int row0 = u.pm * BM + wr * 64 + fr, col0 = u.pn * BM + wc * 32 + 8 * fq;
        const bool rope = (u.pn == 2);
        const int j0 = (8 * fq) >> 1;
#pragma unroll
        for (int ai = 0; ai < 2; ++ai)
#pragma unroll
            for (int m = 0; m < 4; ++m) { const int row = row0 + ai * HALF + m * 16; bf16_t* rowp = O + (size_t)row * ldc + col0; const int s = row & 4095;
                const f32x4 q_ = *(const f32x4*)(ssl + (size_t)row * 8); const float sc_ = scale * __builtin_amdgcn_rsqf(((q_[0] + q_[1]) + (q_[2] + q_[3])) * ssl_inv + ssl_eps);
                f32x4 t0 = (f32x4){1.f, 0.f, 1.f, 0.f}, t1 = (f32x4){1.f, 0.f, 1.f, 0.f};
                if (rope) { t0 = *(const f32x4*)(tab + ((size_t)s * 16 + j0) * 2); t1 = *(const f32x4*)(tab + ((size_t)s * 16 + j0 + 2) * 2); }
#pragma unroll
                for (int bj = 0; bj < 2; ++bj) { const f32x4 v0 = acc[ai][bj][m][0], v1 = acc[ai][bj][m][1];
                    f32x4 r0, r1;
                    r0[0] = v0[0] * t0[0] - v0[1] * t0[1]; r0[1] = v0[1] * t0[0] + v0[0] * t0[1];
                    r0[2] = v0[2] * t0[2] - v0[3] * t0[3]; r0[3] = v0[3] * t0[2] + v0[2] * t0[3];
                    r1[0] = v1[0] * t1[0] - v1[1] * t1[1]; r1[1] = v1[1] * t1[0] + v1[0] * t1[1];
                    r1[2] = v1[2] * t1[2] - v1[3] * t1[3]; r1[3] = v1[3] * t1[2] + v1[2] * t1[3];
                    r0 = r0 * sc_; r1 = r1 * sc_;
                    u32x4 w; w.x = cvt_pk_bf16(r0[0], r0[1]); w.y = cvt_pk_bf16(r0[2], r0[3]); w.z = cvt_pk_bf16(r1[0], r1[1]); w.w = cvt_pk_bf16(r1[2], r1[3]);
                    *(u32x4*)(rowp + bj * HALF) = w; }
                asm volatile("" ::: "memory"); }
    }
};
struct EpiBf16RowNorm {
    static constexpr bool PERM = true;
    bf16_t* O; int ldc; float scale; const float* ss; float inv_n, eps;
    __device__ __forceinline__ void operator()(const f32x4 (&acc)[2][2][4][2], const Unit& u, int wr, int wc, int fr, int fq) const {
        const int row0 = u.pm * BM + wr * 64 + fr, col0 = u.pn * BM + wc * 32 + 8 * fq;
#pragma unroll
        for (int ai = 0; ai < 2; ++ai)
#pragma unroll
            for (int m = 0; m < 4; ++m) { const int row = row0 + ai * HALF + m * 16; bf16_t* rowp = O + (size_t)row * ldc + col0;
                const f32x4 q0 = *(const f32x4*)(ss + (size_t)row * 16), q1 = *(const f32x4*)(ss + (size_t)row * 16 + 4), q2 = *(const f32x4*)(ss + (size_t)row * 16 + 8), q3 = *(const f32x4*)(ss + (size_t)row * 16 + 12);
                const float tot = ((((q0[0] + q0[1]) + (q0[2] + q0[3])) + ((q1[0] + q1[1]) + (q1[2] + q1[3]))) + (((q2[0] + q2[1]) + (q2[2] + q2[3])) + ((q3[0] + q3[1]) + (q3[2] + q3[3]))));
                const float sc = scale * __builtin_amdgcn_rsqf(tot * inv_n + eps);
#pragma unroll
                for (int bj = 0; bj < 2; ++bj) { const f32x4 v0 = acc[ai][bj][m][0] * sc, v1 = acc[ai][bj][m][1] * sc;
                    u32x4 w; w.x = cvt_pk_bf16(v0[0], v0[1]); w.y = cvt_pk_bf16(v0[2], v0[3]); w.z = cvt_pk_bf16(v1[0], v1[1]); w.w = cvt_pk_bf16(v1[2], v1[3]);
                    *(u32x4*)(rowp + bj * HALF) = w; } }
    }
};
__device__ __forceinline__ float bf_lo(unsigned w) { return __uint_as_float(w << 16); }
__device__ __forceinline__ float bf_hi(unsigned w) { return __uint_as_float(w & 0xffff0000u); }
struct EpiResidualX {
    static constexpr bool PERM = true;
    bf16_t* X; float* SSX; int ldc; float inv_n, eps, mul;
    __device__ __forceinline__ void operator()(const f32x4 (&acc)[2][2][4][2], const Unit& u, int wr, int wc, int fr, int fq, const PG8_LAS float* tab) const {
        const int rl0 = wr * 64 + fr, col0 = u.pn * BM + wc * 32 + 8 * fq;
#pragma unroll
        for (int ai = 0; ai < 2; ++ai)
#pragma unroll
            for (int m = 0; m < 4; ++m) { const int rl = rl0 + ai * HALF + m * 16, row = u.pm * BM + rl; bf16_t* rowp = X + (size_t)row * ldc + col0;
                const float rm = mul * __builtin_amdgcn_rsqf((tab[rl * 4 + 2] + tab[rl * 4 + 3]) * inv_n + eps);
                u32x4 xv[2]; float s = 0.f;
#pragma unroll
                for (int bj = 0; bj < 2; ++bj) xv[bj] = *(const u32x4*)(rowp + bj * HALF);
#pragma unroll
                for (int bj = 0; bj < 2; ++bj) { const f32x4 a0 = acc[ai][bj][m][0] * rm, a1 = acc[ai][bj][m][1] * rm; u32x4 w;
                    w.x = cvt_pk_bf16(bf_lo(xv[bj].x) + a0[0], bf_hi(xv[bj].x) + a0[1]); w.y = cvt_pk_bf16(bf_lo(xv[bj].y) + a0[2], bf_hi(xv[bj].y) + a0[3]);
                    w.z = cvt_pk_bf16(bf_lo(xv[bj].z) + a1[0], bf_hi(xv[bj].z) + a1[1]); w.w = cvt_pk_bf16(bf_lo(xv[bj].w) + a1[2], bf_hi(xv[bj].w) + a1[3]);
                    *(u32x4*)(rowp + bj * HALF) = w;
                    const float r0 = bf_lo(w.x), r1 = bf_hi(w.x), r2 = bf_lo(w.y), r3 = bf_hi(w.y), r4 = bf_lo(w.z), r5 = bf_hi(w.z), r6 = bf_lo(w.w), r7 = bf_hi(w.w);
                    s += ((r0 * r0 + r1 * r1) + (r2 * r2 + r3 * r3)) + ((r4 * r4 + r5 * r5) + (r6 * r6 + r7 * r7)); }
                s += __shfl_xor(s, 16); s += __shfl_xor(s, 32);
                if (fq == 0) SSX[(size_t)row * 16 + u.pn * 4 + wc] = s;
                if (m & 1) asm volatile("" ::: "memory"); }
    }
};
struct EpiResidual {
    static constexpr bool PERM = true;
    bf16_t* X; int ldc; float mul;
    __device__ __forceinline__ void operator()(const f32x4 (&acc)[2][2][4][2], const Unit& u, int wr, int wc, int fr, int fq) const {
        const int row0 = u.pm * BM + wr * 64 + fr, col0 = u.pn * BM + wc * 32 + 8 * fq;
#pragma unroll
        for (int ai = 0; ai < 2; ++ai)
#pragma unroll
            for (int m = 0; m < 4; ++m) { bf16_t* rowp = X + (size_t)(row0 + ai * HALF + m * 16) * ldc + col0;
                u32x4 xv[2];
#pragma unroll
                for (int bj = 0; bj < 2; ++bj) xv[bj] = *(const u32x4*)(rowp + bj * HALF);
#pragma unroll
                for (int bj = 0; bj < 2; ++bj) { const f32x4 a0 = acc[ai][bj][m][0] * mul, a1 = acc[ai][bj][m][1] * mul; u32x4 w;
                    w.x = cvt_pk_bf16(bf_lo(xv[bj].x) + a0[0], bf_hi(xv[bj].x) + a0[1]); w.y = cvt_pk_bf16(bf_lo(xv[bj].y) + a0[2], bf_hi(xv[bj].y) + a0[3]);
                    w.z = cvt_pk_bf16(bf_lo(xv[bj].z) + a1[0], bf_hi(xv[bj].z) + a1[1]); w.w = cvt_pk_bf16(bf_lo(xv[bj].w) + a1[2], bf_hi(xv[bj].w) + a1[3]);
                    *(u32x4*)(rowp + bj * HALF) = w; } }
    }
};
struct EpiInProj {
    static constexpr bool PERM = true;
    const float* rs; const float* gq; const float* gk; const float* tabg; const float* tabm;
    bf16_t* QG; bf16_t* KG; bf16_t* VG; bf16_t* LAT; bf16_t* KROPE; float* SSL; float qscale, eps;
    __device__ __forceinline__ static void rope2(f32x4& v, const f32x4 t) { const float a0 = v[0], b0 = v[1], a1 = v[2], b1 = v[3];
        v[0] = a0 * t[0] - b0 * t[1]; v[1] = b0 * t[0] + a0 * t[1]; v[2] = a1 * t[2] - b1 * t[3]; v[3] = b1 * t[2] + a1 * t[3]; }
    __device__ __forceinline__ static u32x4 pack(const f32x4 a, const f32x4 b) { u32x4 w; w.x = cvt_pk_bf16(a[0], a[1]); w.y = cvt_pk_bf16(a[2], a[3]); w.z = cvt_pk_bf16(b[0], b[1]); w.w = cvt_pk_bf16(b[2], b[3]); return w; }
    __device__ __forceinline__ void operator()(const f32x4 (&acc)[2][2][4][2], const Unit& u, int wr, int wc, int fr, int fq) const {
        const int row0 = u.pm * BM + wr * 64 + fr;
        if (u.pn < 2 || (u.pn == 2 && wc < 2)) {
            const bool isq = u.pn < 2; const float* g = isq ? gq : gk; bf16_t* dst = isq ? QG : KG; const int ld = isq ? 512 : 128, hcol = (isq ? (u.pn * 4 + wc) : wc) * 64; const float osc = isq ? qscale : 1.0f;
            f32x4 gv[2][2];
#pragma unroll
            for (int bj = 0; bj < 2; ++bj)
#pragma unroll
                for (int n = 0; n < 2; ++n)
#pragma unroll
                    for (int i = 0; i < 4; ++i) { const int p = 32 * bj + 8 * fq + 4 * n + i; gv[bj][n][i] = g[(p >> 1) + 32 * (p & 1)]; }
#pragma unroll
            for (int ai = 0; ai < 2; ++ai)
#pragma unroll
                for (int m = 0; m < 4; ++m) { const int row = row0 + ai * HALF + m * 16, s = row & 4095; const float sc = rs[row];
                    f32x4 v[2][2]; float ss = 0.f;
#pragma unroll
                    for (int bj = 0; bj < 2; ++bj)
#pragma unroll
                        for (int n = 0; n < 2; ++n) { v[bj][n] = acc[ai][bj][m][n] * sc; ss += (v[bj][n][0] * v[bj][n][0] + v[bj][n][1] * v[bj][n][1]) + (v[bj][n][2] * v[bj][n][2] + v[bj][n][3] * v[bj][n][3]); }
                    ss += __shfl_xor(ss, 16); ss += __shfl_xor(ss, 32);
                    const float rstd = __builtin_amdgcn_rsqf(ss * (1.0f / 64.0f) + eps);
#pragma unroll
                    for (int bj = 0; bj < 2; ++bj) {
#pragma unroll
                        for (int n = 0; n < 2; ++n) { v[bj][n] = v[bj][n] * rstd * gv[bj][n];
                            const f32x4 t = *(const f32x4*)(tabg + ((size_t)s * 32 + 16 * bj + 4 * fq + 2 * n) * 2); rope2(v[bj][n], t); v[bj][n] = v[bj][n] * osc; }
                        *(u32x4*)(dst + (size_t)row * ld + hcol + 32 * bj + 8 * fq) = pack(v[bj][0], v[bj][1]); } }
        } else if (u.pn == 2) {
#pragma unroll
            for (int ai = 0; ai < 2; ++ai)
#pragma unroll
                for (int m = 0; m < 4; ++m) { const int row = row0 + ai * HALF + m * 16; const float sc = rs[row];
#pragma unroll
                    for (int bj = 0; bj < 2; ++bj) *(u32x4*)(VG + (size_t)row * 128 + (wc - 2) * 64 + 32 * bj + 8 * fq) = pack(acc[ai][bj][m][0] * sc, acc[ai][bj][m][1] * sc); }
        } else if (u.pn == 3) {
#pragma unroll
            for (int ai = 0; ai < 2; ++ai)
#pragma unroll
                for (int m = 0; m < 4; ++m) { const int row = row0 + ai * HALF + m * 16; const float sc = rs[row]; float ss = 0.f;
#pragma unroll
                    for (int bj = 0; bj < 2; ++bj) { const f32x4 a = acc[ai][bj][m][0] * sc, b = acc[ai][bj][m][1] * sc;
                        ss += ((a[0] * a[0] + a[1] * a[1]) + (a[2] * a[2] + a[3] * a[3])) + ((b[0] * b[0] + b[1] * b[1]) + (b[2] * b[2] + b[3] * b[3]));
                        *(u32x4*)(LAT + (size_t)row * 512 + 128 * bj + 32 * wc + 8 * fq) = pack(a, b); }
                    ss += __shfl_xor(ss, 16); ss += __shfl_xor(ss, 32);
                    if (fq == 0) SSL[(size_t)row * 8 + wc] = ss; }
        } else {
#pragma unroll
            for (int ai = 0; ai < 2; ++ai)
#pragma unroll
                for (int m = 0; m < 4; ++m) { const int row = row0 + ai * HALF + m * 16, s = row & 4095; const float sc = rs[row];
                    const f32x4 a = acc[ai][0][m][0] * sc, b = acc[ai][0][m][1] * sc;
                    float ss = ((a[0] * a[0] + a[1] * a[1]) + (a[2] * a[2] + a[3] * a[3])) + ((b[0] * b[0] + b[1] * b[1]) + (b[2] * b[2] + b[3] * b[3]));
                    *(u32x4*)(LAT + (size_t)row * 512 + 256 + 32 * wc + 8 * fq) = pack(a, b);
                    ss += __shfl_xor(ss, 16); ss += __shfl_xor(ss, 32);
                    if (fq == 0) SSL[(size_t)row * 8 + 4 + wc] = ss;
                    if (wc == 0) { f32x4 c = acc[ai][1][m][0] * sc, d = acc[ai][1][m][1] * sc;
                        rope2(c, *(const f32x4*)(tabm + ((size_t)s * 16 + 4 * fq) * 2)); rope2(d, *(const f32x4*)(tabm + ((size_t)s * 16 + 4 * fq + 2) * 2));
                        *(u32x4*)(KROPE + (size_t)row * 32 + 8 * fq) = pack(c, d); } }
        }
    }
};
struct EpiSwiGLU {
    static constexpr bool PERM = true;
    bf16_t* O; int ldc; const float* rs;
    __device__ __forceinline__ static float silu_mul(float g, float u) { return g * u * __builtin_amdgcn_rcpf(1.0f + __builtin_amdgcn_exp2f(-1.4426950408889634f * g)); }
    __device__ __forceinline__ void operator()(const f32x4 (&acc)[2][2][4][2], const Unit& u, int wr, int wc, int fr, int fq) const {
        const int row0 = u.pm * BM + wr * 64 + fr, col0 = u.pn * HALF + wc * 32 + 8 * fq;
#pragma unroll
        for (int ai = 0; ai < 2; ++ai)
#pragma unroll
            for (int m = 0; m < 4; ++m) { const int row = row0 + ai * HALF + m * 16; bf16_t* rowp = O + (size_t)row * ldc + col0; const float sc = rs[row];
                const f32x4 g0 = acc[ai][0][m][0] * sc, g1 = acc[ai][0][m][1] * sc, u0 = acc[ai][1][m][0] * sc, u1 = acc[ai][1][m][1] * sc;
                u32x4 w; w.x = cvt_pk_bf16(silu_mul(g0[0], u0[0]), silu_mul(g0[1], u0[1])); w.y = cvt_pk_bf16(silu_mul(g0[2], u0[2]), silu_mul(g0[3], u0[3]));
                w.z = cvt_pk_bf16(silu_mul(g1[0], u1[0]), silu_mul(g1[1], u1[1])); w.w = cvt_pk_bf16(silu_mul(g1[2], u1[2]), silu_mul(g1[3], u1[3]));
                *(u32x4*)rowp = w; }
    }
};

template <class Epi, class Sched, bool ALIGN_EPI = false, bool GATHER = false, bool MIDSCALE = false>
__device__ __forceinline__ void gemm_phase(PG8_LAS unsigned char* lds, const Gemm g, const Sched& S, const Epi& E, PG8_LAS unsigned char* gtab = nullptr, float ms_inv_n = 0.f, float ms_eps = 0.f) {
    int tid_ = threadIdx.x; asm volatile("" : "+v"(tid_));
    const int tid = tid_, wid = __builtin_amdgcn_readfirstlane(tid >> 6), lane = tid & 63, wr = wid >> 2, wc = wid & 3, fr = lane & 15, fq = lane >> 4;
    const int K = g.K, nt = K / BK;
    unsigned voffA[2], voffB[2]; int gR[2], gC[2];
#pragma unroll
    for (int i = 0; i < 2; ++i) { int R, C; stage_rc(tid * 16 + i * 8192, R, C); const int Rb = Epi::PERM ? ((R & ~31) + perm32(R & 31)) : R; gR[i] = R; gC[i] = C;
        voffA[i] = (unsigned)(R * g.lda + C) * 2u; voffB[i] = (unsigned)(Rb * g.ldb + C) * 2u; }
    unsigned goffc[2][2], goffn[2][2];
#define PG8_GISSUE(u) do { _Pragma("unroll") for (int h_ = 0; h_ < 2; ++h_) _Pragma("unroll") for (int i_ = 0; i_ < 2; ++i_) \
        __builtin_amdgcn_global_load_lds((const unsigned*)(g.idx + (u).pm * BM + h_ * HALF + gR[i_]), (PG8_LAS unsigned*)(gtab + ((h_ * 2 + i_) * 8 + wid) * 256), 4, 0, 0); } while (0)
#define PG8_GREAD(dst, u) do { asm volatile("" ::: "memory"); _Pragma("unroll") for (int h_ = 0; h_ < 2; ++h_) _Pragma("unroll") for (int i_ = 0; i_ < 2; ++i_) { \
        const int tok_ = *(const PG8_LAS int*)(gtab + ((h_ * 2 + i_) * 8 + wid) * 256 + lane * 4); \
        dst[h_][i_] = (unsigned)(((((u).pm >> 1) & 7) * 4096 + tok_) * g.lda + gC[i_]) * 2u; } } while (0)
    const size_t kstep = (size_t)(BK * 2);
    const size_t hstepA = (size_t)HALF * g.lda * 2, hstepB = (size_t)HALF * g.ldb * 2;
    const size_t tstepA = 2 * hstepA, tstepB = 2 * hstepB;
    const unsigned ldsw = (unsigned)wid * 1024u;
    const int aoff = lds_byte(wr * 64 + fr, fq * 8), boff = lds_byte(wc * 32 + fr, fq * 8);
#define PG8_SA(b, h) (((b) * 2 + (h)) * HTB)
#define PG8_SB(b, h) ((4 + (b) * 2 + (h)) * HTB)
#define PG8_STAGE(bufoff, gbase, voff) do { _Pragma("unroll") for (int _i = 0; _i < 2; ++_i) \
        __builtin_amdgcn_global_load_lds((const unsigned*)((const char*)(gbase) + (voff)[_i]), (PG8_LAS unsigned*)(lds + (bufoff) + ldsw + _i * 8192), 16, 0, 0); } while (0)
#define PG8_LDA(dst, b, h) do { _Pragma("unroll") for (int m = 0; m < 4; ++m) _Pragma("unroll") for (int k = 0; k < 2; ++k) dst[m][k] = *(const PG8_LAS bf16x8*)(lds + PG8_SA(b, h) + aoff + m * 2048 + k * 1024); } while (0)
#define PG8_LDB(dst, b, h) do { _Pragma("unroll") for (int n = 0; n < 2; ++n) _Pragma("unroll") for (int k = 0; k < 2; ++k) dst[n][k] = *(const PG8_LAS bf16x8*)(lds + PG8_SB(b, h) + boff + n * 2048 + k * 1024); } while (0)
#define PG8_MMA(ai, bj, At, Bt) do { __builtin_amdgcn_s_setprio(1); _Pragma("unroll") for (int m = 0; m < 4; ++m) _Pragma("unroll") for (int n = 0; n < 2; ++n) _Pragma("unroll") for (int k = 0; k < 2; ++k) \
        acc[ai][bj][m][n] = __builtin_amdgcn_mfma_f32_16x16x32_bf16(Bt[n][k], At[m][k], acc[ai][bj][m][n], 0, 0, 0); __builtin_amdgcn_s_setprio(0); } while (0)
#define PG8_WAIT_V(n) asm volatile("s_waitcnt vmcnt(" #n ")" ::: "memory")
#define PG8_WAIT_L(n) asm volatile("s_waitcnt lgkmcnt(" #n ")" ::: "memory")
#define PG8_BAR __builtin_amdgcn_s_barrier()
#define PG8_SCHED __builtin_amdgcn_sched_barrier(0)
#define PG8_ABASE(u) (GATHER ? (const char*)g.A : (const char*)g.A + (size_t)((u).pm % g.amod) * tstepA)
#define PG8_STA(bufoff, kptr, h, nx) do { if constexpr (GATHER) { unsigned o_[2]; o_[0] = (nx) ? goffn[h][0] : goffc[h][0]; o_[1] = (nx) ? goffn[h][1] : goffc[h][1]; PG8_STAGE(bufoff, kptr, o_); } \
        else { PG8_STAGE(bufoff, (kptr) + (h) * hstepA, voffA); } } while (0)
#define PG8_BBASE(u) ((const char*)g.Bt + ((size_t)((u).pm / g.gdiv) * g.gstride) * 2 + (size_t)(u).pn * tstepB)
    Unit cur, nxt; int ui = 0;
    if (!S.next(0, cur)) return;
    f32x4 acc[2][2][4][2];
#pragma unroll
    for (int a = 0; a < 2; ++a)
#pragma unroll
        for (int b = 0; b < 2; ++b)
#pragma unroll
            for (int m = 0; m < 4; ++m)
#pragma unroll
                for (int n = 0; n < 2; ++n) acc[a][b][m][n] = (f32x4){0.f, 0.f, 0.f, 0.f};
    bf16x8 At[4][2], B0[2][2], B1[2][2];
    const char* cA = PG8_ABASE(cur); const char* cB = PG8_BBASE(cur);
    if constexpr (GATHER) { PG8_GISSUE(cur); PG8_WAIT_V(0); PG8_GREAD(goffc, cur);
#pragma unroll
        for (int h_ = 0; h_ < 2; ++h_) { goffn[h_][0] = goffc[h_][0]; goffn[h_][1] = goffc[h_][1]; } }
    PG8_STAGE(PG8_SB(0, 0), cB, voffB); PG8_STAGE(PG8_SB(0, 1), cB + hstepB, voffB); PG8_STA(PG8_SA(0, 0), cA, 0, false); PG8_STA(PG8_SA(0, 1), cA, 1, false);
    if (wr == 1) PG8_BAR;
    PG8_WAIT_V(2); PG8_BAR;
    PG8_STAGE(PG8_SB(1, 0), cB + kstep, voffB); PG8_STA(PG8_SA(1, 0), cA + kstep, 0, false); PG8_STAGE(PG8_SB(1, 1), cB + hstepB + kstep, voffB);
    PG8_WAIT_V(6); PG8_BAR;
    for (;;) {
        const bool has_next = S.next(ui + 1, nxt);
        const char* nA = has_next ? PG8_ABASE(nxt) : cA; const char* nB = has_next ? PG8_BBASE(nxt) : cB;
        if constexpr (GATHER) { if (has_next) PG8_GISSUE(nxt); }
        if constexpr (MIDSCALE) {
#pragma unroll
            for (int q_ = 0; q_ < 2; ++q_) __builtin_amdgcn_global_load_lds((const unsigned*)(g.ss + (size_t)cur.pm * 1024 + q_ * 512 + wid * 64 + lane), (PG8_LAS unsigned*)(gtab + (ui & 1) * 4096 + q_ * 2048 + wid * 256), 4, 0, 0); }
#pragma nounroll
        for (int t = 0; t < nt; t += 2) {
            const bool last = (t == nt - 2);
            const char* a1 = cA + (size_t)(t + 1) * kstep;
            const char* a2 = last ? nA : cA + (size_t)(t + 2) * kstep; const char* b2 = last ? nB : cB + (size_t)(t + 2) * kstep;
            const char* a3 = a2 + kstep; const char* b3 = b2 + kstep;
            if constexpr (GATHER) { if (last && has_next) PG8_GREAD(goffn, nxt); }
            if constexpr (MIDSCALE) { if (t == nt / 2) { asm volatile("" ::: "memory"); const PG8_LAS float* tab = (const PG8_LAS float*)(gtab + (ui & 1) * 4096);
#pragma unroll
                for (int ai = 0; ai < 2; ++ai)
#pragma unroll
                    for (int m = 0; m < 4; ++m) { const int rl = ai * HALF + wr * 64 + m * 16 + fr; const float sg = tab[rl * 4] + tab[rl * 4 + 1], sm = tab[rl * 4 + 2] + tab[rl * 4 + 3];
                        const float ratio = __builtin_amdgcn_rsqf(sg * ms_inv_n + ms_eps) * __builtin_amdgcn_rcpf(__builtin_amdgcn_rsqf(sm * ms_inv_n + ms_eps));
#pragma unroll
                        for (int bj = 0; bj < 2; ++bj)
#pragma unroll
                            for (int n = 0; n < 2; ++n) acc[ai][bj][m][n] = acc[ai][bj][m][n] * ratio; } } }
            PG8_LDB(B0, 0, 0); PG8_LDB(B1, 0, 1); PG8_SCHED; PG8_LDA(At, 0, 0); PG8_STA(PG8_SA(1, 1), a1, 1, false);
            PG8_WAIT_V(8); PG8_WAIT_L(0); PG8_BAR; PG8_MMA(0, 0, At, B0); PG8_MMA(0, 1, At, B1); PG8_BAR; PG8_SCHED;
            PG8_LDA(At, 0, 1); PG8_STAGE(PG8_SB(0, 0), b2, voffB); PG8_STAGE(PG8_SB(0, 1), b2 + hstepB, voffB); PG8_STA(PG8_SA(0, 0), a2, 0, last);
            PG8_WAIT_V(8); PG8_WAIT_L(0); PG8_BAR; PG8_MMA(1, 0, At, B0); PG8_MMA(1, 1, At, B1); PG8_BAR; PG8_SCHED;
            PG8_LDB(B0, 1, 0); PG8_LDB(B1, 1, 1); PG8_SCHED; PG8_LDA(At, 1, 0); PG8_STA(PG8_SA(0, 1), a2, 1, last);
            PG8_WAIT_V(8); PG8_WAIT_L(0); PG8_BAR; PG8_MMA(0, 0, At, B0); PG8_MMA(0, 1, At, B1); PG8_BAR; PG8_SCHED;
            PG8_LDA(At, 1, 1); PG8_STAGE(PG8_SB(1, 0), b3, voffB); PG8_STAGE(PG8_SB(1, 1), b3 + hstepB, voffB); PG8_STA(PG8_SA(1, 0), a3, 0, last);
            PG8_WAIT_V(8); PG8_WAIT_L(0); PG8_BAR; PG8_MMA(1, 0, At, B0); PG8_MMA(1, 1, At, B1); PG8_BAR; PG8_SCHED;
        }
        if constexpr (ALIGN_EPI) { if (wr == 0) PG8_BAR; }
        if constexpr (MIDSCALE) E(acc, cur, wr, wc, fr, fq, (const PG8_LAS float*)(gtab + (ui & 1) * 4096)); else E(acc, cur, wr, wc, fr, fq);
        if (!has_next) break;
#pragma unroll
        for (int a = 0; a < 2; ++a)
#pragma unroll
            for (int b = 0; b < 2; ++b)
#pragma unroll
                for (int m = 0; m < 4; ++m)
#pragma unroll
                    for (int n = 0; n < 2; ++n) acc[a][b][m][n] = (f32x4){0.f, 0.f, 0.f, 0.f};
        cur = nxt; cA = nA; cB = nB; ++ui;
        if constexpr (GATHER) {
#pragma unroll
            for (int h_ = 0; h_ < 2; ++h_) { goffc[h_][0] = goffn[h_][0]; goffc[h_][1] = goffn[h_][1]; } }
        if constexpr (ALIGN_EPI) { if (wr == 1) PG8_BAR; }
    }
    PG8_WAIT_V(0);
    if constexpr (!ALIGN_EPI) { if (wr == 0) PG8_BAR; }
    PG8_BAR;
#undef PG8_SA
#undef PG8_SB
#undef PG8_STAGE
#undef PG8_LDA
#undef PG8_LDB
#undef PG8_MMA
#undef PG8_WAIT_V
#undef PG8_WAIT_L
#undef PG8_BAR
#undef PG8_SCHED
#undef PG8_ABASE
#undef PG8_STA
#undef PG8_GISSUE
#undef PG8_GREAD
#undef PG8_BBASE
}
}
namespace att {
typedef unsigned short bf16;
using bf16x8 = __attribute__((ext_vector_type(8))) short;
using s16x4  = __attribute__((ext_vector_type(4))) short;
using f32x16 = __attribute__((ext_vector_type(16))) float;
using u32x4  = __attribute__((ext_vector_type(4))) unsigned;
#define ATT_SBAR() __builtin_amdgcn_sched_barrier(0)
constexpr int KCH = 1040;
constexpr float THR = 8.0f;
__device__ __forceinline__ int crow(int r, int hi) { return (r & 3) + 8 * (r >> 2) + 4 * hi; }
__device__ __forceinline__ unsigned cvtpk(float lo, float hi) { unsigned r; asm volatile("v_cvt_pk_bf16_f32 %0, %1, %2" : "=v"(r) : "v"(lo), "v"(hi)); return r; }
typedef float f32x2_t __attribute__((ext_vector_type(2))); typedef __bf16 bf16x2_t __attribute__((ext_vector_type(2)));
__device__ __forceinline__ unsigned cvtpk_c(float lo, float hi) { const f32x2_t v = {lo, hi}; const bf16x2_t b = __builtin_convertvector(v, bf16x2_t); return __builtin_bit_cast(unsigned, b); }
__device__ __forceinline__ unsigned short f2bf1(float f) { unsigned u = __builtin_bit_cast(unsigned, f); return (unsigned short)((u + 0x7fffu + ((u >> 16) & 1u)) >> 16); }

#define ATT_MX3(a, b, c) __builtin_fmaxf(__builtin_fmaxf((a), (b)), (c))
template <int MODE, bool FIRST>
__device__ __forceinline__ void partialSM(f32x16& p0, f32x16& p1, float& m_run, f32x16& negm, float& alpha) {
  if constexpr (MODE == 0) {
    float a = ATT_MX3(p0[0], p0[1], p1[0]), b = ATT_MX3(p0[2], p0[3], p1[1]); a = ATT_MX3(a, p1[2], p1[3]);
#pragma unroll
    for (int r = 4; r < 16; r += 4) { a = ATT_MX3(a, p0[r], p0[r + 1]); b = ATT_MX3(b, p0[r + 2], p0[r + 3]); a = ATT_MX3(a, p1[r], p1[r + 1]); b = ATT_MX3(b, p1[r + 2], p1[r + 3]); }
    float pmax = fmaxf(a, b);
    { auto rr = __builtin_amdgcn_permlane32_swap(__float_as_uint(pmax), __float_as_uint(pmax), false, false);
      pmax = fmaxf(__uint_as_float(rr[0]), __uint_as_float(rr[1])); }
    alpha = 1.f;
    if (FIRST || __builtin_expect(__any(pmax > THR), 0)) {
      const float dl = FIRST ? pmax : fmaxf(pmax, 0.f);
      m_run += dl;
#pragma unroll
      for (int r = 0; r < 16; ++r) { p0[r] -= dl; p1[r] -= dl; }
#pragma unroll
      for (int r = 0; r < 16; ++r) negm[r] = -m_run;
      asm volatile("" : "+v"(negm));
      alpha = FIRST ? 1.f : __builtin_amdgcn_exp2f(-dl);
    }
  } else { alpha = 1.f; }
#pragma unroll
  for (int r = 0; r < 16; ++r) p0[r] = __builtin_amdgcn_exp2f(p0[r]);
}
__device__ __forceinline__ void finishSM(f32x16& p0, f32x16& p1, float alpha, float& l_reg, bf16x8& pa0, bf16x8& pa1, bf16x8& pa2, bf16x8& pa3) {
#pragma unroll
  for (int r = 0; r < 16; ++r) p1[r] = __builtin_amdgcn_exp2f(p1[r]);
  float ps = 0;
#pragma unroll
  for (int r = 0; r < 16; ++r) ps += p0[r];
#pragma unroll
  for (int r = 0; r < 16; ++r) ps += p1[r];
  { auto rr = __builtin_amdgcn_permlane32_swap(__float_as_uint(ps), __float_as_uint(ps), false, false);
    ps = __uint_as_float(rr[0]) + __uint_as_float(rr[1]); }
  l_reg = l_reg * alpha + ps;
#define ATT_PK4(P, BASE, OUT) do { const u32x4 w = {cvtpk_c(P[BASE + 0], P[BASE + 1]), cvtpk_c(P[BASE + 2], P[BASE + 3]), cvtpk_c(P[BASE + 4], P[BASE + 5]), cvtpk_c(P[BASE + 6], P[BASE + 7])}; \
    OUT = __builtin_bit_cast(bf16x8, w); } while (0)
  ATT_PK4(p0, 0, pa0); ATT_PK4(p0, 8, pa1); ATT_PK4(p1, 0, pa2); ATT_PK4(p1, 8, pa3);
#undef ATT_PK4
}
template <int ND0, int MODE = 0>
__device__ __forceinline__ void qkt(f32x16& p0, f32x16& p1, const char* Ks, const bf16x8* qr, const f32x16& negm, int r32, int hi) {
#pragma unroll
  for (int d0 = 0; d0 < ND0; ++d0) {
    const char* kb = Ks + (2 * d0 + hi) * KCH + r32 * 16;
    bf16x8 b0 = *reinterpret_cast<const bf16x8*>(kb);
    bf16x8 b1 = *reinterpret_cast<const bf16x8*>(kb + 512);
    if (d0 == 0) { if constexpr (MODE == 1) { p0 = __builtin_amdgcn_mfma_f32_32x32x16_bf16(b0, qr[0], f32x16{}, 0, 0, 0); p1 = __builtin_amdgcn_mfma_f32_32x32x16_bf16(b1, qr[0], f32x16{}, 0, 0, 0); }
                   else { p0 = __builtin_amdgcn_mfma_f32_32x32x16_bf16(b0, qr[0], negm, 0, 0, 0); p1 = __builtin_amdgcn_mfma_f32_32x32x16_bf16(b1, qr[0], negm, 0, 0, 0); } }
    else { p0 = __builtin_amdgcn_mfma_f32_32x32x16_bf16(b0, qr[d0], p0, 0, 0, 0); p1 = __builtin_amdgcn_mfma_f32_32x32x16_bf16(b1, qr[d0], p1, 0, 0, 0); } }
}
template <int NB> __device__ __forceinline__ int v_st(int k, int c) { const int kk = k; return ((kk >> 3) * NB + (c >> 5)) * 512 + ((kk & 7) * 32 + (c & 31)) * 2; }
__device__ __forceinline__ int v_rd_base(int lane) { return ((lane & 3) << 3) | (((lane >> 2) & 3) << 6) | (((lane >> 4) & 1) << 5) | (((lane >> 5) & 1) << 8); }
template <int OFF> __device__ __forceinline__ s16x4 tr_read(int vb) {
  s16x4 r; asm volatile("ds_read_b64_tr_b16 %0, %1 offset:%2" : "=&v"(r) : "v"(vb), "i"(OFF) : "memory"); return r;
}
template <int NB, int D0> __device__ __forceinline__ void pv_one(f32x16& od, int vb, bf16x8 pa0, bf16x8 pa1, bf16x8 pa2, bf16x8 pa3) {
#define ATT_VO(ks, half) (D0 * 512 + (2 * (ks) + (half)) * NB * 512)
  const s16x4 l0 = tr_read<ATT_VO(0, 0)>(vb), h0 = tr_read<ATT_VO(0, 1)>(vb), l1 = tr_read<ATT_VO(1, 0)>(vb), h1 = tr_read<ATT_VO(1, 1)>(vb);
  const s16x4 l2 = tr_read<ATT_VO(2, 0)>(vb), h2 = tr_read<ATT_VO(2, 1)>(vb), l3 = tr_read<ATT_VO(3, 0)>(vb), h3 = tr_read<ATT_VO(3, 1)>(vb);
#undef ATT_VO
  asm volatile("s_waitcnt lgkmcnt(0)" ::: "memory"); ATT_SBAR();
#define ATT_PK(L, H) (bf16x8){L[0], L[1], L[2], L[3], H[0], H[1], H[2], H[3]}
  od = __builtin_amdgcn_mfma_f32_32x32x16_bf16(pa0, ATT_PK(l0, h0), od, 0, 0, 0);
  od = __builtin_amdgcn_mfma_f32_32x32x16_bf16(pa1, ATT_PK(l1, h1), od, 0, 0, 0);
  od = __builtin_amdgcn_mfma_f32_32x32x16_bf16(pa2, ATT_PK(l2, h2), od, 0, 0, 0);
  od = __builtin_amdgcn_mfma_f32_32x32x16_bf16(pa3, ATT_PK(l3, h3), od, 0, 0, 0);
#undef ATT_PK
}
template <int NB> __device__ __forceinline__ void pv_all(f32x16* o, int vb, bf16x8 pa0, bf16x8 pa1, bf16x8 pa2, bf16x8 pa3) {
  if constexpr (NB == 2) {
#define ATT_VO(d0, ks, half) ((d0) * 512 + (2 * (ks) + (half)) * NB * 512)
    const s16x4 l0 = tr_read<ATT_VO(0, 0, 0)>(vb), h0 = tr_read<ATT_VO(0, 0, 1)>(vb), l1 = tr_read<ATT_VO(0, 1, 0)>(vb), h1 = tr_read<ATT_VO(0, 1, 1)>(vb);
    const s16x4 l2 = tr_read<ATT_VO(0, 2, 0)>(vb), h2 = tr_read<ATT_VO(0, 2, 1)>(vb), l3 = tr_read<ATT_VO(0, 3, 0)>(vb), h3 = tr_read<ATT_VO(0, 3, 1)>(vb);
    const s16x4 m0 = tr_read<ATT_VO(1, 0, 0)>(vb), n0 = tr_read<ATT_VO(1, 0, 1)>(vb), m1 = tr_read<ATT_VO(1, 1, 0)>(vb), n1 = tr_read<ATT_VO(1, 1, 1)>(vb);
    const s16x4 m2 = tr_read<ATT_VO(1, 2, 0)>(vb), n2 = tr_read<ATT_VO(1, 2, 1)>(vb), m3 = tr_read<ATT_VO(1, 3, 0)>(vb), n3 = tr_read<ATT_VO(1, 3, 1)>(vb);
#undef ATT_VO
#define ATT_PK(L, H) (bf16x8){L[0], L[1], L[2], L[3], H[0], H[1], H[2], H[3]}
    asm volatile("s_waitcnt lgkmcnt(8)" ::: "memory"); ATT_SBAR();
    o[0] = __builtin_amdgcn_mfma_f32_32x32x16_bf16(pa0, ATT_PK(l0, h0), o[0], 0, 0, 0);
    o[0] = __builtin_amdgcn_mfma_f32_32x32x16_bf16(pa1, ATT_PK(l1, h1), o[0], 0, 0, 0);
    o[0] = __builtin_amdgcn_mfma_f32_32x32x16_bf16(pa2, ATT_PK(l2, h2), o[0], 0, 0, 0);
    o[0] = __builtin_amdgcn_mfma_f32_32x32x16_bf16(pa3, ATT_PK(l3, h3), o[0], 0, 0, 0);
    asm volatile("s_waitcnt lgkmcnt(0)" ::: "memory"); ATT_SBAR();
    o[1] = __builtin_amdgcn_mfma_f32_32x32x16_bf16(pa0, ATT_PK(m0, n0), o[1], 0, 0, 0);
    o[1] = __builtin_amdgcn_mfma_f32_32x32x16_bf16(pa1, ATT_PK(m1, n1), o[1], 0, 0, 0);
    o[1] = __builtin_amdgcn_mfma_f32_32x32x16_bf16(pa2, ATT_PK(m2, n2), o[1], 0, 0, 0);
    o[1] = __builtin_amdgcn_mfma_f32_32x32x16_bf16(pa3, ATT_PK(m3, n3), o[1], 0, 0, 0);
#undef ATT_PK
  } else {
    pv_one<NB, 0>(o[0], vb, pa0, pa1, pa2, pa3); pv_one<NB, 1>(o[1], vb, pa0, pa1, pa2, pa3);
    pv_one<NB, 2>(o[2], vb, pa0, pa1, pa2, pa3); pv_one<NB, 3>(o[3], vb, pa0, pa1, pa2, pa3);
  }
}

template <int W1, int W2, int DV> struct AttnCfg {
  static constexpr int DQK = W1 + W2, NCH = DQK / 8, ND0 = DQK / 16, NB = DV / 32;
  static constexpr int KT_BYTES = NCH * KCH, VT_BYTES = 64 * DV * 2;
  static constexpr int OST_BYTES = 32 * DV * 2;
  static constexpr bool OSTAGE = (DV == 64);
  static constexpr int LDS_BYTES = 3 * VT_BYTES + 3 * KT_BYTES + 8 * 64 * 4 + (OSTAGE ? 8 * OST_BYTES : 0);
  static constexpr int CW1 = W1 / 8, N1 = (64 * CW1) / 512;
  static constexpr int CWV = DV / 8, NV = (64 * CWV) / 512;
  static_assert(W1 == 64 || W1 == 128, "W1"); static_assert(W2 == 0 || W2 == 32, "W2"); static_assert(DV == 64 || DV == 128, "DV");
};

template <int W1, int W2, int DV, int MODE, bool SSQ>
__device__ __forceinline__ void attn_unit(const bf16* __restrict__ Qb, const bf16* __restrict__ Qb2, int ldq, const bf16* __restrict__ K1, int ldk1, const bf16* __restrict__ K2, int ldk2,
                                          const bf16* __restrict__ Vh, int ldv, bf16* __restrict__ Ob, int ldo, int nkeys, char* lds, float (&ssacc)[16]) {
  using C = AttnCfg<W1, W2, DV>;
  constexpr int ND0 = C::ND0, NB = C::NB, N1 = C::N1, NV = C::NV, CW1 = C::CW1, CWV = C::CWV;
  constexpr int SHM_V = C::VT_BYTES, SHM_K = C::KT_BYTES;
  int tid_ = threadIdx.x; asm volatile("" : "+v"(tid_));
  const int tid = tid_, wid = tid >> 6, lane = tid & 63, r32 = lane & 31, hi = lane >> 5;
  char* V_lds = lds; char* K_lds = lds + 3 * SHM_V;
  float* ws = (float*)(lds + 3 * SHM_V + 3 * SHM_K) + wid * 64; float* li_l = ws; float* al_l = ws + 32;
  float m_reg = 0.f, l_reg = 0; f32x16 o[NB]; bf16x8 qr[ND0]; f32x16 negm = f32x16{}; if constexpr (MODE == 0) asm volatile("" : "+v"(negm));
#pragma unroll
  for (int d = 0; d < NB; ++d) o[d] = f32x16{};
  const bf16* Qw = Qb + (long)(wid * 32 + r32) * ldq + hi * 8;
#pragma unroll
  for (int d0 = 0; d0 < W1 / 16; ++d0) qr[d0] = *reinterpret_cast<const bf16x8*>(Qw + d0 * 16);
  if constexpr (W2 > 0) { const bf16* Qw2 = Qb2 + (long)(wid * 32 + r32) * ldq + hi * 8;
#pragma unroll
    for (int d0 = 0; d0 < W2 / 16; ++d0) qr[W1 / 16 + d0] = *reinterpret_cast<const bf16x8*>(Qw2 + d0 * 16); }
  int k1row[N1], k1col[N1], k1lds[N1], vrow[NV], vcol[NV], vlds[NV];
#pragma unroll
  for (int i = 0; i < N1; ++i) { const int p = tid + 512 * i; k1row[i] = p / CW1; k1col[i] = (p % CW1) * 8; k1lds[i] = (p % CW1) * KCH + (p / CW1) * 16; }
#pragma unroll
  for (int i = 0; i < NV; ++i) { const int p = tid + 512 * i; vrow[i] = p / CWV; vcol[i] = (p % CWV) * 8; vlds[i] = v_st<NB>(p / CWV, (p % CWV) * 8); }
  const int k2row = tid >> 2, k2col = (tid & 3) * 8, k2lds = (CW1 + (tid & 3)) * KCH + (tid >> 2) * 16; const bool k2on = (W2 > 0) && (tid < 256);
  const int vb0 = (int)(uintptr_t)V_lds + v_rd_base(lane);
  struct Slot { bf16x8 k1[N1]; bf16x8 k2; bf16x8 v[NV]; } sr_[2];
#define ATT_SLOAD(i, k0) do { _Pragma("unroll") for (int _j = 0; _j < N1; ++_j) sr_[i].k1[_j] = *reinterpret_cast<const bf16x8*>(&K1[(long)((k0) + k1row[_j]) * ldk1 + k1col[_j]]); \
    if constexpr (W2 > 0) { if (k2on) sr_[i].k2 = *reinterpret_cast<const bf16x8*>(&K2[(long)((k0) + k2row) * ldk2 + k2col]); } \
    _Pragma("unroll") for (int _j = 0; _j < NV; ++_j) sr_[i].v[_j] = *reinterpret_cast<const bf16x8*>(&Vh[(long)((k0) + vrow[_j]) * ldv + vcol[_j]]); } while (0)
#define ATT_SWRITE(b, i) do { _Pragma("unroll") for (int _j = 0; _j < NV; ++_j) *(bf16x8*)(V_lds + (b) * SHM_V + vlds[_j]) = sr_[i].v[_j]; \
    _Pragma("unroll") for (int _j = 0; _j < N1; ++_j) *(bf16x8*)(K_lds + (b) * SHM_K + k1lds[_j]) = sr_[i].k1[_j]; \
    if constexpr (W2 > 0) { if (k2on) *(bf16x8*)(K_lds + (b) * SHM_K + k2lds) = sr_[i].k2; } } while (0)
#define ATT_SWAIT() asm volatile("s_waitcnt vmcnt(%0)" :: "n"(N1 + NV) : "memory")
#define ATT_RESC(a) do { if (MODE == 0 && __any((a) != 1.f)) { if (hi == 0) al_l[r32] = (a); asm volatile("s_waitcnt lgkmcnt(0)" ::: "memory"); \
    _Pragma("unroll") for (int d = 0; d < NB; ++d) _Pragma("unroll") for (int r = 0; r < 16; ++r) o[d][r] *= al_l[crow(r, hi)]; } } while (0)
  f32x16 pA0, pA1, pB0, pB1; float alA, alB; bf16x8 pa0, pa1, pa2, pa3; const int NT = nkeys / 64;
  ATT_SLOAD(0, 0); asm volatile("s_waitcnt vmcnt(0)" ::: "memory"); ATT_SWRITE(0, 0); __syncthreads();
  qkt<ND0, MODE>(pA0, pA1, K_lds, qr, negm, r32, hi); partialSM<MODE, true>(pA0, pA1, m_reg, negm, alA);
  ATT_SLOAD(1, 64); if (2 < NT) ATT_SLOAD(0, 128);
  ATT_SWAIT(); ATT_SWRITE(1, 1); __syncthreads();
  int bp = 0, bc = 1, bn = 2;
  if (wid >= 4) __builtin_amdgcn_s_setprio(1);
#define ATT_ROT() do { const int t_ = bp; bp = bc; bc = bn; bn = t_; } while (0)
  for (int j = 1; j + 1 < NT; j += 2) {
    ATT_SBAR(); qkt<ND0, MODE>(pB0, pB1, K_lds + bc * SHM_K, qr, negm, r32, hi);
    finishSM(pA0, pA1, alA, l_reg, pa0, pa1, pa2, pa3); ATT_SBAR();
    ATT_SLOAD(1, (j + 2) * 64); ATT_SBAR();
    pv_all<NB>(o, vb0 + bp * SHM_V, pa0, pa1, pa2, pa3); partialSM<MODE, false>(pB0, pB1, m_reg, negm, alB);
    ATT_SWAIT(); ATT_SWRITE(bn, 0);
    ATT_RESC(alB); __syncthreads(); ATT_ROT();
    ATT_SBAR(); qkt<ND0, MODE>(pA0, pA1, K_lds + bc * SHM_K, qr, negm, r32, hi);
    finishSM(pB0, pB1, alB, l_reg, pa0, pa1, pa2, pa3); ATT_SBAR();
    if (j + 3 < NT) ATT_SLOAD(0, (j + 3) * 64); ATT_SBAR();
    pv_all<NB>(o, vb0 + bp * SHM_V, pa0, pa1, pa2, pa3); partialSM<MODE, false>(pA0, pA1, m_reg, negm, alA);
    ATT_SWAIT(); ATT_SWRITE(bn, 1);
    ATT_RESC(alA); __syncthreads(); ATT_ROT();
  }
  ATT_SBAR(); qkt<ND0, MODE>(pB0, pB1, K_lds + bc * SHM_K, qr, negm, r32, hi);
  finishSM(pA0, pA1, alA, l_reg, pa0, pa1, pa2, pa3); ATT_SBAR();
  pv_all<NB>(o, vb0 + bp * SHM_V, pa0, pa1, pa2, pa3); partialSM<MODE, false>(pB0, pB1, m_reg, negm, alB);
  ATT_RESC(alB);
  finishSM(pB0, pB1, alB, l_reg, pa0, pa1, pa2, pa3); ATT_SBAR();
  pv_all<NB>(o, vb0 + bc * SHM_V, pa0, pa1, pa2, pa3);
#undef ATT_ROT
  __builtin_amdgcn_s_setprio(0);
  if (hi == 0) li_l[r32] = l_reg; asm volatile("s_waitcnt lgkmcnt(0)" ::: "memory");
  float rli[16];
#pragma unroll
  for (int r = 0; r < 16; ++r) rli[r] = __builtin_amdgcn_rcpf(li_l[crow(r, hi)]);
  bf16* Ow = Ob + (long)(wid * 32) * ldo;
  if constexpr (C::OSTAGE) { unsigned short* stg = (unsigned short*)(lds + 3 * SHM_V + 3 * SHM_K + 8 * 64 * 4 + wid * C::OST_BYTES);
#pragma unroll
    for (int r = 0; r < 16; ++r) { const int orow = crow(r, hi);
#pragma unroll
      for (int d0 = 0; d0 < NB; ++d0) stg[orow * DV + d0 * 32 + r32] = f2bf1(o[d0][r] * rli[r]); }
    asm volatile("s_waitcnt lgkmcnt(0)" ::: "memory");
    constexpr int CPR = DV / 8;
#pragma unroll
    for (int i = 0; i < (32 * CPR) / 64; ++i) { const int p = i * 64 + lane, row = p / CPR, ch = p % CPR;
      const u32x4 v = *(const u32x4*)(stg + row * DV + ch * 8); *(u32x4*)(Ow + (long)row * ldo + ch * 8) = v; } }
  else {
#pragma unroll
    for (int r = 0; r < 16; ++r) { const int orow = crow(r, hi);
#pragma unroll
      for (int d0 = 0; d0 < NB; ++d0) Ow[(long)orow * ldo + d0 * 32 + r32] = f2bf1(o[d0][r] * rli[r]); } }
  if constexpr (SSQ) {
#pragma unroll
    for (int r = 0; r < 16; ++r) {
#pragma unroll
      for (int d0 = 0; d0 < NB; ++d0) { const float v = o[d0][r] * rli[r]; ssacc[r] += v * v; } } }
  __syncthreads();
#undef ATT_SLOAD
#undef ATT_SWRITE
#undef ATT_SWAIT
#undef ATT_RESC
}
#undef ATT_SBAR
}
constexpr int NWAVES = 8;
#ifndef MK_N_LAUNCHES
#define MK_N_LAUNCHES 1
#endif
constexpr int BATCH = 8, SEQ = 4096, DM = 1024, DEPTH = 4, MTOK = BATCH * SEQ;
constexpr int IN_W = 1184, IN_WP = 1280;
constexpr int MEM_T = 256, MROWS = BATCH * MEM_T;
constexpr int NEXP = 16, CAP = 512, EFF = 512, MOE_ROWS = NEXP * BATCH * CAP;
constexpr float EPS = 1e-6f, LOG2E = 1.4426950408889634f;
constexpr int NPH = 2 + 16 * DEPTH;
constexpr size_t MiB = 1u << 20;
constexpr size_t WS_CTL = 0, CTL_ZERO_BYTES = 1 * MiB;
constexpr size_t WS_TABG = 1 * MiB, WS_TABM = 2 * MiB, WS_WR = 2 * MiB + 512 * 1024, WS_GAINS = 3 * MiB, WS_SSO = 3 * MiB + 64 * 1024, WS_SSX = 346 * MiB, WS_RS1 = WS_SSO + 512 * 1024, WS_RS3 = WS_RS1 + 128 * 1024, WS_RG = 118 * MiB + 256 * 1024, WS_SSL = 118 * MiB + 512 * 1024;
constexpr size_t WS_WSMALL = 4 * MiB, WSMALL_STRIDE = 10 * MiB;
constexpr size_t OFF_WIN = 0, OFF_WQB = 5 * MiB / 2, OFF_WKVB = 3 * MiB, OFF_WO = 7 * MiB / 2, OFF_WMQ = 11 * MiB / 2, OFF_WMKV = 13 * MiB / 2, OFF_WMO = 17 * MiB / 2;
constexpr size_t WS_WGU = 44 * MiB, WS_WD = 76 * MiB;
constexpr size_t WS_MEMN = 92 * MiB, WS_MEMKV = 96 * MiB;
constexpr size_t WS_AFF = 112 * MiB, WS_AFFT = 114 * MiB, WS_SLOT = 116 * MiB, WS_IDX = 118 * MiB;
constexpr size_t WS_H = 120 * MiB, WS_PROJ = 184 * MiB, WS_QG = 264 * MiB, WS_KG = 296 * MiB, WS_VG = 304 * MiB, WS_LAT = 312 * MiB, WS_KROPE = 344 * MiB, WS_QM = 346 * MiB;
constexpr size_t WS_XB = 264 * MiB;
constexpr size_t WS_O = WS_H, WS_KVM = WS_PROJ, WS_QMEM = 184 * MiB, WS_OMEM = 216 * MiB, WS_XG = 184 * MiB, WS_Y = WS_XG, WS_ACT = 312 * MiB;
constexpr size_t WS_WGU2 = 394 * MiB, WS_WD2 = 426 * MiB;
constexpr size_t WS_X = 442 * MiB;
constexpr size_t WS_END = 506 * MiB;
constexpr int CW_BAR = 4096;
constexpr int RING_BYTES = 131072, LDSCTL_OFF = 135168, MISC_OFF = LDSCTL_OFF + 320, GTAB_OFF = LDSCTL_OFF + 1024, STAB_OFF = GTAB_OFF + 8192, LDS_BYTES = 163840;

#define GAS __attribute__((address_space(1)))
#define LAS __attribute__((address_space(3)))
typedef unsigned short bf16;
typedef unsigned v4u __attribute__((ext_vector_type(4)));
typedef float f32x4 __attribute__((ext_vector_type(4)));
#define LDS_WAIT() asm volatile("s_waitcnt lgkmcnt(0)" ::: "memory")
__device__ __forceinline__ unsigned pk2(float lo, float hi) { unsigned r; asm volatile("v_cvt_pk_bf16_f32 %0, %1, %2" : "=v"(r) : "v"(lo), "v"(hi)); return r; }
__device__ __forceinline__ float bflo(unsigned w) { return __uint_as_float(w << 16); }
__device__ __forceinline__ float bfhi(unsigned w) { return __uint_as_float(w & 0xffff0000u); }
#define UNPACK8(W_, V_) do { V_[0] = bflo(W_[0]); V_[1] = bfhi(W_[0]); V_[2] = bflo(W_[1]); V_[3] = bfhi(W_[1]); V_[4] = bflo(W_[2]); V_[5] = bfhi(W_[2]); V_[6] = bflo(W_[3]); V_[7] = bfhi(W_[3]); } while (0)
#define PACK8(V_, W_) do { W_[0] = pk2(V_[0], V_[1]); W_[1] = pk2(V_[2], V_[3]); W_[2] = pk2(V_[4], V_[5]); W_[3] = pk2(V_[6], V_[7]); } while (0)
__device__ __forceinline__ float wave_sum(float v) {
#pragma unroll
    for (int o = 1; o < 64; o <<= 1) v += __shfl_xor(v, o);
    return v;
}
__device__ __forceinline__ int wave_sum_i(int v) {
#pragma unroll
    for (int o = 1; o < 64; o <<= 1) v += __shfl_xor(v, o);
    return v;
}

#define XB_TMO      128
#define XB_XCNT(j)  (256  + 64 * (j))
#define XB_XSUB(j)  (1280 + 64 * (j))
#define XB_XGEN(j)  (2304 + 64 * (j))
#define XB_TOP      3328
#define XB_TOPGEN   3392
#define XCD_BAR_WORDS 3456
#define XB_SPIN_CAP (1u << 20)
__device__ __forceinline__ unsigned xb_ld(unsigned* p)              { return __hip_atomic_load(p, __ATOMIC_RELAXED, __HIP_MEMORY_SCOPE_AGENT); }
__device__ __forceinline__ unsigned xb_add(unsigned* p, unsigned v) { return __hip_atomic_fetch_add(p, v, __ATOMIC_RELAXED, __HIP_MEMORY_SCOPE_AGENT); }
__device__ __forceinline__ unsigned xb_xcc_id() { return (unsigned)__builtin_amdgcn_s_getreg((3 << 11) | 20) & 0xFu; }
#define XB_SPIN(cond, bar) do { unsigned _sp = 0; while (cond) { __builtin_amdgcn_s_sleep(1); \
    if ((++_sp & 255u) == 0u) { if (xb_ld(&(bar)[XB_TMO])) break; if (_sp > XB_SPIN_CAP) { atomicAdd(&(bar)[XB_TMO], 1u); break; } } } } while (0)
struct XcdBarrier { unsigned* bar; unsigned x; volatile LAS unsigned* st; };
__device__ __forceinline__ XcdBarrier xcd_barrier_post(unsigned* bar, volatile LAS unsigned* st) {
    XcdBarrier b; b.bar = bar; b.x = xb_xcc_id(); b.st = st;
    if (threadIdx.x == 0) (void)xb_add(&bar[XB_XCNT(b.x)], 1u);
    return b;
}
__device__ __forceinline__ void xcd_barrier_complete(unsigned* bar, unsigned x, unsigned& nloc, unsigned& nx) {
    const unsigned G = gridDim.x * gridDim.y * gridDim.z;
    unsigned sum, cnt, mine, sp = 0u;
    for (;;) {
        sum = 0u; cnt = 0u; mine = 0u;
#pragma unroll
        for (unsigned j = 0; j < 16; ++j) { const unsigned c = xb_ld(&bar[XB_XCNT(j)]); sum += c; cnt += (c > 0u) ? 1u : 0u; mine = (j == x) ? c : mine; }
        if (sum == G) break;
        __builtin_amdgcn_s_sleep(1);
        if ((++sp & 255u) == 0u) { if (xb_ld(&bar[XB_TMO])) break; if (sp > XB_SPIN_CAP) { atomicAdd(&bar[XB_TMO], 1u); break; } }
    }
    nloc = mine > 0u ? mine : 1u; nx = cnt > 0u ? cnt : 1u;
}
__device__ __forceinline__ void xcd_barrier(const XcdBarrier& b) {
    asm volatile("s_waitcnt vmcnt(0)" ::: "memory");
    __syncthreads();
    if (threadIdx.x == 0) {
        unsigned* bar = b.bar;
        __builtin_amdgcn_s_waitcnt(0);
        unsigned nloc = b.st[0], nx = b.st[1];
        if (nloc == 0u) { xcd_barrier_complete(bar, b.x, nloc, nx); b.st[0] = nloc; b.st[1] = nx; }
        const unsigned old = xb_add(&bar[XB_XSUB(b.x)], 1u);
        const unsigned gen = old / nloc;
        if (old + 1u == (gen + 1u) * nloc) {
            __builtin_amdgcn_fence(__ATOMIC_RELEASE, "agent");
            asm volatile("s_waitcnt vmcnt(0)" ::: "memory");
            const unsigned og = xb_add(&bar[XB_TOP], 1u);
            const unsigned tg = og / nx;
            if (og + 1u == (tg + 1u) * nx) xb_add(&bar[XB_TOPGEN], 1u);
            else XB_SPIN(xb_ld(&bar[XB_TOPGEN]) == tg, bar);
            __builtin_amdgcn_fence(__ATOMIC_ACQUIRE, "agent");
            xb_add(&bar[XB_XGEN(b.x)], 1u);
            asm volatile("s_waitcnt vmcnt(0)" ::: "memory");
        } else {
            XB_SPIN(xb_ld(&bar[XB_XGEN(b.x)]) == gen, bar);
            __builtin_amdgcn_fence(__ATOMIC_ACQUIRE, "agent");
            asm volatile("s_waitcnt vmcnt(0)" ::: "memory");
        }
    }
    __syncthreads();
}

struct Args { const float* in[24]; float* out; unsigned char* ws; int ph_lo, ph_hi; };
struct Ctx {
    LAS unsigned char* lds; char* ldsg;
    int tid, lane, wave, vcu, vcu0, G, G0, gw, NGW;
    bf16* x; float* out;
    unsigned char* ws;
};
#define WSP(T, off) ((T*)(F.ws + (off)))
__device__ __forceinline__ void refresh(Ctx& F) { int t = threadIdx.x; asm volatile("" : "+v"(t)); F.tid = t; F.lane = t & 63;
    int w = __builtin_amdgcn_readfirstlane(t >> 6), v = F.vcu0, g = F.G0; asm volatile("" : "+s"(w), "+s"(v), "+s"(g)); F.wave = w; F.vcu = v; F.G = g; F.gw = v * NWAVES + w; F.NGW = g * NWAVES; }

__device__ __forceinline__ int il32(int i) { return (i < 16) ? 2 * i : 2 * (i - 16) + 1; }
__device__ __forceinline__ int il64(int d) { return (d < 32) ? 2 * d : 2 * (d - 32) + 1; }
__device__ __forceinline__ int dstrow(int kind, int n) {
    if (kind == 1) {
        if (n < 512) { const int h = n >> 6, p = il64(n & 63); return 256 * (h >> 2) + 128 * (p >> 5) + 32 * (h & 3) + (p & 31); }
        if (n < 640) { const int kh = (n - 512) >> 6, p = il64(n & 63); return 512 + 128 * (p >> 5) + 32 * kh + (p & 31); }
        if (n < 768) { const int vh = (n - 640) >> 6, d = n & 63; return 512 + 128 * (d >> 5) + 32 * (2 + vh) + (d & 31); }
        if (n >= 1152) return 1152 + il32(n - 1152);
        return n; }
    if (kind == 2) { const int h = n / 96, p = n % 96; return (p < 64) ? h * 64 + p : 512 + h * 32 + il32(p - 64); }
    if (kind == 3) return (n >> 7) * 256 + (n & 127);
    if (kind == 4) return (n >> 7) * 256 + 128 + (n & 127);
    return n;
}
__device__ __forceinline__ void tr_item(const float* W, int N, const float* gain, bf16* WT, int ldk, int kind, int item, LAS float* scr, int lane) {
    const int nblk = (N + 63) / 64, kb = item / nblk, nb = item % nblk, k0 = 64 * kb, n0 = 64 * nb;
    const int lr = lane >> 4, lc = (lane & 15) * 4; const bool okc = (n0 + lc) < N;
    f32x4 v[16];
#pragma unroll
    for (int i = 0; i < 16; ++i) v[i] = okc ? *(const GAS f32x4*)(W + (size_t)(k0 + 4 * i + lr) * N + n0 + lc) : (f32x4){0.f, 0.f, 0.f, 0.f};
#pragma unroll
    for (int i = 0; i < 16; ++i) { const int kk = 4 * i + lr; const float gk = gain ? gain[k0 + kk] : 1.0f; LAS float* d = scr + kk * 65 + lc;
        d[0] = v[i].x * gk; d[1] = v[i].y * gk; d[2] = v[i].z * gk; d[3] = v[i].w * gk; }
    LDS_WAIT(); asm volatile("" ::: "memory");
    const int c = lane & 7;
#pragma unroll
    for (int j = 0; j < 8; ++j) { const int n = (lane >> 3) + 8 * j; const LAS float* s = scr + (8 * c) * 65 + n;
        v4u o; o.x = pk2(s[0 * 65], s[1 * 65]); o.y = pk2(s[2 * 65], s[3 * 65]); o.z = pk2(s[4 * 65], s[5 * 65]); o.w = pk2(s[6 * 65], s[7 * 65]);
        if (n0 + n < N) *(GAS v4u*)(WT + (size_t)dstrow(kind, n0 + n) * ldk + k0 + 8 * c) = o; }
    LDS_WAIT(); asm volatile("" ::: "memory");
}
constexpr int SMALL_ITEMS = 1152;
__device__ __forceinline__ void small_weight_item(const Ctx& F, const Args& A, int l, int r, LAS float* scr) {
    bf16* wl = WSP(bf16, WS_WSMALL + (size_t)l * WSMALL_STRIDE);
    if (r < 304) { tr_item(A.in[3] + (size_t)l * DM * IN_W, IN_W, A.in[2] + l * DM, wl + OFF_WIN / 2, DM, 1, r, scr, F.lane); return; } r -= 304;
    if (r < 48)  { tr_item(A.in[8] + (size_t)l * 256 * 768, 768, A.in[6] + l * 256, wl + OFF_WQB / 2, 256, 2, r, scr, F.lane); return; } r -= 48;
    if (r < 32)  { tr_item(A.in[9] + (size_t)l * 128 * 1024, 1024, A.in[7] + l * 128, wl + OFF_WKVB / 2, 128, 0, r, scr, F.lane); return; } r -= 32;
    if (r < 256) { const int kb = r / 16; const float* gain = (kb < 8) ? (A.in[10] + l * 512) : (A.in[11] + l * 512 - 512);
                   tr_item(A.in[12] + (size_t)l * DM * DM, DM, gain, wl + OFF_WO / 2, DM, 0, r, scr, F.lane); return; } r -= 256;
    if (r < 128) { tr_item(A.in[15] + (size_t)l * DM * 512, 512, A.in[13] + l * DM, wl + OFF_WMQ / 2, DM, 0, r, scr, F.lane); return; } r -= 128;
    if (r < 256) { tr_item(A.in[16] + (size_t)l * DM * DM, DM, A.in[14] + l * DM, wl + OFF_WMKV / 2, DM, 0, r, scr, F.lane); return; } r -= 256;
    tr_item(A.in[17] + (size_t)l * 512 * DM, DM, nullptr, wl + OFF_WMO / 2, 512, 0, r, scr, F.lane);
}
constexpr int MOE_ITEMS = 3 * 2048;
__device__ __forceinline__ void moe_weight_item(const Ctx& F, const Args& A, int l, int it, LAS float* scr) {
    bf16* wgu = WSP(bf16, (l & 1) ? WS_WGU2 : WS_WGU); bf16* wd = WSP(bf16, (l & 1) ? WS_WD2 : WS_WD);
    const int which = it >> 11, e = (it >> 7) & 15, r = it & 127;
    if (which < 2) tr_item((which == 0 ? A.in[20] : A.in[21]) + (size_t)(l * NEXP + e) * DM * EFF, EFF, A.in[18] + l * DM, wgu + (size_t)e * 1024 * 1024, DM, 3 + which, r, scr, F.lane);
    else           tr_item(A.in[22] + (size_t)(l * NEXP + e) * EFF * DM, DM, nullptr, wd + (size_t)e * 1024 * 512, EFF, 0, r, scr, F.lane);
}
__device__ __forceinline__ void convert_moe_weights(const Ctx& F, const Args& A, int l) {
    LAS float* scr = (LAS float*)(F.lds + F.wave * 16640);
    for (int it = F.gw; it < MOE_ITEMS; it += F.NGW) moe_weight_item(F, A, l, it, scr);
}

__device__ __forceinline__ void rms_row_f32(const float* xrow, bf16* xb, bf16* orow, float* rs, int lane) {
    const GAS f32x4* xr = (const GAS f32x4*)xrow + lane;
    f32x4 v[4]; float s = 0.f;
#pragma unroll
    for (int j = 0; j < 4; ++j) { v[j] = xr[64 * j]; s += (v[j].x * v[j].x + v[j].y * v[j].y) + (v[j].z * v[j].z + v[j].w * v[j].w); }
    const float rstd = __builtin_amdgcn_rsqf(wave_sum(s) * (1.f / DM) + EPS);
    if (xb) { GAS unsigned long long* x8 = (GAS unsigned long long*)xb + lane;
#pragma unroll
        for (int j = 0; j < 4; ++j) x8[64 * j] = (unsigned long long)pk2(v[j].x, v[j].y) | ((unsigned long long)pk2(v[j].z, v[j].w) << 32); }
    if (rs && lane == 0) *rs = rstd;
    if (orow) { GAS unsigned long long* o8 = (GAS unsigned long long*)orow + lane;
#pragma unroll
        for (int j = 0; j < 4; ++j) o8[64 * j] = (unsigned long long)pk2(v[j].x * rstd, v[j].y * rstd) | ((unsigned long long)pk2(v[j].z * rstd, v[j].w * rstd) << 32); }
}
__device__ __forceinline__ void phase_prologue(const Ctx& F, const Args& A) {
    LAS float* scr = (LAS float*)(F.lds + F.wave * 16640);
    for (int it = F.gw; it < DEPTH * SMALL_ITEMS; it += F.NGW) small_weight_item(F, A, it / SMALL_ITEMS, it % SMALL_ITEMS, scr);
    convert_moe_weights(F, A, 0);
    const int gt = F.vcu * (NWAVES * 64) + F.tid, NGT = F.G * NWAVES * 64;
    for (int i = gt; i < DEPTH * 12288; i += NGT) { const int l = i / 12288, r = i % 12288;
        bf16* wl = WSP(bf16, WS_WSMALL + (size_t)l * WSMALL_STRIDE);
        *(GAS v4u*)(wl + OFF_WIN / 2 + (size_t)IN_W * DM + (size_t)r * 8) = (v4u){0u, 0u, 0u, 0u}; }
    for (int i = gt; i < 1536; i += NGT) WSP(float, WS_GAINS)[i] = (i < 256) ? A.in[4][i] : (i < 512) ? A.in[5][i - 256] : A.in[23][i - 512];
    for (int i = gt; i < DEPTH * NEXP * DM; i += NGT) { const int l = i / (NEXP * DM), e = (i / DM) % NEXP, k = i % DM;
        WSP(float, WS_WR)[i] = A.in[19][(size_t)(l * DM + k) * NEXP + e] * A.in[18][l * DM + k]; }
    for (int i = gt; i < SEQ * 48; i += NGT) { const int s = i / 48, j = i % 48; const float row = (float)(s >> 6), col = (float)(s & 63);
        const bool isg = (j < 32); const int j2 = isg ? j : j - 32, half = isg ? 16 : 8, jj = j2 & (half - 1);
        const float inv = __builtin_amdgcn_exp2f(-(float)(2 * jj) / (float)(2 * half) * 13.287712379549449f);
        const float ang = ((j2 < half) ? row : col) * inv;
        double td = (double)ang * 0.15915494309189535; td -= rint(td);
        const float sn = __builtin_amdgcn_sinf((float)td), cs = __builtin_amdgcn_cosf((float)td);
        float* dst = isg ? (WSP(float, WS_TABG) + ((size_t)s * 32 + j2) * 2) : (WSP(float, WS_TABM) + ((size_t)s * 16 + j2) * 2);
        dst[0] = cs; dst[1] = sn; }
    for (int m = F.gw; m < MROWS; m += F.NGW) rms_row_f32(A.in[1] + (size_t)m * DM, nullptr, WSP(bf16, WS_MEMN) + (size_t)m * DM, nullptr, F.lane);
    {
        const int lane = F.lane; f32x4 vn[4];
#pragma unroll
        for (int j = 0; j < 4; ++j) vn[j] = (f32x4){0.f, 0.f, 0.f, 0.f};
        if (F.gw < MTOK) { const GAS f32x4* xr = (const GAS f32x4*)(A.in[0] + (size_t)F.gw * DM) + lane;
#pragma unroll
            for (int j = 0; j < 4; ++j) vn[j] = xr[64 * j]; }
        for (int m = F.gw; m < MTOK; m += F.NGW) {
            f32x4 v[4]; float s = 0.f;
#pragma unroll
            for (int j = 0; j < 4; ++j) { v[j] = vn[j]; s += (v[j].x * v[j].x + v[j].y * v[j].y) + (v[j].z * v[j].z + v[j].w * v[j].w); }
            if (m + F.NGW < MTOK) { const GAS f32x4* xr = (const GAS f32x4*)(A.in[0] + (size_t)(m + F.NGW) * DM) + lane;
#pragma unroll
                for (int j = 0; j < 4; ++j) vn[j] = xr[64 * j]; }
            const float rstd = __builtin_amdgcn_rsqf(wave_sum(s) * (1.f / DM) + EPS);
            GAS unsigned long long* x8 = (GAS unsigned long long*)(F.x + (size_t)m * DM) + lane;
#pragma unroll
            for (int j = 0; j < 4; ++j) x8[64 * j] = (unsigned long long)pk2(v[j].x, v[j].y) | ((unsigned long long)pk2(v[j].z, v[j].w) << 32);
            if (lane == 0) WSP(float, WS_RS1)[m] = rstd;
        } }
}

__device__ __forceinline__ void rope4(float* v, const float* tab) {
    const f32x4 t0 = *(const f32x4*)tab, t1 = *(const f32x4*)(tab + 4);
    float a, b;
    a = v[0]; b = v[1]; v[0] = a * t0[0] - b * t0[1]; v[1] = b * t0[0] + a * t0[1];
    a = v[2]; b = v[3]; v[2] = a * t0[2] - b * t0[3]; v[3] = b * t0[2] + a * t0[3];
    a = v[4]; b = v[5]; v[4] = a * t1[0] - b * t1[1]; v[5] = b * t1[0] + a * t1[1];
    a = v[6]; b = v[7]; v[6] = a * t1[2] - b * t1[3]; v[7] = b * t1[2] + a * t1[3];
}
__device__ __forceinline__ void phase_postproj(const Ctx& F, int l) {
    int lane_ = F.lane; asm volatile("" : "+v"(lane_)); const int lane = lane_;
    const float* gq = WSP(float, WS_GAINS) + l * 64; const float* gk = WSP(float, WS_GAINS) + 256 + l * 64;
    float gqv[8], gkv[8];
#pragma unroll
    for (int i = 0; i < 8; ++i) { const int p = 8 * (lane & 7) + i, d = (p >> 1) + 32 * (p & 1); gqv[i] = gq[d]; gkv[i] = gk[d]; }
    const float* tabg = WSP(float, WS_TABG); const float* tabm = WSP(float, WS_TABM);
    const float C2G = 0.125f * LOG2E;
    v4u wa_n = (v4u){0u, 0u, 0u, 0u}, wb_n = wa_n, wc_n = wa_n;
    if (F.gw < MTOK) { const bf16* pr = WSP(bf16, WS_PROJ) + (size_t)F.gw * IN_WP; wa_n = *(const GAS v4u*)(pr + 8 * lane); wb_n = *(const GAS v4u*)(pr + 512 + 8 * lane); if (lane < 20) wc_n = *(const GAS v4u*)(pr + 1024 + 8 * lane); }
    for (int m = F.gw; m < MTOK; m += F.NGW) {
        const int s = m & (SEQ - 1);
        const v4u wa = wa_n, wb = wb_n, wc = wc_n;
        if (m + F.NGW < MTOK) { const bf16* pr = WSP(bf16, WS_PROJ) + (size_t)(m + F.NGW) * IN_WP; wa_n = *(const GAS v4u*)(pr + 8 * lane); wb_n = *(const GAS v4u*)(pr + 512 + 8 * lane); if (lane < 20) wc_n = *(const GAS v4u*)(pr + 1024 + 8 * lane); }
        { const v4u w = wa; float v[8]; UNPACK8(w, v);
          float ss = 0.f;
#pragma unroll
          for (int i = 0; i < 8; ++i) ss += v[i] * v[i];
          ss += __shfl_xor(ss, 1); ss += __shfl_xor(ss, 2); ss += __shfl_xor(ss, 4);
          const float rstd = __builtin_amdgcn_rsqf(ss * (1.f / 64.f) + EPS);
#pragma unroll
          for (int i = 0; i < 8; ++i) v[i] = v[i] * rstd * gqv[i];
          rope4(v, tabg + ((size_t)s * 32 + 4 * (lane & 7)) * 2);
#pragma unroll
          for (int i = 0; i < 8; ++i) v[i] *= C2G;
          v4u o; PACK8(v, o); *(GAS v4u*)(WSP(bf16, WS_QG) + (size_t)m * 512 + 8 * lane) = o; }
        { const v4u w = wb; float v[8]; UNPACK8(w, v);
          float ss = 0.f;
#pragma unroll
          for (int i = 0; i < 8; ++i) ss += v[i] * v[i];
          ss += __shfl_xor(ss, 1); ss += __shfl_xor(ss, 2); ss += __shfl_xor(ss, 4);
          const float ss8 = ss;
          ss += __shfl_xor(ss, 8); ss += __shfl_xor(ss, 16);
          if (lane < 16) {
              const float rstd = __builtin_amdgcn_rsqf(ss8 * (1.f / 64.f) + EPS);
#pragma unroll
              for (int i = 0; i < 8; ++i) v[i] = v[i] * rstd * gkv[i];
              rope4(v, tabg + ((size_t)s * 32 + 4 * (lane & 7)) * 2);
              v4u o; PACK8(v, o); *(GAS v4u*)(WSP(bf16, WS_KG) + (size_t)m * 128 + 8 * lane) = o;
          } else if (lane < 32) {
              *(GAS v4u*)(WSP(bf16, WS_VG) + (size_t)m * 128 + 8 * (lane - 16)) = w;
          } else {
              const float rstd = __builtin_amdgcn_rsqf(ss * (1.f / 256.f) + EPS);
#pragma unroll
              for (int i = 0; i < 8; ++i) v[i] *= rstd;
              v4u o; PACK8(v, o); *(GAS v4u*)(WSP(bf16, WS_LAT) + (size_t)m * 512 + 8 * (lane - 32)) = o;
          } }
        { const v4u w = wc;
          float v[8]; UNPACK8(w, v);
          float ss = 0.f;
#pragma unroll
          for (int i = 0; i < 8; ++i) ss += v[i] * v[i];
          ss += __shfl_xor(ss, 1); ss += __shfl_xor(ss, 2); ss += __shfl_xor(ss, 4); ss += __shfl_xor(ss, 8);
          if (lane < 16) {
              const float rstd = __builtin_amdgcn_rsqf(ss * (1.f / 128.f) + EPS);
#pragma unroll
              for (int i = 0; i < 8; ++i) v[i] *= rstd;
              v4u o; PACK8(v, o); *(GAS v4u*)(WSP(bf16, WS_LAT) + (size_t)m * 512 + 256 + 8 * lane) = o;
          } else if (lane < 20) {
              rope4(v, tabm + ((size_t)s * 16 + 4 * (lane - 16)) * 2);
              v4u o; PACK8(v, o); *(GAS v4u*)(WSP(bf16, WS_KROPE) + (size_t)m * 32 + 8 * (lane - 16)) = o;
          } else if (lane < 36) {
              *(GAS v4u*)(WSP(bf16, WS_LAT) + (size_t)m * 512 + 384 + 8 * (lane - 20)) = (v4u){0u, 0u, 0u, 0u};
          } }
    }
}

__device__ __forceinline__ void phase_outnorm(const Ctx& F) {
    int lane_ = F.lane; asm volatile("" : "+v"(lane_)); const int lane = lane_;
    for (int m = F.gw; m < MTOK; m += F.NGW) {
        bf16* orow = WSP(bf16, WS_O) + (size_t)m * DM;
#pragma unroll
        for (int g = 0; g < 2; ++g) {
            v4u w = *(const GAS v4u*)(orow + g * 512 + 8 * lane); float v[8]; UNPACK8(w, v);
            float ss = 0.f;
#pragma unroll
            for (int i = 0; i < 8; ++i) ss += v[i] * v[i];
            const float rstd = __builtin_amdgcn_rsqf(wave_sum(ss) * (1.f / 512.f) + EPS);
#pragma unroll
            for (int i = 0; i < 8; ++i) v[i] *= rstd;
            v4u o; PACK8(v, o); *(GAS v4u*)(orow + g * 512 + 8 * lane) = o;
        }
    }
}

__device__ __forceinline__ void phase_router(const Ctx& F, int l) {
    int lane_ = F.lane; asm volatile("" : "+v"(lane_)); const int lane = lane_;
    int tid_ = F.tid; asm volatile("" : "+v"(tid_)); const int tid = tid_;
    typedef short rbf16x8 __attribute__((ext_vector_type(8)));
    const int NB = MTOK / 16, tok = lane & 15, kq = lane >> 4;
    int tb = F.gw;
    v4u xf[32];
#define RT_LOAD() do { const GAS v4u* xr_ = (const GAS v4u*)(F.x + ((size_t)tb * 16 + tok) * DM) + kq; _Pragma("unroll") for (int s_ = 0; s_ < 32; ++s_) xf[s_] = xr_[4 * s_]; } while (0)
    if (tb < NB) RT_LOAD();
    {
        const GAS f32x4* src = (const GAS f32x4*)(WSP(float, WS_WR) + (size_t)l * NEXP * DM);
        for (int it = tid; it < NEXP * DM / 8; it += NWAVES * 64) { const int e = it & 15, k8 = it >> 4;
            const f32x4 a = src[(e * DM + 8 * k8) / 4], b = src[(e * DM + 8 * k8) / 4 + 1];
            v4u hi, lo; hi.x = pk2(a.x, a.y); hi.y = pk2(a.z, a.w); hi.z = pk2(b.x, b.y); hi.w = pk2(b.z, b.w);
            lo.x = pk2(a.x - bflo(hi.x), a.y - bfhi(hi.x)); lo.y = pk2(a.z - bflo(hi.y), a.w - bfhi(hi.y)); lo.z = pk2(b.x - bflo(hi.z), b.y - bfhi(hi.z)); lo.w = pk2(b.z - bflo(hi.w), b.w - bfhi(hi.w));
            const int s = k8 >> 2, ln = (k8 & 3) * 16 + e;
            *(LAS v4u*)(F.lds + ((s * 2 + 0) * 64 + ln) * 16) = hi; *(LAS v4u*)(F.lds + ((s * 2 + 1) * 64 + ln) * 16) = lo; }
    }
    __syncthreads();
    while (tb < NB) {
        asm volatile("" ::: "memory");
        f32x4 ah = {0.f, 0.f, 0.f, 0.f}, al = {0.f, 0.f, 0.f, 0.f}; float ss0 = 0.f, ss1 = 0.f;
#pragma unroll
        for (int s = 0; s < 32; ++s) {
            const rbf16x8 wh = *(const LAS rbf16x8*)(F.lds + ((s * 2 + 0) * 64 + lane) * 16), wl = *(const LAS rbf16x8*)(F.lds + ((s * 2 + 1) * 64 + lane) * 16);
            const rbf16x8 xb = __builtin_bit_cast(rbf16x8, xf[s]);
            ah = __builtin_amdgcn_mfma_f32_16x16x32_bf16(wh, xb, ah, 0, 0, 0);
            al = __builtin_amdgcn_mfma_f32_16x16x32_bf16(wl, xb, al, 0, 0, 0);
            const v4u q = xf[s];
            ss0 += (bflo(q.x) * bflo(q.x) + bfhi(q.x) * bfhi(q.x)) + (bflo(q.y) * bflo(q.y) + bfhi(q.y) * bfhi(q.y));
            ss1 += (bflo(q.z) * bflo(q.z) + bfhi(q.z) * bfhi(q.z)) + (bflo(q.w) * bflo(q.w) + bfhi(q.w) * bfhi(q.w));
        }
        float ss = ss0 + ss1; ss += __shfl_xor(ss, 16); ss += __shfl_xor(ss, 32);
        const float rstd = __builtin_amdgcn_rsqf(ss * (1.f / DM) + EPS);
        const int row = tb * 16 + tok;
        if (lane < 16) WSP(float, WS_RS3)[row] = rstd;
        f32x4 lg = (ah + al) * rstd;
        float mx = fmaxf(fmaxf(lg.x, lg.y), fmaxf(lg.z, lg.w)); mx = fmaxf(mx, __shfl_xor(mx, 16)); mx = fmaxf(mx, __shfl_xor(mx, 32));
        f32x4 ex = {__expf(lg.x - mx), __expf(lg.y - mx), __expf(lg.z - mx), __expf(lg.w - mx)};
        float den = (ex.x + ex.y) + (ex.z + ex.w); den += __shfl_xor(den, 16); den += __shfl_xor(den, 32);
        ex = {ex.x / den, ex.y / den, ex.z / den, ex.w / den};
        *(f32x4*)(WSP(float, WS_AFF) + (size_t)row * 16 + 4 * kq) = ex;
        float* at = WSP(float, WS_AFFT) + ((size_t)(row >> 12) * 16 + 4 * kq) * SEQ + (row & (SEQ - 1));
        at[0] = ex.x; at[SEQ] = ex.y; at[2 * SEQ] = ex.z; at[3 * SEQ] = ex.w;
        tb += F.NGW; if (tb < NB) RT_LOAD();
    }
#undef RT_LOAD
    __syncthreads();
}

__device__ __forceinline__ int block_excl_scan(int v, LAS int* red, int lane, int wave, int& total) {
    int inc = v;
#pragma unroll
    for (int o = 1; o < 64; o <<= 1) { const int t = __shfl_up(inc, o); if (lane >= o) inc += t; }
    __syncthreads();
    if (lane == 63) red[wave] = inc;
    __syncthreads();
    int base = 0, tot = 0;
#pragma unroll
    for (int w = 0; w < 8; ++w) { const int t = red[w]; if (w < wave) base += t; tot += t; }
    total = tot;
    return base + inc - v;
}
__device__ __forceinline__ void phase_select(const Ctx& F, const Args& A, int l) {
    LAS int* red = (LAS int*)F.lds;
    int tid_ = F.tid; asm volatile("" : "+v"(tid_)); const int tid = tid_, lane = tid & 63, wave = F.wave;
    for (int pair = F.vcu; pair < BATCH * NEXP; pair += F.G) {
        const int b = pair >> 4, e = pair & 15;
        const GAS v4u* src = (const GAS v4u*)(WSP(float, WS_AFFT) + (size_t)pair * SEQ) + 2 * tid;
        const v4u w0 = src[0], w1 = src[1];
        unsigned v[8] = {w0.x, w0.y, w0.z, w0.w, w1.x, w1.y, w1.z, w1.w};
        unsigned T = 0u; int par = 0;
        for (int bit = 30; bit >= 0; --bit) {
            const unsigned cand = T | (1u << bit);
            int c = 0;
#pragma unroll
            for (int i = 0; i < 8; ++i) c += (v[i] >= cand) ? 1 : 0;
            c = wave_sum_i(c);
            if (lane == 0) red[par * 8 + wave] = c;
            __syncthreads();
            int tot = 0;
#pragma unroll
            for (int w = 0; w < 8; ++w) tot += red[par * 8 + w];
            if (tot >= CAP) T = cand;
            par ^= 1;
        }
        int cgt = 0, ceq = 0;
#pragma unroll
        for (int i = 0; i < 8; ++i) { cgt += (v[i] > T) ? 1 : 0; ceq += (v[i] == T) ? 1 : 0; }
        int ngt, neq_tot;
        (void)block_excl_scan(cgt, red + 16, lane, wave, ngt);
        int eqb = block_excl_scan(ceq, red + 16, lane, wave, neq_tot);
        const int need_eq = CAP - ngt;
        int sel[8], csel = 0;
#pragma unroll
        for (int i = 0; i < 8; ++i) { const bool iseq = (v[i] == T); sel[i] = ((v[i] > T) || (iseq && eqb < need_eq)) ? 1 : 0; eqb += iseq ? 1 : 0; csel += sel[i]; }
        int nsel;
        int pos = block_excl_scan(csel, red + 16, lane, wave, nsel);
        int* idx = WSP(int, WS_IDX) + (size_t)(e * BATCH + b) * CAP; float* rg = WSP(float, WS_RG) + (size_t)(e * BATCH + b) * CAP; const float* rs3 = WSP(float, WS_RS3) + (size_t)b * SEQ;
        int* slot = WSP(int, WS_SLOT) + ((size_t)b * SEQ + (size_t)tid * 8) * NEXP + e;
#pragma unroll
        for (int i = 0; i < 8; ++i) { if (sel[i]) { if (pos < CAP) { idx[pos] = tid * 8 + i; rg[pos] = rs3[tid * 8 + i]; } slot[i * NEXP] = pos; ++pos; } else slot[i * NEXP] = -1; }
        __syncthreads();
    }
    if (l + 1 < DEPTH) {
        const bool split = F.G > BATCH * NEXP; const int nw = split ? (F.G - BATCH * NEXP) * NWAVES : F.NGW, wi = split ? (F.vcu - BATCH * NEXP) * NWAVES + F.wave : F.gw;
        LAS float* scr = (LAS float*)(F.lds + F.wave * 16640);
        if (wi >= 0) for (int it = wi; it < MOE_ITEMS; it += nw) moe_weight_item(F, A, l + 1, it, scr);
    }
}

__device__ __forceinline__ void phase_gather(const Ctx& F) {
    int lane_ = F.lane; asm volatile("" : "+v"(lane_)); const int lane = lane_;
    for (int r = F.gw; r < MOE_ROWS; r += F.NGW) {
        const int b = (r >> 9) & 7; const int t = WSP(int, WS_IDX)[r];
        const GAS v4u* src = (const GAS v4u*)(WSP(bf16, WS_H) + ((size_t)b * SEQ + t) * DM) + lane;
        GAS v4u* dst = (GAS v4u*)(WSP(bf16, WS_XG) + (size_t)r * DM) + lane;
        const v4u a = src[0], c = src[64]; dst[0] = a; dst[64] = c;
    }
}

__device__ __forceinline__ void phase_combine(const Ctx& F, const Args& A, int l, float amul) {
    int lane_ = F.lane; asm volatile("" : "+v"(lane_)); const int lane = lane_; const bool lastl = (l == DEPTH - 1);
    const float* gfin = WSP(float, WS_GAINS) + 512;
    v4u xa_n = (v4u){0u, 0u, 0u, 0u}, xc_n = xa_n; int sl_n = -1; float af_n = 0.f;
    if (F.gw < MTOK) { const GAS v4u* xp = (const GAS v4u*)(F.x + (size_t)F.gw * DM) + lane; xa_n = xp[0]; xc_n = xp[64];
        sl_n = WSP(int, WS_SLOT)[(size_t)F.gw * NEXP + (lane & 15)]; af_n = WSP(float, WS_AFF)[(size_t)F.gw * NEXP + (lane & 15)]; }
    for (int m = F.gw; m < MTOK; m += F.NGW) {
        const int b = m >> 12;
        GAS v4u* xr = (GAS v4u*)(F.x + (size_t)m * DM) + lane;
        const v4u xa = xa_n, xc = xc_n; const int sl = sl_n; const float af = amul * af_n;
        if (m + F.NGW < MTOK) { const int mn = m + F.NGW; const GAS v4u* xp = (const GAS v4u*)(F.x + (size_t)mn * DM) + lane; xa_n = xp[0]; xc_n = xp[64];
            sl_n = WSP(int, WS_SLOT)[(size_t)mn * NEXP + (lane & 15)]; af_n = WSP(float, WS_AFF)[(size_t)mn * NEXP + (lane & 15)]; }
        f32x4 x0 = (f32x4){bflo(xa.x), bfhi(xa.x), bflo(xa.y), bfhi(xa.y)}, x1 = (f32x4){bflo(xa.z), bfhi(xa.z), bflo(xa.w), bfhi(xa.w)};
        f32x4 x2 = (f32x4){bflo(xc.x), bfhi(xc.x), bflo(xc.y), bfhi(xc.y)}, x3 = (f32x4){bflo(xc.z), bfhi(xc.z), bflo(xc.w), bfhi(xc.w)};
        unsigned mask = (unsigned)(__ballot(sl >= 0 && lane < 16));
#define CMB_ACC(Y0, Y1, AE) do { x0.x += AE * bflo(Y0.x); x0.y += AE * bfhi(Y0.x); x0.z += AE * bflo(Y0.y); x0.w += AE * bfhi(Y0.y); \
            x1.x += AE * bflo(Y0.z); x1.y += AE * bfhi(Y0.z); x1.z += AE * bflo(Y0.w); x1.w += AE * bfhi(Y0.w); \
            x2.x += AE * bflo(Y1.x); x2.y += AE * bfhi(Y1.x); x2.z += AE * bflo(Y1.y); x2.w += AE * bfhi(Y1.y); \
            x3.x += AE * bflo(Y1.z); x3.y += AE * bfhi(Y1.z); x3.z += AE * bflo(Y1.w); x3.w += AE * bfhi(Y1.w); } while (0)
        while (mask) {
            const int e1 = __builtin_ctz(mask); mask &= mask - 1u;
            const bool two = mask != 0u; const int e2 = two ? __builtin_ctz(mask) : e1; if (two) mask &= mask - 1u;
            const int s1 = __shfl(sl, e1), s2 = __shfl(sl, e2); const float a1 = __shfl(af, e1), a2 = two ? __shfl(af, e2) : 0.f;
            const GAS v4u* yr1 = (const GAS v4u*)(WSP(bf16, WS_Y) + ((size_t)(e1 * BATCH + b) * CAP + s1) * DM) + lane;
            const GAS v4u* yr2 = (const GAS v4u*)(WSP(bf16, WS_Y) + ((size_t)(e2 * BATCH + b) * CAP + s2) * DM) + lane;
            const v4u y0 = yr1[0], y1 = yr1[64], z0 = yr2[0], z1 = yr2[64];
            CMB_ACC(y0, y1, a1); CMB_ACC(z0, z1, a2);
        }
#undef CMB_ACC
        float s = (x0.x * x0.x + x0.y * x0.y) + (x0.z * x0.z + x0.w * x0.w) + (x1.x * x1.x + x1.y * x1.y) + (x1.z * x1.z + x1.w * x1.w)
                + (x2.x * x2.x + x2.y * x2.y) + (x2.z * x2.z + x2.w * x2.w) + (x3.x * x3.x + x3.y * x3.y) + (x3.z * x3.z + x3.w * x3.w);
        const float rstd = __builtin_amdgcn_rsqf(wave_sum(s) * (1.f / DM) + EPS);
        if (lastl) {
            const f32x4 g0 = *(const f32x4*)(gfin + 8 * lane), g1 = *(const f32x4*)(gfin + 8 * lane + 4), g2 = *(const f32x4*)(gfin + 512 + 8 * lane), g3 = *(const f32x4*)(gfin + 512 + 8 * lane + 4);
            GAS f32x4* ow = (GAS f32x4*)(F.out + (size_t)m * DM);
            ow[2 * lane] = x0 * rstd * g0; ow[2 * lane + 1] = x1 * rstd * g1; ow[128 + 2 * lane] = x2 * rstd * g2; ow[128 + 2 * lane + 1] = x3 * rstd * g3;
        } else {
            v4u n0, n1; n0.x = pk2(x0.x, x0.y); n0.y = pk2(x0.z, x0.w); n0.z = pk2(x1.x, x1.y); n0.w = pk2(x1.z, x1.w); n1.x = pk2(x2.x, x2.y); n1.y = pk2(x2.z, x2.w); n1.z = pk2(x3.x, x3.y); n1.w = pk2(x3.z, x3.w);
            xr[0] = n0; xr[64] = n1;
            if (lane == 0) WSP(float, WS_RS1)[m] = rstd;
        }
    }
}

__device__ __forceinline__ void phase_attn_self(const Ctx& F, int l) {
    float gmq = fabsf(WSP(float, WS_GAINS)[l * 64 + F.lane]), gmk = fabsf(WSP(float, WS_GAINS)[256 + l * 64 + F.lane]);
#pragma unroll
    for (int o = 1; o < 64; o <<= 1) { gmq = fmaxf(gmq, __shfl_xor(gmq, o)); gmk = fmaxf(gmk, __shfl_xor(gmk, o)); }
    const bool bounded = (8.0f * LOG2E * gmq * gmk) < 64.0f;
    const int lane = F.lane, r32 = lane & 31, hi = lane >> 5, wid = F.wave;
#ifndef DUPATT
#define DUPATT 0
#endif
    for (int g = 0; g < 2; ++g)
      for (int rep2_ = 0; rep2_ < 1 + ((DUPATT >> g) & 1); ++rep2_)
        for (int u = F.vcu; u < 256; u += F.G) {
            const int b = u >> 5, qb = (u >> 1) & 15, hh = u & 1;
            const size_t r0 = (size_t)b * SEQ, q0 = r0 + (size_t)qb * 256;
            float ssacc[16];
#pragma unroll
            for (int r = 0; r < 16; ++r) ssacc[r] = 0.f;
            for (int hq = 0; hq < 4; ++hq) {
                const int h = hh * 4 + hq;
                if (g == 0) {
                    if (bounded) att::attn_unit<64, 0, 64, 1, true>(WSP(bf16, WS_QG) + q0 * 512 + h * 64, nullptr, 512, WSP(bf16, WS_KG) + r0 * 128 + hh * 64, 128, nullptr, 0,
                                              WSP(bf16, WS_VG) + r0 * 128 + hh * 64, 128, WSP(bf16, WS_O) + q0 * DM + h * 64, DM, SEQ, F.ldsg, ssacc);
                    else         att::attn_unit<64, 0, 64, 0, true>(WSP(bf16, WS_QG) + q0 * 512 + h * 64, nullptr, 512, WSP(bf16, WS_KG) + r0 * 128 + hh * 64, 128, nullptr, 0,
                                              WSP(bf16, WS_VG) + r0 * 128 + hh * 64, 128, WSP(bf16, WS_O) + q0 * DM + h * 64, DM, SEQ, F.ldsg, ssacc);
                } else {
                    att::attn_unit<64, 32, 64, 0, true>(WSP(bf16, WS_QM) + q0 * 768 + h * 64, WSP(bf16, WS_QM) + q0 * 768 + 512 + h * 32, 768, WSP(bf16, WS_KVM) + r0 * DM + h * 128, DM, WSP(bf16, WS_KROPE) + r0 * 32, 32,
                                               WSP(bf16, WS_KVM) + r0 * DM + h * 128 + 64, DM, WSP(bf16, WS_O) + q0 * DM + 512 + h * 64, DM, SEQ, F.ldsg, ssacc);
                }
            }
#pragma unroll
            for (int r = 0; r < 16; ++r) { float s = ssacc[r];
                s += __shfl_xor(s, 1); s += __shfl_xor(s, 2); s += __shfl_xor(s, 4); s += __shfl_xor(s, 8); s += __shfl_xor(s, 16);
                if (r32 == 0) WSP(float, WS_SSO)[(q0 + wid * 32 + att::crow(r, hi)) * 4 + g * 2 + hh] = s; }
        }
}
__device__ __forceinline__ void phase_attn_mem(const Ctx& F, int l) {
    const bf16* kv = WSP(bf16, WS_MEMKV) + (size_t)l * MROWS * DM; float dummy[16];
    for (int idx = F.vcu; idx < 256; idx += F.G) {
        const int pm = idx >> 1, pn = idx & 1, b = pm >> 4;
        const size_t q0 = (size_t)pm * 256, k0 = (size_t)b * MEM_T;
        for (int hh = 0; hh < 2; ++hh) { const int h = 2 * pn + hh;
            att::attn_unit<128, 0, 128, 0, false>(WSP(bf16, WS_QMEM) + q0 * 512 + h * 128, nullptr, 512, kv + k0 * DM + h * 128, DM, nullptr, 0,
                                        kv + k0 * DM + 512 + h * 128, DM, WSP(bf16, WS_OMEM) + q0 * 512 + h * 128, 512, MEM_T, F.ldsg, dummy); }
    }
}

__global__ void __launch_bounds__(NWAVES * 64, 2) enc_fwd(Args args) {
    extern __shared__ __attribute__((aligned(16))) unsigned char lds[];
    Ctx F;
    F.lds = (LAS unsigned char*)lds; F.ldsg = (char*)lds;
    F.tid = threadIdx.x; F.lane = F.tid & 63; F.wave = __builtin_amdgcn_readfirstlane(F.tid >> 6);
    F.G = gridDim.x; F.G0 = F.G; { const int bx = blockIdx.x; F.vcu0 = (F.G % 8 == 0) ? (bx % 8) * (F.G / 8) + bx / 8 : bx; F.vcu = F.vcu0; }
    F.gw = F.vcu * NWAVES + F.wave; F.NGW = F.G * NWAVES;
    F.out = args.out; F.ws = args.ws; F.x = (bf16*)(args.ws + WS_X);
    volatile LAS unsigned* MISC = (volatile LAS unsigned*)(F.lds + MISC_OFF);
    for (int u = F.tid; u < (LDS_BYTES - LDSCTL_OFF) / 4; u += NWAVES * 64) ((LAS unsigned*)(F.lds + LDSCTL_OFF))[u] = 0u;
    __syncthreads();
    XcdBarrier bar; bar.bar = (unsigned*)(F.ws + WS_CTL) + CW_BAR; bar.x = 0; bar.st = nullptr;
    if (MK_N_LAUNCHES == 1) bar = xcd_barrier_post((unsigned*)(F.ws + WS_CTL) + CW_BAR, MISC + 8);
    const int lo = args.ph_lo, hi = args.ph_hi;
#ifndef ONLY_SITE
#define ONLY_SITE -1
#endif
#define ON(s) (ONLY_SITE < 0 || ONLY_SITE == (s))
#ifndef DUPMASK
#define DUPMASK 0u
#endif
#define REP(s) for (int rep_ = 0; rep_ < 1 + (int)((DUPMASK >> (s)) & 1u); ++rep_)
#define IN(k) (lo <= (k) && (k) < hi)
#define SEAM(k) do { if (IN(k) && IN((k) + 1)) xcd_barrier(bar); } while (0)
#define LOCAL_SEAM() do { asm volatile("s_waitcnt vmcnt(0)" ::: "memory"); __syncthreads(); __builtin_amdgcn_fence(__ATOMIC_ACQUIRE, "agent"); asm volatile("s_waitcnt vmcnt(0)" ::: "memory"); __syncthreads(); } while (0)
#define GEMM(EpiT, epi, Ap, lda_, Bp, ldb_, K_, nM_, nN_, gdiv_, gstride_) do { const pg8::Gemm g_{(const bf16*)(Ap), (const bf16*)(Bp), lda_, ldb_, K_, gdiv_, 1 << 30, (size_t)(gstride_), nullptr, nullptr}; \
        pg8::StaticOrder S_; S_.init(nM_, nN_, F.G, (int)blockIdx.x); pg8::gemm_phase<EpiT, pg8::StaticOrder, true>(F.lds, g_, S_, epi); } while (0)

    #ifndef PRODUP
#define PRODUP 0
#endif
    if (ON(100) && IN(0)) for (int rp_ = 0; rp_ <= PRODUP; ++rp_) { refresh(F); phase_prologue(F, args); }
    SEAM(0);
    if (ON(101) && IN(1)) {
        pg8::EpiBf16 E{WSP(bf16, WS_MEMKV), DM, 1.0f, nullptr, nullptr, 0.f, 0.f};
        const pg8::Gemm g_{WSP(bf16, WS_MEMN), WSP(bf16, WS_WSMALL + OFF_WMKV), DM, DM, DM, MROWS / 256, MROWS / 256, (size_t)(WSMALL_STRIDE / 2), nullptr, nullptr};
        pg8::StaticOrder S_; S_.init(DEPTH * MROWS / 256, DM / 256, F.G, (int)blockIdx.x); pg8::gemm_phase<pg8::EpiBf16, pg8::StaticOrder, true>(F.lds, g_, S_, E); }
    SEAM(1);
    for (int l = 0; l < DEPTH; ++l) {
        const int pb = 2 + 16 * l;
        unsigned char* wl = F.ws + WS_WSMALL + (size_t)l * WSMALL_STRIDE;
        if (ON(0) && IN(pb + 0)) REP(0) if (refresh(F), true) {
            int bxs = (int)blockIdx.x; asm volatile("" : "+s"(bxs));
            pg8::EpiInProj E{WSP(float, WS_RS1), WSP(float, WS_GAINS) + l * 64, WSP(float, WS_GAINS) + 256 + l * 64, WSP(float, WS_TABG), WSP(float, WS_TABM),
                             WSP(bf16, WS_QG), WSP(bf16, WS_KG), WSP(bf16, WS_VG), WSP(bf16, WS_LAT), WSP(bf16, WS_KROPE), WSP(float, WS_SSL), 0.125f * LOG2E, EPS};
            const pg8::Gemm g_{(const bf16*)F.x, (const bf16*)(wl + OFF_WIN), DM, DM, DM, 1, 1 << 30, 0, nullptr, nullptr};
            typedef pg8::SplitOrder<2, 3, 0, 0> SO; SO S_; S_.init(MTOK / 256, F.G, bxs); pg8::gemm_phase<pg8::EpiInProj, SO, true>(F.lds, g_, S_, E); }
        SEAM(pb + 0);
        if ((ON(2) || ON(16) || ON(17)) && IN(pb + 2)) REP(2) { refresh(F);
            int bxs = (int)blockIdx.x; asm volatile("" : "+s"(bxs)); const int bxo = (F.G == 256) ? (bxs ^ 128) : bxs;
            if (ON(2)) {
                pg8::EpiInProj E{WSP(float, WS_RS1), WSP(float, WS_GAINS) + l * 64, WSP(float, WS_GAINS) + 256 + l * 64, WSP(float, WS_TABG), WSP(float, WS_TABM),
                                 WSP(bf16, WS_QG), WSP(bf16, WS_KG), WSP(bf16, WS_VG), WSP(bf16, WS_LAT), WSP(bf16, WS_KROPE), WSP(float, WS_SSL), 0.125f * LOG2E, EPS};
                const pg8::Gemm g_{(const bf16*)F.x, (const bf16*)(wl + OFF_WIN), DM, DM, DM, 1, 1 << 30, 0, nullptr, nullptr};
                typedef pg8::SplitOrder<3, 0, 2, 1> SO; SO S_; S_.init(MTOK / 256, F.G, bxs); pg8::gemm_phase<pg8::EpiInProj, SO, true>(F.lds, g_, S_, E); }
            if (ON(2) || ON(17)) { pg8::EpiQmRope E{WSP(bf16, WS_QM), 768, 0.10206207261596577f * LOG2E, WSP(float, WS_TABM), WSP(float, WS_SSL), 1.0f / 256.0f, EPS};
                const pg8::Gemm g_{WSP(bf16, WS_LAT), (const bf16*)(wl + OFF_WQB), 512, 256, 256, 1, 1 << 30, 0, nullptr, nullptr};
                typedef pg8::SplitOrder<3, 0, 2, 1> SO; SO S_; S_.init(MTOK / 256, F.G, bxo); pg8::gemm_phase<pg8::EpiQmRope, SO, true>(F.lds, g_, S_, E); }
            if (ON(2) || ON(16)) { pg8::EpiBf16 E{WSP(bf16, WS_KVM), DM, 1.0f, nullptr, WSP(float, WS_SSL) + 4, 1.0f / 128.0f, EPS};
                const pg8::Gemm g_{WSP(bf16, WS_LAT) + 256, (const bf16*)(wl + OFF_WKVB), 512, 128, 128, 1, 1 << 30, 0, nullptr, nullptr};
                typedef pg8::SplitOrder<4, 0, 3, 1> SO; SO S_; S_.init(MTOK / 256, F.G, bxo); pg8::gemm_phase<pg8::EpiBf16, SO, true>(F.lds, g_, S_, E); } }
        SEAM(pb + 2);
        if (ON(3) && IN(pb + 3)) REP(3) if (refresh(F), true) phase_attn_self(F, l);
        SEAM(pb + 3);
        if (ON(5) && IN(pb + 5)) REP(5) if (refresh(F), true) {
            pg8::EpiResidualX E{F.x, WSP(float, WS_SSX), DM, 1.0f / 512.0f, EPS, rep_ ? 0.f : 1.f};
            const pg8::Gemm g_{WSP(bf16, WS_O), (const bf16*)(wl + OFF_WO), DM, DM, DM, 1, 1 << 30, 0, nullptr, WSP(float, WS_SSO)};
            pg8::StaticOrder S_; S_.init(MTOK / 256, 4, F.G, (int)blockIdx.x); pg8::gemm_phase<pg8::EpiResidualX, pg8::StaticOrder, true, false, true>(F.lds, g_, S_, E, F.lds + STAB_OFF, 1.0f / 512.0f, EPS); }
        SEAM(pb + 5);
        if (ON(7) && IN(pb + 7)) REP(7) if (refresh(F), true) { pg8::EpiBf16RowNorm E{WSP(bf16, WS_QMEM), 512, 0.08838834764831845f * LOG2E, WSP(float, WS_SSX), 1.0f / DM, EPS}; GEMM(pg8::EpiBf16RowNorm, E, F.x, DM, wl + OFF_WMQ, DM, DM, MTOK / 256, 2, 1, 0); }
        SEAM(pb + 7);
        if (ON(8) && IN(pb + 8)) REP(8) if (refresh(F), true) phase_attn_mem(F, l);
        SEAM(pb + 8);
        if (ON(9) && IN(pb + 9)) REP(9) if (refresh(F), true) { pg8::EpiResidual E{F.x, DM, rep_ ? 0.f : 1.f}; GEMM(pg8::EpiResidual, E, WSP(bf16, WS_OMEM), 512, wl + OFF_WMO, 512, 512, MTOK / 256, 4, 1, 0); }
        SEAM(pb + 9);
        if (ON(10) && IN(pb + 10)) REP(10) if (refresh(F), true) phase_router(F, l);
        SEAM(pb + 10);
        if (ON(11) && IN(pb + 11)) REP(11) if (refresh(F), true) phase_select(F, args, l);
        SEAM(pb + 11);
        if (ON(13) && IN(pb + 13)) REP(13) if (refresh(F), true) { pg8::EpiSwiGLU E{WSP(bf16, WS_ACT), EFF, WSP(float, WS_RG)};
            const pg8::Gemm g_{F.x, WSP(bf16, (l & 1) ? WS_WGU2 : WS_WGU), DM, DM, DM, 16, 1 << 30, (size_t)(1024 * 1024), WSP(int, WS_IDX), nullptr};
            pg8::StaticOrder S_; S_.init(MOE_ROWS / 256, 4, F.G, (int)blockIdx.x); pg8::gemm_phase<pg8::EpiSwiGLU, pg8::StaticOrder, true, true>(F.lds, g_, S_, E, F.lds + GTAB_OFF); }
        SEAM(pb + 13);
        if (ON(14) && IN(pb + 14)) REP(14) if (refresh(F), true) { pg8::EpiBf16 E{WSP(bf16, WS_Y), DM, 1.0f, nullptr, nullptr, 0.f, 0.f}; GEMM(pg8::EpiBf16, E, WSP(bf16, WS_ACT), EFF, WSP(bf16, (l & 1) ? WS_WD2 : WS_WD), EFF, EFF, MOE_ROWS / 256, 4, 16, 1024 * 512); }
        SEAM(pb + 14);
        if (ON(15) && IN(pb + 15)) REP(15) if (refresh(F), true) phase_combine(F, args, l, (rep_ && l < DEPTH - 1) ? 0.f : 1.f);
        SEAM(pb + 15);
    }
#undef IN
#undef SEAM
#undef GEMM
}

extern "C" void kernel_launch(void* const* d_in, const int* in_sizes, int n_in, void* d_out, int out_size, void* d_ws, size_t ws_size, hipStream_t stream) {
    static int grid = 0;
    if (grid == 0) {
        if (n_in != 24 || out_size != MTOK * DM || ws_size < WS_END) { fprintf(stderr, "kernel_launch: unexpected shapes: n_in %d out %d ws %zu (need %zu)\n", n_in, out_size, ws_size, (size_t)WS_END); grid = -1; return; }
        int dev = 0, cus = 0, per_cu = 0;
        if (hipGetDevice(&dev) != hipSuccess || hipDeviceGetAttribute(&cus, hipDeviceAttributeMultiprocessorCount, dev) != hipSuccess) { grid = -1; return; }
        if (hipFuncSetAttribute((const void*)enc_fwd, hipFuncAttributeMaxDynamicSharedMemorySize, LDS_BYTES) != hipSuccess) { fprintf(stderr, "kernel_launch: hipFuncSetAttribute failed\n"); grid = -1; return; }
        if (hipOccupancyMaxActiveBlocksPerMultiprocessor(&per_cu, (const void*)enc_fwd, NWAVES * 64, LDS_BYTES) != hipSuccess || per_cu < 1)
            fprintf(stderr, "kernel_launch: occupancy query reports %d workgroups per CU\n", per_cu);
        (void)hipGetLastError();
        grid = cus;
        fprintf(stderr, "kernel_launch: grid %d, ws %zu bytes\n", grid, ws_size);
    }
    if (grid < 0) return;
    (void)hipMemsetAsync((char*)d_ws + WS_CTL, 0, CTL_ZERO_BYTES, stream);
    Args a{};
    for (int i = 0; i < 24; ++i) a.in[i] = (const float*)d_in[i];
    a.out = (float*)d_out; a.ws = (unsigned char*)d_ws;
#if MK_N_LAUNCHES == 1
    a.ph_lo = 0; a.ph_hi = NPH;
    hipLaunchKernelGGL(enc_fwd, dim3(grid), dim3(NWAVES * 64), LDS_BYTES, stream, a);
#else
    for (int p = 0; p < NPH; ++p) { a.ph_lo = p; a.ph_hi = p + 1; hipLaunchKernelGGL(enc_fwd, dim3(grid), dim3(NWAVES * 64), LDS_BYTES, stream, a); }
#endif
    const hipError_t le = hipPeekAtLastError();
    if (le != hipSuccess) fprintf(stderr, "kernel_launch: launch failed: %s\n", hipGetErrorName(le));
}
```

```cpp
#include <hip/hip_runtime.h>
#include <cstdio>
#include <cstdint>

namespace pg8 {
#define PG8_LAS __attribute__((address_space(3)))
typedef unsigned short bf16_t;
typedef short bf16x8 __attribute__((ext_vector_type(8)));
typedef float f32x4 __attribute__((ext_vector_type(4)));
typedef unsigned u32x4 __attribute__((ext_vector_type(4)));
constexpr int BM = 256, BK = 64, HALF = 128, HTB = HALF * BK * 2  , STAGE_BYTES = 8 * HTB, NXCD = 8, WGM = 8;

__host__ __device__ __forceinline__ int lds_byte(int r, int c) { const int st = (r >> 4) * 2 + (c >> 5), rr = r & 15, cc = c & 31, ob = rr * 64 + cc * 2; return st * 1024 + (ob ^ (((ob >> 9) & 1) << 5)); }
__host__ __device__ __forceinline__ void stage_rc(int b, int& R, int& C) { const int st = b / 1024, sb = b % 1024, swz = sb ^ (((sb >> 9) & 1) << 5); R = (st >> 1) * 16 + swz / 64; C = (st & 1) * 32 + (swz % 64) / 2; }
__host__ __device__ __forceinline__ int perm32(int rho) { const int n = rho >> 4, i = rho & 15; return 8 * (i >> 2) + 4 * n + (i & 3); }

struct Unit { int pm, pn; };
struct Gemm { const bf16_t* A; const bf16_t* Bt; int lda, ldb, K, gdiv, amod; size_t gstride; const int* idx; const float* ss; };

struct StaticOrder {
    int nM, nN, nwg, G, c;
    __host__ __device__ void init(int nM_, int nN_, int G_, int c_) { nM = nM_; nN = nN_; nwg = nM * nN; G = G_; c = c_; }
    __host__ __device__ bool next(int i, Unit& u) const {
        const long L = (long)i * G + c; if (L >= nwg) return false;
        int wgid = (int)L; { const int q = nwg / NXCD, r = nwg % NXCD, xcd = wgid % NXCD, off = wgid / NXCD; wgid = (xcd < r ? xcd * (q + 1) : r * (q + 1) + (xcd - r) * q) + off; }
        const int nig = WGM * nN, gid = wgid / nig, fm = gid * WGM, gsz = (nM - fm) < WGM ? (nM - fm) : WGM;
        u.pm = fm + ((wgid % nig) % gsz); u.pn = (wgid % nig) / gsz; return true;
    }
};

template <int NN, int PN0, int KH, int KL> struct SplitOrder {
    int nM, G, c;
    __host__ __device__ void init(int nM_, int G_, int c_) { nM = nM_; G = G_; c = c_; }
    __host__ __device__ bool next(int i, Unit& u) const {
        const int nwg = nM * NN; long L;
        if (KH == 0 || G != 256) L = (long)i * G + c;
        else if (c < 128) { if (i >= KH) return false; L = (long)i * 128 + c; }
        else { if (i >= KL) return false; L = 128L * KH + (long)i * 128 + (c - 128); }
        if (L >= nwg) return false;
        int wgid = (int)L; { const int q = nwg / NXCD, r = nwg % NXCD, xcd = wgid % NXCD, off = wgid / NXCD; wgid = (xcd < r ? xcd * (q + 1) : r * (q + 1) + (xcd - r) * q) + off; }
        const int nig = WGM * NN, gid = wgid / nig, fm = gid * WGM, gsz = (nM - fm) < WGM ? (nM - fm) : WGM;
        u.pm = fm + ((wgid % nig) % gsz); u.pn = PN0 + (wgid % nig) / gsz; return true;
    }
};

struct LinearOrder {
    int nM, nN, G, c, per;
    __host__ __device__ void init(int nM_, int nN_, int G_, int c_, int per_) { nM = nM_; nN = nN_; G = G_; c = c_; per = per_; }
    __host__ __device__ bool next(int i, Unit& u) const { const int idx = (c + (i / per) * G) * per + (i % per); if (idx >= nM * nN) return false; u.pm = idx / nN; u.pn = idx % nN; return true; }
};

__device__ __forceinline__ unsigned cvt_pk_bf16(float lo, float hi) { unsigned r; asm volatile("v_cvt_pk_bf16_f32 %0, %1, %2" : "=v"(r) : "v"(lo), "v"(hi)); return r; }

struct EpiBf16 {
    static constexpr bool PERM = true;
    bf16_t* O; int ldc; float scale; const float* rs; const float* ssl; float ssl_inv, ssl_eps;
    __device__ __forceinline__ void operator()(const f32x4 (&acc)[2][2][4][2], const Unit& u, int wr, int wc, int fr, int fq) const {
        const int row0 = u.pm * BM + wr * 64 + fr, col0 = u.pn * BM + wc * 32 + 8 * fq;
#pragma unroll
        for (int ai = 0; ai < 2; ++ai)
#pragma unroll
            for (int m = 0; m < 4; ++m) { const int row = row0 + ai * HALF + m * 16; bf16_t* rowp = O + (size_t)row * ldc + col0; float sc = rs ? scale * rs[row] : scale;
                if (ssl) { const f32x4 q_ = *(const f32x4*)(ssl + (size_t)row * 8); sc *= __builtin_amdgcn_rsqf(((q_[0] + q_[1]) + (q_[2] + q_[3])) * ssl_inv + ssl_eps); }
#pragma unroll
                for (int bj = 0; bj < 2; ++bj) { const f32x4 v0 = acc[ai][bj][m][0] * sc, v1 = acc[ai][bj][m][1] * sc;
                    u32x4 w; w.x = cvt_pk_bf16(v0[0], v0[1]); w.y = cvt_pk_bf16(v0[2], v0[3]); w.z = cvt_pk_bf16(v1[0], v1[1]); w.w = cvt_pk_bf16(v1[2], v1[3]);
                    *(u32x4*)(rowp + bj * HALF) = w; } }
    }
};
struct EpiQmRope {
    static constexpr bool PERM = true;
    bf16_t* O; int ldc; float scale; const float* tab; const float* ssl; float ssl_inv, ssl_eps;
    __device__ __forceinline__ void operator()(const f32x4 (&acc)[2][2][4][2], const Unit& u, int wr, int wc, int fr, int fq) const {
        const int row0 = u.pm * BM + wr * 64 + fr, col0 = u.pn * BM + wc * 32 + 8 * fq;
        const bool rope = (u.pn == 2);
        const int j0 = (8 * fq) >> 1;
#pragma unroll
        for (int ai = 0; ai < 2; ++ai)
#pragma unroll
            for (int m = 0; m < 4; ++m) { const int row = row0 + ai * HALF + m * 16; bf16_t* rowp = O + (size_t)row * ldc + col0; const int s = row & 4095;
                const f32x4 q_ = *(const f32x4*)(ssl + (size_t)row * 8); const float sc_ = scale * __builtin_amdgcn_rsqf(((q_[0] + q_[1]) + (q_[2] + q_[3])) * ssl_inv + ssl_eps);
                f32x4 t0 = (f32x4){1.f, 0.f, 1.f, 0.f}, t1 = (f32x4){1.f, 0.f, 1.f, 0.f};
                if (rope) { t0 = *(const f32x4*)(tab + ((size_t)s * 16 + j0) * 2); t1 = *(const f32x4*)(tab + ((size_t)s * 16 + j0 + 2) * 2); }
#pragma unroll
                for (int bj = 0; bj < 2; ++bj) { const f32x4 v0 = acc[ai][bj][m][0], v1 = acc[ai][bj][m][1];
                    f32x4 r0, r1;
                    r0[0] = v0[0] * t0[0] - v0[1] * t0[1]; r0[1] = v0[1] * t0[0] + v0[0] * t0[1];
                    r0[2] = v0[2] * t0[2] - v0[3] * t0[3]; r0[3] = v0[3] * t0[2] + v0[2] * t0[3];
                    r1[0] = v1[0] * t1[0] - v1[1] * t1[1]; r1[1] = v1[1] * t1[0] + v1[0] * t1[1];
                    r1[2] = v1[2] * t1[2] - v1[3] * t1[3]; r1[3] = v1[3] * t1[2] + v1[2] * t1[3];
                    r0 = r0 * sc_; r1 = r1 * sc_;
                    u32x4 w; w.x = cvt_pk_bf16(r0[0], r0[1]); w.y = cvt_pk_bf16(r0[2], r0[3]); w.z = cvt_pk_bf16(r1[0], r1[1]); w.w = cvt_pk_bf16(r1[2], r1[3]);
                    *(u32x4*)(rowp + bj * HALF) = w; }
                asm volatile("" ::: "memory"); }
    }
};
struct EpiBf16RowNorm {
    static constexpr bool PERM = true;
    bf16_t* O; int ldc; float scale; const float* ss; float inv_n, eps;
    __device__ __forceinline__ void operator()(const f32x4 (&acc)[2][2][4][2], const Unit& u, int wr, int wc, int fr, int fq) const {
        const int row0 = u.pm * BM + wr * 64 + fr, col0 = u.pn * BM + wc * 32 + 8 * fq;
#pragma unroll
        for (int ai = 0; ai < 2; ++ai)
#pragma unroll
            for (int m = 0; m < 4; ++m) { const int row = row0 + ai * HALF + m * 16; bf16_t* rowp = O + (size_t)row * ldc + col0;
                const f32x4 q0 = *(const f32x4*)(ss + (size_t)row * 16), q1 = *(const f32x4*)(ss + (size_t)row * 16 + 4), q2 = *(const f32x4*)(ss + (size_t)row * 16 + 8), q3 = *(const f32x4*)(ss + (size_t)row * 16 + 12);
                const float tot = ((((q0[0] + q0[1]) + (q0[2] + q0[3])) + ((q1[0] + q1[1]) + (q1[2] + q1[3]))) + (((q2[0] + q2[1]) + (q2[2] + q2[3])) + ((q3[0] + q3[1]) + (q3[2] + q3[3]))));
                const float sc = scale * __builtin_amdgcn_rsqf(tot * inv_n + eps);
#pragma unroll
                for (int bj = 0; bj < 2; ++bj) { const f32x4 v0 = acc[ai][bj][m][0] * sc, v1 = acc[ai][bj][m][1] * sc;
                    u32x4 w; w.x = cvt_pk_bf16(v0[0], v0[1]); w.y = cvt_pk_bf16(v0[2], v0[3]); w.z = cvt_pk_bf16(v1[0], v1[1]); w.w = cvt_pk_bf16(v1[2], v1[3]);
                    *(u32x4*)(rowp + bj * HALF) = w; } }
    }
};
__device__ __forceinline__ float bf_lo(unsigned w) { return __uint_as_float(w << 16); }
__device__ __forceinline__ float bf_hi(unsigned w) { return __uint_as_float(w & 0xffff0000u); }
struct EpiResidualX {
    static constexpr bool PERM = true;
    bf16_t* X; float* SSX; int ldc; float inv_n, eps, mul;
    __device__ __forceinline__ void operator()(const f32x4 (&acc)[2][2][4][2], const Unit& u, int wr, int wc, int fr, int fq, const PG8_LAS float* tab) const {
        const int rl0 = wr * 64 + fr, col0 = u.pn * BM + wc * 32 + 8 * fq;
#pragma unroll
        for (int ai = 0; ai < 2; ++ai)
#pragma unroll
            for (int m = 0; m < 4; ++m) { const int rl = rl0 + ai * HALF + m * 16, row = u.pm * BM + rl; bf16_t* rowp = X + (size_t)row * ldc + col0;
                const float rm = mul * __builtin_amdgcn_rsqf((tab[rl * 4 + 2] + tab[rl * 4 + 3]) * inv_n + eps);
                u32x4 xv[2]; float s = 0.f;
#pragma unroll
                for (int bj = 0; bj < 2; ++bj) xv[bj] = *(const u32x4*)(rowp + bj * HALF);
#pragma unroll
                for (int bj = 0; bj < 2; ++bj) { const f32x4 a0 = acc[ai][bj][m][0] * rm, a1 = acc[ai][bj][m][1] * rm; u32x4 w;
                    w.x = cvt_pk_bf16(bf_lo(xv[bj].x) + a0[0], bf_hi(xv[bj].x) + a0[1]); w.y = cvt_pk_bf16(bf_lo(xv[bj].y) + a0[2], bf_hi(xv[bj].y) + a0[3]);
                    w.z = cvt_pk_bf16(bf_lo(xv[bj].z) + a1[0], bf_hi(xv[bj].z) + a1[1]); w.w = cvt_pk_bf16(bf_lo(xv[bj].w) + a1[2], bf_hi(xv[bj].w) + a1[3]);
                    *(u32x4*)(rowp + bj * HALF) = w;
                    const float r0 = bf_lo(w.x), r1 = bf_hi(w.x), r2 = bf_lo(w.y), r3 = bf_hi(w.y), r4 = bf_lo(w.z), r5 = bf_hi(w.z), r6 = bf_lo(w.w), r7 = bf_hi(w.w);
                    s += ((r0 * r0 + r1 * r1) + (r2 * r2 + r3 * r3)) + ((r4 * r4 + r5 * r5) + (r6 * r6 + r7 * r7)); }
                s += __shfl_xor(s, 16); s += __shfl_xor(s, 32);
                if (fq == 0) SSX[(size_t)row * 16 + u.pn * 4 + wc] = s;
                if (m & 1) asm volatile("" ::: "memory"); }
    }
};
struct EpiResidual {
    static constexpr bool PERM = true;
    bf16_t* X; int ldc; float mul;
    __device__ __forceinline__ void operator()(const f32x4 (&acc)[2][2][4][2], const Unit& u, int wr, int wc, int fr, int fq) const {
        const int row0 = u.pm * BM + wr * 64 + fr, col0 = u.pn * BM + wc * 32 + 8 * fq;
#pragma unroll
        for (int ai = 0; ai < 2; ++ai)
#pragma unroll
            for (int m = 0; m < 4; ++m) { bf16_t* rowp = X + (size_t)(row0 + ai * HALF + m * 16) * ldc + col0;
                u32x4 xv[2];
#pragma unroll
                for (int bj = 0; bj < 2; ++bj) xv[bj] = *(const u32x4*)(rowp + bj * HALF);
#pragma unroll
                for (int bj = 0; bj < 2; ++bj) { const f32x4 a0 = acc[ai][bj][m][0] * mul, a1 = acc[ai][bj][m][1] * mul; u32x4 w;
                    w.x = cvt_pk_bf16(bf_lo(xv[bj].x) + a0[0], bf_hi(xv[bj].x) + a0[1]); w.y = cvt_pk_bf16(bf_lo(xv[bj].y) + a0[2], bf_hi(xv[bj].y) + a0[3]);
                    w.z = cvt_pk_bf16(bf_lo(xv[bj].z) + a1[0], bf_hi(xv[bj].z) + a1[1]); w.w = cvt_pk_bf16(bf_lo(xv[bj].w) + a1[2], bf_hi(xv[bj].w) + a1[3]);
                    *(u32x4*)(rowp + bj * HALF) = w; } }
    }
};
struct EpiInProj {
    static constexpr bool PERM = true;
    const float* rs; const float* gq; const float* gk; const float* tabg; const float* tabm;
    bf16_t* QG; bf16_t* KG; bf16_t* VG; bf16_t* LAT; bf16_t* KROPE; float* SSL; float qscale, eps;
    __device__ __forceinline__ static void rope2(f32x4& v, const f32x4 t) { const float a0 = v[0], b0 = v[1], a1 = v[2], b1 = v[3];
        v[0] = a0 * t[0] - b0 * t[1]; v[1] = b0 * t[0] + a0 * t[1]; v[2] = a1 * t[2] - b1 * t[3]; v[3] = b1 * t[2] + a1 * t[3]; }
    __device__ __forceinline__ static u32x4 pack(const f32x4 a, const f32x4 b) { u32x4 w; w.x = cvt_pk_bf16(a[0], a[1]); w.y = cvt_pk_bf16(a[2], a[3]); w.z = cvt_pk_bf16(b[0], b[1]); w.w = cvt_pk_bf16(b[2], b[3]); return w; }
    __device__ __forceinline__ void operator()(const f32x4 (&acc)[2][2][4][2], const Unit& u, int wr, int wc, int fr, int fq) const {
        const int row0 = u.pm * BM + wr * 64 + fr;
        if (u.pn < 2 || (u.pn == 2 && wc < 2)) {
            const bool isq = u.pn < 2; const float* g = isq ? gq : gk; bf16_t* dst = isq ? QG : KG; const int ld = isq ? 512 : 128, hcol = (isq ? (u.pn * 4 + wc) : wc) * 64; const float osc = isq ? qscale : 1.0f;
            f32x4 gv[2][2];
#pragma unroll
            for (int bj = 0; bj < 2; ++bj)
#pragma unroll
                for (int n = 0; n < 2; ++n)
#pragma unroll
                    for (int i = 0; i < 4; ++i) { const int p = 32 * bj + 8 * fq + 4 * n + i; gv[bj][n][i] = g[(p >> 1) + 32 * (p & 1)]; }
#pragma unroll
            for (int ai = 0; ai < 2; ++ai)
#pragma unroll
                for (int m = 0; m < 4; ++m) { const int row = row0 + ai * HALF + m * 16, s = row & 4095; const float sc = rs[row];
                    f32x4 v[2][2]; float ss = 0.f;
#pragma unroll
                    for (int bj = 0; bj < 2; ++bj)
#pragma unroll
                        for (int n = 0; n < 2; ++n) { v[bj][n] = acc[ai][bj][m][n] * sc; ss += (v[bj][n][0] * v[bj][n][0] + v[bj][n][1] * v[bj][n][1]) + (v[bj][n][2] * v[bj][n][2] + v[bj][n][3] * v[bj][n][3]); }
                    ss += __shfl_xor(ss, 16); ss += __shfl_xor(ss, 32);
                    const float rstd = __builtin_amdgcn_rsqf(ss * (1.0f / 64.0f) + eps);
#pragma unroll
                    for (int bj = 0; bj < 2; ++bj) {
#pragma unroll
                        for (int n = 0; n < 2; ++n) { v[bj][n] = v[bj][n] * rstd * gv[bj][n];
                            const f32x4 t = *(const f32x4*)(tabg + ((size_t)s * 32 + 16 * bj + 4 * fq + 2 * n) * 2); rope2(v[bj][n], t); v[bj][n] = v[bj][n] * osc; }
                        *(u32x4*)(dst + (size_t)row * ld + hcol + 32 * bj + 8 * fq) = pack(v[bj][0], v[bj][1]); } }
        } else if (u.pn == 2) {
#pragma unroll
            for (int ai = 0; ai < 2; ++ai)
#pragma unroll
                for (int m = 0; m < 4; ++m) { const int row = row0 + ai * HALF + m * 16; const float sc = rs[row];
#pragma unroll
                    for (int bj = 0; bj < 2; ++bj) *(u32x4*)(VG + (size_t)row * 128 + (wc - 2) * 64 + 32 * bj + 8 * fq) = pack(acc[ai][bj][m][0] * sc, acc[ai][bj][m][1] * sc); }
        } else if (u.pn == 3) {
#pragma unroll
            for (int ai = 0; ai < 2; ++ai)
#pragma unroll
                for (int m = 0; m < 4; ++m) { const int row = row0 + ai * HALF + m * 16; const float sc = rs[row]; float ss = 0.f;
#pragma unroll
                    for (int bj = 0; bj < 2; ++bj) { const f32x4 a = acc[ai][bj][m][0] * sc, b = acc[ai][bj][m][1] * sc;
                        ss += ((a[0] * a[0] + a[1] * a[1]) + (a[2] * a[2] + a[3] * a[3])) + ((b[0] * b[0] + b[1] * b[1]) + (b[2] * b[2] + b[3] * b[3]));
                        *(u32x4*)(LAT + (size_t)row * 512 + 128 * bj + 32 * wc + 8 * fq) = pack(a, b); }
                    ss += __shfl_xor(ss, 16); ss += __shfl_xor(ss, 32);
                    if (fq == 0) SSL[(size_t)row * 8 + wc] = ss; }
        } else {
#pragma unroll
            for (int ai = 0; ai < 2; ++ai)
#pragma unroll
                for (int m = 0; m < 4; ++m) { const int row = row0 + ai * HALF + m * 16, s = row & 4095; const float sc = rs[row];
                    const f32x4 a = acc[ai][0][m][0] * sc, b = acc[ai][0][m][1] * sc;
                    float ss = ((a[0] * a[0] + a[1] * a[1]) + (a[2] * a[2] + a[3] * a[3])) + ((b[0] * b[0] + b[1] * b[1]) + (b[2] * b[2] + b[3] * b[3]));
                    *(u32x4*)(LAT + (size_t)row * 512 + 256 + 32 * wc + 8 * fq) = pack(a, b);
                    ss += __shfl_xor(ss, 16); ss += __shfl_xor(ss, 32);
                    if (fq == 0) SSL[(size_t)row * 8 + 4 + wc] = ss;
                    if (wc == 0) { f32x4 c = acc[ai][1][m][0] * sc, d = acc[ai][1][m][1] * sc;
                        rope2(c, *(const f32x4*)(tabm + ((size_t)s * 16 + 4 * fq) * 2)); rope2(d, *(const f32x4*)(tabm + ((size_t)s * 16 + 4 * fq + 2) * 2));
                        *(u32x4*)(KROPE + (size_t)row * 32 + 8 * fq) = pack(c, d); } }
        }
    }
};
struct EpiSwiGLU {
    static constexpr bool PERM = true;
    bf16_t* O; int ldc; const float* rs;
    __device__ __forceinline__ static float silu_mul(float g, float u) { return g * u * __builtin_amdgcn_rcpf(1.0f + __builtin_amdgcn_exp2f(-1.4426950408889634f * g)); }
    __device__ __forceinline__ void operator()(const f32x4 (&acc)[2][2][4][2], const Unit& u, int wr, int wc, int fr, int fq) const {
        const int row0 = u.pm * BM + wr * 64 + fr, col0 = u.pn * HALF + wc * 32 + 8 * fq;
#pragma unroll
        for (int ai = 0; ai < 2; ++ai)
#pragma unroll
            for (int m = 0; m < 4; ++m) { const int row = row0 + ai * HALF + m * 16; bf16_t* rowp = O + (size_t)row * ldc + col0; const float sc = rs[row];
                const f32x4 g0 = acc[ai][0][m][0] * sc, g1 = acc[ai][0][m][1] * sc, u0 = acc[ai][1][m][0] * sc, u1 = acc[ai][1][m][1] * sc;
                u32x4 w; w.x = cvt_pk_bf16(silu_mul(g0[0], u0[0]), silu_mul(g0[1], u0[1])); w.y = cvt_pk_bf16(silu_mul(g0[2], u0[2]), silu_mul(g0[3], u0[3]));
                w.z = cvt_pk_bf16(silu_mul(g1[0], u1[0]), silu_mul(g1[1], u1[1])); w.w = cvt_pk_bf16(silu_mul(g1[2], u1[2]), silu_mul(g1[3], u1[3]));
                *(u32x4*)rowp = w; }
    }
};

template <class Epi, class Sched, bool ALIGN_EPI = false, bool GATHER = false, bool MIDSCALE = false>
__device__ __forceinline__ void gemm_phase(PG8_LAS unsigned char* lds, const Gemm g, const Sched& S, const Epi& E, PG8_LAS unsigned char* gtab = nullptr, float ms_inv_n = 0.f, float ms_eps = 0.f) {
    int tid_ = threadIdx.x; asm volatile("" : "+v"(tid_));
    const int tid = tid_, wid = __builtin_amdgcn_readfirstlane(tid >> 6), lane = tid & 63, wr = wid >> 2, wc = wid & 3, fr = lane & 15, fq = lane >> 4;
    const int K = g.K, nt = K / BK;
    unsigned voffA[2], voffB[2]; int gR[2], gC[2];
#pragma unroll
    for (int i = 0; i < 2; ++i) { int R, C; stage_rc(tid * 16 + i * 8192, R, C); const int Rb = Epi::PERM ? ((R & ~31) + perm32(R & 31)) : R; gR[i] = R; gC[i] = C;
        voffA[i] = (unsigned)(R * g.lda + C) * 2u; voffB[i] = (unsigned)(Rb * g.ldb + C) * 2u; }
    unsigned goffc[2][2], goffn[2][2];
#define PG8_GISSUE(u) do { _Pragma("unroll") for (int h_ = 0; h_ < 2; ++h_) _Pragma("unroll") for (int i_ = 0; i_ < 2; ++i_) \
        __builtin_amdgcn_global_load_lds((const unsigned*)(g.idx + (u).pm * BM + h_ * HALF + gR[i_]), (PG8_LAS unsigned*)(gtab + ((h_ * 2 + i_) * 8 + wid) * 256), 4, 0, 0); } while (0)
#define PG8_GREAD(dst, u) do { asm volatile("" ::: "memory"); _Pragma("unroll") for (int h_ = 0; h_ < 2; ++h_) _Pragma("unroll") for (int i_ = 0; i_ < 2; ++i_) { \
        const int tok_ = *(const PG8_LAS int*)(gtab + ((h_ * 2 + i_) * 8 + wid) * 256 + lane * 4); \
        dst[h_][i_] = (unsigned)(((((u).pm >> 1) & 7) * 4096 + tok_) * g.lda + gC[i_]) * 2u; } } while (0)
    const size_t kstep = (size_t)(BK * 2);
    const size_t hstepA = (size_t)HALF * g.lda * 2, hstepB = (size_t)HALF * g.ldb * 2;
    const size_t tstepA = 2 * hstepA, tstepB = 2 * hstepB;
    const unsigned ldsw = (unsigned)wid * 1024u;
    const int aoff = lds_byte(wr * 64 + fr, fq * 8), boff = lds_byte(wc * 32 + fr, fq * 8);
#define PG8_SA(b, h) (((b) * 2 + (h)) * HTB)
#define PG8_SB(b, h) ((4 + (b) * 2 + (h)) * HTB)
#define PG8_STAGE(bufoff, gbase, voff) do { _Pragma("unroll") for (int _i = 0; _i < 2; ++_i) \
        __builtin_amdgcn_global_load_lds((const unsigned*)((const char*)(gbase) + (voff)[_i]), (PG8_LAS unsigned*)(lds + (bufoff) + ldsw + _i * 8192), 16, 0, 0); } while (0)
#define PG8_LDA(dst, b, h) do { _Pragma("unroll") for (int m = 0; m < 4; ++m) _Pragma("unroll") for (int k = 0; k < 2; ++k) dst[m][k] = *(const PG8_LAS bf16x8*)(lds + PG8_SA(b, h) + aoff + m * 2048 + k * 1024); } while (0)
#define PG8_LDB(dst, b, h) do { _Pragma("unroll") for (int n = 0; n < 2; ++n) _Pragma("unroll") for (int k = 0; k < 2; ++k) dst[n][k] = *(const PG8_LAS bf16x8*)(lds + PG8_SB(b, h) + boff + n * 2048 + k * 1024); } while (0)
#define PG8_MMA(ai, bj, At, Bt) do { __builtin_amdgcn_s_setprio(1); _Pragma("unroll") for (int m = 0; m < 4; ++m) _Pragma("unroll") for (int n = 0; n < 2; ++n) _Pragma("unroll") for (int k = 0; k < 2; ++k) \
        acc[ai][bj][m][n] = __builtin_amdgcn_mfma_f32_16x16x32_bf16(Bt[n][k], At[m][k], acc[ai][bj][m][n], 0, 0, 0); __builtin_amdgcn_s_setprio(0); } while (0)
#define PG8_WAIT_V(n) asm volatile("s_waitcnt vmcnt(" #n ")" ::: "memory")
#define PG8_WAIT_L(n) asm volatile("s_waitcnt lgkmcnt(" #n ")" ::: "memory")
#define PG8_BAR __builtin_amdgcn_s_barrier()
#define PG8_SCHED __builtin_amdgcn_sched_barrier(0)
#define PG8_ABASE(u) (GATHER ? (const char*)g.A : (const char*)g.A + (size_t)((u).pm % g.amod) * tstepA)
#define PG8_STA(bufoff, kptr, h, nx) do { if constexpr (GATHER) { unsigned o_[2]; o_[0] = (nx) ? goffn[h][0] : goffc[h][0]; o_[1] = (nx) ? goffn[h][1] : goffc[h][1]; PG8_STAGE(bufoff, kptr, o_); } \
        else { PG8_STAGE(bufoff, (kptr) + (h) * hstepA, voffA); } } while (0)
#define PG8_BBASE(u) ((const char*)g.Bt + ((size_t)((u).pm / g.gdiv) * g.gstride) * 2 + (size_t)(u).pn * tstepB)
    Unit cur, nxt; int ui = 0;
    if (!S.next(0, cur)) return;
    f32x4 acc[2][2][4][2];
#pragma unroll
    for (int a = 0; a < 2; ++a)
#pragma unroll
        for (int b = 0; b < 2; ++b)
#pragma unroll
            for (int m = 0; m < 4; ++m)
#pragma unroll
                for (int n = 0; n < 2; ++n) acc[a][b][m][n] = (f32x4){0.f, 0.f, 0.f, 0.f};
    bf16x8 At[4][2], B0[2][2], B1[2][2];
    const char* cA = PG8_ABASE(cur); const char* cB = PG8_BBASE(cur);
    if constexpr (GATHER) { PG8_GISSUE(cur); PG8_WAIT_V(0); PG8_GREAD(goffc, cur);
#pragma unroll
        for (int h_ = 0; h_ < 2; ++h_) { goffn[h_][0] = goffc[h_][0]; goffn[h_][1] = goffc[h_][1]; } }
    PG8_STAGE(PG8_SB(0, 0), cB, voffB); PG8_STAGE(PG8_SB(0, 1), cB + hstepB, voffB); PG8_STA(PG8_SA(0, 0), cA, 0, false); PG8_STA(PG8_SA(0, 1), cA, 1, false);
    if (wr == 1) PG8_BAR;
    PG8_WAIT_V(2); PG8_BAR;
    PG8_STAGE(PG8_SB(1, 0), cB + kstep, voffB); PG8_STA(PG8_SA(1, 0), cA + kstep, 0, false); PG8_STAGE(PG8_SB(1, 1), cB + hstepB + kstep, voffB);
    PG8_WAIT_V(6); PG8_BAR;
    for (;;) {
        const bool has_next = S.next(ui + 1, nxt);
        const char* nA = has_next ? PG8_ABASE(nxt) : cA; const char* nB = has_next ? PG8_BBASE(nxt) : cB;
        if constexpr (GATHER) { if (has_next) PG8_GISSUE(nxt); }
        if constexpr (MIDSCALE) {
#pragma unroll
            for (int q_ = 0; q_ < 2; ++q_) __builtin_amdgcn_global_load_lds((const unsigned*)(g.ss + (size_t)cur.pm * 1024 + q_ * 512 + wid * 64 + lane), (PG8_LAS unsigned*)(gtab + (ui & 1) * 4096 + q_ * 2048 + wid * 256), 4, 0, 0); }
#pragma nounroll
        for (int t = 0; t < nt; t += 2) {
            const bool last = (t == nt - 2);
            const char* a1 = cA + (size_t)(t + 1) * kstep;
            const char* a2 = last ? nA : cA + (size_t)(t + 2) * kstep; const char* b2 = last ? nB : cB + (size_t)(t + 2) * kstep;
            const char* a3 = a2 + kstep; const char* b3 = b2 + kstep;
            if constexpr (GATHER) { if (last && has_next) PG8_GREAD(goffn, nxt); }
            if constexpr (MIDSCALE) { if (t == nt / 2) { asm volatile("" ::: "memory"); const PG8_LAS float* tab = (const PG8_LAS float*)(gtab + (ui & 1) * 4096);
#pragma unroll
                for (int ai = 0; ai < 2; ++ai)
#pragma unroll
                    for (int m = 0; m < 4; ++m) { const int rl = ai * HALF + wr * 64 + m * 16 + fr; const float sg = tab[rl * 4] + tab[rl * 4 + 1], sm = tab[rl * 4 + 2] + tab[rl * 4 + 3];
                        const float ratio = __builtin_amdgcn_rsqf(sg * ms_inv_n + ms_eps) * __builtin_amdgcn_rcpf(__builtin_amdgcn_rsqf(sm * ms_inv_n + ms_eps));
#pragma unroll
                        for (int bj = 0; bj < 2; ++bj)
#pragma unroll
                            for (int n = 0; n < 2; ++n) acc[ai][bj][m][n] = acc[ai][bj][m][n] * ratio; } } }
            PG8_LDB(B0, 0, 0); PG8_LDB(B1, 0, 1); PG8_SCHED; PG8_LDA(At, 0, 0); PG8_STA(PG8_SA(1, 1), a1, 1, false);
            PG8_WAIT_V(8); PG8_WAIT_L(0); PG8_BAR; PG8_MMA(0, 0, At, B0); PG8_MMA(0, 1, At, B1); PG8_BAR; PG8_SCHED;
            PG8_LDA(At, 0, 1); PG8_STAGE(PG8_SB(0, 0), b2, voffB); PG8_STAGE(PG8_SB(0, 1), b2 + hstepB, voffB); PG8_STA(PG8_SA(0, 0), a2, 0, last);
            PG8_WAIT_V(8); PG8_WAIT_L(0); PG8_BAR; PG8_MMA(1, 0, At, B0); PG8_MMA(1, 1, At, B1); PG8_BAR; PG8_SCHED;
            PG8_LDB(B0, 1, 0); PG8_LDB(B1, 1, 1); PG8_SCHED; PG8_LDA(At, 1, 0); PG8_STA(PG8_SA(0, 1), a2, 1, last);
            PG8_WAIT_V(8); PG8_WAIT_L(0); PG8_BAR; PG8_MMA(0, 0, At, B0); PG8_MMA(0, 1, At, B1); PG8_BAR; PG8_SCHED;
            PG8_LDA(At, 1, 1); PG8_STAGE(PG8_SB(1, 0), b3, voffB); PG8_STAGE(PG8_SB(1, 1), b3 + hstepB, voffB); PG8_STA(PG8_SA(1, 0), a3, 0, last);
            PG8_WAIT_V(8); PG8_WAIT_L(0); PG8_BAR; PG8_MMA(1, 0, At, B0); PG8_MMA(1, 1, At, B1); PG8_BAR; PG8_SCHED;
        }
        if constexpr (ALIGN_EPI) { if (wr == 0) PG8_BAR; }
        if constexpr (MIDSCALE) E(acc, cur, wr, wc, fr, fq, (const PG8_LAS float*)(gtab + (ui & 1) * 4096)); else E(acc, cur, wr, wc, fr, fq);
        if (!has_next) break;
#pragma unroll
        for (int a = 0; a < 2; ++a)
#pragma unroll
            for (int b = 0; b < 2; ++b)
#pragma unroll
                for (int m = 0; m < 4; ++m)
#pragma unroll
                    for (int n = 0; n < 2; ++n) acc[a][b][m][n] = (f32x4){0.f, 0.f, 0.f, 0.f};
        cur = nxt; cA = nA; cB = nB; ++ui;
        if constexpr (GATHER) {
#pragma unroll
            for (int h_ = 0; h_ < 2; ++h_) { goffc[h_][0] = goffn[h_][0]; goffc[h_][1] = goffn[h_][1]; } }
        if constexpr (ALIGN_EPI) { if (wr == 1) PG8_BAR; }
    }
    PG8_WAIT_V(0);
    if constexpr (!ALIGN_EPI) { if (wr == 0) PG8_BAR; }
    PG8_BAR;
#undef PG8_SA
#undef PG8_SB
#undef PG8_STAGE
#undef PG8_LDA
#undef PG8_LDB
#undef PG8_MMA
#undef PG8_WAIT_V
#undef PG8_WAIT_L
#undef PG8_BAR
#undef PG8_SCHED
#undef PG8_ABASE
#undef PG8_STA
#undef PG8_GISSUE
#undef PG8_GREAD
#undef PG8_BBASE
}
}
namespace att {
typedef unsigned short bf16;
using bf16x8 = __attribute__((ext_vector_type(8))) short;
using s16x4  = __attribute__((ext_vector_type(4))) short;
using f32x16 = __attribute__((ext_vector_type(16))) float;
using u32x4  = __attribute__((ext_vector_type(4))) unsigned;
#define ATT_SBAR() __builtin_amdgcn_sched_barrier(0)
constexpr int KCH = 1040;
constexpr float THR = 8.0f;
__device__ __forceinline__ int crow(int r, int hi) { return (r & 3) + 8 * (r >> 2) + 4 * hi; }
__device__ __forceinline__ unsigned cvtpk(float lo, float hi) { unsigned r; asm volatile("v_cvt_pk_bf16_f32 %0, %1, %2" : "=v"(r) : "v"(lo), "v"(hi)); return r; }
typedef float f32x2_t __attribute__((ext_vector_type(2))); typedef __bf16 bf16x2_t __attribute__((ext_vector_type(2)));
__device__ __forceinline__ unsigned cvtpk_c(float lo, float hi) { const f32x2_t v = {lo, hi}; const bf16x2_t b = __builtin_convertvector(v, bf16x2_t); return __builtin_bit_cast(unsigned, b); }
__device__ __forceinline__ unsigned short f2bf1(float f) { unsigned u = __builtin_bit_cast(unsigned, f); return (unsigned short)((u + 0x7fffu + ((u >> 16) & 1u)) >> 16); }

#define ATT_MX3(a, b, c) __builtin_fmaxf(__builtin_fmaxf((a), (b)), (c))
template <int MODE, bool FIRST>
__device__ __forceinline__ void partialSM(f32x16& p0, f32x16& p1, float& m_run, f32x16& negm, float& alpha) {
  if constexpr (MODE == 0) {
    float a = ATT_MX3(p0[0], p0[1], p1[0]), b = ATT_MX3(p0[2], p0[3], p1[1]); a = ATT_MX3(a, p1[2], p1[3]);
#pragma unroll
    for (int r = 4; r < 16; r += 4) { a = ATT_MX3(a, p0[r], p0[r + 1]); b = ATT_MX3(b, p0[r + 2], p0[r + 3]); a = ATT_MX3(a, p1[r], p1[r + 1]); b = ATT_MX3(b, p1[r + 2], p1[r + 3]); }
    float pmax = fmaxf(a, b);
    { auto rr = __builtin_amdgcn_permlane32_swap(__float_as_uint(pmax), __float_as_uint(pmax), false, false);
      pmax = fmaxf(__uint_as_float(rr[0]), __uint_as_float(rr[1])); }
    alpha = 1.f;
    if (FIRST || __builtin_expect(__any(pmax > THR), 0)) {
      const float dl = FIRST ? pmax : fmaxf(pmax, 0.f);
      m_run += dl;
#pragma unroll
      for (int r = 0; r < 16; ++r) { p0[r] -= dl; p1[r] -= dl; }
#pragma unroll
      for (int r = 0; r < 16; ++r) negm[r] = -m_run;
      asm volatile("" : "+v"(negm));
      alpha = FIRST ? 1.f : __builtin_amdgcn_exp2f(-dl);
    }
  } else { alpha = 1.f; }
#pragma unroll
  for (int r = 0; r < 16; ++r) p0[r] = __builtin_amdgcn_exp2f(p0[r]);
}
__device__ __forceinline__ void finishSM(f32x16& p0, f32x16& p1, float alpha, float& l_reg, bf16x8& pa0, bf16x8& pa1, bf16x8& pa2, bf16x8& pa3) {
#pragma unroll
  for (int r = 0; r < 16; ++r) p1[r] = __builtin_amdgcn_exp2f(p1[r]);
  float ps = 0;
#pragma unroll
  for (int r = 0; r < 16; ++r) ps += p0[r];
#pragma unroll
  for (int r = 0; r < 16; ++r) ps += p1[r];
  { auto rr = __builtin_amdgcn_permlane32_swap(__float_as_uint(ps), __float_as_uint(ps), false, false);
    ps = __uint_as_float(rr[0]) + __uint_as_float(rr[1]); }
  l_reg = l_reg * alpha + ps;
#define ATT_PK4(P, BASE, OUT) do { const u32x4 w = {cvtpk_c(P[BASE + 0], P[BASE + 1]), cvtpk_c(P[BASE + 2], P[BASE + 3]), cvtpk_c(P[BASE + 4], P[BASE + 5]), cvtpk_c(P[BASE + 6], P[BASE + 7])}; \
    OUT = __builtin_bit_cast(bf16x8, w); } while (0)
  ATT_PK4(p0, 0, pa0); ATT_PK4(p0, 8, pa1); ATT_PK4(p1, 0, pa2); ATT_PK4(p1, 8, pa3);
#undef ATT_PK4
}
template <int ND0, int MODE = 0>
__device__ __forceinline__ void qkt(f32x16& p0, f32x16& p1, const char* Ks, const bf16x8* qr, const f32x16& negm, int r32, int hi) {
#pragma unroll
  for (int d0 = 0; d0 < ND0; ++d0) {
    const char* kb = Ks + (2 * d0 + hi) * KCH + r32 * 16;
    bf16x8 b0 = *reinterpret_cast<const bf16x8*>(kb);
    bf16x8 b1 = *reinterpret_cast<const bf16x8*>(kb + 512);
    if (d0 == 0) { if constexpr (MODE == 1) { p0 = __builtin_amdgcn_mfma_f32_32x32x16_bf16(b0, qr[0], f32x16{}, 0, 0, 0); p1 = __builtin_amdgcn_mfma_f32_32x32x16_bf16(b1, qr[0], f32x16{}, 0, 0, 0); }
                   else { p0 = __builtin_amdgcn_mfma_f32_32x32x16_bf16(b0, qr[0], negm, 0, 0, 0); p1 = __builtin_amdgcn_mfma_f32_32x32x16_bf16(b1, qr[0], negm, 0, 0, 0); } }
    else { p0 = __builtin_amdgcn_mfma_f32_32x32x16_bf16(b0, qr[d0], p0, 0, 0, 0); p1 = __builtin_amdgcn_mfma_f32_32x32x16_bf16(b1, qr[d0], p1, 0, 0, 0); } }
}
template <int NB> __device__ __forceinline__ int v_st(int k, int c) { const int kk = k; return ((kk >> 3) * NB + (c >> 5)) * 512 + ((kk & 7) * 32 + (c & 31)) * 2; }
__device__ __forceinline__ int v_rd_base(int lane) { return ((lane & 3) << 3) | (((lane >> 2) & 3) << 6) | (((lane >> 4) & 1) << 5) | (((lane >> 5) & 1) << 8); }
template <int OFF> __device__ __forceinline__ s16x4 tr_read(int vb) {
  s16x4 r; asm volatile("ds_read_b64_tr_b16 %0, %1 offset:%2" : "=&v"(r) : "v"(vb), "i"(OFF) : "memory"); return r;
}
template <int NB, int D0> __device__ __forceinline__ void pv_one(f32x16& od, int vb, bf16x8 pa0, bf16x8 pa1, bf16x8 pa2, bf16x8 pa3) {
#define ATT_VO(ks, half) (D0 * 512 + (2 * (ks) + (half)) * NB * 512)
  const s16x4 l0 = tr_read<ATT_VO(0, 0)>(vb), h0 = tr_read<ATT_VO(0, 1)>(vb), l1 = tr_read<ATT_VO(1, 0)>(vb), h1 = tr_read<ATT_VO(1, 1)>(vb);
  const s16x4 l2 = tr_read<ATT_VO(2, 0)>(vb), h2 = tr_read<ATT_VO(2, 1)>(vb), l3 = tr_read<ATT_VO(3, 0)>(vb), h3 = tr_read<ATT_VO(3, 1)>(vb);
#undef ATT_VO
  asm volatile("s_waitcnt lgkmcnt(0)" ::: "memory"); ATT_SBAR();
#define ATT_PK(L, H) (bf16x8){L[0], L[1], L[2], L[3], H[0], H[1], H[2], H[3]}
  od = __builtin_amdgcn_mfma_f32_32x32x16_bf16(pa0, ATT_PK(l0, h0), od, 0, 0, 0);
  od = __builtin_amdgcn_mfma_f32_32x32x16_bf16(pa1, ATT_PK(l1, h1), od, 0, 0, 0);
  od = __builtin_amdgcn_mfma_f32_32x32x16_bf16(pa2, ATT_PK(l2, h2), od, 0, 0, 0);
  od = __builtin_amdgcn_mfma_f32_32x32x16_bf16(pa3, ATT_PK(l3, h3), od, 0, 0, 0);
#undef ATT_PK
}
template <int NB> __device__ __forceinline__ void pv_all(f32x16* o, int vb, bf16x8 pa0, bf16x8 pa1, bf16x8 pa2, bf16x8 pa3) {
  if constexpr (NB == 2) {
#define ATT_VO(d0, ks, half) ((d0) * 512 + (2 * (ks) + (half)) * NB * 512)
    const s16x4 l0 = tr_read<ATT_VO(0, 0, 0)>(vb), h0 = tr_read<ATT_VO(0, 0, 1)>(vb), l1 = tr_read<ATT_VO(0, 1, 0)>(vb), h1 = tr_read<ATT_VO(0, 1, 1)>(vb);
    const s16x4 l2 = tr_read<ATT_VO(0, 2, 0)>(vb), h2 = tr_read<ATT_VO(0, 2, 1)>(vb), l3 = tr_read<ATT_VO(0, 3, 0)>(vb), h3 = tr_read<ATT_VO(0, 3, 1)>(vb);
    const s16x4 m0 = tr_read<ATT_VO(1, 0, 0)>(vb), n0 = tr_read<ATT_VO(1, 0, 1)>(vb), m1 = tr_read<ATT_VO(1, 1, 0)>(vb), n1 = tr_read<ATT_VO(1, 1, 1)>(vb);
    const s16x4 m2 = tr_read<ATT_VO(1, 2, 0)>(vb), n2 = tr_read<ATT_VO(1, 2, 1)>(vb), m3 = tr_read<ATT_VO(1, 3, 0)>(vb), n3 = tr_read<ATT_VO(1, 3, 1)>(vb);
#undef ATT_VO
#define ATT_PK(L, H) (bf16x8){L[0], L[1], L[2], L[3], H[0], H[1], H[2], H[3]}
    asm volatile("s_waitcnt lgkmcnt(8)" ::: "memory"); ATT_SBAR();
    o[0] = __builtin_amdgcn_mfma_f32_32x32x16_bf16(pa0, ATT_PK(l0, h0), o[0], 0, 0, 0);
    o[0] = __builtin_amdgcn_mfma_f32_32x32x16_bf16(pa1, ATT_PK(l1, h1), o[0], 0, 0, 0);
    o[0] = __builtin_amdgcn_mfma_f32_32x32x16_bf16(pa2, ATT_PK(l2, h2), o[0], 0, 0, 0);
    o[0] = __builtin_amdgcn_mfma_f32_32x32x16_bf16(pa3, ATT_PK(l3, h3), o[0], 0, 0, 0);
    asm volatile("s_waitcnt lgkmcnt(0)" ::: "memory"); ATT_SBAR();
    o[1] = __builtin_amdgcn_mfma_f32_32x32x16_bf16(pa0, ATT_PK(m0, n0), o[1], 0, 0, 0);
    o[1] = __builtin_amdgcn_mfma_f32_32x32x16_bf16(pa1, ATT_PK(m1, n1), o[1], 0, 0, 0);
    o[1] = __builtin_amdgcn_mfma_f32_32x32x16_bf16(pa2, ATT_PK(m2, n2), o[1], 0, 0, 0);
    o[1] = __builtin_amdgcn_mfma_f32_32x32x16_bf16(pa3, ATT_PK(m3, n3), o[1], 0, 0, 0);
#undef ATT_PK
  } else {
    pv_one<NB, 0>(o[0], vb, pa0, pa1, pa2, pa3); pv_one<NB, 1>(o[1], vb, pa0, pa1, pa2, pa3);
    pv_one<NB, 2>(o[2], vb, pa0, pa1, pa2, pa3); pv_one<NB, 3>(o[3], vb, pa0, pa1, pa2, pa3);
  }
}

template <int W1, int W2, int DV> struct AttnCfg {
  static constexpr int DQK = W1 + W2, NCH = DQK / 8, ND0 = DQK / 16, NB = DV / 32;
  static constexpr int KT_BYTES = NCH * KCH, VT_BYTES = 64 * DV * 2;
  static constexpr int OST_BYTES = 32 * DV * 2;
  static constexpr bool OSTAGE = (DV == 64);
  static constexpr int LDS_BYTES = 3 * VT_BYTES + 3 * KT_BYTES + 8 * 64 * 4 + (OSTAGE ? 8 * OST_BYTES : 0);
  static constexpr int CW1 = W1 / 8, N1 = (64 * CW1) / 512;
  static constexpr int CWV = DV / 8, NV = (64 * CWV) / 512;
  static_assert(W1 == 64 || W1 == 128, "W1"); static_assert(W2 == 0 || W2 == 32, "W2"); static_assert(DV == 64 || DV == 128, "DV");
};

template <int W1, int W2, int DV, int MODE, bool SSQ>
__device__ __forceinline__ void attn_unit(const bf16* __restrict__ Qb, const bf16* __restrict__ Qb2, int ldq, const bf16* __restrict__ K1, int ldk1, const bf16* __restrict__ K2, int ldk2,
                                          const bf16* __restrict__ Vh, int ldv, bf16* __restrict__ Ob, int ldo, int nkeys, char* lds, float (&ssacc)[16]) {
  using C = AttnCfg<W1, W2, DV>;
  constexpr int ND0 = C::ND0, NB = C::NB, N1 = C::N1, NV = C::NV, CW1 = C::CW1, CWV = C::CWV;
  constexpr int SHM_V = C::VT_BYTES, SHM_K = C::KT_BYTES;
  int tid_ = threadIdx.x; asm volatile("" : "+v"(tid_));
  const int tid = tid_, wid = tid >> 6, lane = tid & 63, r32 = lane & 31, hi = lane >> 5;
  char* V_lds = lds; char* K_lds = lds + 3 * SHM_V;
  float* ws = (float*)(lds + 3 * SHM_V + 3 * SHM_K) + wid * 64; float* li_l = ws; float* al_l = ws + 32;
  float m_reg = 0.f, l_reg = 0; f32x16 o[NB]; bf16x8 qr[ND0]; f32x16 negm = f32x16{}; if constexpr (MODE == 0) asm volatile("" : "+v"(negm));
#pragma unroll
  for (int d = 0; d < NB; ++d) o[d] = f32x16{};
  const bf16* Qw = Qb + (long)(wid * 32 + r32) * ldq + hi * 8;
#pragma unroll
  for (int d0 = 0; d0 < W1 / 16; ++d0) qr[d0] = *reinterpret_cast<const bf16x8*>(Qw + d0 * 16);
  if constexpr (W2 > 0) { const bf16* Qw2 = Qb2 + (long)(wid * 32 + r32) * ldq + hi * 8;
#pragma unroll
    for (int d0 = 0; d0 < W2 / 16; ++d0) qr[W1 / 16 + d0] = *reinterpret_cast<const bf16x8*>(Qw2 + d0 * 16); }
  int k1row[N1], k1col[N1], k1lds[N1], vrow[NV], vcol[NV], vlds[NV];
#pragma unroll
  for (int i = 0; i < N1; ++i) { const int p = tid + 512 * i; k1row[i] = p / CW1; k1col[i] = (p % CW1) * 8; k1lds[i] = (p % CW1) * KCH + (p / CW1) * 16; }
#pragma unroll
  for (int i = 0; i < NV; ++i) { const int p = tid + 512 * i; vrow[i] = p / CWV; vcol[i] = (p % CWV) * 8; vlds[i] = v_st<NB>(p / CWV, (p % CWV) * 8); }
  const int k2row = tid >> 2, k2col = (tid & 3) * 8, k2lds = (CW1 + (tid & 3)) * KCH + (tid >> 2) * 16; const bool k2on = (W2 > 0) && (tid < 256);
  const int vb0 = (int)(uintptr_t)V_lds + v_rd_base(lane);
  struct Slot { bf16x8 k1[N1]; bf16x8 k2; bf16x8 v[NV]; } sr_[2];
#define ATT_SLOAD(i, k0) do { _Pragma("unroll") for (int _j = 0; _j < N1; ++_j) sr_[i].k1[_j] = *reinterpret_cast<const bf16x8*>(&K1[(long)((k0) + k1row[_j]) * ldk1 + k1col[_j]]); \
    if constexpr (W2 > 0) { if (k2on) sr_[i].k2 = *reinterpret_cast<const bf16x8*>(&K2[(long)((k0) + k2row) * ldk2 + k2col]); } \
    _Pragma("unroll") for (int _j = 0; _j < NV; ++_j) sr_[i].v[_j] = *reinterpret_cast<const bf16x8*>(&Vh[(long)((k0) + vrow[_j]) * ldv + vcol[_j]]); } while (0)
#define ATT_SWRITE(b, i) do { _Pragma("unroll") for (int _j = 0; _j < NV; ++_j) *(bf16x8*)(V_lds + (b) * SHM_V + vlds[_j]) = sr_[i].v[_j]; \
    _Pragma("unroll") for (int _j = 0; _j < N1; ++_j) *(bf16x8*)(K_lds + (b) * SHM_K + k1lds[_j]) = sr_[i].k1[_j]; \
    if constexpr (W2 > 0) { if (k2on) *(bf16x8*)(K_lds + (b) * SHM_K + k2lds) = sr_[i].k2; } } while (0)
#define ATT_SWAIT() asm volatile("s_waitcnt vmcnt(%0)" :: "n"(N1 + NV) : "memory")
#define ATT_RESC(a) do { if (MODE == 0 && __any((a) != 1.f)) { if (hi == 0) al_l[r32] = (a); asm volatile("s_waitcnt lgkmcnt(0)" ::: "memory"); \
    _Pragma("unroll") for (int d = 0; d < NB; ++d) _Pragma("unroll") for (int r = 0; r < 16; ++r) o[d][r] *= al_l[crow(r, hi)]; } } while (0)
  f32x16 pA0, pA1, pB0, pB1; float alA, alB; bf16x8 pa0, pa1, pa2, pa3; const int NT = nkeys / 64;
  ATT_SLOAD(0, 0); asm volatile("s_waitcnt vmcnt(0)" ::: "memory"); ATT_SWRITE(0, 0); __syncthreads();
  qkt<ND0, MODE>(pA0, pA1, K_lds, qr, negm, r32, hi); partialSM<MODE, true>(pA0, pA1, m_reg, negm, alA);
  ATT_SLOAD(1, 64); if (2 < NT) ATT_SLOAD(0, 128);
  ATT_SWAIT(); ATT_SWRITE(1, 1); __syncthreads();
  int bp = 0, bc = 1, bn = 2;
  if (wid >= 4) __builtin_amdgcn_s_setprio(1);
#define ATT_ROT() do { const int t_ = bp; bp = bc; bc = bn; bn = t_; } while (0)
  for (int j = 1; j + 1 < NT; j += 2) {
    ATT_SBAR(); qkt<ND0, MODE>(pB0, pB1, K_lds + bc * SHM_K, qr, negm, r32, hi);
    finishSM(pA0, pA1, alA, l_reg, pa0, pa1, pa2, pa3); ATT_SBAR();
    ATT_SLOAD(1, (j + 2) * 64); ATT_SBAR();
    pv_all<NB>(o, vb0 + bp * SHM_V, pa0, pa1, pa2, pa3); partialSM<MODE, false>(pB0, pB1, m_reg, negm, alB);
    ATT_SWAIT(); ATT_SWRITE(bn, 0);
    ATT_RESC(alB); __syncthreads(); ATT_ROT();
    ATT_SBAR(); qkt<ND0, MODE>(pA0, pA1, K_lds + bc * SHM_K, qr, negm, r32, hi);
    finishSM(pB0, pB1, alB, l_reg, pa0, pa1, pa2, pa3); ATT_SBAR();
    if (j + 3 < NT) ATT_SLOAD(0, (j + 3) * 64); ATT_SBAR();
    pv_all<NB>(o, vb0 + bp * SHM_V, pa0, pa1, pa2, pa3); partialSM<MODE, false>(pA0, pA1, m_reg, negm, alA);
    ATT_SWAIT(); ATT_SWRITE(bn, 1);
    ATT_RESC(alA); __syncthreads(); ATT_ROT();
  }
  ATT_SBAR(); qkt<ND0, MODE>(pB0, pB1, K_lds + bc * SHM_K, qr, negm, r32, hi);
  finishSM(pA0, pA1, alA, l_reg, pa0, pa1, pa2, pa3); ATT_SBAR();
  pv_all<NB>(o, vb0 + bp * SHM_V, pa0, pa1, pa2, pa3); partialSM<MODE, false>(pB0, pB1, m_reg, negm, alB);
  ATT_RESC(alB);
  finishSM(pB0, pB1, alB, l_reg, pa0, pa1, pa2, pa3); ATT_SBAR();
  pv_all<NB>(o, vb0 + bc * SHM_V, pa0, pa1, pa2, pa3);
#undef ATT_ROT
  __builtin_amdgcn_s_setprio(0);
  if (hi == 0) li_l[r32] = l_reg; asm volatile("s_waitcnt lgkmcnt(0)" ::: "memory");
  float rli[16];
#pragma unroll
  for (int r = 0; r < 16; ++r) rli[r] = __builtin_amdgcn_rcpf(li_l[crow(r, hi)]);
  bf16* Ow = Ob + (long)(wid * 32) * ldo;
  if constexpr (C::OSTAGE) { unsigned short* stg = (unsigned short*)(lds + 3 * SHM_V + 3 * SHM_K + 8 * 64 * 4 + wid * C::OST_BYTES);
#pragma unroll
    for (int r = 0; r < 16; ++r) { const int orow = crow(r, hi);
#pragma unroll
      for (int d0 = 0; d0 < NB; ++d0) stg[orow * DV + d0 * 32 + r32] = f2bf1(o[d0][r] * rli[r]); }
    asm volatile("s_waitcnt lgkmcnt(0)" ::: "memory");
    constexpr int CPR = DV / 8;
#pragma unroll
    for (int i = 0; i < (32 * CPR) / 64; ++i) { const int p = i * 64 + lane, row = p / CPR, ch = p % CPR;
      const u32x4 v = *(const u32x4*)(stg + row * DV + ch * 8); *(u32x4*)(Ow + (long)row * ldo + ch * 8) = v; } }
  else {
#pragma unroll
    for (int r = 0; r < 16; ++r) { const int orow = crow(r, hi);
#pragma unroll
      for (int d0 = 0; d0 < NB; ++d0) Ow[(long)orow * ldo + d0 * 32 + r32] = f2bf1(o[d0][r] * rli[r]); } }
  if constexpr (SSQ) {
#pragma unroll
    for (int r = 0; r < 16; ++r) {
#pragma unroll
      for (int d0 = 0; d0 < NB; ++d0) { const float v = o[d0][r] * rli[r]; ssacc[r] += v * v; } } }
  __syncthreads();
#undef ATT_SLOAD
#undef ATT_SWRITE
#undef ATT_SWAIT
#undef ATT_RESC
}

__device__ __forceinline__ void attn_mem_unit(const bf16* __restrict__ Qb, int ldq, const bf16* __restrict__ Kh, int ldk, const bf16* __restrict__ Vh, int ldv, bf16* __restrict__ Ob, int ldo, char* lds) {
  constexpr int ND0 = 8, NB = 4, DV = 128, SHM_V = 64 * 128 * 2, SHM_K = 16 * KCH;
  int tid_ = threadIdx.x; asm volatile("" : "+v"(tid_));
  const int tid = tid_, wid = tid >> 6, lane = tid & 63, r32 = lane & 31, hi = lane >> 5;
  char* V_lds = lds; char* K_lds = lds + 4 * SHM_V;
  float* ws = (float*)(lds + 4 * SHM_V + 4 * SHM_K) + wid * 64; float* li_l = ws; float* al_l = ws + 32;
  bf16x8 qr[ND0];
  const bf16* Qw = Qb + (long)(wid * 32 + r32) * ldq + hi * 8;
#pragma unroll
  for (int d0 = 0; d0 < ND0; ++d0) qr[d0] = *reinterpret_cast<const bf16x8*>(Qw + d0 * 16);
  {
    int krow[2], kcol[2], klds[2], vlds[2];
#pragma unroll
    for (int i = 0; i < 2; ++i) { const int p = tid + 512 * i; krow[i] = p >> 4; kcol[i] = (p & 15) * 8; klds[i] = (p & 15) * KCH + (p >> 4) * 16; vlds[i] = v_st<NB>(p >> 4, (p & 15) * 8); }
#pragma unroll
    for (int b = 0; b < 2; ++b) {
      bf16x8 kk[2][2], vv[2][2];
#pragma unroll
      for (int t = 0; t < 2; ++t)
#pragma unroll
        for (int i = 0; i < 2; ++i) { const long r = (2 * b + t) * 64 + krow[i]; kk[t][i] = *reinterpret_cast<const bf16x8*>(&Kh[r * ldk + kcol[i]]); vv[t][i] = *reinterpret_cast<const bf16x8*>(&Vh[r * ldv + kcol[i]]); }
#pragma unroll
      for (int t = 0; t < 2; ++t)
#pragma unroll
        for (int i = 0; i < 2; ++i) { *(bf16x8*)(K_lds + (2 * b + t) * SHM_K + klds[i]) = kk[t][i]; *(bf16x8*)(V_lds + (2 * b + t) * SHM_V + vlds[i]) = vv[t][i]; }
    }
  }
  __syncthreads();
  const int vb0 = (int)(uintptr_t)V_lds + v_rd_base(lane);
  float m_reg = 0.f, l_reg = 0.f, al; f32x16 o[NB]; f32x16 negm = f32x16{}; asm volatile("" : "+v"(negm));
#pragma unroll
  for (int d = 0; d < NB; ++d) o[d] = f32x16{};
  f32x16 p0, p1; bf16x8 pa0, pa1, pa2, pa3;
#define ATT_MRESC(a) do { if (__any((a) != 1.f)) { if (hi == 0) al_l[r32] = (a); asm volatile("s_waitcnt lgkmcnt(0)" ::: "memory"); \
    _Pragma("unroll") for (int d = 0; d < NB; ++d) _Pragma("unroll") for (int r = 0; r < 16; ++r) o[d][r] *= al_l[crow(r, hi)]; } } while (0)
  qkt<ND0, 0>(p0, p1, K_lds, qr, negm, r32, hi); partialSM<0, true>(p0, p1, m_reg, negm, al); finishSM(p0, p1, al, l_reg, pa0, pa1, pa2, pa3);
  ATT_SBAR(); pv_all<NB>(o, vb0, pa0, pa1, pa2, pa3);
#pragma unroll
  for (int t = 1; t < 4; ++t) {
    ATT_SBAR(); qkt<ND0, 0>(p0, p1, K_lds + t * SHM_K, qr, negm, r32, hi); partialSM<0, false>(p0, p1, m_reg, negm, al); finishSM(p0, p1, al, l_reg, pa0, pa1, pa2, pa3);
    ATT_MRESC(al);
    ATT_SBAR(); pv_all<NB>(o, vb0 + t * SHM_V, pa0, pa1, pa2, pa3);
  }
#undef ATT_MRESC
  if (hi == 0) li_l[r32] = l_reg; asm volatile("s_waitcnt lgkmcnt(0)" ::: "memory");
  float rli[16];
#pragma unroll
  for (int r = 0; r < 16; ++r) rli[r] = __builtin_amdgcn_rcpf(li_l[crow(r, hi)]);
  bf16* Ow = Ob + (long)(wid * 32) * ldo;
#pragma unroll
  for (int r = 0; r < 16; ++r) { const int orow = crow(r, hi);
#pragma unroll
    for (int d0 = 0; d0 < NB; ++d0) Ow[(long)orow * ldo + d0 * 32 + r32] = f2bf1(o[d0][r] * rli[r]); }
  __syncthreads();
}
#undef ATT_SBAR
}
constexpr int NWAVES = 8;
#ifndef MK_N_LAUNCHES
#define MK_N_LAUNCHES 1
#endif
constexpr int BATCH = 8, SEQ = 4096, DM = 1024, DEPTH = 4, MTOK = BATCH * SEQ;
constexpr int IN_W = 1184, IN_WP = 1280;
constexpr int MEM_T = 256, MROWS = BATCH * MEM_T;
constexpr int NEXP = 16, CAP = 512, EFF = 512, MOE_ROWS = NEXP * BATCH * CAP;
constexpr float EPS = 1e-6f, LOG2E = 1.4426950408889634f;
constexpr int NPH = 2 + 16 * DEPTH;
constexpr size_t MiB = 1u << 20;
constexpr size_t WS_CTL = 0, CTL_ZERO_BYTES = 1 * MiB;
constexpr size_t WS_TABG = 1 * MiB, WS_TABM = 2 * MiB, WS_WR = 2 * MiB + 512 * 1024, WS_GAINS = 3 * MiB, WS_SSO = 3 * MiB + 64 * 1024, WS_SSX = 346 * MiB, WS_RS1 = WS_SSO + 512 * 1024, WS_RS3 = WS_RS1 + 128 * 1024, WS_RG = 118 * MiB + 256 * 1024, WS_SSL = 118 * MiB + 512 * 1024;
constexpr size_t WS_WSMALL = 4 * MiB, WSMALL_STRIDE = 10 * MiB;
constexpr size_t OFF_WIN = 0, OFF_WQB = 5 * MiB / 2, OFF_WKVB = 3 * MiB, OFF_WO = 7 * MiB / 2, OFF_WMQ = 11 * MiB / 2, OFF_WMKV = 13 * MiB / 2, OFF_WMO = 17 * MiB / 2;
constexpr size_t WS_WGU = 44 * MiB, WS_WD = 76 * MiB;
constexpr size_t WS_MEMN = 92 * MiB, WS_MEMKV = 96 * MiB;
constexpr size_t WS_AFF = 112 * MiB, WS_AFFT = 114 * MiB, WS_SLOT = 116 * MiB, WS_IDX = 118 * MiB;
constexpr size_t WS_H = 120 * MiB, WS_PROJ = 184 * MiB, WS_QG = 264 * MiB, WS_KG = 296 * MiB, WS_VG = 304 * MiB, WS_LAT = 312 * MiB, WS_KROPE = 344 * MiB, WS_QM = 346 * MiB;
constexpr size_t WS_XB = 264 * MiB;
constexpr size_t WS_O = WS_H, WS_KVM = WS_PROJ, WS_QMEM = 184 * MiB, WS_OMEM = 216 * MiB, WS_XG = 184 * MiB, WS_Y = WS_XG, WS_ACT = 312 * MiB;
constexpr size_t WS_WGU2 = 394 * MiB, WS_WD2 = 426 * MiB;
constexpr size_t WS_X = 442 * MiB;
constexpr size_t WS_END = 506 * MiB;
constexpr int CW_BAR = 4096;
constexpr int RING_BYTES = 131072, LDSCTL_OFF = 135168, MISC_OFF = LDSCTL_OFF + 320, GTAB_OFF = LDSCTL_OFF + 1024, STAB_OFF = GTAB_OFF + 8192, LDS_BYTES = 163840;

#define GAS __attribute__((address_space(1)))
#define LAS __attribute__((address_space(3)))
typedef unsigned short bf16;
typedef unsigned v4u __attribute__((ext_vector_type(4)));
typedef float f32x4 __attribute__((ext_vector_type(4)));
#define LDS_WAIT() asm volatile("s_waitcnt lgkmcnt(0)" ::: "memory")
__device__ __forceinline__ unsigned pk2(float lo, float hi) { unsigned r; asm volatile("v_cvt_pk_bf16_f32 %0, %1, %2" : "=v"(r) : "v"(lo), "v"(hi)); return r; }
__device__ __forceinline__ float bflo(unsigned w) { return __uint_as_float(w << 16); }
__device__ __forceinline__ float bfhi(unsigned w) { return __uint_as_float(w & 0xffff0000u); }
#define UNPACK8(W_, V_) do { V_[0] = bflo(W_[0]); V_[1] = bfhi(W_[0]); V_[2] = bflo(W_[1]); V_[3] = bfhi(W_[1]); V_[4] = bflo(W_[2]); V_[5] = bfhi(W_[2]); V_[6] = bflo(W_[3]); V_[7] = bfhi(W_[3]); } while (0)
#define PACK8(V_, W_) do { W_[0] = pk2(V_[0], V_[1]); W_[1] = pk2(V_[2], V_[3]); W_[2] = pk2(V_[4], V_[5]); W_[3] = pk2(V_[6], V_[7]); } while (0)
__device__ __forceinline__ float wave_sum(float v) {
#pragma unroll
    for (int o = 1; o < 64; o <<= 1) v += __shfl_xor(v, o);
    return v;
}
__device__ __forceinline__ int wave_sum_i(int v) {
#pragma unroll
    for (int o = 1; o < 64; o <<= 1) v += __shfl_xor(v, o);
    return v;
}

#define XB_TMO      128
#define XB_XCNT(j)  (256  + 64 * (j))
#define XB_XSUB(j)  (1280 + 64 * (j))
#define XB_XGEN(j)  (2304 + 64 * (j))
#define XB_TOP      3328
#define XB_TOPGEN   3392
#define XCD_BAR_WORDS 3456
#define XB_SPIN_CAP (1u << 20)
__device__ __forceinline__ unsigned xb_ld(unsigned* p)              { return __hip_atomic_load(p, __ATOMIC_RELAXED, __HIP_MEMORY_SCOPE_AGENT); }
__device__ __forceinline__ unsigned xb_add(unsigned* p, unsigned v) { return __hip_atomic_fetch_add(p, v, __ATOMIC_RELAXED, __HIP_MEMORY_SCOPE_AGENT); }
__device__ __forceinline__ unsigned xb_xcc_id() { return (unsigned)__builtin_amdgcn_s_getreg((3 << 11) | 20) & 0xFu; }
#define XB_SPIN(cond, bar) do { unsigned _sp = 0; while (cond) { __builtin_amdgcn_s_sleep(1); \
    if ((++_sp & 255u) == 0u) { if (xb_ld(&(bar)[XB_TMO])) break; if (_sp > XB_SPIN_CAP) { atomicAdd(&(bar)[XB_TMO], 1u); break; } } } } while (0)
struct XcdBarrier { unsigned* bar; unsigned x; volatile LAS unsigned* st; };
__device__ __forceinline__ XcdBarrier xcd_barrier_post(unsigned* bar, volatile LAS unsigned* st) {
    XcdBarrier b; b.bar = bar; b.x = xb_xcc_id(); b.st = st;
    if (threadIdx.x == 0) (void)xb_add(&bar[XB_XCNT(b.x)], 1u);
    return b;
}
__device__ __forceinline__ void xcd_barrier_complete(unsigned* bar, unsigned x, unsigned& nloc, unsigned& nx) {
    const unsigned G = gridDim.x * gridDim.y * gridDim.z;
    unsigned sum, cnt, mine, sp = 0u;
    for (;;) {
        sum = 0u; cnt = 0u; mine = 0u;
#pragma unroll
        for (unsigned j = 0; j < 16; ++j) { const unsigned c = xb_ld(&bar[XB_XCNT(j)]); sum += c; cnt += (c > 0u) ? 1u : 0u; mine = (j == x) ? c : mine; }
        if (sum == G) break;
        __builtin_amdgcn_s_sleep(1);
        if ((++sp & 255u) == 0u) { if (xb_ld(&bar[XB_TMO])) break; if (sp > XB_SPIN_CAP) { atomicAdd(&bar[XB_TMO], 1u); break; } }
    }
    nloc = mine > 0u ? mine : 1u; nx = cnt > 0u ? cnt : 1u;
}
__device__ __forceinline__ void xcd_barrier(const XcdBarrier& b) {
    asm volatile("s_waitcnt vmcnt(0)" ::: "memory");
    __syncthreads();
    if (threadIdx.x == 0) {
        unsigned* bar = b.bar;
        __builtin_amdgcn_s_waitcnt(0);
        unsigned nloc = b.st[0], nx = b.st[1];
        if (nloc == 0u) { xcd_barrier_complete(bar, b.x, nloc, nx); b.st[0] = nloc; b.st[1] = nx; }
        const unsigned old = xb_add(&bar[XB_XSUB(b.x)], 1u);
        const unsigned gen = old / nloc;
        if (old + 1u == (gen + 1u) * nloc) {
            __builtin_amdgcn_fence(__ATOMIC_RELEASE, "agent");
            asm volatile("s_waitcnt vmcnt(0)" ::: "memory");
            const unsigned og = xb_add(&bar[XB_TOP], 1u);
            const unsigned tg = og / nx;
            if (og + 1u == (tg + 1u) * nx) xb_add(&bar[XB_TOPGEN], 1u);
            else XB_SPIN(xb_ld(&bar[XB_TOPGEN]) == tg, bar);
            __builtin_amdgcn_fence(__ATOMIC_ACQUIRE, "agent");
            xb_add(&bar[XB_XGEN(b.x)], 1u);
            asm volatile("s_waitcnt vmcnt(0)" ::: "memory");
        } else {
            XB_SPIN(xb_ld(&bar[XB_XGEN(b.x)]) == gen, bar);
            __builtin_amdgcn_fence(__ATOMIC_ACQUIRE, "agent");
            asm volatile("s_waitcnt vmcnt(0)" ::: "memory");
        }
    }
    __syncthreads();
}

struct Args { const float* in[24]; float* out; unsigned char* ws; int ph_lo, ph_hi; };
struct Ctx {
    LAS unsigned char* lds; char* ldsg;
    int tid, lane, wave, vcu, vcu0, G, G0, gw, NGW;
    bf16* x; float* out;
    unsigned char* ws;
};
#define WSP(T, off) ((T*)(F.ws + (off)))
__device__ __forceinline__ void refresh(Ctx& F) { int t = threadIdx.x; asm volatile("" : "+v"(t)); F.tid = t; F.lane = t & 63;
    int w = __builtin_amdgcn_readfirstlane(t >> 6), v = F.vcu0, g = F.G0; asm volatile("" : "+s"(w), "+s"(v), "+s"(g)); F.wave = w; F.vcu = v; F.G = g; F.gw = v * NWAVES + w; F.NGW = g * NWAVES; }

__device__ __forceinline__ int il32(int i) { return (i < 16) ? 2 * i : 2 * (i - 16) + 1; }
__device__ __forceinline__ int il64(int d) { return (d < 32) ? 2 * d : 2 * (d - 32) + 1; }
__device__ __forceinline__ int dstrow(int kind, int n) {
    if (kind == 1) {
        if (n < 512) { const int h = n >> 6, p = il64(n & 63); return 256 * (h >> 2) + 128 * (p >> 5) + 32 * (h & 3) + (p & 31); }
        if (n < 640) { const int kh = (n - 512) >> 6, p = il64(n & 63); return 512 + 128 * (p >> 5) + 32 * kh + (p & 31); }
        if (n < 768) { const int vh = (n - 640) >> 6, d = n & 63; return 512 + 128 * (d >> 5) + 32 * (2 + vh) + (d & 31); }
        if (n >= 1152) return 1152 + il32(n - 1152);
        return n; }
    if (kind == 2) { const int h = n / 96, p = n % 96; return (p < 64) ? h * 64 + p : 512 + h * 32 + il32(p - 64); }
    if (kind == 3) return (n >> 7) * 256 + (n & 127);
    if (kind == 4) return (n >> 7) * 256 + 128 + (n & 127);
    return n;
}
__device__ __forceinline__ void tr_item(const float* W, int N, const float* gain, bf16* WT, int ldk, int kind, int item, LAS float* scr, int lane) {
    const int nblk = (N + 63) / 64, kb = item / nblk, nb = item % nblk, k0 = 64 * kb, n0 = 64 * nb;
    const int lr = lane >> 4, lc = (lane & 15) * 4; const bool okc = (n0 + lc) < N;
    f32x4 v[16];
#pragma unroll
    for (int i = 0; i < 16; ++i) v[i] = okc ? *(const GAS f32x4*)(W + (size_t)(k0 + 4 * i + lr) * N + n0 + lc) : (f32x4){0.f, 0.f, 0.f, 0.f};
#pragma unroll
    for (int i = 0; i < 16; ++i) { const int kk = 4 * i + lr; const float gk = gain ? gain[k0 + kk] : 1.0f; LAS float* d = scr + kk * 65 + lc;
        d[0] = v[i].x * gk; d[1] = v[i].y * gk; d[2] = v[i].z * gk; d[3] = v[i].w * gk; }
    LDS_WAIT(); asm volatile("" ::: "memory");
    const int c = lane & 7;
#pragma unroll
    for (int j = 0; j < 8; ++j) { const int n = (lane >> 3) + 8 * j; const LAS float* s = scr + (8 * c) * 65 + n;
        v4u o; o.x = pk2(s[0 * 65], s[1 * 65]); o.y = pk2(s[2 * 65], s[3 * 65]); o.z = pk2(s[4 * 65], s[5 * 65]); o.w = pk2(s[6 * 65], s[7 * 65]);
        if (n0 + n < N) *(GAS v4u*)(WT + (size_t)dstrow(kind, n0 + n) * ldk + k0 + 8 * c) = o; }
    LDS_WAIT(); asm volatile("" ::: "memory");
}
constexpr int SMALL_ITEMS = 1152;
__device__ __forceinline__ void small_weight_item(const Ctx& F, const Args& A, int l, int r, LAS float* scr) {
    bf16* wl = WSP(bf16, WS_WSMALL + (size_t)l * WSMALL_STRIDE);
    if (r < 304) { tr_item(A.in[3] + (size_t)l * DM * IN_W, IN_W, A.in[2] + l * DM, wl + OFF_WIN / 2, DM, 1, r, scr, F.lane); return; } r -= 304;
    if (r < 48)  { tr_item(A.in[8] + (size_t)l * 256 * 768, 768, A.in[6] + l * 256, wl + OFF_WQB / 2, 256, 2, r, scr, F.lane); return; } r -= 48;
    if (r < 32)  { tr_item(A.in[9] + (size_t)l * 128 * 1024, 1024, A.in[7] + l * 128, wl + OFF_WKVB / 2, 128, 0, r, scr, F.lane); return; } r -= 32;
    if (r < 256) { const int kb = r / 16; const float* gain = (kb < 8) ? (A.in[10] + l * 512) : (A.in[11] + l * 512 - 512);
                   tr_item(A.in[12] + (size_t)l * DM * DM, DM, gain, wl + OFF_WO / 2, DM, 0, r, scr, F.lane); return; } r -= 256;
    if (r < 128) { tr_item(A.in[15] + (size_t)l * DM * 512, 512, A.in[13] + l * DM, wl + OFF_WMQ / 2, DM, 0, r, scr, F.lane); return; } r -= 128;
    if (r < 256) { tr_item(A.in[16] + (size_t)l * DM * DM, DM, A.in[14] + l * DM, wl + OFF_WMKV / 2, DM, 0, r, scr, F.lane); return; } r -= 256;
    tr_item(A.in[17] + (size_t)l * 512 * DM, DM, nullptr, wl + OFF_WMO / 2, 512, 0, r, scr, F.lane);
}
constexpr int MOE_ITEMS = 3 * 2048;
__device__ __forceinline__ void moe_weight_item(const Ctx& F, const Args& A, int l, int it, LAS float* scr) {
    bf16* wgu = WSP(bf16, (l & 1) ? WS_WGU2 : WS_WGU); bf16* wd = WSP(bf16, (l & 1) ? WS_WD2 : WS_WD);
    const int which = it >> 11, e = (it >> 7) & 15, r = it & 127;
    if (which < 2) tr_item((which == 0 ? A.in[20] : A.in[21]) + (size_t)(l * NEXP + e) * DM * EFF, EFF, A.in[18] + l * DM, wgu + (size_t)e * 1024 * 1024, DM, 3 + which, r, scr, F.lane);
    else           tr_item(A.in[22] + (size_t)(l * NEXP + e) * EFF * DM, DM, nullptr, wd + (size_t)e * 1024 * 512, EFF, 0, r, scr, F.lane);
}
__device__ __forceinline__ void convert_moe_weights(const Ctx& F, const Args& A, int l) {
    LAS float* scr = (LAS float*)(F.lds + F.wave * 16640);
    for (int it = F.gw; it < MOE_ITEMS; it += F.NGW) moe_weight_item(F, A, l, it, scr);
}

__device__ __forceinline__ void rms_row_f32(const float* xrow, bf16* xb, bf16* orow, float* rs, int lane) {
    const GAS f32x4* xr = (const GAS f32x4*)xrow + lane;
    f32x4 v[4]; float s = 0.f;
#pragma unroll
    for (int j = 0; j < 4; ++j) { v[j] = xr[64 * j]; s += (v[j].x * v[j].x + v[j].y * v[j].y) + (v[j].z * v[j].z + v[j].w * v[j].w); }
    const float rstd = __builtin_amdgcn_rsqf(wave_sum(s) * (1.f / DM) + EPS);
    if (xb) { GAS unsigned long long* x8 = (GAS unsigned long long*)xb + lane;
#pragma unroll
        for (int j = 0; j < 4; ++j) x8[64 * j] = (unsigned long long)pk2(v[j].x, v[j].y) | ((unsigned long long)pk2(v[j].z, v[j].w) << 32); }
    if (rs && lane == 0) *rs = rstd;
    if (orow) { GAS unsigned long long* o8 = (GAS unsigned long long*)orow + lane;
#pragma unroll
        for (int j = 0; j < 4; ++j) o8[64 * j] = (unsigned long long)pk2(v[j].x * rstd, v[j].y * rstd) | ((unsigned long long)pk2(v[j].z * rstd, v[j].w * rstd) << 32); }
}
__device__ __forceinline__ void phase_prologue(const Ctx& F, const Args& A) {
    LAS float* scr = (LAS float*)(F.lds + F.wave * 16640);
    for (int it = F.gw; it < DEPTH * SMALL_ITEMS; it += F.NGW) small_weight_item(F, A, it / SMALL_ITEMS, it % SMALL_ITEMS, scr);
    convert_moe_weights(F, A, 0);
    const int gt = F.vcu * (NWAVES * 64) + F.tid, NGT = F.G * NWAVES * 64;
    for (int i = gt; i < DEPTH * 12288; i += NGT) { const int l = i / 12288, r = i % 12288;
        bf16* wl = WSP(bf16, WS_WSMALL + (size_t)l * WSMALL_STRIDE);
        *(GAS v4u*)(wl + OFF_WIN / 2 + (size_t)IN_W * DM + (size_t)r * 8) = (v4u){0u, 0u, 0u, 0u}; }
    for (int i = gt; i < 1536; i += NGT) WSP(float, WS_GAINS)[i] = (i < 256) ? A.in[4][i] : (i < 512) ? A.in[5][i - 256] : A.in[23][i - 512];
    for (int i = gt; i < DEPTH * NEXP * DM; i += NGT) { const int l = i / (NEXP * DM), e = (i / DM) % NEXP, k = i % DM;
        WSP(float, WS_WR)[i] = A.in[19][(size_t)(l * DM + k) * NEXP + e] * A.in[18][l * DM + k]; }
    for (int i = gt; i < SEQ * 48; i += NGT) { const int s = i / 48, j = i % 48; const float row = (float)(s >> 6), col = (float)(s & 63);
        const bool isg = (j < 32); const int j2 = isg ? j : j - 32, half = isg ? 16 : 8, jj = j2 & (half - 1);
        const float inv = __builtin_amdgcn_exp2f(-(float)(2 * jj) / (float)(2 * half) * 13.287712379549449f);
        const float ang = ((j2 < half) ? row : col) * inv;
        double td = (double)ang * 0.15915494309189535; td -= rint(td);
        const float sn = __builtin_amdgcn_sinf((float)td), cs = __builtin_amdgcn_cosf((float)td);
        float* dst = isg ? (WSP(float, WS_TABG) + ((size_t)s * 32 + j2) * 2) : (WSP(float, WS_TABM) + ((size_t)s * 16 + j2) * 2);
        dst[0] = cs; dst[1] = sn; }
    for (int m = F.gw; m < MROWS; m += F.NGW) rms_row_f32(A.in[1] + (size_t)m * DM, nullptr, WSP(bf16, WS_MEMN) + (size_t)m * DM, nullptr, F.lane);
    {
        const int lane = F.lane; f32x4 vn[4];
#pragma unroll
        for (int j = 0; j < 4; ++j) vn[j] = (f32x4){0.f, 0.f, 0.f, 0.f};
        if (F.gw < MTOK) { const GAS f32x4* xr = (const GAS f32x4*)(A.in[0] + (size_t)F.gw * DM) + lane;
#pragma unroll
            for (int j = 0; j < 4; ++j) vn[j] = xr[64 * j]; }
        for (int m = F.gw; m < MTOK; m += F.NGW) {
            f32x4 v[4]; float s = 0.f;
#pragma unroll
            for (int j = 0; j < 4; ++j) { v[j] = vn[j]; s += (v[j].x * v[j].x + v[j].y * v[j].y) + (v[j].z * v[j].z + v[j].w * v[j].w); }
            if (m + F.NGW < MTOK) { const GAS f32x4* xr = (const GAS f32x4*)(A.in[0] + (size_t)(m + F.NGW) * DM) + lane;
#pragma unroll
                for (int j = 0; j < 4; ++j) vn[j] = xr[64 * j]; }
            const float rstd = __builtin_amdgcn_rsqf(wave_sum(s) * (1.f / DM) + EPS);
            GAS unsigned long long* x8 = (GAS unsigned long long*)(F.x + (size_t)m * DM) + lane;
#pragma unroll
            for (int j = 0; j < 4; ++j) x8[64 * j] = (unsigned long long)pk2(v[j].x, v[j].y) | ((unsigned long long)pk2(v[j].z, v[j].w) << 32);
            if (lane == 0) WSP(float, WS_RS1)[m] = rstd;
        } }
}

__device__ __forceinline__ void rope4(float* v, const float* tab) {
    const f32x4 t0 = *(const f32x4*)tab, t1 = *(const f32x4*)(tab + 4);
    float a, b;
    a = v[0]; b = v[1]; v[0] = a * t0[0] - b * t0[1]; v[1] = b * t0[0] + a * t0[1];
    a = v[2]; b = v[3]; v[2] = a * t0[2] - b * t0[3]; v[3] = b * t0[2] + a * t0[3];
    a = v[4]; b = v[5]; v[4] = a * t1[0] - b * t1[1]; v[5] = b * t1[0] + a * t1[1];
    a = v[6]; b = v[7]; v[6] = a * t1[2] - b * t1[3]; v[7] = b * t1[2] + a * t1[3];
}
__device__ __forceinline__ void phase_postproj(const Ctx& F, int l) {
    int lane_ = F.lane; asm volatile("" : "+v"(lane_)); const int lane = lane_;
    const float* gq = WSP(float, WS_GAINS) + l * 64; const float* gk = WSP(float, WS_GAINS) + 256 + l * 64;
    float gqv[8], gkv[8];
#pragma unroll
    for (int i = 0; i < 8; ++i) { const int p = 8 * (lane & 7) + i, d = (p >> 1) + 32 * (p & 1); gqv[i] = gq[d]; gkv[i] = gk[d]; }
    const float* tabg = WSP(float, WS_TABG); const float* tabm = WSP(float, WS_TABM);
    const float C2G = 0.125f * LOG2E;
    v4u wa_n = (v4u){0u, 0u, 0u, 0u}, wb_n = wa_n, wc_n = wa_n;
    if (F.gw < MTOK) { const bf16* pr = WSP(bf16, WS_PROJ) + (size_t)F.gw * IN_WP; wa_n = *(const GAS v4u*)(pr + 8 * lane); wb_n = *(const GAS v4u*)(pr + 512 + 8 * lane); if (lane < 20) wc_n = *(const GAS v4u*)(pr + 1024 + 8 * lane); }
    for (int m = F.gw; m < MTOK; m += F.NGW) {
        const int s = m & (SEQ - 1);
        const v4u wa = wa_n, wb = wb_n, wc = wc_n;
        if (m + F.NGW < MTOK) { const bf16* pr = WSP(bf16, WS_PROJ) + (size_t)(m + F.NGW) * IN_WP; wa_n = *(const GAS v4u*)(pr + 8 * lane); wb_n = *(const GAS v4u*)(pr + 512 + 8 * lane); if (lane < 20) wc_n = *(const GAS v4u*)(pr + 1024 + 8 * lane); }
        { const v4u w = wa; float v[8]; UNPACK8(w, v);
          float ss = 0.f;
#pragma unroll
          for (int i = 0; i < 8; ++i) ss += v[i] * v[i];
          ss += __shfl_xor(ss, 1); ss += __shfl_xor(ss, 2); ss += __shfl_xor(ss, 4);
          const float rstd = __builtin_amdgcn_rsqf(ss * (1.f / 64.f) + EPS);
#pragma unroll
          for (int i = 0; i < 8; ++i) v[i] = v[i] * rstd * gqv[i];
          rope4(v, tabg + ((size_t)s * 32 + 4 * (lane & 7)) * 2);
#pragma unroll
          for (int i = 0; i < 8; ++i) v[i] *= C2G;
          v4u o; PACK8(v, o); *(GAS v4u*)(WSP(bf16, WS_QG) + (size_t)m * 512 + 8 * lane) = o; }
        { const v4u w = wb; float v[8]; UNPACK8(w, v);
          float ss = 0.f;
#pragma unroll
          for (int i = 0; i < 8; ++i) ss += v[i] * v[i];
          ss += __shfl_xor(ss, 1); ss += __shfl_xor(ss, 2); ss += __shfl_xor(ss, 4);
          const float ss8 = ss;
          ss += __shfl_xor(ss, 8); ss += __shfl_xor(ss, 16);
          if (lane < 16) {
              const float rstd = __builtin_amdgcn_rsqf(ss8 * (1.f / 64.f) + EPS);
#pragma unroll
              for (int i = 0; i < 8; ++i) v[i] = v[i] * rstd * gkv[i];
              rope4(v, tabg + ((size_t)s * 32 + 4 * (lane & 7)) * 2);
              v4u o; PACK8(v, o); *(GAS v4u*)(WSP(bf16, WS_KG) + (size_t)m * 128 + 8 * lane) = o;
          } else if (lane < 32) {
              *(GAS v4u*)(WSP(bf16, WS_VG) + (size_t)m * 128 + 8 * (lane - 16)) = w;
          } else {
              const float rstd = __builtin_amdgcn_rsqf(ss * (1.f / 256.f) + EPS);
#pragma unroll
              for (int i = 0; i < 8; ++i) v[i] *= rstd;
              v4u o; PACK8(v, o); *(GAS v4u*)(WSP(bf16, WS_LAT) + (size_t)m * 512 + 8 * (lane - 32)) = o;
          } }
        { const v4u w = wc;
          float v[8]; UNPACK8(w, v);
          float ss = 0.f;
#pragma unroll
          for (int i = 0; i < 8; ++i) ss += v[i] * v[i];
          ss += __shfl_xor(ss, 1); ss += __shfl_xor(ss, 2); ss += __shfl_xor(ss, 4); ss += __shfl_xor(ss, 8);
          if (lane < 16) {
              const float rstd = __builtin_amdgcn_rsqf(ss * (1.f / 128.f) + EPS);
#pragma unroll
              for (int i = 0; i < 8; ++i) v[i] *= rstd;
              v4u o; PACK8(v, o); *(GAS v4u*)(WSP(bf16, WS_LAT) + (size_t)m * 512 + 256 + 8 * lane) = o;
          } else if (lane < 20) {
              rope4(v, tabm + ((size_t)s * 16 + 4 * (lane - 16)) * 2);
              v4u o; PACK8(v, o); *(GAS v4u*)(WSP(bf16, WS_KROPE) + (size_t)m * 32 + 8 * (lane - 16)) = o;
          } else if (lane < 36) {
              *(GAS v4u*)(WSP(bf16, WS_LAT) + (size_t)m * 512 + 384 + 8 * (lane - 20)) = (v4u){0u, 0u, 0u, 0u};
          } }
    }
}

__device__ __forceinline__ void phase_outnorm(const Ctx& F) {
    int lane_ = F.lane; asm volatile("" : "+v"(lane_)); const int lane = lane_;
    for (int m = F.gw; m < MTOK; m += F.NGW) {
        bf16* orow = WSP(bf16, WS_O) + (size_t)m * DM;
#pragma unroll
        for (int g = 0; g < 2; ++g) {
            v4u w = *(const GAS v4u*)(orow + g * 512 + 8 * lane); float v[8]; UNPACK8(w, v);
            float ss = 0.f;
#pragma unroll
            for (int i = 0; i < 8; ++i) ss += v[i] * v[i];
            const float rstd = __builtin_amdgcn_rsqf(wave_sum(ss) * (1.f / 512.f) + EPS);
#pragma unroll
            for (int i = 0; i < 8; ++i) v[i] *= rstd;
            v4u o; PACK8(v, o); *(GAS v4u*)(orow + g * 512 + 8 * lane) = o;
        }
    }
}

__device__ __forceinline__ void phase_router(const Ctx& F, int l) {
    int lane_ = F.lane; asm volatile("" : "+v"(lane_)); const int lane = lane_;
    int tid_ = F.tid; asm volatile("" : "+v"(tid_)); const int tid = tid_;
    typedef short rbf16x8 __attribute__((ext_vector_type(8)));
    const int NB = MTOK / 16, tok = lane & 15, kq = lane >> 4;
    int tb = F.gw;
    v4u xf[32];
#define RT_LOAD() do { const GAS v4u* xr_ = (const GAS v4u*)(F.x + ((size_t)tb * 16 + tok) * DM) + kq; _Pragma("unroll") for (int s_ = 0; s_ < 32; ++s_) xf[s_] = xr_[4 * s_]; } while (0)
    if (tb < NB) RT_LOAD();
    {
        const GAS f32x4* src = (const GAS f32x4*)(WSP(float, WS_WR) + (size_t)l * NEXP * DM);
        for (int it = tid; it < NEXP * DM / 8; it += NWAVES * 64) { const int e = it & 15, k8 = it >> 4;
            const f32x4 a = src[(e * DM + 8 * k8) / 4], b = src[(e * DM + 8 * k8) / 4 + 1];
            v4u hi, lo; hi.x = pk2(a.x, a.y); hi.y = pk2(a.z, a.w); hi.z = pk2(b.x, b.y); hi.w = pk2(b.z, b.w);
            lo.x = pk2(a.x - bflo(hi.x), a.y - bfhi(hi.x)); lo.y = pk2(a.z - bflo(hi.y), a.w - bfhi(hi.y)); lo.z = pk2(b.x - bflo(hi.z), b.y - bfhi(hi.z)); lo.w = pk2(b.z - bflo(hi.w), b.w - bfhi(hi.w));
            const int s = k8 >> 2, ln = (k8 & 3) * 16 + e;
            *(LAS v4u*)(F.lds + ((s * 2 + 0) * 64 + ln) * 16) = hi; *(LAS v4u*)(F.lds + ((s * 2 + 1) * 64 + ln) * 16) = lo; }
    }
    __syncthreads();
    while (tb < NB) {
        asm volatile("" ::: "memory");
        f32x4 ah = {0.f, 0.f, 0.f, 0.f}, al = {0.f, 0.f, 0.f, 0.f}; float ss0 = 0.f, ss1 = 0.f;
#pragma unroll
        for (int s = 0; s < 32; ++s) {
            const rbf16x8 wh = *(const LAS rbf16x8*)(F.lds + ((s * 2 + 0) * 64 + lane) * 16), wl = *(const LAS rbf16x8*)(F.lds + ((s * 2 + 1) * 64 + lane) * 16);
            const rbf16x8 xb = __builtin_bit_cast(rbf16x8, xf[s]);
            ah = __builtin_amdgcn_mfma_f32_16x16x32_bf16(wh, xb, ah, 0, 0, 0);
            al = __builtin_amdgcn_mfma_f32_16x16x32_bf16(wl, xb, al, 0, 0, 0);
            const v4u q = xf[s];
            ss0 += (bflo(q.x) * bflo(q.x) + bfhi(q.x) * bfhi(q.x)) + (bflo(q.y) * bflo(q.y) + bfhi(q.y) * bfhi(q.y));
            ss1 += (bflo(q.z) * bflo(q.z) + bfhi(q.z) * bfhi(q.z)) + (bflo(q.w) * bflo(q.w) + bfhi(q.w) * bfhi(q.w));
        }
        float ss = ss0 + ss1; ss += __shfl_xor(ss, 16); ss += __shfl_xor(ss, 32);
        const float rstd = __builtin_amdgcn_rsqf(ss * (1.f / DM) + EPS);
        const int row = tb * 16 + tok;
        if (lane < 16) WSP(float, WS_RS3)[row] = rstd;
        f32x4 lg = (ah + al) * rstd;
        float mx = fmaxf(fmaxf(lg.x, lg.y), fmaxf(lg.z, lg.w)); mx = fmaxf(mx, __shfl_xor(mx, 16)); mx = fmaxf(mx, __shfl_xor(mx, 32));
        f32x4 ex = {__expf(lg.x - mx), __expf(lg.y - mx), __expf(lg.z - mx), __expf(lg.w - mx)};
        float den = (ex.x + ex.y) + (ex.z + ex.w); den += __shfl_xor(den, 16); den += __shfl_xor(den, 32);
        ex = {ex.x / den, ex.y / den, ex.z / den, ex.w / den};
        *(f32x4*)(WSP(float, WS_AFF) + (size_t)row * 16 + 4 * kq) = ex;
        float* at = WSP(float, WS_AFFT) + ((size_t)(row >> 12) * 16 + 4 * kq) * SEQ + (row & (SEQ - 1));
        at[0] = ex.x; at[SEQ] = ex.y; at[2 * SEQ] = ex.z; at[3 * SEQ] = ex.w;
        tb += F.NGW; if (tb < NB) RT_LOAD();
    }
#undef RT_LOAD
    __syncthreads();
}

__device__ __forceinline__ int block_excl_scan(int v, LAS int* red, int lane, int wave, int& total) {
    int inc = v;
#pragma unroll
    for (int o = 1; o < 64; o <<= 1) { const int t = __shfl_up(inc, o); if (lane >= o) inc += t; }
    __syncthreads();
    if (lane == 63) red[wave] = inc;
    __syncthreads();
    int base = 0, tot = 0;
#pragma unroll
    for (int w = 0; w < 8; ++w) { const int t = red[w]; if (w < wave) base += t; tot += t; }
    total = tot;
    return base + inc - v;
}
__device__ __forceinline__ void phase_select(const Ctx& F, const Args& A, int l) {
    LAS int* red = (LAS int*)F.lds;
    int tid_ = F.tid; asm volatile("" : "+v"(tid_)); const int tid = tid_, lane = tid & 63, wave = F.wave;
    for (int pair = F.vcu; pair < BATCH * NEXP; pair += F.G) {
        const int b = pair >> 4, e = pair & 15;
        const GAS v4u* src = (const GAS v4u*)(WSP(float, WS_AFFT) + (size_t)pair * SEQ) + 2 * tid;
        const v4u w0 = src[0], w1 = src[1];
        unsigned v[8] = {w0.x, w0.y, w0.z, w0.w, w1.x, w1.y, w1.z, w1.w};
        unsigned T = 0u; int par = 0;
        for (int bit = 30; bit >= 0; --bit) {
            const unsigned cand = T | (1u << bit);
            int c = 0;
#pragma unroll
            for (int i = 0; i < 8; ++i) c += (v[i] >= cand) ? 1 : 0;
            c = wave_sum_i(c);
            if (lane == 0) red[par * 8 + wave] = c;
            __syncthreads();
            int tot = 0;
#pragma unroll
            for (int w = 0; w < 8; ++w) tot += red[par * 8 + w];
            if (tot >= CAP) T = cand;
            par ^= 1;
        }
        int cgt = 0, ceq = 0;
#pragma unroll
        for (int i = 0; i < 8; ++i) { cgt += (v[i] > T) ? 1 : 0; ceq += (v[i] == T) ? 1 : 0; }
        int ngt, neq_tot;
        (void)block_excl_scan(cgt, red + 16, lane, wave, ngt);
        int eqb = block_excl_scan(ceq, red + 16, lane, wave, neq_tot);
        const int need_eq = CAP - ngt;
        int sel[8], csel = 0;
#pragma unroll
        for (int i = 0; i < 8; ++i) { const bool iseq = (v[i] == T); sel[i] = ((v[i] > T) || (iseq && eqb < need_eq)) ? 1 : 0; eqb += iseq ? 1 : 0; csel += sel[i]; }
        int nsel;
        int pos = block_excl_scan(csel, red + 16, lane, wave, nsel);
        int* idx = WSP(int, WS_IDX) + (size_t)(e * BATCH + b) * CAP; float* rg = WSP(float, WS_RG) + (size_t)(e * BATCH + b) * CAP; const float* rs3 = WSP(float, WS_RS3) + (size_t)b * SEQ;
        int* slot = WSP(int, WS_SLOT) + ((size_t)b * SEQ + (size_t)tid * 8) * NEXP + e;
#pragma unroll
        for (int i = 0; i < 8; ++i) { if (sel[i]) { if (pos < CAP) { idx[pos] = tid * 8 + i; rg[pos] = rs3[tid * 8 + i]; } slot[i * NEXP] = pos; ++pos; } else slot[i * NEXP] = -1; }
        __syncthreads();
    }
    if (l + 1 < DEPTH) {
        const bool split = F.G > BATCH * NEXP; const int nw = split ? (F.G - BATCH * NEXP) * NWAVES : F.NGW, wi = split ? (F.vcu - BATCH * NEXP) * NWAVES + F.wave : F.gw;
        LAS float* scr = (LAS float*)(F.lds + F.wave * 16640);
        if (wi >= 0) for (int it = wi; it < MOE_ITEMS; it += nw) moe_weight_item(F, A, l + 1, it, scr);
    }
}

__device__ __forceinline__ void phase_gather(const Ctx& F) {
    int lane_ = F.lane; asm volatile("" : "+v"(lane_)); const int lane = lane_;
    for (int r = F.gw; r < MOE_ROWS; r += F.NGW) {
        const int b = (r >> 9) & 7; const int t = WSP(int, WS_IDX)[r];
        const GAS v4u* src = (const GAS v4u*)(WSP(bf16, WS_H) + ((size_t)b * SEQ + t) * DM) + lane;
        GAS v4u* dst = (GAS v4u*)(WSP(bf16, WS_XG) + (size_t)r * DM) + lane;
        const v4u a = src[0], c = src[64]; dst[0] = a; dst[64] = c;
    }
}

__device__ __forceinline__ void phase_combine(const Ctx& F, const Args& A, int l, float amul) {
    int lane_ = F.lane; asm volatile("" : "+v"(lane_)); const int lane = lane_; const bool lastl = (l == DEPTH - 1);
    const float* gfin = WSP(float, WS_GAINS) + 512;
    v4u xa_n = (v4u){0u, 0u, 0u, 0u}, xc_n = xa_n; int sl_n = -1; float af_n = 0.f;
    if (F.gw < MTOK) { const GAS v4u* xp = (const GAS v4u*)(F.x + (size_t)F.gw * DM) + lane; xa_n = xp[0]; xc_n = xp[64];
        sl_n = WSP(int, WS_SLOT)[(size_t)F.gw * NEXP + (lane & 15)]; af_n = WSP(float, WS_AFF)[(size_t)F.gw * NEXP + (lane & 15)]; }
    for (int m = F.gw; m < MTOK; m += F.NGW) {
        const int b = m >> 12;
        GAS v4u* xr = (GAS v4u*)(F.x + (size_t)m * DM) + lane;
        const v4u xa = xa_n, xc = xc_n; const int sl = sl_n; const float af = amul * af_n;
        if (m + F.NGW < MTOK) { const int mn = m + F.NGW; const GAS v4u* xp = (const GAS v4u*)(F.x + (size_t)mn * DM) + lane; xa_n = xp[0]; xc_n = xp[64];
            sl_n = WSP(int, WS_SLOT)[(size_t)mn * NEXP + (lane & 15)]; af_n = WSP(float, WS_AFF)[(size_t)mn * NEXP + (lane & 15)]; }
        f32x4 x0 = (f32x4){bflo(xa.x), bfhi(xa.x), bflo(xa.y), bfhi(xa.y)}, x1 = (f32x4){bflo(xa.z), bfhi(xa.z), bflo(xa.w), bfhi(xa.w)};
        f32x4 x2 = (f32x4){bflo(xc.x), bfhi(xc.x), bflo(xc.y), bfhi(xc.y)}, x3 = (f32x4){bflo(xc.z), bfhi(xc.z), bflo(xc.w), bfhi(xc.w)};
        unsigned mask = (unsigned)(__ballot(sl >= 0 && lane < 16));
#define CMB_ACC(Y0, Y1, AE) do { x0.x += AE * bflo(Y0.x); x0.y += AE * bfhi(Y0.x); x0.z += AE * bflo(Y0.y); x0.w += AE * bfhi(Y0.y); \
            x1.x += AE * bflo(Y0.z); x1.y += AE * bfhi(Y0.z); x1.z += AE * bflo(Y0.w); x1.w += AE * bfhi(Y0.w); \
            x2.x += AE * bflo(Y1.x); x2.y += AE * bfhi(Y1.x); x2.z += AE * bflo(Y1.y); x2.w += AE * bfhi(Y1.y); \
            x3.x += AE * bflo(Y1.z); x3.y += AE * bfhi(Y1.z); x3.z += AE * bflo(Y1.w); x3.w += AE * bfhi(Y1.w); } while (0)
        while (mask) {
            const int e1 = __builtin_ctz(mask); mask &= mask - 1u;
            const bool two = mask != 0u; const int e2 = two ? __builtin_ctz(mask) : e1; if (two) mask &= mask - 1u;
            const int s1 = __shfl(sl, e1), s2 = __shfl(sl, e2); const float a1 = __shfl(af, e1), a2 = two ? __shfl(af, e2) : 0.f;
            const GAS v4u* yr1 = (const GAS v4u*)(WSP(bf16, WS_Y) + ((size_t)(e1 * BATCH + b) * CAP + s1) * DM) + lane;
            const GAS v4u* yr2 = (const GAS v4u*)(WSP(bf16, WS_Y) + ((size_t)(e2 * BATCH + b) * CAP + s2) * DM) + lane;
            const v4u y0 = yr1[0], y1 = yr1[64], z0 = yr2[0], z1 = yr2[64];
            CMB_ACC(y0, y1, a1); CMB_ACC(z0, z1, a2);
        }
#undef CMB_ACC
        float s = (x0.x * x0.x + x0.y * x0.y) + (x0.z * x0.z + x0.w * x0.w) + (x1.x * x1.x + x1.y * x1.y) + (x1.z * x1.z + x1.w * x1.w)
                + (x2.x * x2.x + x2.y * x2.y) + (x2.z * x2.z + x2.w * x2.w) + (x3.x * x3.x + x3.y * x3.y) + (x3.z * x3.z + x3.w * x3.w);
        const float rstd = __builtin_amdgcn_rsqf(wave_sum(s) * (1.f / DM) + EPS);
        if (lastl) {
            const f32x4 g0 = *(const f32x4*)(gfin + 8 * lane), g1 = *(const f32x4*)(gfin + 8 * lane + 4), g2 = *(const f32x4*)(gfin + 512 + 8 * lane), g3 = *(const f32x4*)(gfin + 512 + 8 * lane + 4);
            GAS f32x4* ow = (GAS f32x4*)(F.out + (size_t)m * DM);
            ow[2 * lane] = x0 * rstd * g0; ow[2 * lane + 1] = x1 * rstd * g1; ow[128 + 2 * lane] = x2 * rstd * g2; ow[128 + 2 * lane + 1] = x3 * rstd * g3;
        } else {
            v4u n0, n1; n0.x = pk2(x0.x, x0.y); n0.y = pk2(x0.z, x0.w); n0.z = pk2(x1.x, x1.y); n0.w = pk2(x1.z, x1.w); n1.x = pk2(x2.x, x2.y); n1.y = pk2(x2.z, x2.w); n1.z = pk2(x3.x, x3.y); n1.w = pk2(x3.z, x3.w);
            xr[0] = n0; xr[64] = n1;
            if (lane == 0) WSP(float, WS_RS1)[m] = rstd;
        }
    }
}

__device__ __forceinline__ void phase_attn_self(const Ctx& F, int l) {
    float gmq = fabsf(WSP(float, WS_GAINS)[l * 64 + F.lane]), gmk = fabsf(WSP(float, WS_GAINS)[256 + l * 64 + F.lane]);
#pragma unroll
    for (int o = 1; o < 64; o <<= 1) { gmq = fmaxf(gmq, __shfl_xor(gmq, o)); gmk = fmaxf(gmk, __shfl_xor(gmk, o)); }
    const bool bounded = (8.0f * LOG2E * gmq * gmk) < 64.0f;
    const int lane = F.lane, r32 = lane & 31, hi = lane >> 5, wid = F.wave;
#ifndef DUPATT
#define DUPATT 0
#endif
    for (int g = 0; g < 2; ++g)
      for (int rep2_ = 0; rep2_ < 1 + ((DUPATT >> g) & 1); ++rep2_)
        for (int u = F.vcu; u < 256; u += F.G) {
            const int b = u >> 5, qb = (u >> 1) & 15, hh = u & 1;
            const size_t r0 = (size_t)b * SEQ, q0 = r0 + (size_t)qb * 256;
            float ssacc[16];
#pragma unroll
            for (int r = 0; r < 16; ++r) ssacc[r] = 0.f;
            for (int hq = 0; hq < 4; ++hq) {
                const int h = hh * 4 + hq;
                if (g == 0) {
                    if (bounded) att::attn_unit<64, 0, 64, 1, true>(WSP(bf16, WS_QG) + q0 * 512 + h * 64, nullptr, 512, WSP(bf16, WS_KG) + r0 * 128 + hh * 64, 128, nullptr, 0,
                                              WSP(bf16, WS_VG) + r0 * 128 + hh * 64, 128, WSP(bf16, WS_O) + q0 * DM + h * 64, DM, SEQ, F.ldsg, ssacc);
                    else         att::attn_unit<64, 0, 64, 0, true>(WSP(bf16, WS_QG) + q0 * 512 + h * 64, nullptr, 512, WSP(bf16, WS_KG) + r0 * 128 + hh * 64, 128, nullptr, 0,
                                              WSP(bf16, WS_VG) + r0 * 128 + hh * 64, 128, WSP(bf16, WS_O) + q0 * DM + h * 64, DM, SEQ, F.ldsg, ssacc);
                } else {
                    att::attn_unit<64, 32, 64, 0, true>(WSP(bf16, WS_QM) + q0 * 768 + h * 64, WSP(bf16, WS_QM) + q0 * 768 + 512 + h * 32, 768, WSP(bf16, WS_KVM) + r0 * DM + h * 128, DM, WSP(bf16, WS_KROPE) + r0 * 32, 32,
                                               WSP(bf16, WS_KVM) + r0 * DM + h * 128 + 64, DM, WSP(bf16, WS_O) + q0 * DM + 512 + h * 64, DM, SEQ, F.ldsg, ssacc);
                }
            }
#pragma unroll
            for (int r = 0; r < 16; ++r) { float s = ssacc[r];
                s += __shfl_xor(s, 1); s += __shfl_xor(s, 2); s += __shfl_xor(s, 4); s += __shfl_xor(s, 8); s += __shfl_xor(s, 16);
                if (r32 == 0) WSP(float, WS_SSO)[(q0 + wid * 32 + att::crow(r, hi)) * 4 + g * 2 + hh] = s; }
        }
}
__device__ __forceinline__ void phase_attn_mem(const Ctx& F, int l) {
    const bf16* kv = WSP(bf16, WS_MEMKV) + (size_t)l * MROWS * DM; float dummy[16];
    for (int idx = F.vcu; idx < 256; idx += F.G) {
        const int pm = idx >> 1, pn = idx & 1, b = pm >> 4;
        const size_t q0 = (size_t)pm * 256, k0 = (size_t)b * MEM_T;
        for (int hh = 0; hh < 2; ++hh) { const int h = 2 * pn + hh;
            att::attn_mem_unit(WSP(bf16, WS_QMEM) + q0 * 512 + h * 128, 512, kv + k0 * DM + h * 128, DM, kv + k0 * DM + 512 + h * 128, DM, WSP(bf16, WS_OMEM) + q0 * 512 + h * 128, 512, F.ldsg); }
    }
}

__global__ void __launch_bounds__(NWAVES * 64, 2) enc_fwd(Args args) {
    extern __shared__ __attribute__((aligned(16))) unsigned char lds[];
    Ctx F;
    F.lds = (LAS unsigned char*)lds; F.ldsg = (char*)lds;
    F.tid = threadIdx.x; F.lane = F.tid & 63; F.wave = __builtin_amdgcn_readfirstlane(F.tid >> 6);
    F.G = gridDim.x; F.G0 = F.G; { const int bx = blockIdx.x; F.vcu0 = (F.G % 8 == 0) ? (bx % 8) * (F.G / 8) + bx / 8 : bx; F.vcu = F.vcu0; }
    F.gw = F.vcu * NWAVES + F.wave; F.NGW = F.G * NWAVES;
    F.out = args.out; F.ws = args.ws; F.x = (bf16*)(args.ws + WS_X);
    volatile LAS unsigned* MISC = (volatile LAS unsigned*)(F.lds + MISC_OFF);
    for (int u = F.tid; u < (LDS_BYTES - LDSCTL_OFF) / 4; u += NWAVES * 64) ((LAS unsigned*)(F.lds + LDSCTL_OFF))[u] = 0u;
    __syncthreads();
    XcdBarrier bar; bar.bar = (unsigned*)(F.ws + WS_CTL) + CW_BAR; bar.x = 0; bar.st = nullptr;
    if (MK_N_LAUNCHES == 1) bar = xcd_barrier_post((unsigned*)(F.ws + WS_CTL) + CW_BAR, MISC + 8);
    const int lo = args.ph_lo, hi = args.ph_hi;
#ifndef ONLY_SITE
#define ONLY_SITE -1
#endif
#define ON(s) (ONLY_SITE < 0 || ONLY_SITE == (s))
#ifndef DUPMASK
#define DUPMASK 0u
#endif
#define REP(s) for (int rep_ = 0; rep_ < 1 + (int)((DUPMASK >> (s)) & 1u); ++rep_)
#define IN(k) (lo <= (k) && (k) < hi)
#define SEAM(k) do { if (IN(k) && IN((k) + 1)) xcd_barrier(bar); } while (0)
#define LOCAL_SEAM() do { asm volatile("s_waitcnt vmcnt(0)" ::: "memory"); __syncthreads(); __builtin_amdgcn_fence(__ATOMIC_ACQUIRE, "agent"); asm volatile("s_waitcnt vmcnt(0)" ::: "memory"); __syncthreads(); } while (0)
#define GEMM(EpiT, epi, Ap, lda_, Bp, ldb_, K_, nM_, nN_, gdiv_, gstride_) do { const pg8::Gemm g_{(const bf16*)(Ap), (const bf16*)(Bp), lda_, ldb_, K_, gdiv_, 1 << 30, (size_t)(gstride_), nullptr, nullptr}; \
        pg8::StaticOrder S_; S_.init(nM_, nN_, F.G, (int)blockIdx.x); pg8::gemm_phase<EpiT, pg8::StaticOrder, true>(F.lds, g_, S_, epi); } while (0)

    #ifndef PRODUP
#define PRODUP 0
#endif
    if (ON(100) && IN(0)) for (int rp_ = 0; rp_ <= PRODUP; ++rp_) { refresh(F); phase_prologue(F, args); }
    SEAM(0);
    if (ON(101) && IN(1)) {
        pg8::EpiBf16 E{WSP(bf16, WS_MEMKV), DM, 1.0f, nullptr, nullptr, 0.f, 0.f};
        const pg8::Gemm g_{WSP(bf16, WS_MEMN), WSP(bf16, WS_WSMALL + OFF_WMKV), DM, DM, DM, MROWS / 256, MROWS / 256, (size_t)(WSMALL_STRIDE / 2), nullptr, nullptr};
        pg8::StaticOrder S_; S_.init(DEPTH * MROWS / 256, DM / 256, F.G, (int)blockIdx.x); pg8::gemm_phase<pg8::EpiBf16, pg8::StaticOrder, true>(F.lds, g_, S_, E); }
    SEAM(1);
    for (int l = 0; l < DEPTH; ++l) {
        const int pb = 2 + 16 * l;
        unsigned char* wl = F.ws + WS_WSMALL + (size_t)l * WSMALL_STRIDE;
        if (ON(0) && IN(pb + 0)) REP(0) if (refresh(F), true) {
            int bxs = (int)blockIdx.x; asm volatile("" : "+s"(bxs));
            pg8::EpiInProj E{WSP(float, WS_RS1), WSP(float, WS_GAINS) + l * 64, WSP(float, WS_GAINS) + 256 + l * 64, WSP(float, WS_TABG), WSP(float, WS_TABM),
                             WSP(bf16, WS_QG), WSP(bf16, WS_KG), WSP(bf16, WS_VG), WSP(bf16, WS_LAT), WSP(bf16, WS_KROPE), WSP(float, WS_SSL), 0.125f * LOG2E, EPS};
            const pg8::Gemm g_{(const bf16*)F.x, (const bf16*)(wl + OFF_WIN), DM, DM, DM, 1, 1 << 30, 0, nullptr, nullptr};
            typedef pg8::SplitOrder<2, 3, 0, 0> SO; SO S_; S_.init(MTOK / 256, F.G, bxs); pg8::gemm_phase<pg8::EpiInProj, SO, true>(F.lds, g_, S_, E); }
        SEAM(pb + 0);
        if ((ON(2) || ON(16) || ON(17)) && IN(pb + 2)) REP(2) { refresh(F);
            int bxs = (int)blockIdx.x; asm volatile("" : "+s"(bxs)); const int bxo = (F.G == 256) ? (bxs ^ 128) : bxs;
            if (ON(2)) {
                pg8::EpiInProj E{WSP(float, WS_RS1), WSP(float, WS_GAINS) + l * 64, WSP(float, WS_GAINS) + 256 + l * 64, WSP(float, WS_TABG), WSP(float, WS_TABM),
                                 WSP(bf16, WS_QG), WSP(bf16, WS_KG), WSP(bf16, WS_VG), WSP(bf16, WS_LAT), WSP(bf16, WS_KROPE), WSP(float, WS_SSL), 0.125f * LOG2E, EPS};
                const pg8::Gemm g_{(const bf16*)F.x, (const bf16*)(wl + OFF_WIN), DM, DM, DM, 1, 1 << 30, 0, nullptr, nullptr};
                typedef pg8::SplitOrder<3, 0, 2, 1> SO; SO S_; S_.init(MTOK / 256, F.G, bxs); pg8::gemm_phase<pg8::EpiInProj, SO, true>(F.lds, g_, S_, E); }
            if (ON(2) || ON(17)) { pg8::EpiQmRope E{WSP(bf16, WS_QM), 768, 0.10206207261596577f * LOG2E, WSP(float, WS_TABM), WSP(float, WS_SSL), 1.0f / 256.0f, EPS};
                const pg8::Gemm g_{WSP(bf16, WS_LAT), (const bf16*)(wl + OFF_WQB), 512, 256, 256, 1, 1 << 30, 0, nullptr, nullptr};
                typedef pg8::SplitOrder<3, 0, 2, 1> SO; SO S_; S_.init(MTOK / 256, F.G, bxo); pg8::gemm_phase<pg8::EpiQmRope, SO, true>(F.lds, g_, S_, E); }
            if (ON(2) || ON(16)) { pg8::EpiBf16 E{WSP(bf16, WS_KVM), DM, 1.0f, nullptr, WSP(float, WS_SSL) + 4, 1.0f / 128.0f, EPS};
                const pg8::Gemm g_{WSP(bf16, WS_LAT) + 256, (const bf16*)(wl + OFF_WKVB), 512, 128, 128, 1, 1 << 30, 0, nullptr, nullptr};
                typedef pg8::SplitOrder<4, 0, 3, 1> SO; SO S_; S_.init(MTOK / 256, F.G, bxo); pg8::gemm_phase<pg8::EpiBf16, SO, true>(F.lds, g_, S_, E); } }
        SEAM(pb + 2);
        if (ON(3) && IN(pb + 3)) REP(3) if (refresh(F), true) phase_attn_self(F, l);
        SEAM(pb + 3);
        if (ON(5) && IN(pb + 5)) REP(5) if (refresh(F), true) {
            pg8::EpiResidualX E{F.x, WSP(float, WS_SSX), DM, 1.0f / 512.0f, EPS, rep_ ? 0.f : 1.f};
            const pg8::Gemm g_{WSP(bf16, WS_O), (const bf16*)(wl + OFF_WO), DM, DM, DM, 1, 1 << 30, 0, nullptr, WSP(float, WS_SSO)};
            pg8::StaticOrder S_; S_.init(MTOK / 256, 4, F.G, (int)blockIdx.x); pg8::gemm_phase<pg8::EpiResidualX, pg8::StaticOrder, true, false, true>(F.lds, g_, S_, E, F.lds + STAB_OFF, 1.0f / 512.0f, EPS); }
        SEAM(pb + 5);
        if (ON(7) && IN(pb + 7)) REP(7) if (refresh(F), true) { pg8::EpiBf16RowNorm E{WSP(bf16, WS_QMEM), 512, 0.08838834764831845f * LOG2E, WSP(float, WS_SSX), 1.0f / DM, EPS}; GEMM(pg8::EpiBf16RowNorm, E, F.x, DM, wl + OFF_WMQ, DM, DM, MTOK / 256, 2, 1, 0); }
        SEAM(pb + 7);
        if (ON(8) && IN(pb + 8)) REP(8) if (refresh(F), true) phase_attn_mem(F, l);
        SEAM(pb + 8);
        if (ON(9) && IN(pb + 9)) REP(9) if (refresh(F), true) { pg8::EpiResidual E{F.x, DM, rep_ ? 0.f : 1.f}; GEMM(pg8::EpiResidual, E, WSP(bf16, WS_OMEM), 512, wl + OFF_WMO, 512, 512, MTOK / 256, 4, 1, 0); }
        SEAM(pb + 9);
        if (ON(10) && IN(pb + 10)) REP(10) if (refresh(F), true) phase_router(F, l);
        SEAM(pb + 10);
        if (ON(11) && IN(pb + 11)) REP(11) if (refresh(F), true) phase_select(F, args, l);
        SEAM(pb + 11);
        if (ON(13) && IN(pb + 13)) REP(13) if (refresh(F), true) { pg8::EpiSwiGLU E{WSP(bf16, WS_ACT), EFF, WSP(float, WS_RG)};
            const pg8::Gemm g_{F.x, WSP(bf16, (l & 1) ? WS_WGU2 : WS_WGU), DM, DM, DM, 16, 1 << 30, (size_t)(1024 * 1024), WSP(int, WS_IDX), nullptr};
            pg8::StaticOrder S_; S_.init(MOE_ROWS / 256, 4, F.G, (int)blockIdx.x); pg8::gemm_phase<pg8::EpiSwiGLU, pg8::StaticOrder, true, true>(F.lds, g_, S_, E, F.lds + GTAB_OFF); }
        SEAM(pb + 13);
        if (ON(14) && IN(pb + 14)) REP(14) if (refresh(F), true) { pg8::EpiBf16 E{WSP(bf16, WS_Y), DM, 1.0f, nullptr, nullptr, 0.f, 0.f}; GEMM(pg8::EpiBf16, E, WSP(bf16, WS_ACT), EFF, WSP(bf16, (l & 1) ? WS_WD2 : WS_WD), EFF, EFF, MOE_ROWS / 256, 4, 16, 1024 * 512); }
        SEAM(pb + 14);
        if (ON(15) && IN(pb + 15)) REP(15) if (refresh(F), true) phase_combine(F, args, l, (rep_ && l < DEPTH - 1) ? 0.f : 1.f);
        SEAM(pb + 15);
    }
#undef IN
#undef SEAM
#undef GEMM
}

extern "C" void kernel_launch(void* const* d_in, const int* in_sizes, int n_in, void* d_out, int out_size, void* d_ws, size_t ws_size, hipStream_t stream) {
    static int grid = 0;
    if (grid == 0) {
        if (n_in != 24 || out_size != MTOK * DM || ws_size < WS_END) { fprintf(stderr, "kernel_launch: unexpected shapes: n_in %d out %d ws %zu (need %zu)\n", n_in, out_size, ws_size, (size_t)WS_END); grid = -1; return; }
        int dev = 0, cus = 0, per_cu = 0;
        if (hipGetDevice(&dev) != hipSuccess || hipDeviceGetAttribute(&cus, hipDeviceAttributeMultiprocessorCount, dev) != hipSuccess) { grid = -1; return; }
        if (hipFuncSetAttribute((const void*)enc_fwd, hipFuncAttributeMaxDynamicSharedMemorySize, LDS_BYTES) != hipSuccess) { fprintf(stderr, "kernel_launch: hipFuncSetAttribute failed\n"); grid = -1; return; }
        if (hipOccupancyMaxActiveBlocksPerMultiprocessor(&per_cu, (const void*)enc_fwd, NWAVES * 64, LDS_BYTES) != hipSuccess || per_cu < 1)
            fprintf(stderr, "kernel_launch: occupancy query reports %d workgroups per CU\n", per_cu);
        (void)hipGetLastError();
        grid = cus;
        fprintf(stderr, "kernel_launch: grid %d, ws %zu bytes\n", grid, ws_size);
    }
    if (grid < 0) return;
    (void)hipMemsetAsync((char*)d_ws + WS_CTL, 0, CTL_ZERO_BYTES, stream);
    Args a{};
    for (int i = 0; i < 24; ++i) a.in[i] = (const float*)d_in[i];
    a.out = (float*)d_out; a.ws = (unsigned char*)d_ws;
#if MK_N_LAUNCHES == 1
    a.ph_lo = 0; a.ph_hi = NPH;
    hipLaunchKernelGGL(enc_fwd, dim3(grid), dim3(NWAVES * 64), LDS_BYTES, stream, a);
#else
    for (int p = 0; p < NPH; ++p) { a.ph_lo = p; a.ph_hi = p + 1; hipLaunchKernelGGL(enc_fwd, dim3(grid), dim3(NWAVES * 64), LDS_BYTES, stream, a); }
#endif
    const hipError_t le = hipPeekAtLastError();
    if (le != hipSuccess) fprintf(stderr, "kernel_launch: launch failed: %s\n", hipGetErrorName(le));
}
```

```cpp
#include <hip/hip_runtime.h>
#include <cstdio>
#include <cstdint>

namespace pg8 {
#define PG8_LAS __attribute__((address_space(3)))
typedef unsigned short bf16_t;
typedef short bf16x8 __attribute__((ext_vector_type(8)));
typedef float f32x4 __attribute__((ext_vector_type(4)));
typedef unsigned u32x4 __attribute__((ext_vector_type(4)));
constexpr int BM = 256, BK = 64, HALF = 128, HTB = HALF * BK * 2  , STAGE_BYTES = 8 * HTB, NXCD = 8, WGM = 8;

__host__ __device__ __forceinline__ int lds_byte(int r, int c) { const int st = (r >> 4) * 2 + (c >> 5), rr = r & 15, cc = c & 31, ob = rr * 64 + cc * 2; return st * 1024 + (ob ^ (((ob >> 9) & 1) << 5)); }
__host__ __device__ __forceinline__ void stage_rc(int b, int& R, int& C) { const int st = b / 1024, sb = b % 1024, swz = sb ^ (((sb >> 9) & 1) << 5); R = (st >> 1) * 16 + swz / 64; C = (st & 1) * 32 + (swz % 64) / 2; }
__host__ __device__ __forceinline__ int perm32(int rho) { const int n = rho >> 4, i = rho & 15; return 8 * (i >> 2) + 4 * n + (i & 3); }

struct Unit { int pm, pn; };
struct Gemm { const bf16_t* A; const bf16_t* Bt; int lda, ldb, K, gdiv, amod; size_t gstride; const int* idx; const float* ss; };

struct StaticOrder {
    int nM, nN, nwg, G, c;
    __host__ __device__ void init(int nM_, int nN_, int G_, int c_) { nM = nM_; nN = nN_; nwg = nM * nN; G = G_; c = c_; }
    __host__ __device__ bool next(int i, Unit& u) const {
        const long L = (long)i * G + c; if (L >= nwg) return false;
        int wgid = (int)L; { const int q = nwg / NXCD, r = nwg % NXCD, xcd = wgid % NXCD, off = wgid / NXCD; wgid = (xcd < r ? xcd * (q + 1) : r * (q + 1) + (xcd - r) * q) + off; }
        const int nig = WGM * nN, gid = wgid / nig, fm = gid * WGM, gsz = (nM - fm) < WGM ? (nM - fm) : WGM;
        u.pm = fm + ((wgid % nig) % gsz); u.pn = (wgid % nig) / gsz; return true;
    }
};

template <int NN, int PN0, int KH, int KL> struct SplitOrder {
    int nM, G, c;
    __host__ __device__ void init(int nM_, int G_, int c_) { nM = nM_; G = G_; c = c_; }
    __host__ __device__ bool next(int i, Unit& u) const {
        const int nwg = nM * NN; long L;
        if (KH == 0 || G != 256) L = (long)i * G + c;
        else if (c < 128) { if (i >= KH) return false; L = (long)i * 128 + c; }
        else { if (i >= KL) return false; L = 128L * KH + (long)i * 128 + (c - 128); }
        if (L >= nwg) return false;
        int wgid = (int)L; { const int q = nwg / NXCD, r = nwg % NXCD, xcd = wgid % NXCD, off = wgid / NXCD; wgid = (xcd < r ? xcd * (q + 1) : r * (q + 1) + (xcd - r) * q) + off; }
        const int nig = WGM * NN, gid = wgid / nig, fm = gid * WGM, gsz = (nM - fm) < WGM ? (nM - fm) : WGM;
        u.pm = fm + ((wgid % nig) % gsz); u.pn = PN0 + (wgid % nig) / gsz; return true;
    }
};

struct LinearOrder {
    int nM, nN, G, c, per;
    __host__ __device__ void init(int nM_, int nN_, int G_, int c_, int per_) { nM = nM_; nN = nN_; G = G_; c = c_; per = per_; }
    __host__ __device__ bool next(int i, Unit& u) const { const int idx = (c + (i / per) * G) * per + (i % per); if (idx >= nM * nN) return false; u.pm = idx / nN; u.pn = idx % nN; return true; }
};

__device__ __forceinline__ unsigned cvt_pk_bf16(float lo, float hi) { unsigned r; asm volatile("v_cvt_pk_bf16_f32 %0, %1, %2" : "=v"(r) : "v"(lo), "v"(hi)); return r; }

struct EpiBf16 {
    static constexpr bool PERM = true;
    bf16_t* O; int ldc; float scale; const float* rs; const float* ssl; float ssl_inv, ssl_eps;
    __device__ __forceinline__ void operator()(const f32x4 (&acc)[2][2][4][2], const Unit& u, int wr, int wc, int fr, int fq) const {
        const int row0 = u.pm * BM + wr * 64 + fr, col0 = u.pn * BM + wc * 32 + 8 * fq;
#pragma unroll
        for (int ai = 0; ai < 2; ++ai)
#pragma unroll
            for (int m = 0; m < 4; ++m) { const int row = row0 + ai * HALF + m * 16; bf16_t* rowp = O + (size_t)row * ldc + col0; float sc = rs ? scale * rs[row] : scale;
                if (ssl) { const f32x4 q_ = *(const f32x4*)(ssl + (size_t)row * 8); sc *= __builtin_amdgcn_rsqf(((q_[0] + q_[1]) + (q_[2] + q_[3])) * ssl_inv + ssl_eps); }
#pragma unroll
                for (int bj = 0; bj < 2; ++bj) { const f32x4 v0 = acc[ai][bj][m][0] * sc, v1 = acc[ai][bj][m][1] * sc;
                    u32x4 w; w.x = cvt_pk_bf16(v0[0], v0[1]); w.y = cvt_pk_bf16(v0[2], v0[3]); w.z = cvt_pk_bf16(v1[0], v1[1]); w.w = cvt_pk_bf16(v1[2], v1[3]);
                    *(u32x4*)(rowp + bj * HALF) = w; } }
    }
};
struct EpiQmRope {
    static constexpr bool PERM = true;
    bf16_t* O; int ldc; float scale; const float* tab; const float* ssl; float ssl_inv, ssl_eps;
    __device__ __forceinline__ void operator()(const f32x4 (&acc)[2][2][4][2], const Unit& u, int wr, int wc, int fr, int fq) const {
        const int row0 = u.pm * BM + wr * 64 + fr, col0 = u.pn * BM + wc * 32 + 8 * fq;
        const bool rope = (u.pn == 2);
        const int j0 = (8 * fq) >> 1;
#pragma unroll
        for (int ai = 0; ai < 2; ++ai)
#pragma unroll
            for (int m = 0; m < 4; ++m) { const int row = row0 + ai * HALF + m * 16; bf16_t* rowp = O + (size_t)row * ldc + col0; const int s = row & 4095;
                const f32x4 q_ = *(const f32x4*)(ssl + (size_t)row * 8); const float sc_ = scale * __builtin_amdgcn_rsqf(((q_[0] + q_[1]) + (q_[2] + q_[3])) * ssl_inv + ssl_eps);
                f32x4 t0 = (f32x4){1.f, 0.f, 1.f, 0.f}, t1 = (f32x4){1.f, 0.f, 1.f, 0.f};
                if (rope) { t0 = *(const f32x4*)(tab + ((size_t)s * 16 + j0) * 2); t1 = *(const f32x4*)(tab + ((size_t)s * 16 + j0 + 2) * 2); }
#pragma unroll
                for (int bj = 0; bj < 2; ++bj) { const f32x4 v0 = acc[ai][bj][m][0], v1 = acc[ai][bj][m][1];
                    f32x4 r0, r1;
                    r0[0] = v0[0] * t0[0] - v0[1] * t0[1]; r0[1] = v0[1] * t0[0] + v0[0] * t0[1];
                    r0[2] = v0[2] * t0[2] - v0[3] * t0[3]; r0[3] = v0[3] * t0[2] + v0[2] * t0[3];
                    r1[0] = v1[0] * t1[0] - v1[1] * t1[1]; r1[1] = v1[1] * t1[0] + v1[0] * t1[1];
                    r1[2] = v1[2] * t1[2] - v1[3] * t1[3]; r1[3] = v1[3] * t1[2] + v1[2] * t1[3];
                    r0 = r0 * sc_; r1 = r1 * sc_;
                    u32x4 w; w.x = cvt_pk_bf16(r0[0], r0[1]); w.y = cvt_pk_bf16(r0[2], r0[3]); w.z = cvt_pk_bf16(r1[0], r1[1]); w.w = cvt_pk_bf16(r1[2], r1[3]);
                    *(u32x4*)(rowp + bj * HALF) = w; }
                asm volatile("" ::: "memory"); }
    }
};
struct EpiBf16RowNorm {
    static constexpr bool PERM = true;
    bf16_t* O; int ldc; float scale; const float* ss; float inv_n, eps;
    __device__ __forceinline__ void operator()(const f32x4 (&acc)[2][2][4][2], const Unit& u, int wr, int wc, int fr, int fq) const {
        const int row0 = u.pm * BM + wr * 64 + fr, col0 = u.pn * BM + wc * 32 + 8 * fq;
#pragma unroll
        for (int ai = 0; ai < 2; ++ai)
#pragma unroll
            for (int m = 0; m < 4; ++m) { const int row = row0 + ai * HALF + m * 16; bf16_t* rowp = O + (size_t)row * ldc + col0;
                const f32x4 q0 = *(const f32x4*)(ss + (size_t)row * 16), q1 = *(const f32x4*)(ss + (size_t)row * 16 + 4), q2 = *(const f32x4*)(ss + (size_t)row * 16 + 8), q3 = *(const f32x4*)(ss + (size_t)row * 16 + 12);
                const float tot = ((((q0[0] + q0[1]) + (q0[2] + q0[3])) + ((q1[0] + q1[1]) + (q1[2] + q1[3]))) + (((q2[0] + q2[1]) + (q2[2] + q2[3])) + ((q3[0] + q3[1]) + (q3[2] + q3[3]))));
                const float sc = scale * __builtin_amdgcn_rsqf(tot * inv_n + eps);
#pragma unroll
                for (int bj = 0; bj < 2; ++bj) { const f32x4 v0 = acc[ai][bj][m][0] * sc, v1 = acc[ai][bj][m][1] * sc;
                    u32x4 w; w.x = cvt_pk_bf16(v0[0], v0[1]); w.y = cvt_pk_bf16(v0[2], v0[3]); w.z = cvt_pk_bf16(v1[0], v1[1]); w.w = cvt_pk_bf16(v1[2], v1[3]);
                    *(u32x4*)(rowp + bj * HALF) = w; } }
    }
};
__device__ __forceinline__ float bf_lo(unsigned w) { return __uint_as_float(w << 16); }
__device__ __forceinline__ float bf_hi(unsigned w) { return __uint_as_float(w & 0xffff0000u); }
struct EpiResidualX {
    static constexpr bool PERM = true;
    bf16_t* X; float* SSX; int ldc; float inv_n, eps, mul;
    __device__ __forceinline__ void operator()(const f32x4 (&acc)[2][2][4][2], const Unit& u, int wr, int wc, int fr, int fq, const PG8_LAS float* tab) const {
        const int rl0 = wr * 64 + fr, col0 = u.pn * BM + wc * 32 + 8 * fq;
#pragma unroll
        for (int ai = 0; ai < 2; ++ai)
#pragma unroll
            for (int m = 0; m < 4; ++m) { const int rl = rl0 + ai * HALF + m * 16, row = u.pm * BM + rl; bf16_t* rowp = X + (size_t)row * ldc + col0;
                const float rm = mul * __builtin_amdgcn_rsqf((tab[rl * 4 + 2] + tab[rl * 4 + 3]) * inv_n + eps);
                u32x4 xv[2]; float s = 0.f;
#pragma unroll
                for (int bj = 0; bj < 2; ++bj) xv[bj] = *(const u32x4*)(rowp + bj * HALF);
#pragma unroll
                for (int bj = 0; bj < 2; ++bj) { const f32x4 a0 = acc[ai][bj][m][0] * rm, a1 = acc[ai][bj][m][1] * rm; u32x4 w;
                    w.x = cvt_pk_bf16(bf_lo(xv[bj].x) + a0[0], bf_hi(xv[bj].x) + a0[1]); w.y = cvt_pk_bf16(bf_lo(xv[bj].y) + a0[2], bf_hi(xv[bj].y) + a0[3]);
                    w.z = cvt_pk_bf16(bf_lo(xv[bj].z) + a1[0], bf_hi(xv[bj].z) + a1[1]); w.w = cvt_pk_bf16(bf_lo(xv[bj].w) + a1[2], bf_hi(xv[bj].w) + a1[3]);
                    *(u32x4*)(rowp + bj * HALF) = w;
                    const float r0 = bf_lo(w.x), r1 = bf_hi(w.x), r2 = bf_lo(w.y), r3 = bf_hi(w.y), r4 = bf_lo(w.z), r5 = bf_hi(w.z), r6 = bf_lo(w.w), r7 = bf_hi(w.w);
                    s += ((r0 * r0 + r1 * r1) + (r2 * r2 + r3 * r3)) + ((r4 * r4 + r5 * r5) + (r6 * r6 + r7 * r7)); }
                s += __shfl_xor(s, 16); s += __shfl_xor(s, 32);
                if (fq == 0) SSX[(size_t)row * 16 + u.pn * 4 + wc] = s;
                if (m & 1) asm volatile("" ::: "memory"); }
    }
};
struct EpiResidual {
    static constexpr bool PERM = true;
    bf16_t* X; int ldc; float mul;
    __device__ __forceinline__ void operator()(const f32x4 (&acc)[2][2][4][2], const Unit& u, int wr, int wc, int fr, int fq) const {
        const int row0 = u.pm * BM + wr * 64 + fr, col0 = u.pn * BM + wc * 32 + 8 * fq;
#pragma unroll
        for (int ai = 0; ai < 2; ++ai)
#pragma unroll
            for (int m = 0; m < 4; ++m) { bf16_t* rowp = X + (size_t)(row0 + ai * HALF + m * 16) * ldc + col0;
                u32x4 xv[2];
#pragma unroll
                for (int bj = 0; bj < 2; ++bj) xv[bj] = *(const u32x4*)(rowp + bj * HALF);
#pragma unroll
                for (int bj = 0; bj < 2; ++bj) { const f32x4 a0 = acc[ai][bj][m][0] * mul, a1 = acc[ai][bj][m][1] * mul; u32x4 w;
                    w.x = cvt_pk_bf16(bf_lo(xv[bj].x) + a0[0], bf_hi(xv[bj].x) + a0[1]); w.y = cvt_pk_bf16(bf_lo(xv[bj].y) + a0[2], bf_hi(xv[bj].y) + a0[3]);
                    w.z = cvt_pk_bf16(bf_lo(xv[bj].z) + a1[0], bf_hi(xv[bj].z) + a1[1]); w.w = cvt_pk_bf16(bf_lo(xv[bj].w) + a1[2], bf_hi(xv[bj].w) + a1[3]);
                    *(u32x4*)(rowp + bj * HALF) = w; } }
    }
};
struct EpiInProj {
    static constexpr bool PERM = true;
    const float* rs; const float* gq; const float* gk; const float* tabg; const float* tabm;
    bf16_t* QG; bf16_t* KG; bf16_t* VG; bf16_t* LAT; bf16_t* KROPE; float* SSL; float qscale, eps;
    __device__ __forceinline__ static void rope2(f32x4& v, const f32x4 t) { const float a0 = v[0], b0 = v[1], a1 = v[2], b1 = v[3];
        v[0] = a0 * t[0] - b0 * t[1]; v[1] = b0 * t[0] + a0 * t[1]; v[2] = a1 * t[2] - b1 * t[3]; v[3] = b1 * t[2] + a1 * t[3]; }
    __device__ __forceinline__ static u32x4 pack(const f32x4 a, const f32x4 b) { u32x4 w; w.x = cvt_pk_bf16(a[0], a[1]); w.y = cvt_pk_bf16(a[2], a[3]); w.z = cvt_pk_bf16(b[0], b[1]); w.w = cvt_pk_bf16(b[2], b[3]); return w; }
    __device__ __forceinline__ void operator()(const f32x4 (&acc)[2][2][4][2], const Unit& u, int wr, int wc, int fr, int fq) const {
        const int row0 = u.pm * BM + wr * 64 + fr;
        if (u.pn < 2 || (u.pn == 2 && wc < 2)) {
            const bool isq = u.pn < 2; const float* g = isq ? gq : gk; bf16_t* dst = isq ? QG : KG; const int ld = isq ? 512 : 128, hcol = (isq ? (u.pn * 4 + wc) : wc) * 64; const float osc = isq ? qscale : 1.0f;
            f32x4 gv[2][2];
#pragma unroll
            for (int bj = 0; bj < 2; ++bj)
#pragma unroll
                for (int n = 0; n < 2; ++n)
#pragma unroll
                    for (int i = 0; i < 4; ++i) { const int p = 32 * bj + 8 * fq + 4 * n + i; gv[bj][n][i] = g[(p >> 1) + 32 * (p & 1)]; }
#pragma unroll
            for (int ai = 0; ai < 2; ++ai)
#pragma unroll
                for (int m = 0; m < 4; ++m) { const int row = row0 + ai * HALF + m * 16, s = row & 4095; const float sc = rs[row];
                    f32x4 v[2][2]; float ss = 0.f;
#pragma unroll
                    for (int bj = 0; bj < 2; ++bj)
#pragma unroll
                        for (int n = 0; n < 2; ++n) { v[bj][n] = acc[ai][bj][m][n] * sc; ss += (v[bj][n][0] * v[bj][n][0] + v[bj][n][1] * v[bj][n][1]) + (v[bj][n][2] * v[bj][n][2] + v[bj][n][3] * v[bj][n][3]); }
                    ss += __shfl_xor(ss, 16); ss += __shfl_xor(ss, 32);
                    const float rstd = __builtin_amdgcn_rsqf(ss * (1.0f / 64.0f) + eps);
#pragma unroll
                    for (int bj = 0; bj < 2; ++bj) {
#pragma unroll
                        for (int n = 0; n < 2; ++n) { v[bj][n] = v[bj][n] * rstd * gv[bj][n];
                            const f32x4 t = *(const f32x4*)(tabg + ((size_t)s * 32 + 16 * bj + 4 * fq + 2 * n) * 2); rope2(v[bj][n], t); v[bj][n] = v[bj][n] * osc; }
                        *(u32x4*)(dst + (size_t)row * ld + hcol + 32 * bj + 8 * fq) = pack(v[bj][0], v[bj][1]); } }
        } else if (u.pn == 2) {
#pragma unroll
            for (int ai = 0; ai < 2; ++ai)
#pragma unroll
                for (int m = 0; m < 4; ++m) { const int row = row0 + ai * HALF + m * 16; const float sc = rs[row];
#pragma unroll
                    for (int bj = 0; bj < 2; ++bj) *(u32x4*)(VG + (size_t)row * 128 + (wc - 2) * 64 + 32 * bj + 8 * fq) = pack(acc[ai][bj][m][0] * sc, acc[ai][bj][m][1] * sc); }
        } else if (u.pn == 3) {
#pragma unroll
            for (int ai = 0; ai < 2; ++ai)
#pragma unroll
                for (int m = 0; m < 4; ++m) { const int row = row0 + ai * HALF + m * 16; const float sc = rs[row]; float ss = 0.f;
#pragma unroll
                    for (int bj = 0; bj < 2; ++bj) { const f32x4 a = acc[ai][bj][m][0] * sc, b = acc[ai][bj][m][1] * sc;
                        ss += ((a[0] * a[0] + a[1] * a[1]) + (a[2] * a[2] + a[3] * a[3])) + ((b[0] * b[0] + b[1] * b[1]) + (b[2] * b[2] + b[3] * b[3]));
                        *(u32x4*)(LAT + (size_t)row * 512 + 128 * bj + 32 * wc + 8 * fq) = pack(a, b); }
                    ss += __shfl_xor(ss, 16); ss += __shfl_xor(ss, 32);
                    if (fq == 0) SSL[(size_t)row * 8 + wc] = ss; }
        } else {
#pragma unroll
            for (int ai = 0; ai < 2; ++ai)
#pragma unroll
                for (int m = 0; m < 4; ++m) { const int row = row0 + ai * HALF + m * 16, s = row & 4095; const float sc = rs[row];
                    const f32x4 a = acc[ai][0][m][0] * sc, b = acc[ai][0][m][1] * sc;
                    float ss = ((a[0] * a[0] + a[1] * a[1]) + (a[2] * a[2] + a[3] * a[3])) + ((b[0] * b[0] + b[1] * b[1]) + (b[2] * b[2] + b[3] * b[3]));
                    *(u32x4*)(LAT + (size_t)row * 512 + 256 + 32 * wc + 8 * fq) = pack(a, b);
                    ss += __shfl_xor(ss, 16); ss += __shfl_xor(ss, 32);
                    if (fq == 0) SSL[(size_t)row * 8 + 4 + wc] = ss;
                    if (wc == 0) { f32x4 c = acc[ai][1][m][0] * sc, d = acc[ai][1][m][1] * sc;
                        rope2(c, *(const f32x4*)(tabm + ((size_t)s * 16 + 4 * fq) * 2)); rope2(d, *(const f32x4*)(tabm + ((size_t)s * 16 + 4 * fq + 2) * 2));
                        *(u32x4*)(KROPE + (size_t)row * 32 + 8 * fq) = pack(c, d); } }
        }
    }
};
struct EpiSwiGLU {
    static constexpr bool PERM = true;
    bf16_t* O; int ldc; const float* rs;
    __device__ __forceinline__ static float silu_mul(float g, float u) { return g * u * __builtin_amdgcn_rcpf(1.0f + __builtin_amdgcn_exp2f(-1.4426950408889634f * g)); }
    __device__ __forceinline__ void operator()(const f32x4 (&acc)[2][2][4][2], const Unit& u, int wr, int wc, int fr, int fq) const {
        const int row0 = u.pm * BM + wr * 64 + fr, col0 = u.pn * HALF + wc * 32 + 8 * fq;
#pragma unroll
        for (int ai = 0; ai < 2; ++ai)
#pragma unroll
            for (int m = 0; m < 4; ++m) { const int row = row0 + ai * HALF + m * 16; bf16_t* rowp = O + (size_t)row * ldc + col0; const float sc = rs[row];
                const f32x4 g0 = acc[ai][0][m][0] * sc, g1 = acc[ai][0][m][1] * sc, u0 = acc[ai][1][m][0] * sc, u1 = acc[ai][1][m][1] * sc;
                u32x4 w; w.x = cvt_pk_bf16(silu_mul(g0[0], u0[0]), silu_mul(g0[1], u0[1])); w.y = cvt_pk_bf16(silu_mul(g0[2], u0[2]), silu_mul(g0[3], u0[3]));
                w.z = cvt_pk_bf16(silu_mul(g1[0], u1[0]), silu_mul(g1[1], u1[1])); w.w = cvt_pk_bf16(silu_mul(g1[2], u1[2]), silu_mul(g1[3], u1[3]));
                *(u32x4*)rowp = w; }
    }
};

template <class Epi, class Sched, bool ALIGN_EPI = false, bool GATHER = false, bool MIDSCALE = false>
__device__ __forceinline__ void gemm_phase(PG8_LAS unsigned char* lds, const Gemm g, const Sched& S, const Epi& E, PG8_LAS unsigned char* gtab = nullptr, float ms_inv_n = 0.f, float ms_eps = 0.f) {
    int tid_ = threadIdx.x; asm volatile("" : "+v"(tid_));
    const int tid = tid_, wid = __builtin_amdgcn_readfirstlane(tid >> 6), lane = tid & 63, wr = wid >> 2, wc = wid & 3, fr = lane & 15, fq = lane >> 4;
    const int K = g.K, nt = K / BK;
    unsigned voffA[2], voffB[2]; int gR[2], gC[2];
#pragma unroll
    for (int i = 0; i < 2; ++i) { int R, C; stage_rc(tid * 16 + i * 8192, R, C); const int Rb = Epi::PERM ? ((R & ~31) + perm32(R & 31)) : R; gR[i] = R; gC[i] = C;
        voffA[i] = (unsigned)(R * g.lda + C) * 2u; voffB[i] = (unsigned)(Rb * g.ldb + C) * 2u; }
    unsigned goffc[2][2], goffn[2][2];
#define PG8_GISSUE(u) do { _Pragma("unroll") for (int h_ = 0; h_ < 2; ++h_) _Pragma("unroll") for (int i_ = 0; i_ < 2; ++i_) \
        __builtin_amdgcn_global_load_lds((const unsigned*)(g.idx + (u).pm * BM + h_ * HALF + gR[i_]), (PG8_LAS unsigned*)(gtab + ((h_ * 2 + i_) * 8 + wid) * 256), 4, 0, 0); } while (0)
#define PG8_GREAD(dst, u) do { asm volatile("" ::: "memory"); _Pragma("unroll") for (int h_ = 0; h_ < 2; ++h_) _Pragma("unroll") for (int i_ = 0; i_ < 2; ++i_) { \
        const int tok_ = *(const PG8_LAS int*)(gtab + ((h_ * 2 + i_) * 8 + wid) * 256 + lane * 4); \
        dst[h_][i_] = (unsigned)(((((u).pm >> 1) & 7) * 4096 + tok_) * g.lda + gC[i_]) * 2u; } } while (0)
    const size_t kstep = (size_t)(BK * 2);
    const size_t hstepA = (size_t)HALF * g.lda * 2, hstepB = (size_t)HALF * g.ldb * 2;
    const size_t tstepA = 2 * hstepA, tstepB = 2 * hstepB;
    const unsigned ldsw = (unsigned)wid * 1024u;
    const int aoff = lds_byte(wr * 64 + fr, fq * 8), boff = lds_byte(wc * 32 + fr, fq * 8);
#define PG8_SA(b, h) (((b) * 2 + (h)) * HTB)
#define PG8_SB(b, h) ((4 + (b) * 2 + (h)) * HTB)
#define PG8_STAGE(bufoff, gbase, voff) do { _Pragma("unroll") for (int _i = 0; _i < 2; ++_i) \
        __builtin_amdgcn_global_load_lds((const unsigned*)((const char*)(gbase) + (voff)[_i]), (PG8_LAS unsigned*)(lds + (bufoff) + ldsw + _i * 8192), 16, 0, 0); } while (0)
#define PG8_LDA(dst, b, h) do { _Pragma("unroll") for (int m = 0; m < 4; ++m) _Pragma("unroll") for (int k = 0; k < 2; ++k) dst[m][k] = *(const PG8_LAS bf16x8*)(lds + PG8_SA(b, h) + aoff + m * 2048 + k * 1024); } while (0)
#define PG8_LDB(dst, b, h) do { _Pragma("unroll") for (int n = 0; n < 2; ++n) _Pragma("unroll") for (int k = 0; k < 2; ++k) dst[n][k] = *(const PG8_LAS bf16x8*)(lds + PG8_SB(b, h) + boff + n * 2048 + k * 1024); } while (0)
#define PG8_MMA(ai, bj, At, Bt) do { __builtin_amdgcn_s_setprio(1); _Pragma("unroll") for (int m = 0; m < 4; ++m) _Pragma("unroll") for (int n = 0; n < 2; ++n) _Pragma("unroll") for (int k = 0; k < 2; ++k) \
        acc[ai][bj][m][n] = __builtin_amdgcn_mfma_f32_16x16x32_bf16(Bt[n][k], At[m][k], acc[ai][bj][m][n], 0, 0, 0); __builtin_amdgcn_s_setprio(0); } while (0)
#define PG8_WAIT_V(n) asm volatile("s_waitcnt vmcnt(" #n ")" ::: "memory")
#define PG8_WAIT_L(n) asm volatile("s_waitcnt lgkmcnt(" #n ")" ::: "memory")
#define PG8_BAR __builtin_amdgcn_s_barrier()
#define PG8_SCHED __builtin_amdgcn_sched_barrier(0)
#define PG8_ABASE(u) (GATHER ? (const char*)g.A : (const char*)g.A + (size_t)((u).pm % g.amod) * tstepA)
#define PG8_STA(bufoff, kptr, h, nx) do { if constexpr (GATHER) { unsigned o_[2]; o_[0] = (nx) ? goffn[h][0] : goffc[h][0]; o_[1] = (nx) ? goffn[h][1] : goffc[h][1]; PG8_STAGE(bufoff, kptr, o_); } \
        else { PG8_STAGE(bufoff, (kptr) + (h) * hstepA, voffA); } } while (0)
#define PG8_BBASE(u) ((const char*)g.Bt + ((size_t)((u).pm / g.gdiv) * g.gstride) * 2 + (size_t)(u).pn * tstepB)
    Unit cur, nxt; int ui = 0;
    if (!S.next(0, cur)) return;
    f32x4 acc[2][2][4][2];
#pragma unroll
    for (int a = 0; a < 2; ++a)
#pragma unroll
        for (int b = 0; b < 2; ++b)
#pragma unroll
            for (int m = 0; m < 4; ++m)
#pragma unroll
                for (int n = 0; n < 2; ++n) acc[a][b][m][n] = (f32x4){0.f, 0.f, 0.f, 0.f};
    bf16x8 At[4][2], B0[2][2], B1[2][2];
    const char* cA = PG8_ABASE(cur); const char* cB = PG8_BBASE(cur);
    if constexpr (GATHER) { PG8_GISSUE(cur); PG8_WAIT_V(0); PG8_GREAD(goffc, cur);
#pragma unroll
        for (int h_ = 0; h_ < 2; ++h_) { goffn[h_][0] = goffc[h_][0]; goffn[h_][1] = goffc[h_][1]; } }
    PG8_STAGE(PG8_SB(0, 0), cB, voffB); PG8_STAGE(PG8_SB(0, 1), cB + hstepB, voffB); PG8_STA(PG8_SA(0, 0), cA, 0, false); PG8_STA(PG8_SA(0, 1), cA, 1, false);
    if (wr == 1) PG8_BAR;
    PG8_WAIT_V(2); PG8_BAR;
    PG8_STAGE(PG8_SB(1, 0), cB + kstep, voffB); PG8_STA(PG8_SA(1, 0), cA + kstep, 0, false); PG8_STAGE(PG8_SB(1, 1), cB + hstepB + kstep, voffB);
    PG8_WAIT_V(6); PG8_BAR;
    for (;;) {
        const bool has_next = S.next(ui + 1, nxt);
        const char* nA = has_next ? PG8_ABASE(nxt) : cA; const char* nB = has_next ? PG8_BBASE(nxt) : cB;
        if constexpr (GATHER) { if (has_next) PG8_GISSUE(nxt); }
        if constexpr (MIDSCALE) {
#pragma unroll
            for (int q_ = 0; q_ < 2; ++q_) __builtin_amdgcn_global_load_lds((const unsigned*)(g.ss + (size_t)cur.pm * 1024 + q_ * 512 + wid * 64 + lane), (PG8_LAS unsigned*)(gtab + (ui & 1) * 4096 + q_ * 2048 + wid * 256), 4, 0, 0); }
#pragma nounroll
        for (int t = 0; t < nt; t += 2) {
            const bool last = (t == nt - 2);
            const char* a1 = cA + (size_t)(t + 1) * kstep;
            const char* a2 = last ? nA : cA + (size_t)(t + 2) * kstep; const char* b2 = last ? nB : cB + (size_t)(t + 2) * kstep;
            const char* a3 = a2 + kstep; const char* b3 = b2 + kstep;
            if constexpr (GATHER) { if (last && has_next) PG8_GREAD(goffn, nxt); }
            if constexpr (MIDSCALE) { if (t == nt / 2) { asm volatile("" ::: "memory"); const PG8_LAS float* tab = (const PG8_LAS float*)(gtab + (ui & 1) * 4096);
#pragma unroll
                for (int ai = 0; ai < 2; ++ai)
#pragma unroll
                    for (int m = 0; m < 4; ++m) { const int rl = ai * HALF + wr * 64 + m * 16 + fr; const float sg = tab[rl * 4] + tab[rl * 4 + 1], sm = tab[rl * 4 + 2] + tab[rl * 4 + 3];
                        const float ratio = __builtin_amdgcn_rsqf(sg * ms_inv_n + ms_eps) * __builtin_amdgcn_rcpf(__builtin_amdgcn_rsqf(sm * ms_inv_n + ms_eps));
#pragma unroll
                        for (int bj = 0; bj < 2; ++bj)
#pragma unroll
                            for (int n = 0; n < 2; ++n) acc[ai][bj][m][n] = acc[ai][bj][m][n] * ratio; } } }
            PG8_LDB(B0, 0, 0); PG8_LDB(B1, 0, 1); PG8_SCHED; PG8_LDA(At, 0, 0); PG8_STA(PG8_SA(1, 1), a1, 1, false);
            PG8_WAIT_V(8); PG8_WAIT_L(0); PG8_BAR; PG8_MMA(0, 0, At, B0); PG8_MMA(0, 1, At, B1); PG8_BAR; PG8_SCHED;
            PG8_LDA(At, 0, 1); PG8_STAGE(PG8_SB(0, 0), b2, voffB); PG8_STAGE(PG8_SB(0, 1), b2 + hstepB, voffB); PG8_STA(PG8_SA(0, 0), a2, 0, last);
            PG8_WAIT_V(8); PG8_WAIT_L(0); PG8_BAR; PG8_MMA(1, 0, At, B0); PG8_MMA(1, 1, At, B1); PG8_BAR; PG8_SCHED;
            PG8_LDB(B0, 1, 0); PG8_LDB(B1, 1, 1); PG8_SCHED; PG8_LDA(At, 1, 0); PG8_STA(PG8_SA(0, 1), a2, 1, last);
            PG8_WAIT_V(8); PG8_WAIT_L(0); PG8_BAR; PG8_MMA(0, 0, At, B0); PG8_MMA(0, 1, At, B1); PG8_BAR; PG8_SCHED;
            PG8_LDA(At, 1, 1); PG8_STAGE(PG8_SB(1, 0), b3, voffB); PG8_STAGE(PG8_SB(1, 1), b3 + hstepB, voffB); PG8_STA(PG8_SA(1, 0), a3, 0, last);
            PG8_WAIT_V(8); PG8_WAIT_L(0); PG8_BAR; PG8_MMA(1, 0, At, B0); PG8_MMA(1, 1, At, B1); PG8_BAR; PG8_SCHED;
        }
        if constexpr (ALIGN_EPI) { if (wr == 0) PG8_BAR; }
        if constexpr (MIDSCALE) E(acc, cur, wr, wc, fr, fq, (const PG8_LAS float*)(gtab + (ui & 1) * 4096)); else E(acc, cur, wr, wc, fr, fq);
        if (!has_next) break;
#pragma unroll
        for (int a = 0; a < 2; ++a)
#pragma unroll
            for (int b = 0; b < 2; ++b)
#pragma unroll
                for (int m = 0; m < 4; ++m)
#pragma unroll
                    for (int n = 0; n < 2; ++n) acc[a][b][m][n] = (f32x4){0.f, 0.f, 0.f, 0.f};
        cur = nxt; cA = nA; cB = nB; ++ui;
        if constexpr (GATHER) {
#pragma unroll
            for (int h_ = 0; h_ < 2; ++h_) { goffc[h_][0] = goffn[h_][0]; goffc[h_][1] = goffn[h_][1]; } }
        if constexpr (ALIGN_EPI) { if (wr == 1) PG8_BAR; }
    }
    PG8_WAIT_V(0);
    if constexpr (!ALIGN_EPI) { if (wr == 0) PG8_BAR; }
    PG8_BAR;
#undef PG8_SA
#undef PG8_SB
#undef PG8_STAGE
#undef PG8_LDA
#undef PG8_LDB
#undef PG8_MMA
#undef PG8_WAIT_V
#undef PG8_WAIT_L
#undef PG8_BAR
#undef PG8_SCHED
#undef PG8_ABASE
#undef PG8_STA
#undef PG8_GISSUE
#undef PG8_GREAD
#undef PG8_BBASE
}
}
namespace att {
typedef unsigned short bf16;
using bf16x8 = __attribute__((ext_vector_type(8))) short;
using s16x4  = __attribute__((ext_vector_type(4))) short;
using f32x16 = __attribute__((ext_vector_type(16))) float;
using u32x4  = __attribute__((ext_vector_type(4))) unsigned;
#define ATT_SBAR() __builtin_amdgcn_sched_barrier(0)
constexpr int KCH = 1040;
constexpr float THR = 8.0f;
__device__ __forceinline__ int crow(int r, int hi) { return (r & 3) + 8 * (r >> 2) + 4 * hi; }
__device__ __forceinline__ unsigned cvtpk(float lo, float hi) { unsigned r; asm volatile("v_cvt_pk_bf16_f32 %0, %1, %2" : "=v"(r) : "v"(lo), "v"(hi)); return r; }
typedef float f32x2_t __attribute__((ext_vector_type(2))); typedef __bf16 bf16x2_t __attribute__((ext_vector_type(2)));
__device__ __forceinline__ unsigned cvtpk_c(float lo, float hi) { const f32x2_t v = {lo, hi}; const bf16x2_t b = __builtin_convertvector(v, bf16x2_t); return __builtin_bit_cast(unsigned, b); }
__device__ __forceinline__ unsigned short f2bf1(float f) { unsigned u = __builtin_bit_cast(unsigned, f); return (unsigned short)((u + 0x7fffu + ((u >> 16) & 1u)) >> 16); }

#define ATT_MX3(a, b, c) __builtin_fmaxf(__builtin_fmaxf((a), (b)), (c))
template <int MODE, bool FIRST>
__device__ __forceinline__ void partialSM(f32x16& p0, f32x16& p1, float& m_run, f32x16& negm, float& alpha) {
  if constexpr (MODE == 0) {
    float a = ATT_MX3(p0[0], p0[1], p1[0]), b = ATT_MX3(p0[2], p0[3], p1[1]); a = ATT_MX3(a, p1[2], p1[3]);
#pragma unroll
    for (int r = 4; r < 16; r += 4) { a = ATT_MX3(a, p0[r], p0[r + 1]); b = ATT_MX3(b, p0[r + 2], p0[r + 3]); a = ATT_MX3(a, p1[r], p1[r + 1]); b = ATT_MX3(b, p1[r + 2], p1[r + 3]); }
    float pmax = fmaxf(a, b);
    { auto rr = __builtin_amdgcn_permlane32_swap(__float_as_uint(pmax), __float_as_uint(pmax), false, false);
      pmax = fmaxf(__uint_as_float(rr[0]), __uint_as_float(rr[1])); }
    alpha = 1.f;
    if (FIRST || __builtin_expect(__any(pmax > THR), 0)) {
      const float dl = FIRST ? pmax : fmaxf(pmax, 0.f);
      m_run += dl;
#pragma unroll
      for (int r = 0; r < 16; ++r) { p0[r] -= dl; p1[r] -= dl; }
#pragma unroll
      for (int r = 0; r < 16; ++r) negm[r] = -m_run;
      asm volatile("" : "+v"(negm));
      alpha = FIRST ? 1.f : __builtin_amdgcn_exp2f(-dl);
    }
  } else { alpha = 1.f; }
#pragma unroll
  for (int r = 0; r < 16; ++r) p0[r] = __builtin_amdgcn_exp2f(p0[r]);
}
__device__ __forceinline__ void finishSM(f32x16& p0, f32x16& p1, float alpha, float& l_reg, bf16x8& pa0, bf16x8& pa1, bf16x8& pa2, bf16x8& pa3) {
#pragma unroll
  for (int r = 0; r < 16; ++r) p1[r] = __builtin_amdgcn_exp2f(p1[r]);
  float ps = 0;
#pragma unroll
  for (int r = 0; r < 16; ++r) ps += p0[r];
#pragma unroll
  for (int r = 0; r < 16; ++r) ps += p1[r];
  { auto rr = __builtin_amdgcn_permlane32_swap(__float_as_uint(ps), __float_as_uint(ps), false, false);
    ps = __uint_as_float(rr[0]) + __uint_as_float(rr[1]); }
  l_reg = l_reg * alpha + ps;
#define ATT_PK4(P, BASE, OUT) do { const u32x4 w = {cvtpk_c(P[BASE + 0], P[BASE + 1]), cvtpk_c(P[BASE + 2], P[BASE + 3]), cvtpk_c(P[BASE + 4], P[BASE + 5]), cvtpk_c(P[BASE + 6], P[BASE + 7])}; \
    OUT = __builtin_bit_cast(bf16x8, w); } while (0)
  ATT_PK4(p0, 0, pa0); ATT_PK4(p0, 8, pa1); ATT_PK4(p1, 0, pa2); ATT_PK4(p1, 8, pa3);
#undef ATT_PK4
}
template <int ND0, int MODE = 0>
__device__ __forceinline__ void qkt(f32x16& p0, f32x16& p1, const char* Ks, const bf16x8* qr, const f32x16& negm, int r32, int hi) {
#pragma unroll
  for (int d0 = 0; d0 < ND0; ++d0) {
    const char* kb = Ks + (2 * d0 + hi) * KCH + r32 * 16;
    bf16x8 b0 = *reinterpret_cast<const bf16x8*>(kb);
    bf16x8 b1 = *reinterpret_cast<const bf16x8*>(kb + 512);
    if (d0 == 0) { if constexpr (MODE == 1) { p0 = __builtin_amdgcn_mfma_f32_32x32x16_bf16(b0, qr[0], f32x16{}, 0, 0, 0); p1 = __builtin_amdgcn_mfma_f32_32x32x16_bf16(b1, qr[0], f32x16{}, 0, 0, 0); }
                   else { p0 = __builtin_amdgcn_mfma_f32_32x32x16_bf16(b0, qr[0], negm, 0, 0, 0); p1 = __builtin_amdgcn_mfma_f32_32x32x16_bf16(b1, qr[0], negm, 0, 0, 0); } }
    else { p0 = __builtin_amdgcn_mfma_f32_32x32x16_bf16(b0, qr[d0], p0, 0, 0, 0); p1 = __builtin_amdgcn_mfma_f32_32x32x16_bf16(b1, qr[d0], p1, 0, 0, 0); } }
}
template <int NB> __device__ __forceinline__ int v_st(int k, int c) { const int kk = k; return ((kk >> 3) * NB + (c >> 5)) * 512 + ((kk & 7) * 32 + (c & 31)) * 2; }
__device__ __forceinline__ int v_rd_base(int lane) { return ((lane & 3) << 3) | (((lane >> 2) & 3) << 6) | (((lane >> 4) & 1) << 5) | (((lane >> 5) & 1) << 8); }
template <int OFF> __device__ __forceinline__ s16x4 tr_read(int vb) {
  s16x4 r; asm volatile("ds_read_b64_tr_b16 %0, %1 offset:%2" : "=&v"(r) : "v"(vb), "i"(OFF) : "memory"); return r;
}
template <int NB, int D0> __device__ __forceinline__ void pv_one(f32x16& od, int vb, bf16x8 pa0, bf16x8 pa1, bf16x8 pa2, bf16x8 pa3) {
#define ATT_VO(ks, half) (D0 * 512 + (2 * (ks) + (half)) * NB * 512)
  const s16x4 l0 = tr_read<ATT_VO(0, 0)>(vb), h0 = tr_read<ATT_VO(0, 1)>(vb), l1 = tr_read<ATT_VO(1, 0)>(vb), h1 = tr_read<ATT_VO(1, 1)>(vb);
  const s16x4 l2 = tr_read<ATT_VO(2, 0)>(vb), h2 = tr_read<ATT_VO(2, 1)>(vb), l3 = tr_read<ATT_VO(3, 0)>(vb), h3 = tr_read<ATT_VO(3, 1)>(vb);
#undef ATT_VO
  asm volatile("s_waitcnt lgkmcnt(0)" ::: "memory"); ATT_SBAR();
#define ATT_PK(L, H) (bf16x8){L[0], L[1], L[2], L[3], H[0], H[1], H[2], H[3]}
  od = __builtin_amdgcn_mfma_f32_32x32x16_bf16(pa0, ATT_PK(l0, h0), od, 0, 0, 0);
  od = __builtin_amdgcn_mfma_f32_32x32x16_bf16(pa1, ATT_PK(l1, h1), od, 0, 0, 0);
  od = __builtin_amdgcn_mfma_f32_32x32x16_bf16(pa2, ATT_PK(l2, h2), od, 0, 0, 0);
  od = __builtin_amdgcn_mfma_f32_32x32x16_bf16(pa3, ATT_PK(l3, h3), od, 0, 0, 0);
#undef ATT_PK
}
template <int NB> __device__ __forceinline__ void pv_all(f32x16* o, int vb, bf16x8 pa0, bf16x8 pa1, bf16x8 pa2, bf16x8 pa3) {
  if constexpr (NB == 2) {
#define ATT_VO(d0, ks, half) ((d0) * 512 + (2 * (ks) + (half)) * NB * 512)
    const s16x4 l0 = tr_read<ATT_VO(0, 0, 0)>(vb), h0 = tr_read<ATT_VO(0, 0, 1)>(vb), l1 = tr_read<ATT_VO(0, 1, 0)>(vb), h1 = tr_read<ATT_VO(0, 1, 1)>(vb);
    const s16x4 l2 = tr_read<ATT_VO(0, 2, 0)>(vb), h2 = tr_read<ATT_VO(0, 2, 1)>(vb), l3 = tr_read<ATT_VO(0, 3, 0)>(vb), h3 = tr_read<ATT_VO(0, 3, 1)>(vb);
    const s16x4 m0 = tr_read<ATT_VO(1, 0, 0)>(vb), n0 = tr_read<ATT_VO(1, 0, 1)>(vb), m1 = tr_read<ATT_VO(1, 1, 0)>(vb), n1 = tr_read<ATT_VO(1, 1, 1)>(vb);
    const s16x4 m2 = tr_read<ATT_VO(1, 2, 0)>(vb), n2 = tr_read<ATT_VO(1, 2, 1)>(vb), m3 = tr_read<ATT_VO(1, 3, 0)>(vb), n3 = tr_read<ATT_VO(1, 3, 1)>(vb);
#undef ATT_VO
#define ATT_PK(L, H) (bf16x8){L[0], L[1], L[2], L[3], H[0], H[1], H[2], H[3]}
    asm volatile("s_waitcnt lgkmcnt(8)" ::: "memory"); ATT_SBAR();
    o[0] = __builtin_amdgcn_mfma_f32_32x32x16_bf16(pa0, ATT_PK(l0, h0), o[0], 0, 0, 0);
    o[0] = __builtin_amdgcn_mfma_f32_32x32x16_bf16(pa1, ATT_PK(l1, h1), o[0], 0, 0, 0);
    o[0] = __builtin_amdgcn_mfma_f32_32x32x16_bf16(pa2, ATT_PK(l2, h2), o[0], 0, 0, 0);
    o[0] = __builtin_amdgcn_mfma_f32_32x32x16_bf16(pa3, ATT_PK(l3, h3), o[0], 0, 0, 0);
    asm volatile("s_waitcnt lgkmcnt(0)" ::: "memory"); ATT_SBAR();
    o[1] = __builtin_amdgcn_mfma_f32_32x32x16_bf16(pa0, ATT_PK(m0, n0), o[1], 0, 0, 0);
    o[1] = __builtin_amdgcn_mfma_f32_32x32x16_bf16(pa1, ATT_PK(m1, n1), o[1], 0, 0, 0);
    o[1] = __builtin_amdgcn_mfma_f32_32x32x16_bf16(pa2, ATT_PK(m2, n2), o[1], 0, 0, 0);
    o[1] = __builtin_amdgcn_mfma_f32_32x32x16_bf16(pa3, ATT_PK(m3, n3), o[1], 0, 0, 0);
#undef ATT_PK
  } else {
    pv_one<NB, 0>(o[0], vb, pa0, pa1, pa2, pa3); pv_one<NB, 1>(o[1], vb, pa0, pa1, pa2, pa3);
    pv_one<NB, 2>(o[2], vb, pa0, pa1, pa2, pa3); pv_one<NB, 3>(o[3], vb, pa0, pa1, pa2, pa3);
  }
}

template <int W1, int W2, int DV> struct AttnCfg {
  static constexpr int DQK = W1 + W2, NCH = DQK / 8, ND0 = DQK / 16, NB = DV / 32;
  static constexpr int KT_BYTES = NCH * KCH, VT_BYTES = 64 * DV * 2;
  static constexpr int OST_BYTES = 32 * DV * 2;
  static constexpr bool OSTAGE = (DV == 64);
  static constexpr int LDS_BYTES = 3 * VT_BYTES + 3 * KT_BYTES + 8 * 64 * 4 + (OSTAGE ? 8 * OST_BYTES : 0);
  static constexpr int CW1 = W1 / 8, N1 = (64 * CW1) / 512;
  static constexpr int CWV = DV / 8, NV = (64 * CWV) / 512;
  static_assert(W1 == 64 || W1 == 128, "W1"); static_assert(W2 == 0 || W2 == 32, "W2"); static_assert(DV == 64 || DV == 128, "DV");
};

template <int W1, int W2, int DV, int MODE, bool SSQ>
__device__ __forceinline__ void attn_unit(const bf16* __restrict__ Qb, const bf16* __restrict__ Qb2, int ldq, const bf16* __restrict__ K1, int ldk1, const bf16* __restrict__ K2, int ldk2,
                                          const bf16* __restrict__ Vh, int ldv, bf16* __restrict__ Ob, int ldo, int nkeys, char* lds, float (&ssacc)[16]) {
  using C = AttnCfg<W1, W2, DV>;
  constexpr int ND0 = C::ND0, NB = C::NB, N1 = C::N1, NV = C::NV, CW1 = C::CW1, CWV = C::CWV;
  constexpr int SHM_V = C::VT_BYTES, SHM_K = C::KT_BYTES;
  int tid_ = threadIdx.x; asm volatile("" : "+v"(tid_));
  const int tid = tid_, wid = tid >> 6, lane = tid & 63, r32 = lane & 31, hi = lane >> 5;
  char* V_lds = lds; char* K_lds = lds + 3 * SHM_V;
  float* ws = (float*)(lds + 3 * SHM_V + 3 * SHM_K) + wid * 64; float* li_l = ws; float* al_l = ws + 32;
  float m_reg = 0.f, l_reg = 0; f32x16 o[NB]; bf16x8 qr[ND0]; f32x16 negm = f32x16{}; if constexpr (MODE == 0) asm volatile("" : "+v"(negm));
#pragma unroll
  for (int d = 0; d < NB; ++d) o[d] = f32x16{};
  const bf16* Qw = Qb + (long)(wid * 32 + r32) * ldq + hi * 8;
#pragma unroll
  for (int d0 = 0; d0 < W1 / 16; ++d0) qr[d0] = *reinterpret_cast<const bf16x8*>(Qw + d0 * 16);
  if constexpr (W2 > 0) { const bf16* Qw2 = Qb2 + (long)(wid * 32 + r32) * ldq + hi * 8;
#pragma unroll
    for (int d0 = 0; d0 < W2 / 16; ++d0) qr[W1 / 16 + d0] = *reinterpret_cast<const bf16x8*>(Qw2 + d0 * 16); }
  int k1row[N1], k1col[N1], k1lds[N1], vrow[NV], vcol[NV], vlds[NV];
#pragma unroll
  for (int i = 0; i < N1; ++i) { const int p = tid + 512 * i; k1row[i] = p / CW1; k1col[i] = (p % CW1) * 8; k1lds[i] = (p % CW1) * KCH + (p / CW1) * 16; }
#pragma unroll
  for (int i = 0; i < NV; ++i) { const int p = tid + 512 * i; vrow[i] = p / CWV; vcol[i] = (p % CWV) * 8; vlds[i] = v_st<NB>(p / CWV, (p % CWV) * 8); }
  const int k2row = tid >> 2, k2col = (tid & 3) * 8, k2lds = (CW1 + (tid & 3)) * KCH + (tid >> 2) * 16; const bool k2on = (W2 > 0) && (tid < 256);
  const int vb0 = (int)(uintptr_t)V_lds + v_rd_base(lane);
  struct Slot { bf16x8 k1[N1]; bf16x8 k2; bf16x8 v[NV]; } sr_[2];
#define ATT_SLOAD(i, k0) do { _Pragma("unroll") for (int _j = 0; _j < N1; ++_j) sr_[i].k1[_j] = *reinterpret_cast<const bf16x8*>(&K1[(long)((k0) + k1row[_j]) * ldk1 + k1col[_j]]); \
    if constexpr (W2 > 0) { if (k2on) sr_[i].k2 = *reinterpret_cast<const bf16x8*>(&K2[(long)((k0) + k2row) * ldk2 + k2col]); } \
    _Pragma("unroll") for (int _j = 0; _j < NV; ++_j) sr_[i].v[_j] = *reinterpret_cast<const bf16x8*>(&Vh[(long)((k0) + vrow[_j]) * ldv + vcol[_j]]); } while (0)
#define ATT_SWRITE(b, i) do { _Pragma("unroll") for (int _j = 0; _j < NV; ++_j) *(bf16x8*)(V_lds + (b) * SHM_V + vlds[_j]) = sr_[i].v[_j]; \
    _Pragma("unroll") for (int _j = 0; _j < N1; ++_j) *(bf16x8*)(K_lds + (b) * SHM_K + k1lds[_j]) = sr_[i].k1[_j]; \
    if constexpr (W2 > 0) { if (k2on) *(bf16x8*)(K_lds + (b) * SHM_K + k2lds) = sr_[i].k2; } } while (0)
#define ATT_SWAIT() asm volatile("s_waitcnt vmcnt(%0)" :: "n"(N1 + NV) : "memory")
#define ATT_RESC(a) do { if (MODE == 0 && __any((a) != 1.f)) { if (hi == 0) al_l[r32] = (a); asm volatile("s_waitcnt lgkmcnt(0)" ::: "memory"); \
    _Pragma("unroll") for (int d = 0; d < NB; ++d) _Pragma("unroll") for (int r = 0; r < 16; ++r) o[d][r] *= al_l[crow(r, hi)]; } } while (0)
  f32x16 pA0, pA1, pB0, pB1; float alA, alB; bf16x8 pa0, pa1, pa2, pa3; const int NT = nkeys / 64;
  ATT_SLOAD(0, 0); asm volatile("s_waitcnt vmcnt(0)" ::: "memory"); ATT_SWRITE(0, 0); __syncthreads();
  qkt<ND0, MODE>(pA0, pA1, K_lds, qr, negm, r32, hi); partialSM<MODE, true>(pA0, pA1, m_reg, negm, alA);
  ATT_SLOAD(1, 64); if (2 < NT) ATT_SLOAD(0, 128);
  ATT_SWAIT(); ATT_SWRITE(1, 1); __syncthreads();
  int bp = 0, bc = 1, bn = 2;
  if (wid >= 4) __builtin_amdgcn_s_setprio(1);
#define ATT_ROT() do { const int t_ = bp; bp = bc; bc = bn; bn = t_; } while (0)
  for (int j = 1; j + 1 < NT; j += 2) {
    ATT_SBAR(); qkt<ND0, MODE>(pB0, pB1, K_lds + bc * SHM_K, qr, negm, r32, hi);
    finishSM(pA0, pA1, alA, l_reg, pa0, pa1, pa2, pa3); ATT_SBAR();
    ATT_SLOAD(1, (j + 2) * 64); ATT_SBAR();
    pv_all<NB>(o, vb0 + bp * SHM_V, pa0, pa1, pa2, pa3); partialSM<MODE, false>(pB0, pB1, m_reg, negm, alB);
    ATT_SWAIT(); ATT_SWRITE(bn, 0);
    ATT_RESC(alB); __syncthreads(); ATT_ROT();
    ATT_SBAR(); qkt<ND0, MODE>(pA0, pA1, K_lds + bc * SHM_K, qr, negm, r32, hi);
    finishSM(pB0, pB1, alB, l_reg, pa0, pa1, pa2, pa3); ATT_SBAR();
    if (j + 3 < NT) ATT_SLOAD(0, (j + 3) * 64); ATT_SBAR();
    pv_all<NB>(o, vb0 + bp * SHM_V, pa0, pa1, pa2, pa3); partialSM<MODE, false>(pA0, pA1, m_reg, negm, alA);
    ATT_SWAIT(); ATT_SWRITE(bn, 1);
    ATT_RESC(alA); __syncthreads(); ATT_ROT();
  }
  ATT_SBAR(); qkt<ND0, MODE>(pB0, pB1, K_lds + bc * SHM_K, qr, negm, r32, hi);
  finishSM(pA0, pA1, alA, l_reg, pa0, pa1, pa2, pa3); ATT_SBAR();
  pv_all<NB>(o, vb0 + bp * SHM_V, pa0, pa1, pa2, pa3); partialSM<MODE, false>(pB0, pB1, m_reg, negm, alB);
  ATT_RESC(alB);
  finishSM(pB0, pB1, alB, l_reg, pa0, pa1, pa2, pa3); ATT_SBAR();
  pv_all<NB>(o, vb0 + bc * SHM_V, pa0, pa1, pa2, pa3);
#undef ATT_ROT
  __builtin_amdgcn_s_setprio(0);
  if (hi == 0) li_l[r32] = l_reg; asm volatile("s_waitcnt lgkmcnt(0)" ::: "memory");
  float rli[16];
#pragma unroll
  for (int r = 0; r < 16; ++r) rli[r] = __builtin_amdgcn_rcpf(li_l[crow(r, hi)]);
  bf16* Ow = Ob + (long)(wid * 32) * ldo;
  if constexpr (C::OSTAGE) { unsigned short* stg = (unsigned short*)(lds + 3 * SHM_V + 3 * SHM_K + 8 * 64 * 4 + wid * C::OST_BYTES);
#pragma unroll
    for (int r = 0; r < 16; ++r) { const int orow = crow(r, hi);
#pragma unroll
      for (int d0 = 0; d0 < NB; ++d0) stg[orow * DV + d0 * 32 + r32] = f2bf1(o[d0][r] * rli[r]); }
    asm volatile("s_waitcnt lgkmcnt(0)" ::: "memory");
    constexpr int CPR = DV / 8;
#pragma unroll
    for (int i = 0; i < (32 * CPR) / 64; ++i) { const int p = i * 64 + lane, row = p / CPR, ch = p % CPR;
      const u32x4 v = *(const u32x4*)(stg + row * DV + ch * 8); *(u32x4*)(Ow + (long)row * ldo + ch * 8) = v; } }
  else {
#pragma unroll
    for (int r = 0; r < 16; ++r) { const int orow = crow(r, hi);
#pragma unroll
      for (int d0 = 0; d0 < NB; ++d0) Ow[(long)orow * ldo + d0 * 32 + r32] = f2bf1(o[d0][r] * rli[r]); } }
  if constexpr (SSQ) {
#pragma unroll
    for (int r = 0; r < 16; ++r) {
#pragma unroll
      for (int d0 = 0; d0 < NB; ++d0) { const float v = o[d0][r] * rli[r]; ssacc[r] += v * v; } } }
  __syncthreads();
#undef ATT_SLOAD
#undef ATT_SWRITE
#undef ATT_SWAIT
#undef ATT_RESC
}

template <bool SSQ>
__device__ __forceinline__ void attn_unit_2h(const bf16* __restrict__ QbA, const bf16* __restrict__ QbB, int ldq, const bf16* __restrict__ K1, int ldk1, const bf16* __restrict__ Vh, int ldv,
                                             bf16* __restrict__ ObA, bf16* __restrict__ ObB, int ldo, int nkeys, char* lds, float* sslds) {
  using C = AttnCfg<64, 0, 64>;
  constexpr int ND0 = 4, NB = 2, DV = 64, SHM_V = C::VT_BYTES, SHM_K = C::KT_BYTES;
  int tid_ = threadIdx.x; asm volatile("" : "+v"(tid_));
  const int tid = tid_, wid = tid >> 6, lane = tid & 63, r32 = lane & 31, hi = lane >> 5;
  char* V_lds = lds; char* K_lds = lds + 3 * SHM_V;
  float* li_l = (float*)(lds + 3 * SHM_V + 3 * SHM_K) + wid * 64;
  float lA = 0.f, lB = 0.f, mdum = 0.f, aldum; f32x16 oA[NB], oB[NB], ndum = f32x16{}; bf16x8 qA[ND0], qB[ND0];
#pragma unroll
  for (int d = 0; d < NB; ++d) { oA[d] = f32x16{}; oB[d] = f32x16{}; }
  { const long qo = (long)(wid * 32 + r32) * ldq + hi * 8;
#pragma unroll
    for (int d0 = 0; d0 < ND0; ++d0) { qA[d0] = *reinterpret_cast<const bf16x8*>(QbA + qo + d0 * 16); qB[d0] = *reinterpret_cast<const bf16x8*>(QbB + qo + d0 * 16); } }
  const int srow = tid >> 3, scol = (tid & 7) * 8, klds = (tid & 7) * KCH + (tid >> 3) * 16, vlds = v_st<NB>(tid >> 3, (tid & 7) * 8);
  const unsigned koff = (unsigned)(srow * ldk1 + scol) * 2u, voff = (unsigned)(srow * ldv + scol) * 2u;
  const int vb0 = (int)(uintptr_t)V_lds + v_rd_base(lane);
  struct Slot { bf16x8 k, v; } sr_[1];
#define A2_SLOAD(i, k0) do { sr_[i].k = *reinterpret_cast<const bf16x8*>((const char*)K1 + (size_t)(k0) * (size_t)ldk1 * 2 + koff); sr_[i].v = *reinterpret_cast<const bf16x8*>((const char*)Vh + (size_t)(k0) * (size_t)ldv * 2 + voff); } while (0)
#define A2_SWRITE(b, i) do { *(bf16x8*)(V_lds + (b) * SHM_V + vlds) = sr_[i].v; *(bf16x8*)(K_lds + (b) * SHM_K + klds) = sr_[i].k; } while (0)
#define A2_MF(a, b, c) __builtin_amdgcn_mfma_f32_32x32x16_bf16(a, b, c, 0, 0, 0)
#define A2_PK(L, H) (bf16x8){L[0], L[1], L[2], L[3], H[0], H[1], H[2], H[3]}
#define A2_VO(d0, ks, half) ((d0) * 512 + (2 * (ks) + (half)) * NB * 512)
  const int NT = nkeys / 64;
  A2_SLOAD(0, 0); asm volatile("s_waitcnt vmcnt(0)" ::: "memory"); A2_SWRITE(0, 0); __syncthreads();
  if (wid >= 4) __builtin_amdgcn_s_setprio(1);
  f32x16 sA0, sA1, sB0, sB1; bf16x8 a0, a1, a2, a3, b0, b1, b2, b3;
#define A2_STEP(CUR, NXT) do { \
    { const int nx_ = (j + 1 < NT) ? j + 1 : NT - 1; A2_SLOAD(0, nx_ * 64); } \
    const char* kb_ = K_lds + (CUR) * SHM_K + hi * KCH + r32 * 16; \
    bf16x8 kf0[ND0], kf1[ND0]; \
    _Pragma("unroll") for (int d0 = 0; d0 < ND0; ++d0) { kf0[d0] = *reinterpret_cast<const bf16x8*>(kb_ + 2 * d0 * KCH); kf1[d0] = *reinterpret_cast<const bf16x8*>(kb_ + 2 * d0 * KCH + 512); } \
    ATT_SBAR(); \
    sA0 = A2_MF(kf0[0], qA[0], f32x16{}); sA1 = A2_MF(kf1[0], qA[0], f32x16{}); \
    _Pragma("unroll") for (int d0 = 1; d0 < ND0; ++d0) { sA0 = A2_MF(kf0[d0], qA[d0], sA0); sA1 = A2_MF(kf1[d0], qA[d0], sA1); } \
    ATT_SBAR(); \
    sB0 = A2_MF(kf0[0], qB[0], f32x16{}); sB1 = A2_MF(kf1[0], qB[0], f32x16{}); \
    _Pragma("unroll") for (int d0 = 1; d0 < ND0; ++d0) { sB0 = A2_MF(kf0[d0], qB[d0], sB0); sB1 = A2_MF(kf1[d0], qB[d0], sB1); } \
    partialSM<1, false>(sA0, sA1, mdum, ndum, aldum); finishSM(sA0, sA1, 1.f, lA, a0, a1, a2, a3); \
    ATT_SBAR(); \
    { const int vb = vb0 + (CUR) * SHM_V; \
      const s16x4 l0 = tr_read<A2_VO(0, 0, 0)>(vb), h0 = tr_read<A2_VO(0, 0, 1)>(vb), l1 = tr_read<A2_VO(0, 1, 0)>(vb), h1 = tr_read<A2_VO(0, 1, 1)>(vb); \
      const s16x4 l2 = tr_read<A2_VO(0, 2, 0)>(vb), h2 = tr_read<A2_VO(0, 2, 1)>(vb), l3 = tr_read<A2_VO(0, 3, 0)>(vb), h3 = tr_read<A2_VO(0, 3, 1)>(vb); \
      const s16x4 m0 = tr_read<A2_VO(1, 0, 0)>(vb), n0 = tr_read<A2_VO(1, 0, 1)>(vb), m1 = tr_read<A2_VO(1, 1, 0)>(vb), n1 = tr_read<A2_VO(1, 1, 1)>(vb); \
      const s16x4 m2 = tr_read<A2_VO(1, 2, 0)>(vb), n2 = tr_read<A2_VO(1, 2, 1)>(vb), m3 = tr_read<A2_VO(1, 3, 0)>(vb), n3 = tr_read<A2_VO(1, 3, 1)>(vb); \
      asm volatile("s_waitcnt lgkmcnt(0)" ::: "memory"); ATT_SBAR(); \
      oA[0] = A2_MF(a0, A2_PK(l0, h0), oA[0]); oA[1] = A2_MF(a0, A2_PK(m0, n0), oA[1]); oA[0] = A2_MF(a1, A2_PK(l1, h1), oA[0]); oA[1] = A2_MF(a1, A2_PK(m1, n1), oA[1]); \
      oA[0] = A2_MF(a2, A2_PK(l2, h2), oA[0]); oA[1] = A2_MF(a2, A2_PK(m2, n2), oA[1]); oA[0] = A2_MF(a3, A2_PK(l3, h3), oA[0]); oA[1] = A2_MF(a3, A2_PK(m3, n3), oA[1]); \
      partialSM<1, false>(sB0, sB1, mdum, ndum, aldum); finishSM(sB0, sB1, 1.f, lB, b0, b1, b2, b3); \
      ATT_SBAR(); \
      oB[0] = A2_MF(b0, A2_PK(l0, h0), oB[0]); oB[1] = A2_MF(b0, A2_PK(m0, n0), oB[1]); oB[0] = A2_MF(b1, A2_PK(l1, h1), oB[0]); oB[1] = A2_MF(b1, A2_PK(m1, n1), oB[1]); \
      oB[0] = A2_MF(b2, A2_PK(l2, h2), oB[0]); oB[1] = A2_MF(b2, A2_PK(m2, n2), oB[1]); oB[0] = A2_MF(b3, A2_PK(l3, h3), oB[0]); oB[1] = A2_MF(b3, A2_PK(m3, n3), oB[1]); } \
    if (j + 1 < NT) { asm volatile("s_waitcnt vmcnt(0)" ::: "memory"); A2_SWRITE(NXT, 0); } \
    __syncthreads(); } while (0)
  for (int j = 0; j < NT; j += 2) { A2_STEP(0, 1); ++j; A2_STEP(1, 0); --j; }
#undef A2_STEP
  __builtin_amdgcn_s_setprio(0);
#define A2_EPI(O_, L_, OB_) do { \
    if (hi == 0) li_l[r32] = (L_); asm volatile("s_waitcnt lgkmcnt(0)" ::: "memory"); \
    float rli[16]; _Pragma("unroll") for (int r = 0; r < 16; ++r) rli[r] = __builtin_amdgcn_rcpf(li_l[crow(r, hi)]); \
    bf16* Ow = (OB_) + (long)(wid * 32) * ldo; unsigned short* stg = (unsigned short*)(lds + 3 * SHM_V + 3 * SHM_K + 8 * 64 * 4 + wid * C::OST_BYTES); \
    _Pragma("unroll") for (int r = 0; r < 16; ++r) { const int orow = crow(r, hi); _Pragma("unroll") for (int d0 = 0; d0 < NB; ++d0) stg[orow * DV + d0 * 32 + r32] = f2bf1(O_[d0][r] * rli[r]); } \
    asm volatile("s_waitcnt lgkmcnt(0)" ::: "memory"); \
    _Pragma("unroll") for (int i = 0; i < 4; ++i) { const int p = i * 64 + lane, row = p >> 3, ch = p & 7; const u32x4 v = *(const u32x4*)(stg + row * DV + ch * 8); *(u32x4*)(Ow + (long)row * ldo + ch * 8) = v; } \
    if constexpr (SSQ) { _Pragma("unroll") for (int r = 0; r < 16; ++r) { float q_ = sslds[r * 512]; _Pragma("unroll") for (int d0 = 0; d0 < NB; ++d0) { const float v = O_[d0][r] * rli[r]; q_ += v * v; } sslds[r * 512] = q_; } } \
    asm volatile("s_waitcnt lgkmcnt(0)" ::: "memory"); } while (0)
  A2_EPI(oA, lA, ObA); A2_EPI(oB, lB, ObB);
#undef A2_EPI
  __syncthreads();
#undef A2_SLOAD
#undef A2_SWRITE
#undef A2_MF
#undef A2_PK
#undef A2_VO
}

__device__ __forceinline__ void attn_mem_unit(const bf16* __restrict__ Qb, int ldq, const bf16* __restrict__ Kh, int ldk, const bf16* __restrict__ Vh, int ldv, bf16* __restrict__ Ob, int ldo, char* lds) {
  constexpr int ND0 = 8, NB = 4, DV = 128, SHM_V = 64 * 128 * 2, SHM_K = 16 * KCH;
  int tid_ = threadIdx.x; asm volatile("" : "+v"(tid_));
  const int tid = tid_, wid = tid >> 6, lane = tid & 63, r32 = lane & 31, hi = lane >> 5;
  char* V_lds = lds; char* K_lds = lds + 4 * SHM_V;
  float* ws = (float*)(lds + 4 * SHM_V + 4 * SHM_K) + wid * 64; float* li_l = ws; float* al_l = ws + 32;
  bf16x8 qr[ND0];
  const bf16* Qw = Qb + (long)(wid * 32 + r32) * ldq + hi * 8;
#pragma unroll
  for (int d0 = 0; d0 < ND0; ++d0) qr[d0] = *reinterpret_cast<const bf16x8*>(Qw + d0 * 16);
  {
    int krow[2], kcol[2], klds[2], vlds[2];
#pragma unroll
    for (int i = 0; i < 2; ++i) { const int p = tid + 512 * i; krow[i] = p >> 4; kcol[i] = (p & 15) * 8; klds[i] = (p & 15) * KCH + (p >> 4) * 16; vlds[i] = v_st<NB>(p >> 4, (p & 15) * 8); }
#pragma unroll
    for (int b = 0; b < 2; ++b) {
      bf16x8 kk[2][2], vv[2][2];
#pragma unroll
      for (int t = 0; t < 2; ++t)
#pragma unroll
        for (int i = 0; i < 2; ++i) { const long r = (2 * b + t) * 64 + krow[i]; kk[t][i] = *reinterpret_cast<const bf16x8*>(&Kh[r * ldk + kcol[i]]); vv[t][i] = *reinterpret_cast<const bf16x8*>(&Vh[r * ldv + kcol[i]]); }
#pragma unroll
      for (int t = 0; t < 2; ++t)
#pragma unroll
        for (int i = 0; i < 2; ++i) { *(bf16x8*)(K_lds + (2 * b + t) * SHM_K + klds[i]) = kk[t][i]; *(bf16x8*)(V_lds + (2 * b + t) * SHM_V + vlds[i]) = vv[t][i]; }
    }
  }
  __syncthreads();
  const int vb0 = (int)(uintptr_t)V_lds + v_rd_base(lane);
  float m_reg = 0.f, l_reg = 0.f, al; f32x16 o[NB]; f32x16 negm = f32x16{}; asm volatile("" : "+v"(negm));
#pragma unroll
  for (int d = 0; d < NB; ++d) o[d] = f32x16{};
  f32x16 p0, p1; bf16x8 pa0, pa1, pa2, pa3;
#define ATT_MRESC(a) do { if (__any((a) != 1.f)) { if (hi == 0) al_l[r32] = (a); asm volatile("s_waitcnt lgkmcnt(0)" ::: "memory"); \
    _Pragma("unroll") for (int d = 0; d < NB; ++d) _Pragma("unroll") for (int r = 0; r < 16; ++r) o[d][r] *= al_l[crow(r, hi)]; } } while (0)
  qkt<ND0, 0>(p0, p1, K_lds, qr, negm, r32, hi); partialSM<0, true>(p0, p1, m_reg, negm, al); finishSM(p0, p1, al, l_reg, pa0, pa1, pa2, pa3);
  ATT_SBAR(); pv_all<NB>(o, vb0, pa0, pa1, pa2, pa3);
#pragma unroll
  for (int t = 1; t < 4; ++t) {
    ATT_SBAR(); qkt<ND0, 0>(p0, p1, K_lds + t * SHM_K, qr, negm, r32, hi); partialSM<0, false>(p0, p1, m_reg, negm, al); finishSM(p0, p1, al, l_reg, pa0, pa1, pa2, pa3);
    ATT_MRESC(al);
    ATT_SBAR(); pv_all<NB>(o, vb0 + t * SHM_V, pa0, pa1, pa2, pa3);
  }
#undef ATT_MRESC
  if (hi == 0) li_l[r32] = l_reg; asm volatile("s_waitcnt lgkmcnt(0)" ::: "memory");
  float rli[16];
#pragma unroll
  for (int r = 0; r < 16; ++r) rli[r] = __builtin_amdgcn_rcpf(li_l[crow(r, hi)]);
  bf16* Ow = Ob + (long)(wid * 32) * ldo;
#pragma unroll
  for (int r = 0; r < 16; ++r) { const int orow = crow(r, hi);
#pragma unroll
    for (int d0 = 0; d0 < NB; ++d0) Ow[(long)orow * ldo + d0 * 32 + r32] = f2bf1(o[d0][r] * rli[r]); }
  __syncthreads();
}
#undef ATT_SBAR
}
constexpr int NWAVES = 8;
#ifndef MK_N_LAUNCHES
#define MK_N_LAUNCHES 1
#endif
constexpr int BATCH = 8, SEQ = 4096, DM = 1024, DEPTH = 4, MTOK = BATCH * SEQ;
constexpr int IN_W = 1184, IN_WP = 1280;
constexpr int MEM_T = 256, MROWS = BATCH * MEM_T;
constexpr int NEXP = 16, CAP = 512, EFF = 512, MOE_ROWS = NEXP * BATCH * CAP;
constexpr float EPS = 1e-6f, LOG2E = 1.4426950408889634f;
constexpr int NPH = 2 + 16 * DEPTH;
constexpr size_t MiB = 1u << 20;
constexpr size_t WS_CTL = 0, CTL_ZERO_BYTES = 1 * MiB;
constexpr size_t WS_TABG = 1 * MiB, WS_TABM = 2 * MiB, WS_WR = 2 * MiB + 512 * 1024, WS_GAINS = 3 * MiB, WS_SSO = 3 * MiB + 64 * 1024, WS_SSX = 346 * MiB, WS_RS1 = WS_SSO + 512 * 1024, WS_RS3 = WS_RS1 + 128 * 1024, WS_RG = 118 * MiB + 256 * 1024, WS_SSL = 118 * MiB + 512 * 1024;
constexpr size_t WS_WSMALL = 4 * MiB, WSMALL_STRIDE = 10 * MiB;
constexpr size_t OFF_WIN = 0, OFF_WQB = 5 * MiB / 2, OFF_WKVB = 3 * MiB, OFF_WO = 7 * MiB / 2, OFF_WMQ = 11 * MiB / 2, OFF_WMKV = 13 * MiB / 2, OFF_WMO = 17 * MiB / 2;
constexpr size_t WS_WGU = 44 * MiB, WS_WD = 76 * MiB;
constexpr size_t WS_MEMN = 92 * MiB, WS_MEMKV = 96 * MiB;
constexpr size_t WS_AFF = 112 * MiB, WS_AFFT = 114 * MiB, WS_SLOT = 116 * MiB, WS_IDX = 118 * MiB;
constexpr size_t WS_H = 120 * MiB, WS_PROJ = 184 * MiB, WS_QG = 264 * MiB, WS_KG = 296 * MiB, WS_VG = 304 * MiB, WS_LAT = 312 * MiB, WS_KROPE = 344 * MiB, WS_QM = 346 * MiB;
constexpr size_t WS_XB = 264 * MiB;
constexpr size_t WS_O = WS_H, WS_KVM = WS_PROJ, WS_QMEM = 184 * MiB, WS_OMEM = 216 * MiB, WS_XG = 184 * MiB, WS_Y = WS_XG, WS_ACT = 312 * MiB;
constexpr size_t WS_WGU2 = 394 * MiB, WS_WD2 = 426 * MiB;
constexpr size_t WS_X = 442 * MiB;
constexpr size_t WS_END = 506 * MiB;
constexpr int CW_BAR = 4096;
constexpr int RING_BYTES = 131072, LDSCTL_OFF = 135168, MISC_OFF = LDSCTL_OFF + 320, GTAB_OFF = LDSCTL_OFF + 1024, STAB_OFF = GTAB_OFF + 8192, LDS_BYTES = 163840;

#define GAS __attribute__((address_space(1)))
#define LAS __attribute__((address_space(3)))
typedef unsigned short bf16;
typedef unsigned v4u __attribute__((ext_vector_type(4)));
typedef float f32x4 __attribute__((ext_vector_type(4)));
#define LDS_WAIT() asm volatile("s_waitcnt lgkmcnt(0)" ::: "memory")
__device__ __forceinline__ unsigned pk2(float lo, float hi) { unsigned r; asm volatile("v_cvt_pk_bf16_f32 %0, %1, %2" : "=v"(r) : "v"(lo), "v"(hi)); return r; }
__device__ __forceinline__ float bflo(unsigned w) { return __uint_as_float(w << 16); }
__device__ __forceinline__ float bfhi(unsigned w) { return __uint_as_float(w & 0xffff0000u); }
#define UNPACK8(W_, V_) do { V_[0] = bflo(W_[0]); V_[1] = bfhi(W_[0]); V_[2] = bflo(W_[1]); V_[3] = bfhi(W_[1]); V_[4] = bflo(W_[2]); V_[5] = bfhi(W_[2]); V_[6] = bflo(W_[3]); V_[7] = bfhi(W_[3]); } while (0)
#define PACK8(V_, W_) do { W_[0] = pk2(V_[0], V_[1]); W_[1] = pk2(V_[2], V_[3]); W_[2] = pk2(V_[4], V_[5]); W_[3] = pk2(V_[6], V_[7]); } while (0)
__device__ __forceinline__ float wave_sum(float v) {
#pragma unroll
    for (int o = 1; o < 64; o <<= 1) v += __shfl_xor(v, o);
    return v;
}
__device__ __forceinline__ int wave_sum_i(int v) {
#pragma unroll
    for (int o = 1; o < 64; o <<= 1) v += __shfl_xor(v, o);
    return v;
}

#define XB_TMO      128
#define XB_XCNT(j)  (256  + 64 * (j))
#define XB_XSUB(j)  (1280 + 64 * (j))
#define XB_XGEN(j)  (2304 + 64 * (j))
#define XB_TOP      3328
#define XB_TOPGEN   3392
#define XCD_BAR_WORDS 3456
#define XB_SPIN_CAP (1u << 20)
__device__ __forceinline__ unsigned xb_ld(unsigned* p)              { return __hip_atomic_load(p, __ATOMIC_RELAXED, __HIP_MEMORY_SCOPE_AGENT); }
__device__ __forceinline__ unsigned xb_add(unsigned* p, unsigned v) { return __hip_atomic_fetch_add(p, v, __ATOMIC_RELAXED, __HIP_MEMORY_SCOPE_AGENT); }
__device__ __forceinline__ unsigned xb_xcc_id() { return (unsigned)__builtin_amdgcn_s_getreg((3 << 11) | 20) & 0xFu; }
#define XB_SPIN(cond, bar) do { unsigned _sp = 0; while (cond) { __builtin_amdgcn_s_sleep(1); \
    if ((++_sp & 255u) == 0u) { if (xb_ld(&(bar)[XB_TMO])) break; if (_sp > XB_SPIN_CAP) { atomicAdd(&(bar)[XB_TMO], 1u); break; } } } } while (0)
struct XcdBarrier { unsigned* bar; unsigned x; volatile LAS unsigned* st; };
__device__ __forceinline__ XcdBarrier xcd_barrier_post(unsigned* bar, volatile LAS unsigned* st) {
    XcdBarrier b; b.bar = bar; b.x = xb_xcc_id(); b.st = st;
    if (threadIdx.x == 0) (void)xb_add(&bar[XB_XCNT(b.x)], 1u);
    return b;
}
__device__ __forceinline__ void xcd_barrier_complete(unsigned* bar, unsigned x, unsigned& nloc, unsigned& nx) {
    const unsigned G = gridDim.x * gridDim.y * gridDim.z;
    unsigned sum, cnt, mine, sp = 0u;
    for (;;) {
        sum = 0u; cnt = 0u; mine = 0u;
#pragma unroll
        for (unsigned j = 0; j < 16; ++j) { const unsigned c = xb_ld(&bar[XB_XCNT(j)]); sum += c; cnt += (c > 0u) ? 1u : 0u; mine = (j == x) ? c : mine; }
        if (sum == G) break;
        __builtin_amdgcn_s_sleep(1);
        if ((++sp & 255u) == 0u) { if (xb_ld(&bar[XB_TMO])) break; if (sp > XB_SPIN_CAP) { atomicAdd(&bar[XB_TMO], 1u); break; } }
    }
    nloc = mine > 0u ? mine : 1u; nx = cnt > 0u ? cnt : 1u;
}
__device__ __forceinline__ void xcd_barrier(const XcdBarrier& b) {
    asm volatile("s_waitcnt vmcnt(0)" ::: "memory");
    __syncthreads();
    if (threadIdx.x == 0) {
        unsigned* bar = b.bar;
        __builtin_amdgcn_s_waitcnt(0);
        unsigned nloc = b.st[0], nx = b.st[1];
        if (nloc == 0u) { xcd_barrier_complete(bar, b.x, nloc, nx); b.st[0] = nloc; b.st[1] = nx; }
        const unsigned old = xb_add(&bar[XB_XSUB(b.x)], 1u);
        const unsigned gen = old / nloc;
        if (old + 1u == (gen + 1u) * nloc) {
            __builtin_amdgcn_fence(__ATOMIC_RELEASE, "agent");
            asm volatile("s_waitcnt vmcnt(0)" ::: "memory");
            const unsigned og = xb_add(&bar[XB_TOP], 1u);
            const unsigned tg = og / nx;
            if (og + 1u == (tg + 1u) * nx) xb_add(&bar[XB_TOPGEN], 1u);
            else XB_SPIN(xb_ld(&bar[XB_TOPGEN]) == tg, bar);
            __builtin_amdgcn_fence(__ATOMIC_ACQUIRE, "agent");
            xb_add(&bar[XB_XGEN(b.x)], 1u);
            asm volatile("s_waitcnt vmcnt(0)" ::: "memory");
        } else {
            XB_SPIN(xb_ld(&bar[XB_XGEN(b.x)]) == gen, bar);
            __builtin_amdgcn_fence(__ATOMIC_ACQUIRE, "agent");
            asm volatile("s_waitcnt vmcnt(0)" ::: "memory");
        }
    }
    __syncthreads();
}

struct Args { const float* in[24]; float* out; unsigned char* ws; int ph_lo, ph_hi; };
struct Ctx {
    LAS unsigned char* lds; char* ldsg;
    int tid, lane, wave, vcu, vcu0, G, G0, gw, NGW;
    bf16* x; float* out;
    unsigned char* ws;
};
#define WSP(T, off) ((T*)(F.ws + (off)))
__device__ __forceinline__ void refresh(Ctx& F) { int t = threadIdx.x; asm volatile("" : "+v"(t)); F.tid = t; F.lane = t & 63;
    int w = __builtin_amdgcn_readfirstlane(t >> 6), v = F.vcu0, g = F.G0; asm volatile("" : "+s"(w), "+s"(v), "+s"(g)); F.wave = w; F.vcu = v; F.G = g; F.gw = v * NWAVES + w; F.NGW = g * NWAVES; }

__device__ __forceinline__ int il32(int i) { return (i < 16) ? 2 * i : 2 * (i - 16) + 1; }
__device__ __forceinline__ int il64(int d) { return (d < 32) ? 2 * d : 2 * (d - 32) + 1; }
__device__ __forceinline__ int dstrow(int kind, int n) {
    if (kind == 1) {
        if (n < 512) { const int h = n >> 6, p = il64(n & 63); return 256 * (h >> 2) + 128 * (p >> 5) + 32 * (h & 3) + (p & 31); }
        if (n < 640) { const int kh = (n - 512) >> 6, p = il64(n & 63); return 512 + 128 * (p >> 5) + 32 * kh + (p & 31); }
        if (n < 768) { const int vh = (n - 640) >> 6, d = n & 63; return 512 + 128 * (d >> 5) + 32 * (2 + vh) + (d & 31); }
        if (n >= 1152) return 1152 + il32(n - 1152);
        return n; }
    if (kind == 2) { const int h = n / 96, p = n % 96; return (p < 64) ? h * 64 + p : 512 + h * 32 + il32(p - 64); }
    if (kind == 3) return (n >> 7) * 256 + (n & 127);
    if (kind == 4) return (n >> 7) * 256 + 128 + (n & 127);
    return n;
}
__device__ __forceinline__ void tr_item(const float* W, int N, const float* gain, bf16* WT, int ldk, int kind, int item, LAS float* scr, int lane) {
    const int nblk = (N + 63) / 64, kb = item / nblk, nb = item % nblk, k0 = 64 * kb, n0 = 64 * nb;
    const int lr = lane >> 4, lc = (lane & 15) * 4; const bool okc = (n0 + lc) < N;
    f32x4 v[16];
#pragma unroll
    for (int i = 0; i < 16; ++i) v[i] = okc ? *(const GAS f32x4*)(W + (size_t)(k0 + 4 * i + lr) * N + n0 + lc) : (f32x4){0.f, 0.f, 0.f, 0.f};
#pragma unroll
    for (int i = 0; i < 16; ++i) { const int kk = 4 * i + lr; const float gk = gain ? gain[k0 + kk] : 1.0f; LAS float* d = scr + kk * 65 + lc;
        d[0] = v[i].x * gk; d[1] = v[i].y * gk; d[2] = v[i].z * gk; d[3] = v[i].w * gk; }
    LDS_WAIT(); asm volatile("" ::: "memory");
    const int c = lane & 7;
#pragma unroll
    for (int j = 0; j < 8; ++j) { const int n = (lane >> 3) + 8 * j; const LAS float* s = scr + (8 * c) * 65 + n;
        v4u o; o.x = pk2(s[0 * 65], s[1 * 65]); o.y = pk2(s[2 * 65], s[3 * 65]); o.z = pk2(s[4 * 65], s[5 * 65]); o.w = pk2(s[6 * 65], s[7 * 65]);
        if (n0 + n < N) *(GAS v4u*)(WT + (size_t)dstrow(kind, n0 + n) * ldk + k0 + 8 * c) = o; }
    LDS_WAIT(); asm volatile("" ::: "memory");
}
constexpr int SMALL_ITEMS = 1152;
__device__ __forceinline__ void small_weight_item(const Ctx& F, const Args& A, int l, int r, LAS float* scr) {
    bf16* wl = WSP(bf16, WS_WSMALL + (size_t)l * WSMALL_STRIDE);
    if (r < 304) { tr_item(A.in[3] + (size_t)l * DM * IN_W, IN_W, A.in[2] + l * DM, wl + OFF_WIN / 2, DM, 1, r, scr, F.lane); return; } r -= 304;
    if (r < 48)  { tr_item(A.in[8] + (size_t)l * 256 * 768, 768, A.in[6] + l * 256, wl + OFF_WQB / 2, 256, 2, r, scr, F.lane); return; } r -= 48;
    if (r < 32)  { tr_item(A.in[9] + (size_t)l * 128 * 1024, 1024, A.in[7] + l * 128, wl + OFF_WKVB / 2, 128, 0, r, scr, F.lane); return; } r -= 32;
    if (r < 256) { const int kb = r / 16; const float* gain = (kb < 8) ? (A.in[10] + l * 512) : (A.in[11] + l * 512 - 512);
                   tr_item(A.in[12] + (size_t)l * DM * DM, DM, gain, wl + OFF_WO / 2, DM, 0, r, scr, F.lane); return; } r -= 256;
    if (r < 128) { tr_item(A.in[15] + (size_t)l * DM * 512, 512, A.in[13] + l * DM, wl + OFF_WMQ / 2, DM, 0, r, scr, F.lane); return; } r -= 128;
    if (r < 256) { tr_item(A.in[16] + (size_t)l * DM * DM, DM, A.in[14] + l * DM, wl + OFF_WMKV / 2, DM, 0, r, scr, F.lane); return; } r -= 256;
    tr_item(A.in[17] + (size_t)l * 512 * DM, DM, nullptr, wl + OFF_WMO / 2, 512, 0, r, scr, F.lane);
}
constexpr int MOE_ITEMS = 3 * 2048;
__device__ __forceinline__ void moe_weight_item(const Ctx& F, const Args& A, int l, int it, LAS float* scr) {
    bf16* wgu = WSP(bf16, (l & 1) ? WS_WGU2 : WS_WGU); bf16* wd = WSP(bf16, (l & 1) ? WS_WD2 : WS_WD);
    const int which = it >> 11, e = (it >> 7) & 15, r = it & 127;
    if (which < 2) tr_item((which == 0 ? A.in[20] : A.in[21]) + (size_t)(l * NEXP + e) * DM * EFF, EFF, A.in[18] + l * DM, wgu + (size_t)e * 1024 * 1024, DM, 3 + which, r, scr, F.lane);
    else           tr_item(A.in[22] + (size_t)(l * NEXP + e) * EFF * DM, DM, nullptr, wd + (size_t)e * 1024 * 512, EFF, 0, r, scr, F.lane);
}
__device__ __forceinline__ void convert_moe_weights(const Ctx& F, const Args& A, int l) {
    LAS float* scr = (LAS float*)(F.lds + F.wave * 16640);
    for (int it = F.gw; it < MOE_ITEMS; it += F.NGW) moe_weight_item(F, A, l, it, scr);
}

__device__ __forceinline__ void rms_row_f32(const float* xrow, bf16* xb, bf16* orow, float* rs, int lane) {
    const GAS f32x4* xr = (const GAS f32x4*)xrow + lane;
    f32x4 v[4]; float s = 0.f;
#pragma unroll
    for (int j = 0; j < 4; ++j) { v[j] = xr[64 * j]; s += (v[j].x * v[j].x + v[j].y * v[j].y) + (v[j].z * v[j].z + v[j].w * v[j].w); }
    const float rstd = __builtin_amdgcn_rsqf(wave_sum(s) * (1.f / DM) + EPS);
    if (xb) { GAS unsigned long long* x8 = (GAS unsigned long long*)xb + lane;
#pragma unroll
        for (int j = 0; j < 4; ++j) x8[64 * j] = (unsigned long long)pk2(v[j].x, v[j].y) | ((unsigned long long)pk2(v[j].z, v[j].w) << 32); }
    if (rs && lane == 0) *rs = rstd;
    if (orow) { GAS unsigned long long* o8 = (GAS unsigned long long*)orow + lane;
#pragma unroll
        for (int j = 0; j < 4; ++j) o8[64 * j] = (unsigned long long)pk2(v[j].x * rstd, v[j].y * rstd) | ((unsigned long long)pk2(v[j].z * rstd, v[j].w * rstd) << 32); }
}
__device__ __forceinline__ void phase_prologue(const Ctx& F, const Args& A) {
    LAS float* scr = (LAS float*)(F.lds + F.wave * 16640);
    for (int it = F.gw; it < DEPTH * SMALL_ITEMS; it += F.NGW) small_weight_item(F, A, it / SMALL_ITEMS, it % SMALL_ITEMS, scr);
    convert_moe_weights(F, A, 0);
    const int gt = F.vcu * (NWAVES * 64) + F.tid, NGT = F.G * NWAVES * 64;
    for (int i = gt; i < DEPTH * 12288; i += NGT) { const int l = i / 12288, r = i % 12288;
        bf16* wl = WSP(bf16, WS_WSMALL + (size_t)l * WSMALL_STRIDE);
        *(GAS v4u*)(wl + OFF_WIN / 2 + (size_t)IN_W * DM + (size_t)r * 8) = (v4u){0u, 0u, 0u, 0u}; }
    for (int i = gt; i < 1536; i += NGT) WSP(float, WS_GAINS)[i] = (i < 256) ? A.in[4][i] : (i < 512) ? A.in[5][i - 256] : A.in[23][i - 512];
    for (int i = gt; i < DEPTH * NEXP * DM; i += NGT) { const int l = i / (NEXP * DM), e = (i / DM) % NEXP, k = i % DM;
        WSP(float, WS_WR)[i] = A.in[19][(size_t)(l * DM + k) * NEXP + e] * A.in[18][l * DM + k]; }
    for (int i = gt; i < SEQ * 48; i += NGT) { const int s = i / 48, j = i % 48; const float row = (float)(s >> 6), col = (float)(s & 63);
        const bool isg = (j < 32); const int j2 = isg ? j : j - 32, half = isg ? 16 : 8, jj = j2 & (half - 1);
        const float inv = __builtin_amdgcn_exp2f(-(float)(2 * jj) / (float)(2 * half) * 13.287712379549449f);
        const float ang = ((j2 < half) ? row : col) * inv;
        double td = (double)ang * 0.15915494309189535; td -= rint(td);
        const float sn = __builtin_amdgcn_sinf((float)td), cs = __builtin_amdgcn_cosf((float)td);
        float* dst = isg ? (WSP(float, WS_TABG) + ((size_t)s * 32 + j2) * 2) : (WSP(float, WS_TABM) + ((size_t)s * 16 + j2) * 2);
        dst[0] = cs; dst[1] = sn; }
    for (int m = F.gw; m < MROWS; m += F.NGW) rms_row_f32(A.in[1] + (size_t)m * DM, nullptr, WSP(bf16, WS_MEMN) + (size_t)m * DM, nullptr, F.lane);
    {
        const int lane = F.lane; f32x4 vn[4];
#pragma unroll
        for (int j = 0; j < 4; ++j) vn[j] = (f32x4){0.f, 0.f, 0.f, 0.f};
        if (F.gw < MTOK) { const GAS f32x4* xr = (const GAS f32x4*)(A.in[0] + (size_t)F.gw * DM) + lane;
#pragma unroll
            for (int j = 0; j < 4; ++j) vn[j] = xr[64 * j]; }
        for (int m = F.gw; m < MTOK; m += F.NGW) {
            f32x4 v[4]; float s = 0.f;
#pragma unroll
            for (int j = 0; j < 4; ++j) { v[j] = vn[j]; s += (v[j].x * v[j].x + v[j].y * v[j].y) + (v[j].z * v[j].z + v[j].w * v[j].w); }
            if (m + F.NGW < MTOK) { const GAS f32x4* xr = (const GAS f32x4*)(A.in[0] + (size_t)(m + F.NGW) * DM) + lane;
#pragma unroll
                for (int j = 0; j < 4; ++j) vn[j] = xr[64 * j]; }
            const float rstd = __builtin_amdgcn_rsqf(wave_sum(s) * (1.f / DM) + EPS);
            GAS unsigned long long* x8 = (GAS unsigned long long*)(F.x + (size_t)m * DM) + lane;
#pragma unroll
            for (int j = 0; j < 4; ++j) x8[64 * j] = (unsigned long long)pk2(v[j].x, v[j].y) | ((unsigned long long)pk2(v[j].z, v[j].w) << 32);
            if (lane == 0) WSP(float, WS_RS1)[m] = rstd;
        } }
}

__device__ __forceinline__ void rope4(float* v, const float* tab) {
    const f32x4 t0 = *(const f32x4*)tab, t1 = *(const f32x4*)(tab + 4);
    float a, b;
    a = v[0]; b = v[1]; v[0] = a * t0[0] - b * t0[1]; v[1] = b * t0[0] + a * t0[1];
    a = v[2]; b = v[3]; v[2] = a * t0[2] - b * t0[3]; v[3] = b * t0[2] + a * t0[3];
    a = v[4]; b = v[5]; v[4] = a * t1[0] - b * t1[1]; v[5] = b * t1[0] + a * t1[1];
    a = v[6]; b = v[7]; v[6] = a * t1[2] - b * t1[3]; v[7] = b * t1[2] + a * t1[3];
}
__device__ __forceinline__ void phase_postproj(const Ctx& F, int l) {
    int lane_ = F.lane; asm volatile("" : "+v"(lane_)); const int lane = lane_;
    const float* gq = WSP(float, WS_GAINS) + l * 64; const float* gk = WSP(float, WS_GAINS) + 256 + l * 64;
    float gqv[8], gkv[8];
#pragma unroll
    for (int i = 0; i < 8; ++i) { const int p = 8 * (lane & 7) + i, d = (p >> 1) + 32 * (p & 1); gqv[i] = gq[d]; gkv[i] = gk[d]; }
    const float* tabg = WSP(float, WS_TABG); const float* tabm = WSP(float, WS_TABM);
    const float C2G = 0.125f * LOG2E;
    v4u wa_n = (v4u){0u, 0u, 0u, 0u}, wb_n = wa_n, wc_n = wa_n;
    if (F.gw < MTOK) { const bf16* pr = WSP(bf16, WS_PROJ) + (size_t)F.gw * IN_WP; wa_n = *(const GAS v4u*)(pr + 8 * lane); wb_n = *(const GAS v4u*)(pr + 512 + 8 * lane); if (lane < 20) wc_n = *(const GAS v4u*)(pr + 1024 + 8 * lane); }
    for (int m = F.gw; m < MTOK; m += F.NGW) {
        const int s = m & (SEQ - 1);
        const v4u wa = wa_n, wb = wb_n, wc = wc_n;
        if (m + F.NGW < MTOK) { const bf16* pr = WSP(bf16, WS_PROJ) + (size_t)(m + F.NGW) * IN_WP; wa_n = *(const GAS v4u*)(pr + 8 * lane); wb_n = *(const GAS v4u*)(pr + 512 + 8 * lane); if (lane < 20) wc_n = *(const GAS v4u*)(pr + 1024 + 8 * lane); }
        { const v4u w = wa; float v[8]; UNPACK8(w, v);
          float ss = 0.f;
#pragma unroll
          for (int i = 0; i < 8; ++i) ss += v[i] * v[i];
          ss += __shfl_xor(ss, 1); ss += __shfl_xor(ss, 2); ss += __shfl_xor(ss, 4);
          const float rstd = __builtin_amdgcn_rsqf(ss * (1.f / 64.f) + EPS);
#pragma unroll
          for (int i = 0; i < 8; ++i) v[i] = v[i] * rstd * gqv[i];
          rope4(v, tabg + ((size_t)s * 32 + 4 * (lane & 7)) * 2);
#pragma unroll
          for (int i = 0; i < 8; ++i) v[i] *= C2G;
          v4u o; PACK8(v, o); *(GAS v4u*)(WSP(bf16, WS_QG) + (size_t)m * 512 + 8 * lane) = o; }
        { const v4u w = wb; float v[8]; UNPACK8(w, v);
          float ss = 0.f;
#pragma unroll
          for (int i = 0; i < 8; ++i) ss += v[i] * v[i];
          ss += __shfl_xor(ss, 1); ss += __shfl_xor(ss, 2); ss += __shfl_xor(ss, 4);
          const float ss8 = ss;
          ss += __shfl_xor(ss, 8); ss += __shfl_xor(ss, 16);
          if (lane < 16) {
              const float rstd = __builtin_amdgcn_rsqf(ss8 * (1.f / 64.f) + EPS);
#pragma unroll
              for (int i = 0; i < 8; ++i) v[i] = v[i] * rstd * gkv[i];
              rope4(v, tabg + ((size_t)s * 32 + 4 * (lane & 7)) * 2);
              v4u o; PACK8(v, o); *(GAS v4u*)(WSP(bf16, WS_KG) + (size_t)m * 128 + 8 * lane) = o;
          } else if (lane < 32) {
              *(GAS v4u*)(WSP(bf16, WS_VG) + (size_t)m * 128 + 8 * (lane - 16)) = w;
          } else {
              const float rstd = __builtin_amdgcn_rsqf(ss * (1.f / 256.f) + EPS);
#pragma unroll
              for (int i = 0; i < 8; ++i) v[i] *= rstd;
              v4u o; PACK8(v, o); *(GAS v4u*)(WSP(bf16, WS_LAT) + (size_t)m * 512 + 8 * (lane - 32)) = o;
          } }
        { const v4u w = wc;
          float v[8]; UNPACK8(w, v);
          float ss = 0.f;
#pragma unroll
          for (int i = 0; i < 8; ++i) ss += v[i] * v[i];
          ss += __shfl_xor(ss, 1); ss += __shfl_xor(ss, 2); ss += __shfl_xor(ss, 4); ss += __shfl_xor(ss, 8);
          if (lane < 16) {
              const float rstd = __builtin_amdgcn_rsqf(ss * (1.f / 128.f) + EPS);
#pragma unroll
              for (int i = 0; i < 8; ++i) v[i] *= rstd;
              v4u o; PACK8(v, o); *(GAS v4u*)(WSP(bf16, WS_LAT) + (size_t)m * 512 + 256 + 8 * lane) = o;
          } else if (lane < 20) {
              rope4(v, tabm + ((size_t)s * 16 + 4 * (lane - 16)) * 2);
              v4u o; PACK8(v, o); *(GAS v4u*)(WSP(bf16, WS_KROPE) + (size_t)m * 32 + 8 * (lane - 16)) = o;
          } else if (lane < 36) {
              *(GAS v4u*)(WSP(bf16, WS_LAT) + (size_t)m * 512 + 384 + 8 * (lane - 20)) = (v4u){0u, 0u, 0u, 0u};
          } }
    }
}

__device__ __forceinline__ void phase_outnorm(const Ctx& F) {
    int lane_ = F.lane; asm volatile("" : "+v"(lane_)); const int lane = lane_;
    for (int m = F.gw; m < MTOK; m += F.NGW) {
        bf16* orow = WSP(bf16, WS_O) + (size_t)m * DM;
#pragma unroll
        for (int g = 0; g < 2; ++g) {
            v4u w = *(const GAS v4u*)(orow + g * 512 + 8 * lane); float v[8]; UNPACK8(w, v);
            float ss = 0.f;
#pragma unroll
            for (int i = 0; i < 8; ++i) ss += v[i] * v[i];
            const float rstd = __builtin_amdgcn_rsqf(wave_sum(ss) * (1.f / 512.f) + EPS);
#pragma unroll
            for (int i = 0; i < 8; ++i) v[i] *= rstd;
            v4u o; PACK8(v, o); *(GAS v4u*)(orow + g * 512 + 8 * lane) = o;
        }
    }
}

__device__ __forceinline__ void phase_router(const Ctx& F, int l) {
    int lane_ = F.lane; asm volatile("" : "+v"(lane_)); const int lane = lane_;
    int tid_ = F.tid; asm volatile("" : "+v"(tid_)); const int tid = tid_;
    typedef short rbf16x8 __attribute__((ext_vector_type(8)));
    const int NB = MTOK / 16, tok = lane & 15, kq = lane >> 4;
    int tb = F.gw;
    v4u xf[32];
#define RT_LOAD() do { const GAS v4u* xr_ = (const GAS v4u*)(F.x + ((size_t)tb * 16 + tok) * DM) + kq; _Pragma("unroll") for (int s_ = 0; s_ < 32; ++s_) xf[s_] = xr_[4 * s_]; } while (0)
    if (tb < NB) RT_LOAD();
    {
        const GAS f32x4* src = (const GAS f32x4*)(WSP(float, WS_WR) + (size_t)l * NEXP * DM);
        for (int it = tid; it < NEXP * DM / 8; it += NWAVES * 64) { const int e = it & 15, k8 = it >> 4;
            const f32x4 a = src[(e * DM + 8 * k8) / 4], b = src[(e * DM + 8 * k8) / 4 + 1];
            v4u hi, lo; hi.x = pk2(a.x, a.y); hi.y = pk2(a.z, a.w); hi.z = pk2(b.x, b.y); hi.w = pk2(b.z, b.w);
            lo.x = pk2(a.x - bflo(hi.x), a.y - bfhi(hi.x)); lo.y = pk2(a.z - bflo(hi.y), a.w - bfhi(hi.y)); lo.z = pk2(b.x - bflo(hi.z), b.y - bfhi(hi.z)); lo.w = pk2(b.z - bflo(hi.w), b.w - bfhi(hi.w));
            const int s = k8 >> 2, ln = (k8 & 3) * 16 + e;
            *(LAS v4u*)(F.lds + ((s * 2 + 0) * 64 + ln) * 16) = hi; *(LAS v4u*)(F.lds + ((s * 2 + 1) * 64 + ln) * 16) = lo; }
    }
    __syncthreads();
    while (tb < NB) {
        asm volatile("" ::: "memory");
        f32x4 ah = {0.f, 0.f, 0.f, 0.f}, al = {0.f, 0.f, 0.f, 0.f}; float ss0 = 0.f, ss1 = 0.f;
#pragma unroll
        for (int s = 0; s < 32; ++s) {
            const rbf16x8 wh = *(const LAS rbf16x8*)(F.lds + ((s * 2 + 0) * 64 + lane) * 16), wl = *(const LAS rbf16x8*)(F.lds + ((s * 2 + 1) * 64 + lane) * 16);
            const rbf16x8 xb = __builtin_bit_cast(rbf16x8, xf[s]);
            ah = __builtin_amdgcn_mfma_f32_16x16x32_bf16(wh, xb, ah, 0, 0, 0);
            al = __builtin_amdgcn_mfma_f32_16x16x32_bf16(wl, xb, al, 0, 0, 0);
            const v4u q = xf[s];
            ss0 += (bflo(q.x) * bflo(q.x) + bfhi(q.x) * bfhi(q.x)) + (bflo(q.y) * bflo(q.y) + bfhi(q.y) * bfhi(q.y));
            ss1 += (bflo(q.z) * bflo(q.z) + bfhi(q.z) * bfhi(q.z)) + (bflo(q.w) * bflo(q.w) + bfhi(q.w) * bfhi(q.w));
        }
        float ss = ss0 + ss1; ss += __shfl_xor(ss, 16); ss += __shfl_xor(ss, 32);
        const float rstd = __builtin_amdgcn_rsqf(ss * (1.f / DM) + EPS);
        const int row = tb * 16 + tok;
        if (lane < 16) WSP(float, WS_RS3)[row] = rstd;
        f32x4 lg = (ah + al) * rstd;
        float mx = fmaxf(fmaxf(lg.x, lg.y), fmaxf(lg.z, lg.w)); mx = fmaxf(mx, __shfl_xor(mx, 16)); mx = fmaxf(mx, __shfl_xor(mx, 32));
        f32x4 ex = {__expf(lg.x - mx), __expf(lg.y - mx), __expf(lg.z - mx), __expf(lg.w - mx)};
        float den = (ex.x + ex.y) + (ex.z + ex.w); den += __shfl_xor(den, 16); den += __shfl_xor(den, 32);
        ex = {ex.x / den, ex.y / den, ex.z / den, ex.w / den};
        *(f32x4*)(WSP(float, WS_AFF) + (size_t)row * 16 + 4 * kq) = ex;
        float* at = WSP(float, WS_AFFT) + ((size_t)(row >> 12) * 16 + 4 * kq) * SEQ + (row & (SEQ - 1));
        at[0] = ex.x; at[SEQ] = ex.y; at[2 * SEQ] = ex.z; at[3 * SEQ] = ex.w;
        tb += F.NGW; if (tb < NB) RT_LOAD();
    }
#undef RT_LOAD
    __syncthreads();
}

__device__ __forceinline__ int block_excl_scan(int v, LAS int* red, int lane, int wave, int& total) {
    int inc = v;
#pragma unroll
    for (int o = 1; o < 64; o <<= 1) { const int t = __shfl_up(inc, o); if (lane >= o) inc += t; }
    __syncthreads();
    if (lane == 63) red[wave] = inc;
    __syncthreads();
    int base = 0, tot = 0;
#pragma unroll
    for (int w = 0; w < 8; ++w) { const int t = red[w]; if (w < wave) base += t; tot += t; }
    total = tot;
    return base + inc - v;
}
__device__ __forceinline__ void phase_select(const Ctx& F, const Args& A, int l) {
    LAS int* red = (LAS int*)F.lds;
    int tid_ = F.tid; asm volatile("" : "+v"(tid_)); const int tid = tid_, lane = tid & 63, wave = F.wave;
    for (int pair = F.vcu; pair < BATCH * NEXP; pair += F.G) {
        const int b = pair >> 4, e = pair & 15;
        const GAS v4u* src = (const GAS v4u*)(WSP(float, WS_AFFT) + (size_t)pair * SEQ) + 2 * tid;
        const v4u w0 = src[0], w1 = src[1];
        unsigned v[8] = {w0.x, w0.y, w0.z, w0.w, w1.x, w1.y, w1.z, w1.w};
        unsigned T = 0u; int par = 0;
        for (int bit = 30; bit >= 0; --bit) {
            const unsigned cand = T | (1u << bit);
            int c = 0;
#pragma unroll
            for (int i = 0; i < 8; ++i) c += (v[i] >= cand) ? 1 : 0;
            c = wave_sum_i(c);
            if (lane == 0) red[par * 8 + wave] = c;
            __syncthreads();
            int tot = 0;
#pragma unroll
            for (int w = 0; w < 8; ++w) tot += red[par * 8 + w];
            if (tot >= CAP) T = cand;
            par ^= 1;
        }
        int cgt = 0, ceq = 0;
#pragma unroll
        for (int i = 0; i < 8; ++i) { cgt += (v[i] > T) ? 1 : 0; ceq += (v[i] == T) ? 1 : 0; }
        int ngt, neq_tot;
        (void)block_excl_scan(cgt, red + 16, lane, wave, ngt);
        int eqb = block_excl_scan(ceq, red + 16, lane, wave, neq_tot);
        const int need_eq = CAP - ngt;
        int sel[8], csel = 0;
#pragma unroll
        for (int i = 0; i < 8; ++i) { const bool iseq = (v[i] == T); sel[i] = ((v[i] > T) || (iseq && eqb < need_eq)) ? 1 : 0; eqb += iseq ? 1 : 0; csel += sel[i]; }
        int nsel;
        int pos = block_excl_scan(csel, red + 16, lane, wave, nsel);
        int* idx = WSP(int, WS_IDX) + (size_t)(e * BATCH + b) * CAP; float* rg = WSP(float, WS_RG) + (size_t)(e * BATCH + b) * CAP; const float* rs3 = WSP(float, WS_RS3) + (size_t)b * SEQ;
        int* slot = WSP(int, WS_SLOT) + ((size_t)b * SEQ + (size_t)tid * 8) * NEXP + e;
#pragma unroll
        for (int i = 0; i < 8; ++i) { if (sel[i]) { if (pos < CAP) { idx[pos] = tid * 8 + i; rg[pos] = rs3[tid * 8 + i]; } slot[i * NEXP] = pos; ++pos; } else slot[i * NEXP] = -1; }
        __syncthreads();
    }
    if (l + 1 < DEPTH) {
        const bool split = F.G > BATCH * NEXP; const int nw = split ? (F.G - BATCH * NEXP) * NWAVES : F.NGW, wi = split ? (F.vcu - BATCH * NEXP) * NWAVES + F.wave : F.gw;
        LAS float* scr = (LAS float*)(F.lds + F.wave * 16640);
        if (wi >= 0) for (int it = wi; it < MOE_ITEMS; it += nw) moe_weight_item(F, A, l + 1, it, scr);
    }
}

__device__ __forceinline__ void phase_gather(const Ctx& F) {
    int lane_ = F.lane; asm volatile("" : "+v"(lane_)); const int lane = lane_;
    for (int r = F.gw; r < MOE_ROWS; r += F.NGW) {
        const int b = (r >> 9) & 7; const int t = WSP(int, WS_IDX)[r];
        const GAS v4u* src = (const GAS v4u*)(WSP(bf16, WS_H) + ((size_t)b * SEQ + t) * DM) + lane;
        GAS v4u* dst = (GAS v4u*)(WSP(bf16, WS_XG) + (size_t)r * DM) + lane;
        const v4u a = src[0], c = src[64]; dst[0] = a; dst[64] = c;
    }
}

__device__ __forceinline__ void phase_combine(const Ctx& F, const Args& A, int l, float amul) {
    int lane_ = F.lane; asm volatile("" : "+v"(lane_)); const int lane = lane_; const bool lastl = (l == DEPTH - 1);
    const float* gfin = WSP(float, WS_GAINS) + 512;
    v4u xa_n = (v4u){0u, 0u, 0u, 0u}, xc_n = xa_n; int sl_n = -1; float af_n = 0.f;
    if (F.gw < MTOK) { const GAS v4u* xp = (const GAS v4u*)(F.x + (size_t)F.gw * DM) + lane; xa_n = xp[0]; xc_n = xp[64];
        sl_n = WSP(int, WS_SLOT)[(size_t)F.gw * NEXP + (lane & 15)]; af_n = WSP(float, WS_AFF)[(size_t)F.gw * NEXP + (lane & 15)]; }
    for (int m = F.gw; m < MTOK; m += F.NGW) {
        const int b = m >> 12;
        GAS v4u* xr = (GAS v4u*)(F.x + (size_t)m * DM) + lane;
        const v4u xa = xa_n, xc = xc_n; const int sl = sl_n; const float af = amul * af_n;
        if (m + F.NGW < MTOK) { const int mn = m + F.NGW; const GAS v4u* xp = (const GAS v4u*)(F.x + (size_t)mn * DM) + lane; xa_n = xp[0]; xc_n = xp[64];
            sl_n = WSP(int, WS_SLOT)[(size_t)mn * NEXP + (lane & 15)]; af_n = WSP(float, WS_AFF)[(size_t)mn * NEXP + (lane & 15)]; }
        f32x4 x0 = (f32x4){bflo(xa.x), bfhi(xa.x), bflo(xa.y), bfhi(xa.y)}, x1 = (f32x4){bflo(xa.z), bfhi(xa.z), bflo(xa.w), bfhi(xa.w)};
        f32x4 x2 = (f32x4){bflo(xc.x), bfhi(xc.x), bflo(xc.y), bfhi(xc.y)}, x3 = (f32x4){bflo(xc.z), bfhi(xc.z), bflo(xc.w), bfhi(xc.w)};
        unsigned mask = (unsigned)(__ballot(sl >= 0 && lane < 16));
#define CMB_ACC(Y0, Y1, AE) do { x0.x += AE * bflo(Y0.x); x0.y += AE * bfhi(Y0.x); x0.z += AE * bflo(Y0.y); x0.w += AE * bfhi(Y0.y); \
            x1.x += AE * bflo(Y0.z); x1.y += AE * bfhi(Y0.z); x1.z += AE * bflo(Y0.w); x1.w += AE * bfhi(Y0.w); \
            x2.x += AE * bflo(Y1.x); x2.y += AE * bfhi(Y1.x); x2.z += AE * bflo(Y1.y); x2.w += AE * bfhi(Y1.y); \
            x3.x += AE * bflo(Y1.z); x3.y += AE * bfhi(Y1.z); x3.z += AE * bflo(Y1.w); x3.w += AE * bfhi(Y1.w); } while (0)
        while (mask) {
            const int e1 = __builtin_ctz(mask); mask &= mask - 1u;
            const bool two = mask != 0u; const int e2 = two ? __builtin_ctz(mask) : e1; if (two) mask &= mask - 1u;
            const int s1 = __shfl(sl, e1), s2 = __shfl(sl, e2); const float a1 = __shfl(af, e1), a2 = two ? __shfl(af, e2) : 0.f;
            const GAS v4u* yr1 = (const GAS v4u*)(WSP(bf16, WS_Y) + ((size_t)(e1 * BATCH + b) * CAP + s1) * DM) + lane;
            const GAS v4u* yr2 = (const GAS v4u*)(WSP(bf16, WS_Y) + ((size_t)(e2 * BATCH + b) * CAP + s2) * DM) + lane;
            const v4u y0 = yr1[0], y1 = yr1[64], z0 = yr2[0], z1 = yr2[64];
            CMB_ACC(y0, y1, a1); CMB_ACC(z0, z1, a2);
        }
#undef CMB_ACC
        float s = (x0.x * x0.x + x0.y * x0.y) + (x0.z * x0.z + x0.w * x0.w) + (x1.x * x1.x + x1.y * x1.y) + (x1.z * x1.z + x1.w * x1.w)
                + (x2.x * x2.x + x2.y * x2.y) + (x2.z * x2.z + x2.w * x2.w) + (x3.x * x3.x + x3.y * x3.y) + (x3.z * x3.z + x3.w * x3.w);
        const float rstd = __builtin_amdgcn_rsqf(wave_sum(s) * (1.f / DM) + EPS);
        if (lastl) {
            const f32x4 g0 = *(const f32x4*)(gfin + 8 * lane), g1 = *(const f32x4*)(gfin + 8 * lane + 4), g2 = *(const f32x4*)(gfin + 512 + 8 * lane), g3 = *(const f32x4*)(gfin + 512 + 8 * lane + 4);
            GAS f32x4* ow = (GAS f32x4*)(F.out + (size_t)m * DM);
            ow[2 * lane] = x0 * rstd * g0; ow[2 * lane + 1] = x1 * rstd * g1; ow[128 + 2 * lane] = x2 * rstd * g2; ow[128 + 2 * lane + 1] = x3 * rstd * g3;
        } else {
            v4u n0, n1; n0.x = pk2(x0.x, x0.y); n0.y = pk2(x0.z, x0.w); n0.z = pk2(x1.x, x1.y); n0.w = pk2(x1.z, x1.w); n1.x = pk2(x2.x, x2.y); n1.y = pk2(x2.z, x2.w); n1.z = pk2(x3.x, x3.y); n1.w = pk2(x3.z, x3.w);
            xr[0] = n0; xr[64] = n1;
            if (lane == 0) WSP(float, WS_RS1)[m] = rstd;
        }
    }
}

__device__ __forceinline__ void phase_attn_self(const Ctx& F, int l) {
    float gmq = fabsf(WSP(float, WS_GAINS)[l * 64 + F.lane]), gmk = fabsf(WSP(float, WS_GAINS)[256 + l * 64 + F.lane]);
#pragma unroll
    for (int o = 1; o < 64; o <<= 1) { gmq = fmaxf(gmq, __shfl_xor(gmq, o)); gmk = fmaxf(gmk, __shfl_xor(gmk, o)); }
    const bool bounded = (8.0f * LOG2E * gmq * gmk) < 64.0f;
    const int lane = F.lane, r32 = lane & 31, hi = lane >> 5, wid = F.wave;
#ifndef DUPATT
#define DUPATT 0
#endif
    for (int g = 0; g < 2; ++g)
      for (int rep2_ = 0; rep2_ < 1 + ((DUPATT >> g) & 1); ++rep2_)
        for (int u = F.vcu; u < 256; u += F.G) {
            const int b = u >> 5, qb = (u >> 1) & 15, hh = u & 1;
            const size_t r0 = (size_t)b * SEQ, q0 = r0 + (size_t)qb * 256;
            float ssacc[16];
#pragma unroll
            for (int r = 0; r < 16; ++r) ssacc[r] = 0.f;
            if (g == 0 && bounded) {
                float* sslds = (float*)(F.ldsg + att::AttnCfg<64, 0, 64>::LDS_BYTES) + F.tid;
#pragma unroll
                for (int r = 0; r < 16; ++r) sslds[r * 512] = 0.f;
                for (int hq = 0; hq < 4; hq += 2) { const int h = hh * 4 + hq;
                    att::attn_unit_2h<true>(WSP(bf16, WS_QG) + q0 * 512 + h * 64, WSP(bf16, WS_QG) + q0 * 512 + (h + 1) * 64, 512, WSP(bf16, WS_KG) + r0 * 128 + hh * 64, 128,
                                            WSP(bf16, WS_VG) + r0 * 128 + hh * 64, 128, WSP(bf16, WS_O) + q0 * DM + h * 64, WSP(bf16, WS_O) + q0 * DM + (h + 1) * 64, DM, SEQ, F.ldsg, sslds); }
#pragma unroll
                for (int r = 0; r < 16; ++r) ssacc[r] = sslds[r * 512];
            } else
            for (int hq = 0; hq < 4; ++hq) {
                const int h = hh * 4 + hq;
                if (g == 0) {
                    att::attn_unit<64, 0, 64, 0, true>(WSP(bf16, WS_QG) + q0 * 512 + h * 64, nullptr, 512, WSP(bf16, WS_KG) + r0 * 128 + hh * 64, 128, nullptr, 0,
                                              WSP(bf16, WS_VG) + r0 * 128 + hh * 64, 128, WSP(bf16, WS_O) + q0 * DM + h * 64, DM, SEQ, F.ldsg, ssacc);
                } else {
                    att::attn_unit<64, 32, 64, 0, true>(WSP(bf16, WS_QM) + q0 * 768 + h * 64, WSP(bf16, WS_QM) + q0 * 768 + 512 + h * 32, 768, WSP(bf16, WS_KVM) + r0 * DM + h * 128, DM, WSP(bf16, WS_KROPE) + r0 * 32, 32,
                                               WSP(bf16, WS_KVM) + r0 * DM + h * 128 + 64, DM, WSP(bf16, WS_O) + q0 * DM + 512 + h * 64, DM, SEQ, F.ldsg, ssacc);
                }
            }
#pragma unroll
            for (int r = 0; r < 16; ++r) { float s = ssacc[r];
                s += __shfl_xor(s, 1); s += __shfl_xor(s, 2); s += __shfl_xor(s, 4); s += __shfl_xor(s, 8); s += __shfl_xor(s, 16);
                if (r32 == 0) WSP(float, WS_SSO)[(q0 + wid * 32 + att::crow(r, hi)) * 4 + g * 2 + hh] = s; }
        }
}
__device__ __forceinline__ void phase_attn_mem(const Ctx& F, int l) {
    const bf16* kv = WSP(bf16, WS_MEMKV) + (size_t)l * MROWS * DM; float dummy[16];
    for (int idx = F.vcu; idx < 256; idx += F.G) {
        const int pm = idx >> 1, pn = idx & 1, b = pm >> 4;
        const size_t q0 = (size_t)pm * 256, k0 = (size_t)b * MEM_T;
        for (int hh = 0; hh < 2; ++hh) { const int h = 2 * pn + hh;
            att::attn_mem_unit(WSP(bf16, WS_QMEM) + q0 * 512 + h * 128, 512, kv + k0 * DM + h * 128, DM, kv + k0 * DM + 512 + h * 128, DM, WSP(bf16, WS_OMEM) + q0 * 512 + h * 128, 512, F.ldsg); }
    }
}

__global__ void __launch_bounds__(NWAVES * 64, 2) enc_fwd(Args args) {
    extern __shared__ __attribute__((aligned(16))) unsigned char lds[];
    Ctx F;
    F.lds = (LAS unsigned char*)lds; F.ldsg = (char*)lds;
    F.tid = threadIdx.x; F.lane = F.tid & 63; F.wave = __builtin_amdgcn_readfirstlane(F.tid >> 6);
    F.G = gridDim.x; F.G0 = F.G; { const int bx = blockIdx.x; F.vcu0 = (F.G % 8 == 0) ? (bx % 8) * (F.G / 8) + bx / 8 : bx; F.vcu = F.vcu0; }
    F.gw = F.vcu * NWAVES + F.wave; F.NGW = F.G * NWAVES;
    F.out = args.out; F.ws = args.ws; F.x = (bf16*)(args.ws + WS_X);
    volatile LAS unsigned* MISC = (volatile LAS unsigned*)(F.lds + MISC_OFF);
    for (int u = F.tid; u < (LDS_BYTES - LDSCTL_OFF) / 4; u += NWAVES * 64) ((LAS unsigned*)(F.lds + LDSCTL_OFF))[u] = 0u;
    __syncthreads();
    XcdBarrier bar; bar.bar = (unsigned*)(F.ws + WS_CTL) + CW_BAR; bar.x = 0; bar.st = nullptr;
    if (MK_N_LAUNCHES == 1) bar = xcd_barrier_post((unsigned*)(F.ws + WS_CTL) + CW_BAR, MISC + 8);
    const int lo = args.ph_lo, hi = args.ph_hi;
#ifndef ONLY_SITE
#define ONLY_SITE -1
#endif
#define ON(s) (ONLY_SITE < 0 || ONLY_SITE == (s))
#ifndef DUPMASK
#define DUPMASK 0u
#endif
#define REP(s) for (int rep_ = 0; rep_ < 1 + (int)((DUPMASK >> (s)) & 1u); ++rep_)
#define IN(k) (lo <= (k) && (k) < hi)
#define SEAM(k) do { if (IN(k) && IN((k) + 1)) xcd_barrier(bar); } while (0)
#define LOCAL_SEAM() do { asm volatile("s_waitcnt vmcnt(0)" ::: "memory"); __syncthreads(); __builtin_amdgcn_fence(__ATOMIC_ACQUIRE, "agent"); asm volatile("s_waitcnt vmcnt(0)" ::: "memory"); __syncthreads(); } while (0)
#define GEMM(EpiT, epi, Ap, lda_, Bp, ldb_, K_, nM_, nN_, gdiv_, gstride_) do { const pg8::Gemm g_{(const bf16*)(Ap), (const bf16*)(Bp), lda_, ldb_, K_, gdiv_, 1 << 30, (size_t)(gstride_), nullptr, nullptr}; \
        pg8::StaticOrder S_; S_.init(nM_, nN_, F.G, (int)blockIdx.x); pg8::gemm_phase<EpiT, pg8::StaticOrder, true>(F.lds, g_, S_, epi); } while (0)

    #ifndef PRODUP
#define PRODUP 0
#endif
    if (ON(100) && IN(0)) for (int rp_ = 0; rp_ <= PRODUP; ++rp_) { refresh(F); phase_prologue(F, args); }
    SEAM(0);
    if (ON(101) && IN(1)) {
        pg8::EpiBf16 E{WSP(bf16, WS_MEMKV), DM, 1.0f, nullptr, nullptr, 0.f, 0.f};
        const pg8::Gemm g_{WSP(bf16, WS_MEMN), WSP(bf16, WS_WSMALL + OFF_WMKV), DM, DM, DM, MROWS / 256, MROWS / 256, (size_t)(WSMALL_STRIDE / 2), nullptr, nullptr};
        pg8::StaticOrder S_; S_.init(DEPTH * MROWS / 256, DM / 256, F.G, (int)blockIdx.x); pg8::gemm_phase<pg8::EpiBf16, pg8::StaticOrder, true>(F.lds, g_, S_, E); }
    SEAM(1);
    for (int l = 0; l < DEPTH; ++l) {
        const int pb = 2 + 16 * l;
        unsigned char* wl = F.ws + WS_WSMALL + (size_t)l * WSMALL_STRIDE;
        if (ON(0) && IN(pb + 0)) REP(0) if (refresh(F), true) {
            int bxs = (int)blockIdx.x; asm volatile("" : "+s"(bxs));
            pg8::EpiInProj E{WSP(float, WS_RS1), WSP(float, WS_GAINS) + l * 64, WSP(float, WS_GAINS) + 256 + l * 64, WSP(float, WS_TABG), WSP(float, WS_TABM),
                             WSP(bf16, WS_QG), WSP(bf16, WS_KG), WSP(bf16, WS_VG), WSP(bf16, WS_LAT), WSP(bf16, WS_KROPE), WSP(float, WS_SSL), 0.125f * LOG2E, EPS};
            const pg8::Gemm g_{(const bf16*)F.x, (const bf16*)(wl + OFF_WIN), DM, DM, DM, 1, 1 << 30, 0, nullptr, nullptr};
            typedef pg8::SplitOrder<2, 3, 0, 0> SO; SO S_; S_.init(MTOK / 256, F.G, bxs); pg8::gemm_phase<pg8::EpiInProj, SO, true>(F.lds, g_, S_, E); }
        SEAM(pb + 0);
        if ((ON(2) || ON(16) || ON(17)) && IN(pb + 2)) REP(2) { refresh(F);
            int bxs = (int)blockIdx.x; asm volatile("" : "+s"(bxs)); const int bxo = (F.G == 256) ? (bxs ^ 128) : bxs;
            if (ON(2)) {
                pg8::EpiInProj E{WSP(float, WS_RS1), WSP(float, WS_GAINS) + l * 64, WSP(float, WS_GAINS) + 256 + l * 64, WSP(float, WS_TABG), WSP(float, WS_TABM),
                                 WSP(bf16, WS_QG), WSP(bf16, WS_KG), WSP(bf16, WS_VG), WSP(bf16, WS_LAT), WSP(bf16, WS_KROPE), WSP(float, WS_SSL), 0.125f * LOG2E, EPS};
                const pg8::Gemm g_{(const bf16*)F.x, (const bf16*)(wl + OFF_WIN), DM, DM, DM, 1, 1 << 30, 0, nullptr, nullptr};
                typedef pg8::SplitOrder<3, 0, 2, 1> SO; SO S_; S_.init(MTOK / 256, F.G, bxs); pg8::gemm_phase<pg8::EpiInProj, SO, true>(F.lds, g_, S_, E); }
            if (ON(2) || ON(17)) { pg8::EpiQmRope E{WSP(bf16, WS_QM), 768, 0.10206207261596577f * LOG2E, WSP(float, WS_TABM), WSP(float, WS_SSL), 1.0f / 256.0f, EPS};
                const pg8::Gemm g_{WSP(bf16, WS_LAT), (const bf16*)(wl + OFF_WQB), 512, 256, 256, 1, 1 << 30, 0, nullptr, nullptr};
                typedef pg8::SplitOrder<3, 0, 2, 1> SO; SO S_; S_.init(MTOK / 256, F.G, bxo); pg8::gemm_phase<pg8::EpiQmRope, SO, true>(F.lds, g_, S_, E); }
            if (ON(2) || ON(16)) { pg8::EpiBf16 E{WSP(bf16, WS_KVM), DM, 1.0f, nullptr, WSP(float, WS_SSL) + 4, 1.0f / 128.0f, EPS};
                const pg8::Gemm g_{WSP(bf16, WS_LAT) + 256, (const bf16*)(wl + OFF_WKVB), 512, 128, 128, 1, 1 << 30, 0, nullptr, nullptr};
                typedef pg8::SplitOrder<4, 0, 3, 1> SO; SO S_; S_.init(MTOK / 256, F.G, bxo); pg8::gemm_phase<pg8::EpiBf16, SO, true>(F.lds, g_, S_, E); } }
        SEAM(pb + 2);
        if (ON(3) && IN(pb + 3)) REP(3) if (refresh(F), true) phase_attn_self(F, l);
        SEAM(pb + 3);
        if (ON(5) && IN(pb + 5)) REP(5) if (refresh(F), true) {
            pg8::EpiResidualX E{F.x, WSP(float, WS_SSX), DM, 1.0f / 512.0f, EPS, rep_ ? 0.f : 1.f};
            const pg8::Gemm g_{WSP(bf16, WS_O), (const bf16*)(wl + OFF_WO), DM, DM, DM, 1, 1 << 30, 0, nullptr, WSP(float, WS_SSO)};
            pg8::StaticOrder S_; S_.init(MTOK / 256, 4, F.G, (int)blockIdx.x); pg8::gemm_phase<pg8::EpiResidualX, pg8::StaticOrder, true, false, true>(F.lds, g_, S_, E, F.lds + STAB_OFF, 1.0f / 512.0f, EPS); }
        SEAM(pb + 5);
        if (ON(7) && IN(pb + 7)) REP(7) if (refresh(F), true) { pg8::EpiBf16RowNorm E{WSP(bf16, WS_QMEM), 512, 0.08838834764831845f * LOG2E, WSP(float, WS_SSX), 1.0f / DM, EPS}; GEMM(pg8::EpiBf16RowNorm, E, F.x, DM, wl + OFF_WMQ, DM, DM, MTOK / 256, 2, 1, 0); }
        SEAM(pb + 7);
        if (ON(8) && IN(pb + 8)) REP(8) if (refresh(F), true) phase_attn_mem(F, l);
        SEAM(pb + 8);
        if (ON(9) && IN(pb + 9)) REP(9) if (refresh(F), true) { pg8::EpiResidual E{F.x, DM, rep_ ? 0.f : 1.f}; GEMM(pg8::EpiResidual, E, WSP(bf16, WS_OMEM), 512, wl + OFF_WMO, 512, 512, MTOK / 256, 4, 1, 0); }
        SEAM(pb + 9);
        if (ON(10) && IN(pb + 10)) REP(10) if (refresh(F), true) phase_router(F, l);
        SEAM(pb + 10);
        if (ON(11) && IN(pb + 11)) REP(11) if (refresh(F), true) phase_select(F, args, l);
        SEAM(pb + 11);
        if (ON(13) && IN(pb + 13)) REP(13) if (refresh(F), true) { pg8::EpiSwiGLU E{WSP(bf16, WS_ACT), EFF, WSP(float, WS_RG)};
            const pg8::Gemm g_{F.x, WSP(bf16, (l & 1) ? WS_WGU2 : WS_WGU), DM, DM, DM, 16, 1 << 30, (size_t)(1024 * 1024), WSP(int, WS_IDX), nullptr};
            pg8::StaticOrder S_; S_.init(MOE_ROWS / 256, 4, F.G, (int)blockIdx.x); pg8::gemm_phase<pg8::EpiSwiGLU, pg8::StaticOrder, true, true>(F.lds, g_, S_, E, F.lds + GTAB_OFF); }
        SEAM(pb + 13);
        if (ON(14) && IN(pb + 14)) REP(14) if (refresh(F), true) { pg8::EpiBf16 E{WSP(bf16, WS_Y), DM, 1.0f, nullptr, nullptr, 0.f, 0.f}; GEMM(pg8::EpiBf16, E, WSP(bf16, WS_ACT), EFF, WSP(bf16, (l & 1) ? WS_WD2 : WS_WD), EFF, EFF, MOE_ROWS / 256, 4, 16, 1024 * 512); }
        SEAM(pb + 14);
        if (ON(15) && IN(pb + 15)) REP(15) if (refresh(F), true) phase_combine(F, args, l, (rep_ && l < DEPTH - 1) ? 0.f : 1.f);
        SEAM(pb + 15);
    }
#undef IN
#undef SEAM
#undef GEMM
}

extern "C" void kernel_launch(void* const* d_in, const int* in_sizes, int n_in, void* d_out, int out_size, void* d_ws, size_t ws_size, hipStream_t stream) {
    static int grid = 0;
    if (grid == 0) {
        if (n_in != 24 || out_size != MTOK * DM || ws_size < WS_END) { fprintf(stderr, "kernel_launch: unexpected shapes: n_in %d out %d ws %zu (need %zu)\n", n_in, out_size, ws_size, (size_t)WS_END); grid = -1; return; }
        int dev = 0, cus = 0, per_cu = 0;
        if (hipGetDevice(&dev) != hipSuccess || hipDeviceGetAttribute(&cus, hipDeviceAttributeMultiprocessorCount, dev) != hipSuccess) { grid = -1; return; }
        if (hipFuncSetAttribute((const void*)enc_fwd, hipFuncAttributeMaxDynamicSharedMemorySize, LDS_BYTES) != hipSuccess) { fprintf(stderr, "kernel_launch: hipFuncSetAttribute failed\n"); grid = -1; return; }
        if (hipOccupancyMaxActiveBlocksPerMultiprocessor(&per_cu, (const void*)enc_fwd, NWAVES * 64, LDS_BYTES) != hipSuccess || per_cu < 1)
            fprintf(stderr, "kernel_launch: occupancy query reports %d workgroups per CU\n", per_cu);
        (void)hipGetLastError();
        grid = cus;
        fprintf(stderr, "kernel_launch: grid %d, ws %zu bytes\n", grid, ws_size);
    }
    if (grid < 0) return;
    (void)hipMemsetAsync((char*)d_ws + WS_CTL, 0, CTL_ZERO_BYTES, stream);
    Args a{};
    for (int i = 0; i < 24; ++i) a.in[i] = (const float*)d_in[i];
    a.out = (float*)d_out; a.ws = (unsigned char*)d_ws;
#if MK_N_LAUNCHES == 1
    a.ph_lo = 0; a.ph_hi = NPH;
    hipLaunchKernelGGL(enc_fwd, dim3(grid), dim3(NWAVES * 64), LDS_BYTES, stream, a);
#else
    for (int p = 0; p < NPH; ++p) { a.ph_lo = p; a.ph_hi = p + 1; hipLaunchKernelGGL(enc_fwd, dim3(grid), dim3(NWAVES * 64), LDS_BYTES, stream, a); }
#endif
    const hipError_t le = hipPeekAtLastError();
    if (le != hipSuccess) fprintf(stderr, "kernel_launch: launch failed: %s\n", hipGetErrorName(le));
}
```

```cpp
#include <hip/hip_runtime.h>
#include <cstdio>
#include <cstdint>

namespace lx {
template <int M> __device__ __forceinline__ float shx(float v) { static_assert(M >= 1 && M < 32, "mask"); return __int_as_float(__builtin_amdgcn_ds_swizzle(__float_as_int(v), (M << 10) | 0x1f)); }
__device__ __forceinline__ float sum32(float v) { auto rr = __builtin_amdgcn_permlane32_swap(__float_as_uint(v), __float_as_uint(v), false, false); return __uint_as_float(rr[0]) + __uint_as_float(rr[1]); }
__device__ __forceinline__ float max16(float v) { v = fmaxf(v, shx<1>(v)); v = fmaxf(v, shx<2>(v)); v = fmaxf(v, shx<4>(v)); return fmaxf(v, shx<8>(v)); }
__device__ __forceinline__ float bound_rows(float v) { v = max16(v); v += shx<16>(v); return sum32(v); }
}
namespace pg8 {
#define PG8_LAS __attribute__((address_space(3)))
typedef unsigned short bf16_t;
typedef short bf16x8 __attribute__((ext_vector_type(8)));
typedef float f32x4 __attribute__((ext_vector_type(4)));
typedef unsigned u32x4 __attribute__((ext_vector_type(4)));
constexpr int BM = 256, BK = 64, HALF = 128, HTB = HALF * BK * 2  , STAGE_BYTES = 8 * HTB, NXCD = 8, WGM = 8;

__host__ __device__ __forceinline__ int lds_byte(int r, int c) { const int st = (r >> 4) * 2 + (c >> 5), rr = r & 15, cc = c & 31, ob = rr * 64 + cc * 2; return st * 1024 + (ob ^ (((ob >> 9) & 1) << 5)); }
__host__ __device__ __forceinline__ void stage_rc(int b, int& R, int& C) { const int st = b / 1024, sb = b % 1024, swz = sb ^ (((sb >> 9) & 1) << 5); R = (st >> 1) * 16 + swz / 64; C = (st & 1) * 32 + (swz % 64) / 2; }
__host__ __device__ __forceinline__ int perm32(int rho) { const int n = rho >> 4, i = rho & 15; return 8 * (i >> 2) + 4 * n + (i & 3); }

struct Unit { int pm, pn; };
struct Gemm { const bf16_t* A; const bf16_t* Bt; int lda, ldb, K, gdiv, amod; size_t gstride; const int* idx; const float* ss; };

struct StaticOrder {
    int nM, nN, nwg, G, c;
    __host__ __device__ void init(int nM_, int nN_, int G_, int c_) { nM = nM_; nN = nN_; nwg = nM * nN; G = G_; c = c_; }
    __host__ __device__ bool next(int i, Unit& u) const {
        const long L = (long)i * G + c; if (L >= nwg) return false;
        int wgid = (int)L; { const int q = nwg / NXCD, r = nwg % NXCD, xcd = wgid % NXCD, off = wgid / NXCD; wgid = (xcd < r ? xcd * (q + 1) : r * (q + 1) + (xcd - r) * q) + off; }
        const int nig = WGM * nN, gid = wgid / nig, fm = gid * WGM, gsz = (nM - fm) < WGM ? (nM - fm) : WGM;
        u.pm = fm + ((wgid % nig) % gsz); u.pn = (wgid % nig) / gsz; return true;
    }
};

template <int NN, int PN0, int KH, int KL> struct SplitOrder {
    int nM, G, c;
    __host__ __device__ void init(int nM_, int G_, int c_) { nM = nM_; G = G_; c = c_; }
    __host__ __device__ bool next(int i, Unit& u) const {
        const int nwg = nM * NN; long L;
        if (KH == 0 || G != 256) L = (long)i * G + c;
        else if (c < 128) { if (i >= KH) return false; L = (long)i * 128 + c; }
        else { if (i >= KL) return false; L = 128L * KH + (long)i * 128 + (c - 128); }
        if (L >= nwg) return false;
        int wgid = (int)L; { const int q = nwg / NXCD, r = nwg % NXCD, xcd = wgid % NXCD, off = wgid / NXCD; wgid = (xcd < r ? xcd * (q + 1) : r * (q + 1) + (xcd - r) * q) + off; }
        const int nig = WGM * NN, gid = wgid / nig, fm = gid * WGM, gsz = (nM - fm) < WGM ? (nM - fm) : WGM;
        u.pm = fm + ((wgid % nig) % gsz); u.pn = PN0 + (wgid % nig) / gsz; return true;
    }
};

struct LinearOrder {
    int nM, nN, G, c, per;
    __host__ __device__ void init(int nM_, int nN_, int G_, int c_, int per_) { nM = nM_; nN = nN_; G = G_; c = c_; per = per_; }
    __host__ __device__ bool next(int i, Unit& u) const { const int idx = (c + (i / per) * G) * per + (i % per); if (idx >= nM * nN) return false; u.pm = idx / nN; u.pn = idx % nN; return true; }
};

__device__ __forceinline__ unsigned cvt_pk_bf16(float lo, float hi) { unsigned r; asm volatile("v_cvt_pk_bf16_f32 %0, %1, %2" : "=v"(r) : "v"(lo), "v"(hi)); return r; }

struct EpiBf16 {
    static constexpr bool PERM = true;
    bf16_t* O; int ldc; float scale; const float* rs; const float* ssl; float ssl_inv, ssl_eps;
    __device__ __forceinline__ void operator()(const f32x4 (&acc)[2][2][4][2], const Unit& u, int wr, int wc, int fr, int fq) const {
        const int row0 = u.pm * BM + wr * 64 + fr, col0 = u.pn * BM + wc * 32 + 8 * fq;
#pragma unroll
        for (int ai = 0; ai < 2; ++ai)
#pragma unroll
            for (int m = 0; m < 4; ++m) { const int row = row0 + ai * HALF + m * 16; bf16_t* rowp = O + (size_t)row * ldc + col0; float sc = rs ? scale * rs[row] : scale;
                if (ssl) { const f32x4 q_ = *(const f32x4*)(ssl + (size_t)row * 8); sc *= __builtin_amdgcn_rsqf(((q_[0] + q_[1]) + (q_[2] + q_[3])) * ssl_inv + ssl_eps); }
#pragma unroll
                for (int bj = 0; bj < 2; ++bj) { const f32x4 v0 = acc[ai][bj][m][0] * sc, v1 = acc[ai][bj][m][1] * sc;
                    u32x4 w; w.x = cvt_pk_bf16(v0[0], v0[1]); w.y = cvt_pk_bf16(v0[2], v0[3]); w.z = cvt_pk_bf16(v1[0], v1[1]); w.w = cvt_pk_bf16(v1[2], v1[3]);
                    *(u32x4*)(rowp + bj * HALF) = w; } }
    }
};
struct EpiBf16Kv {
    static constexpr bool PERM = true;
    bf16_t* O; int ldc; const float* ssl; float ssl_inv, ssl_eps; unsigned* bnd;
    __device__ __forceinline__ void operator()(const f32x4 (&acc)[2][2][4][2], const Unit& u, int wr, int wc, int fr, int fq) const {
        const int row0 = u.pm * BM + wr * 64 + fr, col0 = u.pn * BM + wc * 32 + 8 * fq;
        float mx0 = 0.f, mx1 = 0.f;
#pragma unroll
        for (int ai = 0; ai < 2; ++ai)
#pragma unroll
            for (int m = 0; m < 4; ++m) { const int row = row0 + ai * HALF + m * 16; bf16_t* rowp = O + (size_t)row * ldc + col0;
                const f32x4 q_ = *(const f32x4*)(ssl + (size_t)row * 8); const float sc = __builtin_amdgcn_rsqf(((q_[0] + q_[1]) + (q_[2] + q_[3])) * ssl_inv + ssl_eps);
#pragma unroll
                for (int bj = 0; bj < 2; ++bj) { const f32x4 v0 = acc[ai][bj][m][0] * sc, v1 = acc[ai][bj][m][1] * sc;
                    { const float ss = ((v0[0] * v0[0] + v0[1] * v0[1]) + (v0[2] * v0[2] + v0[3] * v0[3])) + ((v1[0] * v1[0] + v1[1] * v1[1]) + (v1[2] * v1[2] + v1[3] * v1[3])); if (bj == 0) mx0 = fmaxf(mx0, ss); else mx1 = fmaxf(mx1, ss); }
                    u32x4 w; w.x = cvt_pk_bf16(v0[0], v0[1]); w.y = cvt_pk_bf16(v0[2], v0[3]); w.z = cvt_pk_bf16(v1[0], v1[1]); w.w = cvt_pk_bf16(v1[2], v1[3]);
                    *(u32x4*)(rowp + bj * HALF) = w; } }
        mx0 = lx::bound_rows(mx0); mx1 = lx::bound_rows(mx1);
        if (wc < 2 && fr == 0 && fq == 0) {
            unsigned* bb = bnd + (u.pm >> 4) * 64 + (2 * u.pn) * 8 + 3 + wc; atomicMax(bb, __float_as_uint(mx0)); atomicMax(bb + 8, __float_as_uint(mx1)); }
    }
};

struct EpiQmRope {
    static constexpr bool PERM = true;
    bf16_t* O; int ldc; float scale; const float* tab; const float* ssl; float ssl_inv, ssl_eps; unsigned* bnd;
    __device__ __forceinline__ void operator()(const f32x4 (&acc)[2][2][4][2], const Unit& u, int wr, int wc, int fr, int fq) const {
        const int row0 = u.pm * BM + wr * 64 + fr, col0 = u.pn * BM + wc * 32 + 8 * fq;
        const bool rope = (u.pn == 2);
        float mx0 = 0.f, mx1 = 0.f;
        const int j0 = (8 * fq) >> 1;
#pragma unroll
        for (int ai = 0; ai < 2; ++ai)
#pragma unroll
            for (int m = 0; m < 4; ++m) { const int row = row0 + ai * HALF + m * 16; bf16_t* rowp = O + (size_t)row * ldc + col0; const int s = row & 4095;
                const f32x4 q_ = *(const f32x4*)(ssl + (size_t)row * 8); const float sc_ = scale * __builtin_amdgcn_rsqf(((q_[0] + q_[1]) + (q_[2] + q_[3])) * ssl_inv + ssl_eps);
                f32x4 t0 = (f32x4){1.f, 0.f, 1.f, 0.f}, t1 = (f32x4){1.f, 0.f, 1.f, 0.f};
                if (rope) { t0 = *(const f32x4*)(tab + ((size_t)s * 16 + j0) * 2); t1 = *(const f32x4*)(tab + ((size_t)s * 16 + j0 + 2) * 2); }
#pragma unroll
                for (int bj = 0; bj < 2; ++bj) { const f32x4 v0 = acc[ai][bj][m][0], v1 = acc[ai][bj][m][1];
                    f32x4 r0, r1;
                    r0[0] = v0[0] * t0[0] - v0[1] * t0[1]; r0[1] = v0[1] * t0[0] + v0[0] * t0[1];
                    r0[2] = v0[2] * t0[2] - v0[3] * t0[3]; r0[3] = v0[3] * t0[2] + v0[2] * t0[3];
                    r1[0] = v1[0] * t1[0] - v1[1] * t1[1]; r1[1] = v1[1] * t1[0] + v1[0] * t1[1];
                    r1[2] = v1[2] * t1[2] - v1[3] * t1[3]; r1[3] = v1[3] * t1[2] + v1[2] * t1[3];
                    r0 = r0 * sc_; r1 = r1 * sc_;
                    { const float ss = ((r0[0] * r0[0] + r0[1] * r0[1]) + (r0[2] * r0[2] + r0[3] * r0[3])) + ((r1[0] * r1[0] + r1[1] * r1[1]) + (r1[2] * r1[2] + r1[3] * r1[3])); if (bj == 0) mx0 = fmaxf(mx0, ss); else mx1 = fmaxf(mx1, ss); }
                    u32x4 w; w.x = cvt_pk_bf16(r0[0], r0[1]); w.y = cvt_pk_bf16(r0[2], r0[3]); w.z = cvt_pk_bf16(r1[0], r1[1]); w.w = cvt_pk_bf16(r1[2], r1[3]);
                    *(u32x4*)(rowp + bj * HALF) = w; }
                asm volatile("" ::: "memory"); }
        mx0 = lx::bound_rows(mx0); mx1 = lx::bound_rows(mx1);
        if (fr == 0 && fq == 0) {
            unsigned* bb = bnd + (u.pm >> 4) * 64;
            const int h0 = rope ? wc : u.pn * 4 + (wc >> 1), dh = rope ? 4 : 2, sl = rope ? 2 : (wc & 1);
            atomicMax(bb + h0 * 8 + sl, __float_as_uint(mx0)); atomicMax(bb + (h0 + dh) * 8 + sl, __float_as_uint(mx1)); }
    }
};
struct EpiBf16RowNorm {
    static constexpr bool PERM = true;
    bf16_t* O; int ldc; float scale; const float* ss; float inv_n, eps;
    __device__ __forceinline__ void operator()(const f32x4 (&acc)[2][2][4][2], const Unit& u, int wr, int wc, int fr, int fq) const {
        const int row0 = u.pm * BM + wr * 64 + fr, col0 = u.pn * BM + wc * 32 + 8 * fq;
#pragma unroll
        for (int ai = 0; ai < 2; ++ai)
#pragma unroll
            for (int m = 0; m < 4; ++m) { const int row = row0 + ai * HALF + m * 16; bf16_t* rowp = O + (size_t)row * ldc + col0;
                const f32x4 q0 = *(const f32x4*)(ss + (size_t)row * 16), q1 = *(const f32x4*)(ss + (size_t)row * 16 + 4), q2 = *(const f32x4*)(ss + (size_t)row * 16 + 8), q3 = *(const f32x4*)(ss + (size_t)row * 16 + 12);
                const float tot = ((((q0[0] + q0[1]) + (q0[2] + q0[3])) + ((q1[0] + q1[1]) + (q1[2] + q1[3]))) + (((q2[0] + q2[1]) + (q2[2] + q2[3])) + ((q3[0] + q3[1]) + (q3[2] + q3[3]))));
                const float sc = scale * __builtin_amdgcn_rsqf(tot * inv_n + eps);
#pragma unroll
                for (int bj = 0; bj < 2; ++bj) { const f32x4 v0 = acc[ai][bj][m][0] * sc, v1 = acc[ai][bj][m][1] * sc;
                    u32x4 w; w.x = cvt_pk_bf16(v0[0], v0[1]); w.y = cvt_pk_bf16(v0[2], v0[3]); w.z = cvt_pk_bf16(v1[0], v1[1]); w.w = cvt_pk_bf16(v1[2], v1[3]);
                    *(u32x4*)(rowp + bj * HALF) = w; } }
    }
};
__device__ __forceinline__ float bf_lo(unsigned w) { return __uint_as_float(w << 16); }
__device__ __forceinline__ float bf_hi(unsigned w) { return __uint_as_float(w & 0xffff0000u); }
struct EpiResidualX {
    static constexpr bool PERM = true;
    bf16_t* X; float* SSX; int ldc; float inv_n, eps, mul;
    __device__ __forceinline__ void operator()(const f32x4 (&acc)[2][2][4][2], const Unit& u, int wr, int wc, int fr, int fq, const PG8_LAS float* tab) const {
        const int rl0 = wr * 64 + fr, col0 = u.pn * BM + wc * 32 + 8 * fq;
#pragma unroll
        for (int ai = 0; ai < 2; ++ai)
#pragma unroll
            for (int m = 0; m < 4; ++m) { const int rl = rl0 + ai * HALF + m * 16, row = u.pm * BM + rl; bf16_t* rowp = X + (size_t)row * ldc + col0;
                const float rm = mul * __builtin_amdgcn_rsqf((tab[rl * 4 + 2] + tab[rl * 4 + 3]) * inv_n + eps);
                u32x4 xv[2]; float s = 0.f;
#pragma unroll
                for (int bj = 0; bj < 2; ++bj) xv[bj] = *(const u32x4*)(rowp + bj * HALF);
#pragma unroll
                for (int bj = 0; bj < 2; ++bj) { const f32x4 a0 = acc[ai][bj][m][0] * rm, a1 = acc[ai][bj][m][1] * rm; u32x4 w;
                    w.x = cvt_pk_bf16(bf_lo(xv[bj].x) + a0[0], bf_hi(xv[bj].x) + a0[1]); w.y = cvt_pk_bf16(bf_lo(xv[bj].y) + a0[2], bf_hi(xv[bj].y) + a0[3]);
                    w.z = cvt_pk_bf16(bf_lo(xv[bj].z) + a1[0], bf_hi(xv[bj].z) + a1[1]); w.w = cvt_pk_bf16(bf_lo(xv[bj].w) + a1[2], bf_hi(xv[bj].w) + a1[3]);
                    *(u32x4*)(rowp + bj * HALF) = w;
                    const float r0 = bf_lo(w.x), r1 = bf_hi(w.x), r2 = bf_lo(w.y), r3 = bf_hi(w.y), r4 = bf_lo(w.z), r5 = bf_hi(w.z), r6 = bf_lo(w.w), r7 = bf_hi(w.w);
                    s += ((r0 * r0 + r1 * r1) + (r2 * r2 + r3 * r3)) + ((r4 * r4 + r5 * r5) + (r6 * r6 + r7 * r7)); }
                s += __shfl_xor(s, 16); s += __shfl_xor(s, 32);
                if (fq == 0) SSX[(size_t)row * 16 + u.pn * 4 + wc] = s;
                if (m & 1) asm volatile("" ::: "memory"); }
    }
};
struct EpiResidual {
    static constexpr bool PERM = true;
    bf16_t* X; int ldc; float mul;
    __device__ __forceinline__ void operator()(const f32x4 (&acc)[2][2][4][2], const Unit& u, int wr, int wc, int fr, int fq) const {
        const int row0 = u.pm * BM + wr * 64 + fr, col0 = u.pn * BM + wc * 32 + 8 * fq;
#pragma unroll
        for (int ai = 0; ai < 2; ++ai)
#pragma unroll
            for (int m = 0; m < 4; ++m) { bf16_t* rowp = X + (size_t)(row0 + ai * HALF + m * 16) * ldc + col0;
                u32x4 xv[2];
#pragma unroll
                for (int bj = 0; bj < 2; ++bj) xv[bj] = *(const u32x4*)(rowp + bj * HALF);
#pragma unroll
                for (int bj = 0; bj < 2; ++bj) { const f32x4 a0 = acc[ai][bj][m][0] * mul, a1 = acc[ai][bj][m][1] * mul; u32x4 w;
                    w.x = cvt_pk_bf16(bf_lo(xv[bj].x) + a0[0], bf_hi(xv[bj].x) + a0[1]); w.y = cvt_pk_bf16(bf_lo(xv[bj].y) + a0[2], bf_hi(xv[bj].y) + a0[3]);
                    w.z = cvt_pk_bf16(bf_lo(xv[bj].z) + a1[0], bf_hi(xv[bj].z) + a1[1]); w.w = cvt_pk_bf16(bf_lo(xv[bj].w) + a1[2], bf_hi(xv[bj].w) + a1[3]);
                    *(u32x4*)(rowp + bj * HALF) = w; } }
    }
};
struct EpiInProj {
    static constexpr bool PERM = true;
    const float* rs; const float* gq; const float* gk; const float* tabg; const float* tabm;
    bf16_t* QG; bf16_t* KG; bf16_t* VG; bf16_t* LAT; bf16_t* KROPE; float* SSL; float qscale, eps; unsigned* bnd;
    __device__ __forceinline__ static void rope2(f32x4& v, const f32x4 t) { const float a0 = v[0], b0 = v[1], a1 = v[2], b1 = v[3];
        v[0] = a0 * t[0] - b0 * t[1]; v[1] = b0 * t[0] + a0 * t[1]; v[2] = a1 * t[2] - b1 * t[3]; v[3] = b1 * t[2] + a1 * t[3]; }
    __device__ __forceinline__ static u32x4 pack(const f32x4 a, const f32x4 b) { u32x4 w; w.x = cvt_pk_bf16(a[0], a[1]); w.y = cvt_pk_bf16(a[2], a[3]); w.z = cvt_pk_bf16(b[0], b[1]); w.w = cvt_pk_bf16(b[2], b[3]); return w; }
    __device__ __forceinline__ void operator()(const f32x4 (&acc)[2][2][4][2], const Unit& u, int wr, int wc, int fr, int fq) const {
        const int row0 = u.pm * BM + wr * 64 + fr;
        if (u.pn < 2 || (u.pn == 2 && wc < 2)) {
            const bool isq = u.pn < 2; const float* g = isq ? gq : gk; bf16_t* dst = isq ? QG : KG; const int ld = isq ? 512 : 128, hcol = (isq ? (u.pn * 4 + wc) : wc) * 64; const float osc = isq ? qscale : 1.0f;
            f32x4 gv[2][2];
#pragma unroll
            for (int bj = 0; bj < 2; ++bj)
#pragma unroll
                for (int n = 0; n < 2; ++n)
#pragma unroll
                    for (int i = 0; i < 4; ++i) { const int p = 32 * bj + 8 * fq + 4 * n + i; gv[bj][n][i] = g[(p >> 1) + 32 * (p & 1)]; }
#pragma unroll
            for (int ai = 0; ai < 2; ++ai)
#pragma unroll
                for (int m = 0; m < 4; ++m) { const int row = row0 + ai * HALF + m * 16, s = row & 4095; const float sc = rs[row];
                    f32x4 v[2][2]; float ss = 0.f;
#pragma unroll
                    for (int bj = 0; bj < 2; ++bj)
#pragma unroll
                        for (int n = 0; n < 2; ++n) { v[bj][n] = acc[ai][bj][m][n] * sc; ss += (v[bj][n][0] * v[bj][n][0] + v[bj][n][1] * v[bj][n][1]) + (v[bj][n][2] * v[bj][n][2] + v[bj][n][3] * v[bj][n][3]); }
                    ss += __shfl_xor(ss, 16); ss += __shfl_xor(ss, 32);
                    const float rstd = __builtin_amdgcn_rsqf(ss * (1.0f / 64.0f) + eps);
#pragma unroll
                    for (int bj = 0; bj < 2; ++bj) {
#pragma unroll
                        for (int n = 0; n < 2; ++n) { v[bj][n] = v[bj][n] * rstd * gv[bj][n];
                            const f32x4 t = *(const f32x4*)(tabg + ((size_t)s * 32 + 16 * bj + 4 * fq + 2 * n) * 2); rope2(v[bj][n], t); v[bj][n] = v[bj][n] * osc; }
                        *(u32x4*)(dst + (size_t)row * ld + hcol + 32 * bj + 8 * fq) = pack(v[bj][0], v[bj][1]); } }
        } else if (u.pn == 2) {
#pragma unroll
            for (int ai = 0; ai < 2; ++ai)
#pragma unroll
                for (int m = 0; m < 4; ++m) { const int row = row0 + ai * HALF + m * 16; const float sc = rs[row];
#pragma unroll
                    for (int bj = 0; bj < 2; ++bj) *(u32x4*)(VG + (size_t)row * 128 + (wc - 2) * 64 + 32 * bj + 8 * fq) = pack(acc[ai][bj][m][0] * sc, acc[ai][bj][m][1] * sc); }
        } else if (u.pn == 3) {
#pragma unroll
            for (int ai = 0; ai < 2; ++ai)
#pragma unroll
                for (int m = 0; m < 4; ++m) { const int row = row0 + ai * HALF + m * 16; const float sc = rs[row]; float ss = 0.f;
#pragma unroll
                    for (int bj = 0; bj < 2; ++bj) { const f32x4 a = acc[ai][bj][m][0] * sc, b = acc[ai][bj][m][1] * sc;
                        ss += ((a[0] * a[0] + a[1] * a[1]) + (a[2] * a[2] + a[3] * a[3])) + ((b[0] * b[0] + b[1] * b[1]) + (b[2] * b[2] + b[3] * b[3]));
                        *(u32x4*)(LAT + (size_t)row * 512 + 128 * bj + 32 * wc + 8 * fq) = pack(a, b); }
                    ss += __shfl_xor(ss, 16); ss += __shfl_xor(ss, 32);
                    if (fq == 0) SSL[(size_t)row * 8 + wc] = ss; }
        } else {
            float krm = 0.f;
#pragma unroll
            for (int ai = 0; ai < 2; ++ai)
#pragma unroll
                for (int m = 0; m < 4; ++m) { const int row = row0 + ai * HALF + m * 16, s = row & 4095; const float sc = rs[row];
                    const f32x4 a = acc[ai][0][m][0] * sc, b = acc[ai][0][m][1] * sc;
                    float ss = ((a[0] * a[0] + a[1] * a[1]) + (a[2] * a[2] + a[3] * a[3])) + ((b[0] * b[0] + b[1] * b[1]) + (b[2] * b[2] + b[3] * b[3]));
                    *(u32x4*)(LAT + (size_t)row * 512 + 256 + 32 * wc + 8 * fq) = pack(a, b);
                    ss += __shfl_xor(ss, 16); ss += __shfl_xor(ss, 32);
                    if (fq == 0) SSL[(size_t)row * 8 + 4 + wc] = ss;
                    if (wc == 0) { f32x4 c = acc[ai][1][m][0] * sc, d = acc[ai][1][m][1] * sc;
                        rope2(c, *(const f32x4*)(tabm + ((size_t)s * 16 + 4 * fq) * 2)); rope2(d, *(const f32x4*)(tabm + ((size_t)s * 16 + 4 * fq + 2) * 2));
                        krm = fmaxf(krm, ((c[0] * c[0] + c[1] * c[1]) + (c[2] * c[2] + c[3] * c[3])) + ((d[0] * d[0] + d[1] * d[1]) + (d[2] * d[2] + d[3] * d[3])));
                        *(u32x4*)(KROPE + (size_t)row * 32 + 8 * fq) = pack(c, d); } }
            if (wc == 0) { krm = lx::bound_rows(krm); if (fr == 0 && fq == 0) atomicMax(bnd + (u.pm >> 4) * 64 + 5, __float_as_uint(krm)); }

        }
    }
};
struct EpiSwiGLU {
    static constexpr bool PERM = true;
    bf16_t* O; int ldc; const float* rs;
    __device__ __forceinline__ static float silu_mul(float g, float u) { return g * u * __builtin_amdgcn_rcpf(1.0f + __builtin_amdgcn_exp2f(-1.4426950408889634f * g)); }
    __device__ __forceinline__ void operator()(const f32x4 (&acc)[2][2][4][2], const Unit& u, int wr, int wc, int fr, int fq) const {
        const int row0 = u.pm * BM + wr * 64 + fr, col0 = u.pn * HALF + wc * 32 + 8 * fq;
#pragma unroll
        for (int ai = 0; ai < 2; ++ai)
#pragma unroll
            for (int m = 0; m < 4; ++m) { const int row = row0 + ai * HALF + m * 16; bf16_t* rowp = O + (size_t)row * ldc + col0; const float sc = rs[row];
                const f32x4 g0 = acc[ai][0][m][0] * sc, g1 = acc[ai][0][m][1] * sc, u0 = acc[ai][1][m][0] * sc, u1 = acc[ai][1][m][1] * sc;
                u32x4 w; w.x = cvt_pk_bf16(silu_mul(g0[0], u0[0]), silu_mul(g0[1], u0[1])); w.y = cvt_pk_bf16(silu_mul(g0[2], u0[2]), silu_mul(g0[3], u0[3]));
                w.z = cvt_pk_bf16(silu_mul(g1[0], u1[0]), silu_mul(g1[1], u1[1])); w.w = cvt_pk_bf16(silu_mul(g1[2], u1[2]), silu_mul(g1[3], u1[3]));
                *(u32x4*)rowp = w; }
    }
};

template <class Epi, class Sched, bool ALIGN_EPI = false, bool GATHER = false, bool MIDSCALE = false>
__device__ __forceinline__ void gemm_phase(PG8_LAS unsigned char* lds, const Gemm g, const Sched& S, const Epi& E, PG8_LAS unsigned char* gtab = nullptr, float ms_inv_n = 0.f, float ms_eps = 0.f) {
    int tid_ = threadIdx.x; asm volatile("" : "+v"(tid_));
    const int tid = tid_, wid = __builtin_amdgcn_readfirstlane(tid >> 6), lane = tid & 63, wr = wid >> 2, wc = wid & 3, fr = lane & 15, fq = lane >> 4;
    const int K = g.K, nt = K / BK;
    unsigned voffA[2], voffB[2]; int gR[2], gC[2];
#pragma unroll
    for (int i = 0; i < 2; ++i) { int R, C; stage_rc(tid * 16 + i * 8192, R, C); const int Rb = Epi::PERM ? ((R & ~31) + perm32(R & 31)) : R; gR[i] = R; gC[i] = C;
        voffA[i] = (unsigned)(R * g.lda + C) * 2u; voffB[i] = (unsigned)(Rb * g.ldb + C) * 2u; }
    unsigned goffc[2][2], goffn[2][2];
#define PG8_GISSUE(u) do { _Pragma("unroll") for (int h_ = 0; h_ < 2; ++h_) _Pragma("unroll") for (int i_ = 0; i_ < 2; ++i_) \
        __builtin_amdgcn_global_load_lds((const unsigned*)(g.idx + (u).pm * BM + h_ * HALF + gR[i_]), (PG8_LAS unsigned*)(gtab + ((h_ * 2 + i_) * 8 + wid) * 256), 4, 0, 0); } while (0)
#define PG8_GREAD(dst, u) do { asm volatile("" ::: "memory"); _Pragma("unroll") for (int h_ = 0; h_ < 2; ++h_) _Pragma("unroll") for (int i_ = 0; i_ < 2; ++i_) { \
        const int tok_ = *(const PG8_LAS int*)(gtab + ((h_ * 2 + i_) * 8 + wid) * 256 + lane * 4); \
        dst[h_][i_] = (unsigned)(((((u).pm >> 1) & 7) * 4096 + tok_) * g.lda + gC[i_]) * 2u; } } while (0)
    const size_t kstep = (size_t)(BK * 2);
    const size_t hstepA = (size_t)HALF * g.lda * 2, hstepB = (size_t)HALF * g.ldb * 2;
    const size_t tstepA = 2 * hstepA, tstepB = 2 * hstepB;
    const unsigned ldsw = (unsigned)wid * 1024u;
    const int aoff = lds_byte(wr * 64 + fr, fq * 8), boff = lds_byte(wc * 32 + fr, fq * 8);
#define PG8_SA(b, h) (((b) * 2 + (h)) * HTB)
#define PG8_SB(b, h) ((4 + (b) * 2 + (h)) * HTB)
#define PG8_STAGE(bufoff, gbase, voff) do { _Pragma("unroll") for (int _i = 0; _i < 2; ++_i) \
        __builtin_amdgcn_global_load_lds((const unsigned*)((const char*)(gbase) + (voff)[_i]), (PG8_LAS unsigned*)(lds + (bufoff) + ldsw + _i * 8192), 16, 0, 0); } while (0)
#define PG8_LDA(dst, b, h) do { _Pragma("unroll") for (int m = 0; m < 4; ++m) _Pragma("unroll") for (int k = 0; k < 2; ++k) dst[m][k] = *(const PG8_LAS bf16x8*)(lds + PG8_SA(b, h) + aoff + m * 2048 + k * 1024); } while (0)
#define PG8_LDB(dst, b, h) do { _Pragma("unroll") for (int n = 0; n < 2; ++n) _Pragma("unroll") for (int k = 0; k < 2; ++k) dst[n][k] = *(const PG8_LAS bf16x8*)(lds + PG8_SB(b, h) + boff + n * 2048 + k * 1024); } while (0)
#define PG8_MMA(ai, bj, At, Bt) do { __builtin_amdgcn_s_setprio(1); _Pragma("unroll") for (int m = 0; m < 4; ++m) _Pragma("unroll") for (int n = 0; n < 2; ++n) _Pragma("unroll") for (int k = 0; k < 2; ++k) \
        acc[ai][bj][m][n] = __builtin_amdgcn_mfma_f32_16x16x32_bf16(Bt[n][k], At[m][k], acc[ai][bj][m][n], 0, 0, 0); __builtin_amdgcn_s_setprio(0); } while (0)
#define PG8_WAIT_V(n) asm volatile("s_waitcnt vmcnt(" #n ")" ::: "memory")
#define PG8_WAIT_L(n) asm volatile("s_waitcnt lgkmcnt(" #n ")" ::: "memory")
#define PG8_BAR __builtin_amdgcn_s_barrier()
#define PG8_SCHED __builtin_amdgcn_sched_barrier(0)
#define PG8_ABASE(u) (GATHER ? (const char*)g.A : (const char*)g.A + (size_t)((u).pm % g.amod) * tstepA)
#define PG8_STA(bufoff, kptr, h, nx) do { if constexpr (GATHER) { unsigned o_[2]; o_[0] = (nx) ? goffn[h][0] : goffc[h][0]; o_[1] = (nx) ? goffn[h][1] : goffc[h][1]; PG8_STAGE(bufoff, kptr, o_); } \
        else { PG8_STAGE(bufoff, (kptr) + (h) * hstepA, voffA); } } while (0)
#define PG8_BBASE(u) ((const char*)g.Bt + ((size_t)((u).pm / g.gdiv) * g.gstride) * 2 + (size_t)(u).pn * tstepB)
    Unit cur, nxt; int ui = 0;
    if (!S.next(0, cur)) return;
    f32x4 acc[2][2][4][2];
#pragma unroll
    for (int a = 0; a < 2; ++a)
#pragma unroll
        for (int b = 0; b < 2; ++b)
#pragma unroll
            for (int m = 0; m < 4; ++m)
#pragma unroll
                for (int n = 0; n < 2; ++n) acc[a][b][m][n] = (f32x4){0.f, 0.f, 0.f, 0.f};
    bf16x8 At[4][2], B0[2][2], B1[2][2];
    const char* cA = PG8_ABASE(cur); const char* cB = PG8_BBASE(cur);
    if constexpr (GATHER) { PG8_GISSUE(cur); PG8_WAIT_V(0); PG8_GREAD(goffc, cur);
#pragma unroll
        for (int h_ = 0; h_ < 2; ++h_) { goffn[h_][0] = goffc[h_][0]; goffn[h_][1] = goffc[h_][1]; } }
    PG8_STAGE(PG8_SB(0, 0), cB, voffB); PG8_STAGE(PG8_SB(0, 1), cB + hstepB, voffB); PG8_STA(PG8_SA(0, 0), cA, 0, false); PG8_STA(PG8_SA(0, 1), cA, 1, false);
    if (wr == 1) PG8_BAR;
    PG8_WAIT_V(2); PG8_BAR;
    PG8_STAGE(PG8_SB(1, 0), cB + kstep, voffB); PG8_STA(PG8_SA(1, 0), cA + kstep, 0, false); PG8_STAGE(PG8_SB(1, 1), cB + hstepB + kstep, voffB);
    PG8_WAIT_V(6); PG8_BAR;
    for (;;) {
        const bool has_next = S.next(ui + 1, nxt);
        const char* nA = has_next ? PG8_ABASE(nxt) : cA; const char* nB = has_next ? PG8_BBASE(nxt) : cB;
        if constexpr (GATHER) { if (has_next) PG8_GISSUE(nxt); }
        if constexpr (MIDSCALE) {
#pragma unroll
            for (int q_ = 0; q_ < 2; ++q_) __builtin_amdgcn_global_load_lds((const unsigned*)(g.ss + (size_t)cur.pm * 1024 + q_ * 512 + wid * 64 + lane), (PG8_LAS unsigned*)(gtab + (ui & 1) * 4096 + q_ * 2048 + wid * 256), 4, 0, 0); }
#pragma nounroll
        for (int t = 0; t < nt; t += 2) {
            const bool last = (t == nt - 2);
            const char* a1 = cA + (size_t)(t + 1) * kstep;
            const char* a2 = last ? nA : cA + (size_t)(t + 2) * kstep; const char* b2 = last ? nB : cB + (size_t)(t + 2) * kstep;
            const char* a3 = a2 + kstep; const char* b3 = b2 + kstep;
            if constexpr (GATHER) { if (last && has_next) PG8_GREAD(goffn, nxt); }
            if constexpr (MIDSCALE) { if (t == nt / 2) { asm volatile("" ::: "memory"); const PG8_LAS float* tab = (const PG8_LAS float*)(gtab + (ui & 1) * 4096);
#pragma unroll
                for (int ai = 0; ai < 2; ++ai)
#pragma unroll
                    for (int m = 0; m < 4; ++m) { const int rl = ai * HALF + wr * 64 + m * 16 + fr; const float sg = tab[rl * 4] + tab[rl * 4 + 1], sm = tab[rl * 4 + 2] + tab[rl * 4 + 3];
                        const float ratio = __builtin_amdgcn_rsqf(sg * ms_inv_n + ms_eps) * __builtin_amdgcn_rcpf(__builtin_amdgcn_rsqf(sm * ms_inv_n + ms_eps));
#pragma unroll
                        for (int bj = 0; bj < 2; ++bj)
#pragma unroll
                            for (int n = 0; n < 2; ++n) acc[ai][bj][m][n] = acc[ai][bj][m][n] * ratio; } } }
            PG8_LDB(B0, 0, 0); PG8_LDB(B1, 0, 1); PG8_SCHED; PG8_LDA(At, 0, 0); PG8_STA(PG8_SA(1, 1), a1, 1, false);
            PG8_WAIT_V(8); PG8_WAIT_L(0); PG8_BAR; PG8_MMA(0, 0, At, B0); PG8_MMA(0, 1, At, B1); PG8_BAR; PG8_SCHED;
            PG8_LDA(At, 0, 1); PG8_STAGE(PG8_SB(0, 0), b2, voffB); PG8_STAGE(PG8_SB(0, 1), b2 + hstepB, voffB); PG8_STA(PG8_SA(0, 0), a2, 0, last);
            PG8_WAIT_V(8); PG8_WAIT_L(0); PG8_BAR; PG8_MMA(1, 0, At, B0); PG8_MMA(1, 1, At, B1); PG8_BAR; PG8_SCHED;
            PG8_LDB(B0, 1, 0); PG8_LDB(B1, 1, 1); PG8_SCHED; PG8_LDA(At, 1, 0); PG8_STA(PG8_SA(0, 1), a2, 1, last);
            PG8_WAIT_V(8); PG8_WAIT_L(0); PG8_BAR; PG8_MMA(0, 0, At, B0); PG8_MMA(0, 1, At, B1); PG8_BAR; PG8_SCHED;
            PG8_LDA(At, 1, 1); PG8_STAGE(PG8_SB(1, 0), b3, voffB); PG8_STAGE(PG8_SB(1, 1), b3 + hstepB, voffB); PG8_STA(PG8_SA(1, 0), a3, 0, last);
            PG8_WAIT_V(8); PG8_WAIT_L(0); PG8_BAR; PG8_MMA(1, 0, At, B0); PG8_MMA(1, 1, At, B1); PG8_BAR; PG8_SCHED;
        }
        if constexpr (ALIGN_EPI) { if (wr == 0) PG8_BAR; }
        if constexpr (MIDSCALE) E(acc, cur, wr, wc, fr, fq, (const PG8_LAS float*)(gtab + (ui & 1) * 4096)); else E(acc, cur, wr, wc, fr, fq);
        if (!has_next) break;
#pragma unroll
        for (int a = 0; a < 2; ++a)
#pragma unroll
            for (int b = 0; b < 2; ++b)
#pragma unroll
                for (int m = 0; m < 4; ++m)
#pragma unroll
                    for (int n = 0; n < 2; ++n) acc[a][b][m][n] = (f32x4){0.f, 0.f, 0.f, 0.f};
        cur = nxt; cA = nA; cB = nB; ++ui;
        if constexpr (GATHER) {
#pragma unroll
            for (int h_ = 0; h_ < 2; ++h_) { goffc[h_][0] = goffn[h_][0]; goffc[h_][1] = goffn[h_][1]; } }
        if constexpr (ALIGN_EPI) { if (wr == 1) PG8_BAR; }
    }
    PG8_WAIT_V(0);
    if constexpr (!ALIGN_EPI) { if (wr == 0) PG8_BAR; }
    PG8_BAR;
#undef PG8_SA
#undef PG8_SB
#undef PG8_STAGE
#undef PG8_LDA
#undef PG8_LDB
#undef PG8_MMA
#undef PG8_WAIT_V
#undef PG8_WAIT_L
#undef PG8_BAR
#undef PG8_SCHED
#undef PG8_ABASE
#undef PG8_STA
#undef PG8_GISSUE
#undef PG8_GREAD
#undef PG8_BBASE
}
}
namespace att {
typedef unsigned short bf16;
using bf16x8 = __attribute__((ext_vector_type(8))) short;
using s16x4  = __attribute__((ext_vector_type(4))) short;
using f32x16 = __attribute__((ext_vector_type(16))) float;
using u32x4  = __attribute__((ext_vector_type(4))) unsigned;
#define ATT_SBAR() __builtin_amdgcn_sched_barrier(0)
constexpr int KCH = 1040;
constexpr float THR = 8.0f;
__device__ __forceinline__ int crow(int r, int hi) { return (r & 3) + 8 * (r >> 2) + 4 * hi; }
__device__ __forceinline__ unsigned cvtpk(float lo, float hi) { unsigned r; asm volatile("v_cvt_pk_bf16_f32 %0, %1, %2" : "=v"(r) : "v"(lo), "v"(hi)); return r; }
typedef float f32x2_t __attribute__((ext_vector_type(2))); typedef __bf16 bf16x2_t __attribute__((ext_vector_type(2)));
__device__ __forceinline__ unsigned cvtpk_c(float lo, float hi) { const f32x2_t v = {lo, hi}; const bf16x2_t b = __builtin_convertvector(v, bf16x2_t); return __builtin_bit_cast(unsigned, b); }
__device__ __forceinline__ unsigned short f2bf1(float f) { unsigned u = __builtin_bit_cast(unsigned, f); return (unsigned short)((u + 0x7fffu + ((u >> 16) & 1u)) >> 16); }

#define ATT_MX3(a, b, c) __builtin_fmaxf(__builtin_fmaxf((a), (b)), (c))
template <int MODE, bool FIRST>
__device__ __forceinline__ void partialSM(f32x16& p0, f32x16& p1, float& m_run, f32x16& negm, float& alpha) {
  if constexpr (MODE == 0) {
    float a = ATT_MX3(p0[0], p0[1], p1[0]), b = ATT_MX3(p0[2], p0[3], p1[1]); a = ATT_MX3(a, p1[2], p1[3]);
#pragma unroll
    for (int r = 4; r < 16; r += 4) { a = ATT_MX3(a, p0[r], p0[r + 1]); b = ATT_MX3(b, p0[r + 2], p0[r + 3]); a = ATT_MX3(a, p1[r], p1[r + 1]); b = ATT_MX3(b, p1[r + 2], p1[r + 3]); }
    float pmax = fmaxf(a, b);
    { auto rr = __builtin_amdgcn_permlane32_swap(__float_as_uint(pmax), __float_as_uint(pmax), false, false);
      pmax = fmaxf(__uint_as_float(rr[0]), __uint_as_float(rr[1])); }
    alpha = 1.f;
    if (FIRST || __builtin_expect(__any(pmax > THR), 0)) {
      const float dl = FIRST ? pmax : fmaxf(pmax, 0.f);
      m_run += dl;
#pragma unroll
      for (int r = 0; r < 16; ++r) { p0[r] -= dl; p1[r] -= dl; }
#pragma unroll
      for (int r = 0; r < 16; ++r) negm[r] = -m_run;
      asm volatile("" : "+v"(negm));
      alpha = FIRST ? 1.f : __builtin_amdgcn_exp2f(-dl);
    }
  } else { alpha = 1.f; }
#pragma unroll
  for (int r = 0; r < 16; ++r) p0[r] = __builtin_amdgcn_exp2f(p0[r]);
}
__device__ __forceinline__ void finishSM(f32x16& p0, f32x16& p1, float alpha, float& l_reg, bf16x8& pa0, bf16x8& pa1, bf16x8& pa2, bf16x8& pa3) {
#pragma unroll
  for (int r = 0; r < 16; ++r) p1[r] = __builtin_amdgcn_exp2f(p1[r]);
  float ps = 0;
#pragma unroll
  for (int r = 0; r < 16; ++r) ps += p0[r];
#pragma unroll
  for (int r = 0; r < 16; ++r) ps += p1[r];
  { auto rr = __builtin_amdgcn_permlane32_swap(__float_as_uint(ps), __float_as_uint(ps), false, false);
    ps = __uint_as_float(rr[0]) + __uint_as_float(rr[1]); }
  l_reg = l_reg * alpha + ps;
#define ATT_PK4(P, BASE, OUT) do { const u32x4 w = {cvtpk_c(P[BASE + 0], P[BASE + 1]), cvtpk_c(P[BASE + 2], P[BASE + 3]), cvtpk_c(P[BASE + 4], P[BASE + 5]), cvtpk_c(P[BASE + 6], P[BASE + 7])}; \
    OUT = __builtin_bit_cast(bf16x8, w); } while (0)
  ATT_PK4(p0, 0, pa0); ATT_PK4(p0, 8, pa1); ATT_PK4(p1, 0, pa2); ATT_PK4(p1, 8, pa3);
#undef ATT_PK4
}
template <int ND0, int MODE = 0>
__device__ __forceinline__ void qkt(f32x16& p0, f32x16& p1, const char* Ks, const bf16x8* qr, const f32x16& negm, int r32, int hi) {
#pragma unroll
  for (int d0 = 0; d0 < ND0; ++d0) {
    const char* kb = Ks + (2 * d0 + hi) * KCH + r32 * 16;
    bf16x8 b0 = *reinterpret_cast<const bf16x8*>(kb);
    bf16x8 b1 = *reinterpret_cast<const bf16x8*>(kb + 512);
    if (d0 == 0) { if constexpr (MODE == 1) { p0 = __builtin_amdgcn_mfma_f32_32x32x16_bf16(b0, qr[0], f32x16{}, 0, 0, 0); p1 = __builtin_amdgcn_mfma_f32_32x32x16_bf16(b1, qr[0], f32x16{}, 0, 0, 0); }
                   else { p0 = __builtin_amdgcn_mfma_f32_32x32x16_bf16(b0, qr[0], negm, 0, 0, 0); p1 = __builtin_amdgcn_mfma_f32_32x32x16_bf16(b1, qr[0], negm, 0, 0, 0); } }
    else { p0 = __builtin_amdgcn_mfma_f32_32x32x16_bf16(b0, qr[d0], p0, 0, 0, 0); p1 = __builtin_amdgcn_mfma_f32_32x32x16_bf16(b1, qr[d0], p1, 0, 0, 0); } }
}
template <int NB> __device__ __forceinline__ int v_st(int k, int c) { const int kk = k; return ((kk >> 3) * NB + (c >> 5)) * 512 + ((kk & 7) * 32 + (c & 31)) * 2; }
__device__ __forceinline__ int v_rd_base(int lane) { return ((lane & 3) << 3) | (((lane >> 2) & 3) << 6) | (((lane >> 4) & 1) << 5) | (((lane >> 5) & 1) << 8); }
template <int OFF> __device__ __forceinline__ s16x4 tr_read(int vb) {
  s16x4 r; asm volatile("ds_read_b64_tr_b16 %0, %1 offset:%2" : "=&v"(r) : "v"(vb), "i"(OFF) : "memory"); return r;
}
template <int NB, int D0> __device__ __forceinline__ void pv_one(f32x16& od, int vb, bf16x8 pa0, bf16x8 pa1, bf16x8 pa2, bf16x8 pa3) {
#define ATT_VO(ks, half) (D0 * 512 + (2 * (ks) + (half)) * NB * 512)
  const s16x4 l0 = tr_read<ATT_VO(0, 0)>(vb), h0 = tr_read<ATT_VO(0, 1)>(vb), l1 = tr_read<ATT_VO(1, 0)>(vb), h1 = tr_read<ATT_VO(1, 1)>(vb);
  const s16x4 l2 = tr_read<ATT_VO(2, 0)>(vb), h2 = tr_read<ATT_VO(2, 1)>(vb), l3 = tr_read<ATT_VO(3, 0)>(vb), h3 = tr_read<ATT_VO(3, 1)>(vb);
#undef ATT_VO
  asm volatile("s_waitcnt lgkmcnt(0)" ::: "memory"); ATT_SBAR();
#define ATT_PK(L, H) (bf16x8){L[0], L[1], L[2], L[3], H[0], H[1], H[2], H[3]}
  od = __builtin_amdgcn_mfma_f32_32x32x16_bf16(pa0, ATT_PK(l0, h0), od, 0, 0, 0);
  od = __builtin_amdgcn_mfma_f32_32x32x16_bf16(pa1, ATT_PK(l1, h1), od, 0, 0, 0);
  od = __builtin_amdgcn_mfma_f32_32x32x16_bf16(pa2, ATT_PK(l2, h2), od, 0, 0, 0);
  od = __builtin_amdgcn_mfma_f32_32x32x16_bf16(pa3, ATT_PK(l3, h3), od, 0, 0, 0);
#undef ATT_PK
}
template <int NB> __device__ __forceinline__ void pv_all(f32x16* o, int vb, bf16x8 pa0, bf16x8 pa1, bf16x8 pa2, bf16x8 pa3) {
  if constexpr (NB == 2) {
#define ATT_VO(d0, ks, half) ((d0) * 512 + (2 * (ks) + (half)) * NB * 512)
    const s16x4 l0 = tr_read<ATT_VO(0, 0, 0)>(vb), h0 = tr_read<ATT_VO(0, 0, 1)>(vb), l1 = tr_read<ATT_VO(0, 1, 0)>(vb), h1 = tr_read<ATT_VO(0, 1, 1)>(vb);
    const s16x4 l2 = tr_read<ATT_VO(0, 2, 0)>(vb), h2 = tr_read<ATT_VO(0, 2, 1)>(vb), l3 = tr_read<ATT_VO(0, 3, 0)>(vb), h3 = tr_read<ATT_VO(0, 3, 1)>(vb);
    const s16x4 m0 = tr_read<ATT_VO(1, 0, 0)>(vb), n0 = tr_read<ATT_VO(1, 0, 1)>(vb), m1 = tr_read<ATT_VO(1, 1, 0)>(vb), n1 = tr_read<ATT_VO(1, 1, 1)>(vb);
    const s16x4 m2 = tr_read<ATT_VO(1, 2, 0)>(vb), n2 = tr_read<ATT_VO(1, 2, 1)>(vb), m3 = tr_read<ATT_VO(1, 3, 0)>(vb), n3 = tr_read<ATT_VO(1, 3, 1)>(vb);
#undef ATT_VO
#define ATT_PK(L, H) (bf16x8){L[0], L[1], L[2], L[3], H[0], H[1], H[2], H[3]}
    asm volatile("s_waitcnt lgkmcnt(8)" ::: "memory"); ATT_SBAR();
    o[0] = __builtin_amdgcn_mfma_f32_32x32x16_bf16(pa0, ATT_PK(l0, h0), o[0], 0, 0, 0);
    o[0] = __builtin_amdgcn_mfma_f32_32x32x16_bf16(pa1, ATT_PK(l1, h1), o[0], 0, 0, 0);
    o[0] = __builtin_amdgcn_mfma_f32_32x32x16_bf16(pa2, ATT_PK(l2, h2), o[0], 0, 0, 0);
    o[0] = __builtin_amdgcn_mfma_f32_32x32x16_bf16(pa3, ATT_PK(l3, h3), o[0], 0, 0, 0);
    asm volatile("s_waitcnt lgkmcnt(0)" ::: "memory"); ATT_SBAR();
    o[1] = __builtin_amdgcn_mfma_f32_32x32x16_bf16(pa0, ATT_PK(m0, n0), o[1], 0, 0, 0);
    o[1] = __builtin_amdgcn_mfma_f32_32x32x16_bf16(pa1, ATT_PK(m1, n1), o[1], 0, 0, 0);
    o[1] = __builtin_amdgcn_mfma_f32_32x32x16_bf16(pa2, ATT_PK(m2, n2), o[1], 0, 0, 0);
    o[1] = __builtin_amdgcn_mfma_f32_32x32x16_bf16(pa3, ATT_PK(m3, n3), o[1], 0, 0, 0);
#undef ATT_PK
  } else {
    pv_one<NB, 0>(o[0], vb, pa0, pa1, pa2, pa3); pv_one<NB, 1>(o[1], vb, pa0, pa1, pa2, pa3);
    pv_one<NB, 2>(o[2], vb, pa0, pa1, pa2, pa3); pv_one<NB, 3>(o[3], vb, pa0, pa1, pa2, pa3);
  }
}

template <int W1, int W2, int DV> struct AttnCfg {
  static constexpr int DQK = W1 + W2, NCH = DQK / 8, ND0 = DQK / 16, NB = DV / 32;
  static constexpr int KT_BYTES = NCH * KCH, VT_BYTES = 64 * DV * 2;
  static constexpr int OST_BYTES = 32 * DV * 2;
  static constexpr bool OSTAGE = (DV == 64);
  static constexpr int LDS_BYTES = 3 * VT_BYTES + 3 * KT_BYTES + 8 * 64 * 4 + (OSTAGE ? 8 * OST_BYTES : 0);
  static constexpr int CW1 = W1 / 8, N1 = (64 * CW1) / 512;
  static constexpr int CWV = DV / 8, NV = (64 * CWV) / 512;
  static_assert(W1 == 64 || W1 == 128, "W1"); static_assert(W2 == 0 || W2 == 32, "W2"); static_assert(DV == 64 || DV == 128, "DV");
};

template <int W1, int W2, int DV, int MODE, bool SSQ>
__device__ __forceinline__ void attn_unit(const bf16* __restrict__ Qb, const bf16* __restrict__ Qb2, int ldq, const bf16* __restrict__ K1, int ldk1, const bf16* __restrict__ K2, int ldk2,
                                          const bf16* __restrict__ Vh, int ldv, bf16* __restrict__ Ob, int ldo, int nkeys, char* lds, float (&ssacc)[16]) {
  using C = AttnCfg<W1, W2, DV>;
  constexpr int ND0 = C::ND0, NB = C::NB, N1 = C::N1, NV = C::NV, CW1 = C::CW1, CWV = C::CWV;
  constexpr int SHM_V = C::VT_BYTES, SHM_K = C::KT_BYTES;
  int tid_ = threadIdx.x; asm volatile("" : "+v"(tid_));
  const int tid = tid_, wid = tid >> 6, lane = tid & 63, r32 = lane & 31, hi = lane >> 5;
  char* V_lds = lds; char* K_lds = lds + 3 * SHM_V;
  float* ws = (float*)(lds + 3 * SHM_V + 3 * SHM_K) + wid * 64; float* li_l = ws; float* al_l = ws + 32;
  float m_reg = 0.f, l_reg = 0; f32x16 o[NB]; bf16x8 qr[ND0]; f32x16 negm = f32x16{}; if constexpr (MODE == 0) asm volatile("" : "+v"(negm));
#pragma unroll
  for (int d = 0; d < NB; ++d) o[d] = f32x16{};
  const bf16* Qw = Qb + (long)(wid * 32 + r32) * ldq + hi * 8;
#pragma unroll
  for (int d0 = 0; d0 < W1 / 16; ++d0) qr[d0] = *reinterpret_cast<const bf16x8*>(Qw + d0 * 16);
  if constexpr (W2 > 0) { const bf16* Qw2 = Qb2 + (long)(wid * 32 + r32) * ldq + hi * 8;
#pragma unroll
    for (int d0 = 0; d0 < W2 / 16; ++d0) qr[W1 / 16 + d0] = *reinterpret_cast<const bf16x8*>(Qw2 + d0 * 16); }
  int k1row[N1], k1col[N1], k1lds[N1], vrow[NV], vcol[NV], vlds[NV];
#pragma unroll
  for (int i = 0; i < N1; ++i) { const int p = tid + 512 * i; k1row[i] = p / CW1; k1col[i] = (p % CW1) * 8; k1lds[i] = (p % CW1) * KCH + (p / CW1) * 16; }
#pragma unroll
  for (int i = 0; i < NV; ++i) { const int p = tid + 512 * i; vrow[i] = p / CWV; vcol[i] = (p % CWV) * 8; vlds[i] = v_st<NB>(p / CWV, (p % CWV) * 8); }
  const int k2row = tid >> 2, k2col = (tid & 3) * 8, k2lds = (CW1 + (tid & 3)) * KCH + (tid >> 2) * 16; const bool k2on = (W2 > 0) && (tid < 256);
  const int vb0 = (int)(uintptr_t)V_lds + v_rd_base(lane);
  struct Slot { bf16x8 k1[N1]; bf16x8 k2; bf16x8 v[NV]; } sr_[2];
#define ATT_SLOAD(i, k0) do { _Pragma("unroll") for (int _j = 0; _j < N1; ++_j) sr_[i].k1[_j] = *reinterpret_cast<const bf16x8*>(&K1[(long)((k0) + k1row[_j]) * ldk1 + k1col[_j]]); \
    if constexpr (W2 > 0) { if (k2on) sr_[i].k2 = *reinterpret_cast<const bf16x8*>(&K2[(long)((k0) + k2row) * ldk2 + k2col]); } \
    _Pragma("unroll") for (int _j = 0; _j < NV; ++_j) sr_[i].v[_j] = *reinterpret_cast<const bf16x8*>(&Vh[(long)((k0) + vrow[_j]) * ldv + vcol[_j]]); } while (0)
#define ATT_SWRITE(b, i) do { _Pragma("unroll") for (int _j = 0; _j < NV; ++_j) *(bf16x8*)(V_lds + (b) * SHM_V + vlds[_j]) = sr_[i].v[_j]; \
    _Pragma("unroll") for (int _j = 0; _j < N1; ++_j) *(bf16x8*)(K_lds + (b) * SHM_K + k1lds[_j]) = sr_[i].k1[_j]; \
    if constexpr (W2 > 0) { if (k2on) *(bf16x8*)(K_lds + (b) * SHM_K + k2lds) = sr_[i].k2; } } while (0)
#define ATT_SWAIT() asm volatile("s_waitcnt vmcnt(%0)" :: "n"(N1 + NV) : "memory")
#define ATT_RESC(a) do { if (MODE == 0 && __any((a) != 1.f)) { if (hi == 0) al_l[r32] = (a); asm volatile("s_waitcnt lgkmcnt(0)" ::: "memory"); \
    _Pragma("unroll") for (int d = 0; d < NB; ++d) _Pragma("unroll") for (int r = 0; r < 16; ++r) o[d][r] *= al_l[crow(r, hi)]; } } while (0)
  f32x16 pA0, pA1, pB0, pB1; float alA, alB; bf16x8 pa0, pa1, pa2, pa3; const int NT = nkeys / 64;
  ATT_SLOAD(0, 0); asm volatile("s_waitcnt vmcnt(0)" ::: "memory"); ATT_SWRITE(0, 0); __syncthreads();
  qkt<ND0, MODE>(pA0, pA1, K_lds, qr, negm, r32, hi); partialSM<MODE, true>(pA0, pA1, m_reg, negm, alA);
  ATT_SLOAD(1, 64); if (2 < NT) ATT_SLOAD(0, 128);
  ATT_SWAIT(); ATT_SWRITE(1, 1); __syncthreads();
  int bp = 0, bc = 1, bn = 2;
  if (wid >= 4) __builtin_amdgcn_s_setprio(1);
#define ATT_ROT() do { const int t_ = bp; bp = bc; bc = bn; bn = t_; } while (0)
  for (int j = 1; j + 1 < NT; j += 2) {
    ATT_SBAR(); qkt<ND0, MODE>(pB0, pB1, K_lds + bc * SHM_K, qr, negm, r32, hi);
    finishSM(pA0, pA1, alA, l_reg, pa0, pa1, pa2, pa3); ATT_SBAR();
    ATT_SLOAD(1, (j + 2) * 64); ATT_SBAR();
    pv_all<NB>(o, vb0 + bp * SHM_V, pa0, pa1, pa2, pa3); partialSM<MODE, false>(pB0, pB1, m_reg, negm, alB);
    ATT_SWAIT(); ATT_SWRITE(bn, 0);
    ATT_RESC(alB); __syncthreads(); ATT_ROT();
    ATT_SBAR(); qkt<ND0, MODE>(pA0, pA1, K_lds + bc * SHM_K, qr, negm, r32, hi);
    finishSM(pB0, pB1, alB, l_reg, pa0, pa1, pa2, pa3); ATT_SBAR();
    if (j + 3 < NT) ATT_SLOAD(0, (j + 3) * 64); ATT_SBAR();
    pv_all<NB>(o, vb0 + bp * SHM_V, pa0, pa1, pa2, pa3); partialSM<MODE, false>(pA0, pA1, m_reg, negm, alA);
    ATT_SWAIT(); ATT_SWRITE(bn, 1);
    ATT_RESC(alA); __syncthreads(); ATT_ROT();
  }
  ATT_SBAR(); qkt<ND0, MODE>(pB0, pB1, K_lds + bc * SHM_K, qr, negm, r32, hi);
  finishSM(pA0, pA1, alA, l_reg, pa0, pa1, pa2, pa3); ATT_SBAR();
  pv_all<NB>(o, vb0 + bp * SHM_V, pa0, pa1, pa2, pa3); partialSM<MODE, false>(pB0, pB1, m_reg, negm, alB);
  ATT_RESC(alB);
  finishSM(pB0, pB1, alB, l_reg, pa0, pa1, pa2, pa3); ATT_SBAR();
  pv_all<NB>(o, vb0 + bc * SHM_V, pa0, pa1, pa2, pa3);
#undef ATT_ROT
  __builtin_amdgcn_s_setprio(0);
  if (hi == 0) li_l[r32] = l_reg; asm volatile("s_waitcnt lgkmcnt(0)" ::: "memory");
  float rli[16];
#pragma unroll
  for (int r = 0; r < 16; ++r) rli[r] = __builtin_amdgcn_rcpf(li_l[crow(r, hi)]);
  bf16* Ow = Ob + (long)(wid * 32) * ldo;
  if constexpr (C::OSTAGE) { unsigned short* stg = (unsigned short*)(lds + 3 * SHM_V + 3 * SHM_K + 8 * 64 * 4 + wid * C::OST_BYTES);
#pragma unroll
    for (int r = 0; r < 16; ++r) { const int orow = crow(r, hi);
#pragma unroll
      for (int d0 = 0; d0 < NB; ++d0) stg[orow * DV + d0 * 32 + r32] = f2bf1(o[d0][r] * rli[r]); }
    asm volatile("s_waitcnt lgkmcnt(0)" ::: "memory");
    constexpr int CPR = DV / 8;
#pragma unroll
    for (int i = 0; i < (32 * CPR) / 64; ++i) { const int p = i * 64 + lane, row = p / CPR, ch = p % CPR;
      const u32x4 v = *(const u32x4*)(stg + row * DV + ch * 8); *(u32x4*)(Ow + (long)row * ldo + ch * 8) = v; } }
  else {
#pragma unroll
    for (int r = 0; r < 16; ++r) { const int orow = crow(r, hi);
#pragma unroll
      for (int d0 = 0; d0 < NB; ++d0) Ow[(long)orow * ldo + d0 * 32 + r32] = f2bf1(o[d0][r] * rli[r]); } }
  if constexpr (SSQ) {
#pragma unroll
    for (int r = 0; r < 16; ++r) {
#pragma unroll
      for (int d0 = 0; d0 < NB; ++d0) { const float v = o[d0][r] * rli[r]; ssacc[r] += v * v; } } }
  __syncthreads();
#undef ATT_SLOAD
#undef ATT_SWRITE
#undef ATT_SWAIT
#undef ATT_RESC
}

template <bool SSQ>
__device__ __forceinline__ void attn_unit_2h(const bf16* __restrict__ QbA, const bf16* __restrict__ QbB, int ldq, const bf16* __restrict__ K1, int ldk1, const bf16* __restrict__ Vh, int ldv,
                                             bf16* __restrict__ ObA, bf16* __restrict__ ObB, int ldo, int nkeys, char* lds, float* sslds) {
  using C = AttnCfg<64, 0, 64>;
  constexpr int ND0 = 4, NB = 2, DV = 64, SHM_V = C::VT_BYTES, SHM_K = C::KT_BYTES;
  int tid_ = threadIdx.x; asm volatile("" : "+v"(tid_));
  const int tid = tid_, wid = tid >> 6, lane = tid & 63, r32 = lane & 31, hi = lane >> 5;
  char* V_lds = lds; char* K_lds = lds + 4 * SHM_V;
  float* li_l = (float*)(lds + 4 * SHM_V + 4 * SHM_K) + wid * 64;
  float lA = 0.f, lB = 0.f, mdum = 0.f, aldum; f32x16 oA[NB], oB[NB], ndum = f32x16{}; bf16x8 qA[ND0], qB[ND0];
#pragma unroll
  for (int d = 0; d < NB; ++d) { oA[d] = f32x16{}; oB[d] = f32x16{}; }
  { const long qo = (long)(wid * 32 + r32) * ldq + hi * 8;
#pragma unroll
    for (int d0 = 0; d0 < ND0; ++d0) { qA[d0] = *reinterpret_cast<const bf16x8*>(QbA + qo + d0 * 16); qB[d0] = *reinterpret_cast<const bf16x8*>(QbB + qo + d0 * 16); } }
  const int srow = tid >> 3, scol = (tid & 7) * 8, klds = (tid & 7) * KCH + (tid >> 3) * 16, vlds = v_st<NB>(tid >> 3, (tid & 7) * 8);
  const unsigned koff = (unsigned)(srow * ldk1 + scol) * 2u, voff = (unsigned)(srow * ldv + scol) * 2u;
  const int vb0 = (int)(uintptr_t)V_lds + v_rd_base(lane);
  struct Slot { bf16x8 k, v; } sr_[2];
#define A2_SLOAD(i, k0) do { sr_[i].k = *reinterpret_cast<const bf16x8*>((const char*)K1 + (size_t)(k0) * (size_t)ldk1 * 2 + koff); sr_[i].v = *reinterpret_cast<const bf16x8*>((const char*)Vh + (size_t)(k0) * (size_t)ldv * 2 + voff); } while (0)
#define A2_SWRITE(b, i) do { *(bf16x8*)(V_lds + (b) * SHM_V + vlds) = sr_[i].v; *(bf16x8*)(K_lds + (b) * SHM_K + klds) = sr_[i].k; } while (0)
#define A2_MF(a, b, c) __builtin_amdgcn_mfma_f32_32x32x16_bf16(a, b, c, 0, 0, 0)
#define A2_PK(L, H) (bf16x8){L[0], L[1], L[2], L[3], H[0], H[1], H[2], H[3]}
#define A2_VO(d0, ks, half) ((d0) * 512 + (2 * (ks) + (half)) * NB * 512)
  const int NT = nkeys / 64;
  A2_SLOAD(0, 0); A2_SLOAD(1, 64); asm volatile("s_waitcnt vmcnt(0)" ::: "memory"); A2_SWRITE(0, 0); A2_SWRITE(1, 1); __syncthreads();
  if (wid >= 4) __builtin_amdgcn_s_setprio(1);
  f32x16 sA0, sA1, sB0, sB1; bf16x8 a0, a1, a2, a3, b0, b1, b2, b3;
#define A2_TILE(CUR) do { \
    const char* kb_ = K_lds + (CUR) * SHM_K + hi * KCH + r32 * 16; \
    bf16x8 kf0[ND0], kf1[ND0]; \
    _Pragma("unroll") for (int d0 = 0; d0 < ND0; ++d0) { kf0[d0] = *reinterpret_cast<const bf16x8*>(kb_ + 2 * d0 * KCH); kf1[d0] = *reinterpret_cast<const bf16x8*>(kb_ + 2 * d0 * KCH + 512); } \
    ATT_SBAR(); \
    sA0 = A2_MF(kf0[0], qA[0], f32x16{}); sA1 = A2_MF(kf1[0], qA[0], f32x16{}); \
    _Pragma("unroll") for (int d0 = 1; d0 < ND0; ++d0) { sA0 = A2_MF(kf0[d0], qA[d0], sA0); sA1 = A2_MF(kf1[d0], qA[d0], sA1); } \
    ATT_SBAR(); \
    sB0 = A2_MF(kf0[0], qB[0], f32x16{}); sB1 = A2_MF(kf1[0], qB[0], f32x16{}); \
    _Pragma("unroll") for (int d0 = 1; d0 < ND0; ++d0) { sB0 = A2_MF(kf0[d0], qB[d0], sB0); sB1 = A2_MF(kf1[d0], qB[d0], sB1); } \
    partialSM<1, false>(sA0, sA1, mdum, ndum, aldum); finishSM(sA0, sA1, 1.f, lA, a0, a1, a2, a3); \
    ATT_SBAR(); \
    { const int vb = vb0 + (CUR) * SHM_V; \
      const s16x4 l0 = tr_read<A2_VO(0, 0, 0)>(vb), h0 = tr_read<A2_VO(0, 0, 1)>(vb), l1 = tr_read<A2_VO(0, 1, 0)>(vb), h1 = tr_read<A2_VO(0, 1, 1)>(vb); \
      const s16x4 l2 = tr_read<A2_VO(0, 2, 0)>(vb), h2 = tr_read<A2_VO(0, 2, 1)>(vb), l3 = tr_read<A2_VO(0, 3, 0)>(vb), h3 = tr_read<A2_VO(0, 3, 1)>(vb); \
      const s16x4 m0 = tr_read<A2_VO(1, 0, 0)>(vb), n0 = tr_read<A2_VO(1, 0, 1)>(vb), m1 = tr_read<A2_VO(1, 1, 0)>(vb), n1 = tr_read<A2_VO(1, 1, 1)>(vb); \
      const s16x4 m2 = tr_read<A2_VO(1, 2, 0)>(vb), n2 = tr_read<A2_VO(1, 2, 1)>(vb), m3 = tr_read<A2_VO(1, 3, 0)>(vb), n3 = tr_read<A2_VO(1, 3, 1)>(vb); \
      asm volatile("s_waitcnt lgkmcnt(0)" ::: "memory"); ATT_SBAR(); \
      oA[0] = A2_MF(a0, A2_PK(l0, h0), oA[0]); oA[1] = A2_MF(a0, A2_PK(m0, n0), oA[1]); oA[0] = A2_MF(a1, A2_PK(l1, h1), oA[0]); oA[1] = A2_MF(a1, A2_PK(m1, n1), oA[1]); \
      oA[0] = A2_MF(a2, A2_PK(l2, h2), oA[0]); oA[1] = A2_MF(a2, A2_PK(m2, n2), oA[1]); oA[0] = A2_MF(a3, A2_PK(l3, h3), oA[0]); oA[1] = A2_MF(a3, A2_PK(m3, n3), oA[1]); \
      partialSM<1, false>(sB0, sB1, mdum, ndum, aldum); finishSM(sB0, sB1, 1.f, lB, b0, b1, b2, b3); \
      ATT_SBAR(); \
      oB[0] = A2_MF(b0, A2_PK(l0, h0), oB[0]); oB[1] = A2_MF(b0, A2_PK(m0, n0), oB[1]); oB[0] = A2_MF(b1, A2_PK(l1, h1), oB[0]); oB[1] = A2_MF(b1, A2_PK(m1, n1), oB[1]); \
      oB[0] = A2_MF(b2, A2_PK(l2, h2), oB[0]); oB[1] = A2_MF(b2, A2_PK(m2, n2), oB[1]); oB[0] = A2_MF(b3, A2_PK(l3, h3), oB[0]); oB[1] = A2_MF(b3, A2_PK(m3, n3), oB[1]); } \
    } while (0)
#define A2_STEP(CUR, NXT) do { \
    { const int np_ = (jp + 1 < NP) ? jp + 1 : NP - 1; A2_SLOAD(0, (2 * np_) * 64); A2_SLOAD(1, (2 * np_ + 1) * 64); } \
    A2_TILE(2 * (CUR)); A2_TILE(2 * (CUR) + 1); \
    if (jp + 1 < NP) { asm volatile("s_waitcnt vmcnt(0)" ::: "memory"); A2_SWRITE(2 * (NXT), 0); A2_SWRITE(2 * (NXT) + 1, 1); } \
    __syncthreads(); } while (0)
  const int NP = NT / 2;
  for (int jp = 0; jp < NP; jp += 2) { A2_STEP(0, 1); ++jp; A2_STEP(1, 0); --jp; }
#undef A2_STEP
#undef A2_TILE
  __builtin_amdgcn_s_setprio(0);
#define A2_EPI(O_, L_, OB_) do { \
    if (hi == 0) li_l[r32] = (L_); asm volatile("s_waitcnt lgkmcnt(0)" ::: "memory"); \
    float rli[16]; _Pragma("unroll") for (int r = 0; r < 16; ++r) rli[r] = __builtin_amdgcn_rcpf(li_l[crow(r, hi)]); \
    bf16* Ow = (OB_) + (long)(wid * 32) * ldo; unsigned short* stg = (unsigned short*)(lds + 4 * SHM_V + 4 * SHM_K + 8 * 64 * 4 + wid * C::OST_BYTES); \
    _Pragma("unroll") for (int r = 0; r < 16; ++r) { const int orow = crow(r, hi); _Pragma("unroll") for (int d0 = 0; d0 < NB; ++d0) stg[orow * DV + d0 * 32 + r32] = f2bf1(O_[d0][r] * rli[r]); } \
    asm volatile("s_waitcnt lgkmcnt(0)" ::: "memory"); \
    _Pragma("unroll") for (int i = 0; i < 4; ++i) { const int p = i * 64 + lane, row = p >> 3, ch = p & 7; const u32x4 v = *(const u32x4*)(stg + row * DV + ch * 8); *(u32x4*)(Ow + (long)row * ldo + ch * 8) = v; } \
    if constexpr (SSQ) { _Pragma("unroll") for (int r = 0; r < 16; ++r) { float q_ = sslds[r * 512]; _Pragma("unroll") for (int d0 = 0; d0 < NB; ++d0) { const float v = O_[d0][r] * rli[r]; q_ += v * v; } sslds[r * 512] = q_; } } \
    asm volatile("s_waitcnt lgkmcnt(0)" ::: "memory"); } while (0)
  A2_EPI(oA, lA, ObA); A2_EPI(oB, lB, ObB);
#undef A2_EPI
  __syncthreads();
#undef A2_SLOAD
#undef A2_SWRITE
#undef A2_MF
#undef A2_PK
#undef A2_VO
}

template <bool SSQ>
__device__ __forceinline__ void attn_unit_2t(const bf16* __restrict__ Qb, const bf16* __restrict__ Qb2, int ldq, const bf16* __restrict__ K1, int ldk1, const bf16* __restrict__ K2, int ldk2,
                                             const bf16* __restrict__ Vh, int ldv, bf16* __restrict__ Ob, int ldo, int nkeys, char* lds, float (&ssacc)[16]) {
  using C = AttnCfg<64, 32, 64>;
  constexpr int ND0 = 6, NB = 2, DV = 64, SHM_V = C::VT_BYTES, SHM_K = C::KT_BYTES;
  int tid_ = threadIdx.x; asm volatile("" : "+v"(tid_));
  const int tid = tid_, wid = tid >> 6, lane = tid & 63, r32 = lane & 31, hi = lane >> 5;
  char* V_lds = lds; char* K_lds = lds + 4 * SHM_V;
  float* li_l = (float*)(lds + 4 * SHM_V + 4 * SHM_K) + wid * 64;
  float l_reg = 0.f, mdum = 0.f, aldum; f32x16 o[NB], ndum = f32x16{}; bf16x8 qr[ND0];
#pragma unroll
  for (int d = 0; d < NB; ++d) o[d] = f32x16{};
  { const long qo = (long)(wid * 32 + r32) * ldq + hi * 8;
#pragma unroll
    for (int d0 = 0; d0 < 4; ++d0) qr[d0] = *reinterpret_cast<const bf16x8*>(Qb + qo + d0 * 16);
#pragma unroll
    for (int d0 = 0; d0 < 2; ++d0) qr[4 + d0] = *reinterpret_cast<const bf16x8*>(Qb2 + qo + d0 * 16); }
  const int klds = (tid & 7) * KCH + (tid >> 3) * 16, k2lds = (8 + (tid & 3)) * KCH + (tid >> 2) * 16, vlds = v_st<NB>(tid >> 3, (tid & 7) * 8);
  const unsigned koff = (unsigned)((tid >> 3) * ldk1 + (tid & 7) * 8) * 2u, k2off = (unsigned)((tid >> 2) * ldk2 + (tid & 3) * 8) * 2u, voff = (unsigned)((tid >> 3) * ldv + (tid & 7) * 8) * 2u;
  const bool k2on = tid < 256;
  const int vb0 = (int)(uintptr_t)V_lds + v_rd_base(lane);
  bf16x8 sk[2], sk2[2], sv[2]; sk2[0] = sk2[1] = bf16x8{};
#define T2_SLOAD(PAIR_) do { _Pragma("unroll") for (int t_ = 0; t_ < 2; ++t_) { const size_t k0_ = (size_t)(2 * (PAIR_) + t_) * 64; \
      sk[t_] = *reinterpret_cast<const bf16x8*>((const char*)K1 + k0_ * (size_t)ldk1 * 2 + koff); \
      if (k2on) sk2[t_] = *reinterpret_cast<const bf16x8*>((const char*)K2 + k0_ * (size_t)ldk2 * 2 + k2off); \
      sv[t_] = *reinterpret_cast<const bf16x8*>((const char*)Vh + k0_ * (size_t)ldv * 2 + voff); } } while (0)
#define T2_SWRITE(SP_) do { _Pragma("unroll") for (int t_ = 0; t_ < 2; ++t_) { const int sl_ = 2 * (SP_) + t_; \
      *(bf16x8*)(V_lds + sl_ * SHM_V + vlds) = sv[t_]; *(bf16x8*)(K_lds + sl_ * SHM_K + klds) = sk[t_]; if (k2on) *(bf16x8*)(K_lds + sl_ * SHM_K + k2lds) = sk2[t_]; } } while (0)
  const int NP = nkeys / 128;
  T2_SLOAD(0); asm volatile("s_waitcnt vmcnt(0)" ::: "memory"); T2_SWRITE(0); __syncthreads();
  if (wid >= 4) __builtin_amdgcn_s_setprio(1);
  f32x16 sA0, sA1, sB0, sB1; bf16x8 a0, a1, a2, a3, b0, b1, b2, b3;
#define T2_STEP(CUR, NXT) do { \
    { const int nx_ = (jp + 1 < NP) ? jp + 1 : NP - 1; T2_SLOAD(nx_); } \
    ATT_SBAR(); qkt<ND0, 1>(sA0, sA1, K_lds + (2 * (CUR)) * SHM_K, qr, ndum, r32, hi); \
    ATT_SBAR(); qkt<ND0, 1>(sB0, sB1, K_lds + (2 * (CUR) + 1) * SHM_K, qr, ndum, r32, hi); \
    partialSM<1, false>(sA0, sA1, mdum, ndum, aldum); finishSM(sA0, sA1, 1.f, l_reg, a0, a1, a2, a3); \
    ATT_SBAR(); pv_all<NB>(o, vb0 + (2 * (CUR)) * SHM_V, a0, a1, a2, a3); \
    partialSM<1, false>(sB0, sB1, mdum, ndum, aldum); finishSM(sB0, sB1, 1.f, l_reg, b0, b1, b2, b3); \
    ATT_SBAR(); pv_all<NB>(o, vb0 + (2 * (CUR) + 1) * SHM_V, b0, b1, b2, b3); \
    if (jp + 1 < NP) { asm volatile("s_waitcnt vmcnt(0)" ::: "memory"); T2_SWRITE(NXT); } \
    __syncthreads(); } while (0)
  for (int jp = 0; jp < NP; jp += 2) { T2_STEP(0, 1); ++jp; T2_STEP(1, 0); --jp; }
#undef T2_STEP
  __builtin_amdgcn_s_setprio(0);
  if (hi == 0) li_l[r32] = l_reg; asm volatile("s_waitcnt lgkmcnt(0)" ::: "memory");
  float rli[16];
#pragma unroll
  for (int r = 0; r < 16; ++r) rli[r] = __builtin_amdgcn_rcpf(li_l[crow(r, hi)]);
  bf16* Ow = Ob + (long)(wid * 32) * ldo;
  { unsigned short* stg = (unsigned short*)(lds + 4 * SHM_V + 4 * SHM_K + 8 * 64 * 4 + wid * C::OST_BYTES);
#pragma unroll
    for (int r = 0; r < 16; ++r) { const int orow = crow(r, hi);
#pragma unroll
      for (int d0 = 0; d0 < NB; ++d0) stg[orow * DV + d0 * 32 + r32] = f2bf1(o[d0][r] * rli[r]); }
    asm volatile("s_waitcnt lgkmcnt(0)" ::: "memory");
#pragma unroll
    for (int i = 0; i < 4; ++i) { const int p = i * 64 + lane, row = p >> 3, ch = p & 7;
      const u32x4 v = *(const u32x4*)(stg + row * DV + ch * 8); *(u32x4*)(Ow + (long)row * ldo + ch * 8) = v; } }
  if constexpr (SSQ) {
#pragma unroll
    for (int r = 0; r < 16; ++r) {
#pragma unroll
      for (int d0 = 0; d0 < NB; ++d0) { const float v = o[d0][r] * rli[r]; ssacc[r] += v * v; } } }
  __syncthreads();
#undef T2_SLOAD
#undef T2_SWRITE
}

__device__ __forceinline__ void attn_mem_unit(const bf16* __restrict__ Qb, int ldq, const bf16* __restrict__ Kh, int ldk, const bf16* __restrict__ Vh, int ldv, bf16* __restrict__ Ob, int ldo, char* lds) {
  constexpr int ND0 = 8, NB = 4, DV = 128, SHM_V = 64 * 128 * 2, SHM_K = 16 * KCH;
  int tid_ = threadIdx.x; asm volatile("" : "+v"(tid_));
  const int tid = tid_, wid = tid >> 6, lane = tid & 63, r32 = lane & 31, hi = lane >> 5;
  char* V_lds = lds; char* K_lds = lds + 4 * SHM_V;
  float* ws = (float*)(lds + 4 * SHM_V + 4 * SHM_K) + wid * 64; float* li_l = ws; float* al_l = ws + 32;
  bf16x8 qr[ND0];
  const bf16* Qw = Qb + (long)(wid * 32 + r32) * ldq + hi * 8;
#pragma unroll
  for (int d0 = 0; d0 < ND0; ++d0) qr[d0] = *reinterpret_cast<const bf16x8*>(Qw + d0 * 16);
  {
    int krow[2], kcol[2], klds[2], vlds[2];
#pragma unroll
    for (int i = 0; i < 2; ++i) { const int p = tid + 512 * i; krow[i] = p >> 4; kcol[i] = (p & 15) * 8; klds[i] = (p & 15) * KCH + (p >> 4) * 16; vlds[i] = v_st<NB>(p >> 4, (p & 15) * 8); }
#pragma unroll
    for (int b = 0; b < 2; ++b) {
      bf16x8 kk[2][2], vv[2][2];
#pragma unroll
      for (int t = 0; t < 2; ++t)
#pragma unroll
        for (int i = 0; i < 2; ++i) { const long r = (2 * b + t) * 64 + krow[i]; kk[t][i] = *reinterpret_cast<const bf16x8*>(&Kh[r * ldk + kcol[i]]); vv[t][i] = *reinterpret_cast<const bf16x8*>(&Vh[r * ldv + kcol[i]]); }
#pragma unroll
      for (int t = 0; t < 2; ++t)
#pragma unroll
        for (int i = 0; i < 2; ++i) { *(bf16x8*)(K_lds + (2 * b + t) * SHM_K + klds[i]) = kk[t][i]; *(bf16x8*)(V_lds + (2 * b + t) * SHM_V + vlds[i]) = vv[t][i]; }
    }
  }
  __syncthreads();
  const int vb0 = (int)(uintptr_t)V_lds + v_rd_base(lane);
  float m_reg = 0.f, l_reg = 0.f, al; f32x16 o[NB]; f32x16 negm = f32x16{}; asm volatile("" : "+v"(negm));
#pragma unroll
  for (int d = 0; d < NB; ++d) o[d] = f32x16{};
  f32x16 p0, p1; bf16x8 pa0, pa1, pa2, pa3;
#define ATT_MRESC(a) do { if (__any((a) != 1.f)) { if (hi == 0) al_l[r32] = (a); asm volatile("s_waitcnt lgkmcnt(0)" ::: "memory"); \
    _Pragma("unroll") for (int d = 0; d < NB; ++d) _Pragma("unroll") for (int r = 0; r < 16; ++r) o[d][r] *= al_l[crow(r, hi)]; } } while (0)
  qkt<ND0, 0>(p0, p1, K_lds, qr, negm, r32, hi); partialSM<0, true>(p0, p1, m_reg, negm, al); finishSM(p0, p1, al, l_reg, pa0, pa1, pa2, pa3);
  ATT_SBAR(); pv_all<NB>(o, vb0, pa0, pa1, pa2, pa3);
#pragma unroll
  for (int t = 1; t < 4; ++t) {
    ATT_SBAR(); qkt<ND0, 0>(p0, p1, K_lds + t * SHM_K, qr, negm, r32, hi); partialSM<0, false>(p0, p1, m_reg, negm, al); finishSM(p0, p1, al, l_reg, pa0, pa1, pa2, pa3);
    ATT_MRESC(al);
    ATT_SBAR(); pv_all<NB>(o, vb0 + t * SHM_V, pa0, pa1, pa2, pa3);
  }
#undef ATT_MRESC
  if (hi == 0) li_l[r32] = l_reg; asm volatile("s_waitcnt lgkmcnt(0)" ::: "memory");
  float rli[16];
#pragma unroll
  for (int r = 0; r < 16; ++r) rli[r] = __builtin_amdgcn_rcpf(li_l[crow(r, hi)]);
  bf16* Ow = Ob + (long)(wid * 32) * ldo;
#pragma unroll
  for (int r = 0; r < 16; ++r) { const int orow = crow(r, hi);
#pragma unroll
    for (int d0 = 0; d0 < NB; ++d0) Ow[(long)orow * ldo + d0 * 32 + r32] = f2bf1(o[d0][r] * rli[r]); }
  __syncthreads();
}
#undef ATT_SBAR
}
constexpr int NWAVES = 8;
#ifndef MK_N_LAUNCHES
#define MK_N_LAUNCHES 1
#endif
constexpr int BATCH = 8, SEQ = 4096, DM = 1024, DEPTH = 4, MTOK = BATCH * SEQ;
constexpr int IN_W = 1184, IN_WP = 1280;
constexpr int MEM_T = 256, MROWS = BATCH * MEM_T;
constexpr int NEXP = 16, CAP = 512, EFF = 512, MOE_ROWS = NEXP * BATCH * CAP;
constexpr float EPS = 1e-6f, LOG2E = 1.4426950408889634f;
constexpr int NPH = 2 + 16 * DEPTH;
constexpr size_t MiB = 1u << 20;
constexpr size_t WS_CTL = 0, CTL_ZERO_BYTES = 1 * MiB;
constexpr size_t WS_TABG = 1 * MiB, WS_TABM = 2 * MiB, WS_WR = 2 * MiB + 512 * 1024, WS_GAINS = 3 * MiB, WS_SSO = 3 * MiB + 64 * 1024, WS_SSX = 346 * MiB, WS_RS1 = WS_SSO + 512 * 1024, WS_RS3 = WS_RS1 + 128 * 1024, WS_RG = 118 * MiB + 256 * 1024, WS_SSL = 118 * MiB + 512 * 1024;
constexpr size_t WS_WSMALL = 4 * MiB, WSMALL_STRIDE = 10 * MiB;
constexpr size_t OFF_WIN = 0, OFF_WQB = 5 * MiB / 2, OFF_WKVB = 3 * MiB, OFF_WO = 7 * MiB / 2, OFF_WMQ = 11 * MiB / 2, OFF_WMKV = 13 * MiB / 2, OFF_WMO = 17 * MiB / 2;
constexpr size_t WS_WGU = 44 * MiB, WS_WD = 76 * MiB;
constexpr size_t WS_MEMN = 92 * MiB, WS_MEMKV = 96 * MiB;
constexpr size_t WS_AFF = 112 * MiB, WS_AFFT = 114 * MiB, WS_SLOT = 116 * MiB, WS_IDX = 118 * MiB;
constexpr size_t WS_H = 120 * MiB, WS_PROJ = 184 * MiB, WS_QG = 264 * MiB, WS_KG = 296 * MiB, WS_VG = 304 * MiB, WS_LAT = 312 * MiB, WS_KROPE = 344 * MiB, WS_QM = 346 * MiB;
constexpr size_t WS_XB = 264 * MiB;
constexpr size_t WS_O = WS_H, WS_KVM = WS_PROJ, WS_QMEM = 184 * MiB, WS_OMEM = 216 * MiB, WS_XG = 184 * MiB, WS_Y = WS_XG, WS_ACT = 312 * MiB;
constexpr size_t WS_WGU2 = 394 * MiB, WS_WD2 = 426 * MiB;
constexpr size_t WS_X = 442 * MiB;
constexpr size_t WS_END = 506 * MiB;
constexpr int CW_BND = 65536;
constexpr int CW_BAR = 4096;
constexpr int RING_BYTES = 131072, LDSCTL_OFF = 135168, MISC_OFF = LDSCTL_OFF + 320, GTAB_OFF = LDSCTL_OFF + 1024, STAB_OFF = GTAB_OFF + 8192, LDS_BYTES = 163840;

#define GAS __attribute__((address_space(1)))
#define LAS __attribute__((address_space(3)))
typedef unsigned short bf16;
typedef unsigned v4u __attribute__((ext_vector_type(4)));
typedef float f32x4 __attribute__((ext_vector_type(4)));
#define LDS_WAIT() asm volatile("s_waitcnt lgkmcnt(0)" ::: "memory")
__device__ __forceinline__ unsigned pk2(float lo, float hi) { unsigned r; asm volatile("v_cvt_pk_bf16_f32 %0, %1, %2" : "=v"(r) : "v"(lo), "v"(hi)); return r; }
__device__ __forceinline__ float bflo(unsigned w) { return __uint_as_float(w << 16); }
__device__ __forceinline__ float bfhi(unsigned w) { return __uint_as_float(w & 0xffff0000u); }
#define UNPACK8(W_, V_) do { V_[0] = bflo(W_[0]); V_[1] = bfhi(W_[0]); V_[2] = bflo(W_[1]); V_[3] = bfhi(W_[1]); V_[4] = bflo(W_[2]); V_[5] = bfhi(W_[2]); V_[6] = bflo(W_[3]); V_[7] = bfhi(W_[3]); } while (0)
#define PACK8(V_, W_) do { W_[0] = pk2(V_[0], V_[1]); W_[1] = pk2(V_[2], V_[3]); W_[2] = pk2(V_[4], V_[5]); W_[3] = pk2(V_[6], V_[7]); } while (0)
__device__ __forceinline__ float wave_sum(float v) {
#pragma unroll
    for (int o = 1; o < 64; o <<= 1) v += __shfl_xor(v, o);
    return v;
}
__device__ __forceinline__ int wave_sum_i(int v) {
#pragma unroll
    for (int o = 1; o < 64; o <<= 1) v += __shfl_xor(v, o);
    return v;
}

#define XB_TMO      128
#define XB_XCNT(j)  (256  + 64 * (j))
#define XB_XSUB(j)  (1280 + 64 * (j))
#define XB_XGEN(j)  (2304 + 64 * (j))
#define XB_TOP      3328
#define XB_TOPGEN   3392
#define XCD_BAR_WORDS 3456
#define XB_SPIN_CAP (1u << 20)
__device__ __forceinline__ unsigned xb_ld(unsigned* p)              { return __hip_atomic_load(p, __ATOMIC_RELAXED, __HIP_MEMORY_SCOPE_AGENT); }
__device__ __forceinline__ unsigned xb_add(unsigned* p, unsigned v) { return __hip_atomic_fetch_add(p, v, __ATOMIC_RELAXED, __HIP_MEMORY_SCOPE_AGENT); }
__device__ __forceinline__ unsigned xb_xcc_id() { return (unsigned)__builtin_amdgcn_s_getreg((3 << 11) | 20) & 0xFu; }
#define XB_SPIN(cond, bar) do { unsigned _sp = 0; while (cond) { __builtin_amdgcn_s_sleep(1); \
    if ((++_sp & 255u) == 0u) { if (xb_ld(&(bar)[XB_TMO])) break; if (_sp > XB_SPIN_CAP) { atomicAdd(&(bar)[XB_TMO], 1u); break; } } } } while (0)
struct XcdBarrier { unsigned* bar; unsigned x; volatile LAS unsigned* st; };
__device__ __forceinline__ XcdBarrier xcd_barrier_post(unsigned* bar, volatile LAS unsigned* st) {
    XcdBarrier b; b.bar = bar; b.x = xb_xcc_id(); b.st = st;
    if (threadIdx.x == 0) (void)xb_add(&bar[XB_XCNT(b.x)], 1u);
    return b;
}
__device__ __forceinline__ void xcd_barrier_complete(unsigned* bar, unsigned x, unsigned& nloc, unsigned& nx) {
    const unsigned G = gridDim.x * gridDim.y * gridDim.z;
    unsigned sum, cnt, mine, sp = 0u;
    for (;;) {
        sum = 0u; cnt = 0u; mine = 0u;
#pragma unroll
        for (unsigned j = 0; j < 16; ++j) { const unsigned c = xb_ld(&bar[XB_XCNT(j)]); sum += c; cnt += (c > 0u) ? 1u : 0u; mine = (j == x) ? c : mine; }
        if (sum == G) break;
        __builtin_amdgcn_s_sleep(1);
        if ((++sp & 255u) == 0u) { if (xb_ld(&bar[XB_TMO])) break; if (sp > XB_SPIN_CAP) { atomicAdd(&bar[XB_TMO], 1u); break; } }
    }
    nloc = mine > 0u ? mine : 1u; nx = cnt > 0u ? cnt : 1u;
}
__device__ __forceinline__ void xcd_barrier(const XcdBarrier& b) {
    asm volatile("s_waitcnt vmcnt(0)" ::: "memory");
    __syncthreads();
    if (threadIdx.x == 0) {
        unsigned* bar = b.bar;
        __builtin_amdgcn_s_waitcnt(0);
        unsigned nloc = b.st[0], nx = b.st[1];
        if (nloc == 0u) { xcd_barrier_complete(bar, b.x, nloc, nx); b.st[0] = nloc; b.st[1] = nx; }
        const unsigned old = xb_add(&bar[XB_XSUB(b.x)], 1u);
        const unsigned gen = old / nloc;
        if (old + 1u == (gen + 1u) * nloc) {
            __builtin_amdgcn_fence(__ATOMIC_RELEASE, "agent");
            asm volatile("s_waitcnt vmcnt(0)" ::: "memory");
            const unsigned og = xb_add(&bar[XB_TOP], 1u);
            const unsigned tg = og / nx;
            if (og + 1u == (tg + 1u) * nx) xb_add(&bar[XB_TOPGEN], 1u);
            else XB_SPIN(xb_ld(&bar[XB_TOPGEN]) == tg, bar);
            __builtin_amdgcn_fence(__ATOMIC_ACQUIRE, "agent");
            xb_add(&bar[XB_XGEN(b.x)], 1u);
            asm volatile("s_waitcnt vmcnt(0)" ::: "memory");
        } else {
            XB_SPIN(xb_ld(&bar[XB_XGEN(b.x)]) == gen, bar);
            __builtin_amdgcn_fence(__ATOMIC_ACQUIRE, "agent");
            asm volatile("s_waitcnt vmcnt(0)" ::: "memory");
        }
    }
    __syncthreads();
}

struct Args { const float* in[24]; float* out; unsigned char* ws; int ph_lo, ph_hi; };
struct Ctx {
    LAS unsigned char* lds; char* ldsg;
    int tid, lane, wave, vcu, vcu0, G, G0, gw, NGW;
    bf16* x; float* out;
    unsigned char* ws;
};
#define WSP(T, off) ((T*)(F.ws + (off)))
__device__ __forceinline__ void refresh(Ctx& F) { int t = threadIdx.x; asm volatile("" : "+v"(t)); F.tid = t; F.lane = t & 63;
    int w = __builtin_amdgcn_readfirstlane(t >> 6), v = F.vcu0, g = F.G0; asm volatile("" : "+s"(w), "+s"(v), "+s"(g)); F.wave = w; F.vcu = v; F.G = g; F.gw = v * NWAVES + w; F.NGW = g * NWAVES; }

__device__ __forceinline__ int il32(int i) { return (i < 16) ? 2 * i : 2 * (i - 16) + 1; }
__device__ __forceinline__ int il64(int d) { return (d < 32) ? 2 * d : 2 * (d - 32) + 1; }
__device__ __forceinline__ int dstrow(int kind, int n) {
    if (kind == 1) {
        if (n < 512) { const int h = n >> 6, p = il64(n & 63); return 256 * (h >> 2) + 128 * (p >> 5) + 32 * (h & 3) + (p & 31); }
        if (n < 640) { const int kh = (n - 512) >> 6, p = il64(n & 63); return 512 + 128 * (p >> 5) + 32 * kh + (p & 31); }
        if (n < 768) { const int vh = (n - 640) >> 6, d = n & 63; return 512 + 128 * (d >> 5) + 32 * (2 + vh) + (d & 31); }
        if (n >= 1152) return 1152 + il32(n - 1152);
        return n; }
    if (kind == 2) { const int h = n / 96, p = n % 96; return (p < 64) ? h * 64 + p : 512 + h * 32 + il32(p - 64); }
    if (kind == 3) return (n >> 7) * 256 + (n & 127);
    if (kind == 4) return (n >> 7) * 256 + 128 + (n & 127);
    return n;
}
__device__ __forceinline__ void tr_item(const float* W, int N, const float* gain, bf16* WT, int ldk, int kind, int item, LAS float* scr, int lane) {
    const int nblk = (N + 63) / 64, kb = item / nblk, nb = item % nblk, k0 = 64 * kb, n0 = 64 * nb;
    const int lr = lane >> 4, lc = (lane & 15) * 4; const bool okc = (n0 + lc) < N;
    f32x4 v[16];
#pragma unroll
    for (int i = 0; i < 16; ++i) v[i] = okc ? *(const GAS f32x4*)(W + (size_t)(k0 + 4 * i + lr) * N + n0 + lc) : (f32x4){0.f, 0.f, 0.f, 0.f};
#pragma unroll
    for (int i = 0; i < 16; ++i) { const int kk = 4 * i + lr; const float gk = gain ? gain[k0 + kk] : 1.0f; LAS float* d = scr + kk * 65 + lc;
        d[0] = v[i].x * gk; d[1] = v[i].y * gk; d[2] = v[i].z * gk; d[3] = v[i].w * gk; }
    LDS_WAIT(); asm volatile("" ::: "memory");
    const int c = lane & 7;
#pragma unroll
    for (int j = 0; j < 8; ++j) { const int n = (lane >> 3) + 8 * j; const LAS float* s = scr + (8 * c) * 65 + n;
        v4u o; o.x = pk2(s[0 * 65], s[1 * 65]); o.y = pk2(s[2 * 65], s[3 * 65]); o.z = pk2(s[4 * 65], s[5 * 65]); o.w = pk2(s[6 * 65], s[7 * 65]);
        if (n0 + n < N) *(GAS v4u*)(WT + (size_t)dstrow(kind, n0 + n) * ldk + k0 + 8 * c) = o; }
    LDS_WAIT(); asm volatile("" ::: "memory");
}
constexpr int SMALL_ITEMS = 1152;
__device__ __forceinline__ void small_weight_item(const Ctx& F, const Args& A, int l, int r, LAS float* scr) {
    bf16* wl = WSP(bf16, WS_WSMALL + (size_t)l * WSMALL_STRIDE);
    if (r < 304) { tr_item(A.in[3] + (size_t)l * DM * IN_W, IN_W, A.in[2] + l * DM, wl + OFF_WIN / 2, DM, 1, r, scr, F.lane); return; } r -= 304;
    if (r < 48)  { tr_item(A.in[8] + (size_t)l * 256 * 768, 768, A.in[6] + l * 256, wl + OFF_WQB / 2, 256, 2, r, scr, F.lane); return; } r -= 48;
    if (r < 32)  { tr_item(A.in[9] + (size_t)l * 128 * 1024, 1024, A.in[7] + l * 128, wl + OFF_WKVB / 2, 128, 0, r, scr, F.lane); return; } r -= 32;
    if (r < 256) { const int kb = r / 16; const float* gain = (kb < 8) ? (A.in[10] + l * 512) : (A.in[11] + l * 512 - 512);
                   tr_item(A.in[12] + (size_t)l * DM * DM, DM, gain, wl + OFF_WO / 2, DM, 0, r, scr, F.lane); return; } r -= 256;
    if (r < 128) { tr_item(A.in[15] + (size_t)l * DM * 512, 512, A.in[13] + l * DM, wl + OFF_WMQ / 2, DM, 0, r, scr, F.lane); return; } r -= 128;
    if (r < 256) { tr_item(A.in[16] + (size_t)l * DM * DM, DM, A.in[14] + l * DM, wl + OFF_WMKV / 2, DM, 0, r, scr, F.lane); return; } r -= 256;
    tr_item(A.in[17] + (size_t)l * 512 * DM, DM, nullptr, wl + OFF_WMO / 2, 512, 0, r, scr, F.lane);
}
constexpr int MOE_ITEMS = 3 * 2048;
__device__ __forceinline__ void moe_weight_item(const Ctx& F, const Args& A, int l, int it, LAS float* scr) {
    bf16* wgu = WSP(bf16, (l & 1) ? WS_WGU2 : WS_WGU); bf16* wd = WSP(bf16, (l & 1) ? WS_WD2 : WS_WD);
    const int which = it >> 11, e = (it >> 7) & 15, r = it & 127;
    if (which < 2) tr_item((which == 0 ? A.in[20] : A.in[21]) + (size_t)(l * NEXP + e) * DM * EFF, EFF, A.in[18] + l * DM, wgu + (size_t)e * 1024 * 1024, DM, 3 + which, r, scr, F.lane);
    else           tr_item(A.in[22] + (size_t)(l * NEXP + e) * EFF * DM, DM, nullptr, wd + (size_t)e * 1024 * 512, EFF, 0, r, scr, F.lane);
}
__device__ __forceinline__ void convert_moe_weights(const Ctx& F, const Args& A, int l) {
    LAS float* scr = (LAS float*)(F.lds + F.wave * 16640);
    for (int it = F.gw; it < MOE_ITEMS; it += F.NGW) moe_weight_item(F, A, l, it, scr);
}

__device__ __forceinline__ void rms_row_f32(const float* xrow, bf16* xb, bf16* orow, float* rs, int lane) {
    const GAS f32x4* xr = (const GAS f32x4*)xrow + lane;
    f32x4 v[4]; float s = 0.f;
#pragma unroll
    for (int j = 0; j < 4; ++j) { v[j] = xr[64 * j]; s += (v[j].x * v[j].x + v[j].y * v[j].y) + (v[j].z * v[j].z + v[j].w * v[j].w); }
    const float rstd = __builtin_amdgcn_rsqf(wave_sum(s) * (1.f / DM) + EPS);
    if (xb) { GAS unsigned long long* x8 = (GAS unsigned long long*)xb + lane;
#pragma unroll
        for (int j = 0; j < 4; ++j) x8[64 * j] = (unsigned long long)pk2(v[j].x, v[j].y) | ((unsigned long long)pk2(v[j].z, v[j].w) << 32); }
    if (rs && lane == 0) *rs = rstd;
    if (orow) { GAS unsigned long long* o8 = (GAS unsigned long long*)orow + lane;
#pragma unroll
        for (int j = 0; j < 4; ++j) o8[64 * j] = (unsigned long long)pk2(v[j].x * rstd, v[j].y * rstd) | ((unsigned long long)pk2(v[j].z * rstd, v[j].w * rstd) << 32); }
}
__device__ __forceinline__ void phase_prologue(const Ctx& F, const Args& A) {
    LAS float* scr = (LAS float*)(F.lds + F.wave * 16640);
    for (int it = F.gw; it < DEPTH * SMALL_ITEMS; it += F.NGW) small_weight_item(F, A, it / SMALL_ITEMS, it % SMALL_ITEMS, scr);
    const int gt = F.vcu * (NWAVES * 64) + F.tid, NGT = F.G * NWAVES * 64;
    for (int i = gt; i < DEPTH * 12288; i += NGT) { const int l = i / 12288, r = i % 12288;
        bf16* wl = WSP(bf16, WS_WSMALL + (size_t)l * WSMALL_STRIDE);
        *(GAS v4u*)(wl + OFF_WIN / 2 + (size_t)IN_W * DM + (size_t)r * 8) = (v4u){0u, 0u, 0u, 0u}; }
    for (int i = gt; i < 1536; i += NGT) WSP(float, WS_GAINS)[i] = (i < 256) ? A.in[4][i] : (i < 512) ? A.in[5][i - 256] : A.in[23][i - 512];
    for (int i = gt; i < DEPTH * NEXP * DM; i += NGT) { const int l = i / (NEXP * DM), e = (i / DM) % NEXP, k = i % DM;
        WSP(float, WS_WR)[i] = A.in[19][(size_t)(l * DM + k) * NEXP + e] * A.in[18][l * DM + k]; }
    for (int i = gt; i < SEQ * 48; i += NGT) { const int s = i / 48, j = i % 48; const float row = (float)(s >> 6), col = (float)(s & 63);
        const bool isg = (j < 32); const int j2 = isg ? j : j - 32, half = isg ? 16 : 8, jj = j2 & (half - 1);
        const float inv = __builtin_amdgcn_exp2f(-(float)(2 * jj) / (float)(2 * half) * 13.287712379549449f);
        const float ang = ((j2 < half) ? row : col) * inv;
        double td = (double)ang * 0.15915494309189535; td -= rint(td);
        const float sn = __builtin_amdgcn_sinf((float)td), cs = __builtin_amdgcn_cosf((float)td);
        float* dst = isg ? (WSP(float, WS_TABG) + ((size_t)s * 32 + j2) * 2) : (WSP(float, WS_TABM) + ((size_t)s * 16 + j2) * 2);
        dst[0] = cs; dst[1] = sn; }
    for (int m = F.gw; m < MROWS; m += F.NGW) rms_row_f32(A.in[1] + (size_t)m * DM, nullptr, WSP(bf16, WS_MEMN) + (size_t)m * DM, nullptr, F.lane);
}
__device__ __forceinline__ void phase_prologue2(const Ctx& F, const Args& A, int wi, int nw, int f0, int f1) {
    LAS float* scr = (LAS float*)(F.lds + F.wave * 16640);
    for (int it = MOE_ITEMS / 16 * f0 + wi; it < MOE_ITEMS / 16 * f1; it += nw) moe_weight_item(F, A, 0, it, scr);
    {
        const int lane = F.lane; f32x4 vn[4]; const int m0 = MTOK / 16 * f0 + wi, m1 = MTOK / 16 * f1;
#pragma unroll
        for (int j = 0; j < 4; ++j) vn[j] = (f32x4){0.f, 0.f, 0.f, 0.f};
        if (m0 < m1) { const GAS f32x4* xr = (const GAS f32x4*)(A.in[0] + (size_t)m0 * DM) + lane;
#pragma unroll
            for (int j = 0; j < 4; ++j) vn[j] = xr[64 * j]; }
        for (int m = m0; m < m1; m += nw) {
            f32x4 v[4]; float s = 0.f;
#pragma unroll
            for (int j = 0; j < 4; ++j) { v[j] = vn[j]; s += (v[j].x * v[j].x + v[j].y * v[j].y) + (v[j].z * v[j].z + v[j].w * v[j].w); }
            if (m + nw < m1) { const GAS f32x4* xr = (const GAS f32x4*)(A.in[0] + (size_t)(m + nw) * DM) + lane;
#pragma unroll
                for (int j = 0; j < 4; ++j) vn[j] = xr[64 * j]; }
            const float rstd = __builtin_amdgcn_rsqf(wave_sum(s) * (1.f / DM) + EPS);
            GAS unsigned long long* x8 = (GAS unsigned long long*)(F.x + (size_t)m * DM) + lane;
#pragma unroll
            for (int j = 0; j < 4; ++j) x8[64 * j] = (unsigned long long)pk2(v[j].x, v[j].y) | ((unsigned long long)pk2(v[j].z, v[j].w) << 32);
            if (lane == 0) WSP(float, WS_RS1)[m] = rstd;
        } }
}

__device__ __forceinline__ void rope4(float* v, const float* tab) {
    const f32x4 t0 = *(const f32x4*)tab, t1 = *(const f32x4*)(tab + 4);
    float a, b;
    a = v[0]; b = v[1]; v[0] = a * t0[0] - b * t0[1]; v[1] = b * t0[0] + a * t0[1];
    a = v[2]; b = v[3]; v[2] = a * t0[2] - b * t0[3]; v[3] = b * t0[2] + a * t0[3];
    a = v[4]; b = v[5]; v[4] = a * t1[0] - b * t1[1]; v[5] = b * t1[0] + a * t1[1];
    a = v[6]; b = v[7]; v[6] = a * t1[2] - b * t1[3]; v[7] = b * t1[2] + a * t1[3];
}
__device__ __forceinline__ void phase_postproj(const Ctx& F, int l) {
    int lane_ = F.lane; asm volatile("" : "+v"(lane_)); const int lane = lane_;
    const float* gq = WSP(float, WS_GAINS) + l * 64; const float* gk = WSP(float, WS_GAINS) + 256 + l * 64;
    float gqv[8], gkv[8];
#pragma unroll
    for (int i = 0; i < 8; ++i) { const int p = 8 * (lane & 7) + i, d = (p >> 1) + 32 * (p & 1); gqv[i] = gq[d]; gkv[i] = gk[d]; }
    const float* tabg = WSP(float, WS_TABG); const float* tabm = WSP(float, WS_TABM);
    const float C2G = 0.125f * LOG2E;
    v4u wa_n = (v4u){0u, 0u, 0u, 0u}, wb_n = wa_n, wc_n = wa_n;
    if (F.gw < MTOK) { const bf16* pr = WSP(bf16, WS_PROJ) + (size_t)F.gw * IN_WP; wa_n = *(const GAS v4u*)(pr + 8 * lane); wb_n = *(const GAS v4u*)(pr + 512 + 8 * lane); if (lane < 20) wc_n = *(const GAS v4u*)(pr + 1024 + 8 * lane); }
    for (int m = F.gw; m < MTOK; m += F.NGW) {
        const int s = m & (SEQ - 1);
        const v4u wa = wa_n, wb = wb_n, wc = wc_n;
        if (m + F.NGW < MTOK) { const bf16* pr = WSP(bf16, WS_PROJ) + (size_t)(m + F.NGW) * IN_WP; wa_n = *(const GAS v4u*)(pr + 8 * lane); wb_n = *(const GAS v4u*)(pr + 512 + 8 * lane); if (lane < 20) wc_n = *(const GAS v4u*)(pr + 1024 + 8 * lane); }
        { const v4u w = wa; float v[8]; UNPACK8(w, v);
          float ss = 0.f;
#pragma unroll
          for (int i = 0; i < 8; ++i) ss += v[i] * v[i];
          ss += __shfl_xor(ss, 1); ss += __shfl_xor(ss, 2); ss += __shfl_xor(ss, 4);
          const float rstd = __builtin_amdgcn_rsqf(ss * (1.f / 64.f) + EPS);
#pragma unroll
          for (int i = 0; i < 8; ++i) v[i] = v[i] * rstd * gqv[i];
          rope4(v, tabg + ((size_t)s * 32 + 4 * (lane & 7)) * 2);
#pragma unroll
          for (int i = 0; i < 8; ++i) v[i] *= C2G;
          v4u o; PACK8(v, o); *(GAS v4u*)(WSP(bf16, WS_QG) + (size_t)m * 512 + 8 * lane) = o; }
        { const v4u w = wb; float v[8]; UNPACK8(w, v);
          float ss = 0.f;
#pragma unroll
          for (int i = 0; i < 8; ++i) ss += v[i] * v[i];
          ss += __shfl_xor(ss, 1); ss += __shfl_xor(ss, 2); ss += __shfl_xor(ss, 4);
          const float ss8 = ss;
          ss += __shfl_xor(ss, 8); ss += __shfl_xor(ss, 16);
          if (lane < 16) {
              const float rstd = __builtin_amdgcn_rsqf(ss8 * (1.f / 64.f) + EPS);
#pragma unroll
              for (int i = 0; i < 8; ++i) v[i] = v[i] * rstd * gkv[i];
              rope4(v, tabg + ((size_t)s * 32 + 4 * (lane & 7)) * 2);
              v4u o; PACK8(v, o); *(GAS v4u*)(WSP(bf16, WS_KG) + (size_t)m * 128 + 8 * lane) = o;
          } else if (lane < 32) {
              *(GAS v4u*)(WSP(bf16, WS_VG) + (size_t)m * 128 + 8 * (lane - 16)) = w;
          } else {
              const float rstd = __builtin_amdgcn_rsqf(ss * (1.f / 256.f) + EPS);
#pragma unroll
              for (int i = 0; i < 8; ++i) v[i] *= rstd;
              v4u o; PACK8(v, o); *(GAS v4u*)(WSP(bf16, WS_LAT) + (size_t)m * 512 + 8 * (lane - 32)) = o;
          } }
        { const v4u w = wc;
          float v[8]; UNPACK8(w, v);
          float ss = 0.f;
#pragma unroll
          for (int i = 0; i < 8; ++i) ss += v[i] * v[i];
          ss += __shfl_xor(ss, 1); ss += __shfl_xor(ss, 2); ss += __shfl_xor(ss, 4); ss += __shfl_xor(ss, 8);
          if (lane < 16) {
              const float rstd = __builtin_amdgcn_rsqf(ss * (1.f / 128.f) + EPS);
#pragma unroll
              for (int i = 0; i < 8; ++i) v[i] *= rstd;
              v4u o; PACK8(v, o); *(GAS v4u*)(WSP(bf16, WS_LAT) + (size_t)m * 512 + 256 + 8 * lane) = o;
          } else if (lane < 20) {
              rope4(v, tabm + ((size_t)s * 16 + 4 * (lane - 16)) * 2);
              v4u o; PACK8(v, o); *(GAS v4u*)(WSP(bf16, WS_KROPE) + (size_t)m * 32 + 8 * (lane - 16)) = o;
          } else if (lane < 36) {
              *(GAS v4u*)(WSP(bf16, WS_LAT) + (size_t)m * 512 + 384 + 8 * (lane - 20)) = (v4u){0u, 0u, 0u, 0u};
          } }
    }
}

__device__ __forceinline__ void phase_outnorm(const Ctx& F) {
    int lane_ = F.lane; asm volatile("" : "+v"(lane_)); const int lane = lane_;
    for (int m = F.gw; m < MTOK; m += F.NGW) {
        bf16* orow = WSP(bf16, WS_O) + (size_t)m * DM;
#pragma unroll
        for (int g = 0; g < 2; ++g) {
            v4u w = *(const GAS v4u*)(orow + g * 512 + 8 * lane); float v[8]; UNPACK8(w, v);
            float ss = 0.f;
#pragma unroll
            for (int i = 0; i < 8; ++i) ss += v[i] * v[i];
            const float rstd = __builtin_amdgcn_rsqf(wave_sum(ss) * (1.f / 512.f) + EPS);
#pragma unroll
            for (int i = 0; i < 8; ++i) v[i] *= rstd;
            v4u o; PACK8(v, o); *(GAS v4u*)(orow + g * 512 + 8 * lane) = o;
        }
    }
}

constexpr int MOE_EARLY = 2048;
__device__ __forceinline__ void phase_router(const Ctx& F, const Args& A, int l) {
    int lane_ = F.lane; asm volatile("" : "+v"(lane_)); const int lane = lane_;
    int tid_ = F.tid; asm volatile("" : "+v"(tid_)); const int tid = tid_;
    typedef short rbf16x8 __attribute__((ext_vector_type(8)));
    const int NB = MTOK / 16, tok = lane & 15, kq = lane >> 4;
    const bool shareconv = (F.G == 2 * BATCH * NEXP) && (l + 1 < DEPTH);
    if (shareconv && F.vcu >= BATCH * NEXP) { LAS float* scr = (LAS float*)(F.lds + F.wave * 16640);
        for (int it = (F.vcu - BATCH * NEXP) * NWAVES + F.wave; it < MOE_EARLY; it += BATCH * NEXP * NWAVES) moe_weight_item(F, A, l + 1, it, scr);
        return; }
    const int tstep = shareconv ? BATCH * NEXP * NWAVES : F.NGW;
    int tb = F.gw;
    v4u xf[32];
#define RT_LOAD() do { const GAS v4u* xr_ = (const GAS v4u*)(F.x + ((size_t)tb * 16 + tok) * DM) + kq; _Pragma("unroll") for (int s_ = 0; s_ < 32; ++s_) xf[s_] = xr_[4 * s_]; } while (0)
    if (tb < NB) RT_LOAD();
    {
        const GAS f32x4* src = (const GAS f32x4*)(WSP(float, WS_WR) + (size_t)l * NEXP * DM);
        for (int it = tid; it < NEXP * DM / 8; it += NWAVES * 64) { const int e = it & 15, k8 = it >> 4;
            const f32x4 a = src[(e * DM + 8 * k8) / 4], b = src[(e * DM + 8 * k8) / 4 + 1];
            v4u hi, lo; hi.x = pk2(a.x, a.y); hi.y = pk2(a.z, a.w); hi.z = pk2(b.x, b.y); hi.w = pk2(b.z, b.w);
            lo.x = pk2(a.x - bflo(hi.x), a.y - bfhi(hi.x)); lo.y = pk2(a.z - bflo(hi.y), a.w - bfhi(hi.y)); lo.z = pk2(b.x - bflo(hi.z), b.y - bfhi(hi.z)); lo.w = pk2(b.z - bflo(hi.w), b.w - bfhi(hi.w));
            const int s = k8 >> 2, ln = (k8 & 3) * 16 + e;
            *(LAS v4u*)(F.lds + ((s * 2 + 0) * 64 + ln) * 16) = hi; *(LAS v4u*)(F.lds + ((s * 2 + 1) * 64 + ln) * 16) = lo; }
    }
    __syncthreads();
    while (tb < NB) {
        asm volatile("" ::: "memory");
        f32x4 ah = {0.f, 0.f, 0.f, 0.f}, al = {0.f, 0.f, 0.f, 0.f}; float ss0 = 0.f, ss1 = 0.f;
#pragma unroll
        for (int s = 0; s < 32; ++s) {
            const rbf16x8 wh = *(const LAS rbf16x8*)(F.lds + ((s * 2 + 0) * 64 + lane) * 16), wl = *(const LAS rbf16x8*)(F.lds + ((s * 2 + 1) * 64 + lane) * 16);
            const rbf16x8 xb = __builtin_bit_cast(rbf16x8, xf[s]);
            ah = __builtin_amdgcn_mfma_f32_16x16x32_bf16(wh, xb, ah, 0, 0, 0);
            al = __builtin_amdgcn_mfma_f32_16x16x32_bf16(wl, xb, al, 0, 0, 0);
            const v4u q = xf[s];
            ss0 += (bflo(q.x) * bflo(q.x) + bfhi(q.x) * bfhi(q.x)) + (bflo(q.y) * bflo(q.y) + bfhi(q.y) * bfhi(q.y));
            ss1 += (bflo(q.z) * bflo(q.z) + bfhi(q.z) * bfhi(q.z)) + (bflo(q.w) * bflo(q.w) + bfhi(q.w) * bfhi(q.w));
        }
        float ss = ss0 + ss1; ss += __shfl_xor(ss, 16); ss += __shfl_xor(ss, 32);
        const float rstd = __builtin_amdgcn_rsqf(ss * (1.f / DM) + EPS);
        const int row = tb * 16 + tok;
        if (lane < 16) WSP(float, WS_RS3)[row] = rstd;
        f32x4 lg = (ah + al) * rstd;
        float mx = fmaxf(fmaxf(lg.x, lg.y), fmaxf(lg.z, lg.w)); mx = fmaxf(mx, __shfl_xor(mx, 16)); mx = fmaxf(mx, __shfl_xor(mx, 32));
        f32x4 ex = {__expf(lg.x - mx), __expf(lg.y - mx), __expf(lg.z - mx), __expf(lg.w - mx)};
        float den = (ex.x + ex.y) + (ex.z + ex.w); den += __shfl_xor(den, 16); den += __shfl_xor(den, 32);
        ex = {ex.x / den, ex.y / den, ex.z / den, ex.w / den};
        *(f32x4*)(WSP(float, WS_AFF) + (size_t)row * 16 + 4 * kq) = ex;
        float* at = WSP(float, WS_AFFT) + ((size_t)(row >> 12) * 16 + 4 * kq) * SEQ + (row & (SEQ - 1));
        at[0] = ex.x; at[SEQ] = ex.y; at[2 * SEQ] = ex.z; at[3 * SEQ] = ex.w;
        tb += tstep; if (tb < NB) RT_LOAD();
    }
#undef RT_LOAD
    __syncthreads();
}

__device__ __forceinline__ int block_excl_scan(int v, LAS int* red, int lane, int wave, int& total) {
    int inc = v;
#pragma unroll
    for (int o = 1; o < 64; o <<= 1) { const int t = __shfl_up(inc, o); if (lane >= o) inc += t; }
    __syncthreads();
    if (lane == 63) red[wave] = inc;
    __syncthreads();
    int base = 0, tot = 0;
#pragma unroll
    for (int w = 0; w < 8; ++w) { const int t = red[w]; if (w < wave) base += t; tot += t; }
    total = tot;
    return base + inc - v;
}
__device__ __forceinline__ void phase_select(const Ctx& F, const Args& A, int l) {
    LAS int* red = (LAS int*)F.lds;
    int tid_ = F.tid; asm volatile("" : "+v"(tid_)); const int tid = tid_, lane = tid & 63, wave = F.wave;
    for (int pair = F.vcu; pair < BATCH * NEXP; pair += F.G) {
        const int b = pair >> 4, e = pair & 15;
        const GAS v4u* src = (const GAS v4u*)(WSP(float, WS_AFFT) + (size_t)pair * SEQ) + 2 * tid;
        const v4u w0 = src[0], w1 = src[1];
        unsigned v[8] = {w0.x, w0.y, w0.z, w0.w, w1.x, w1.y, w1.z, w1.w};
        unsigned T = 0u; int par = 0;
        for (int bit = 30; bit >= 0; --bit) {
            const unsigned cand = T | (1u << bit);
            int c = 0;
#pragma unroll
            for (int i = 0; i < 8; ++i) c += __popcll(__ballot(v[i] >= cand));
            if (lane == 0) red[par * 8 + wave] = c;
            __syncthreads();
            int tot = 0;
#pragma unroll
            for (int w = 0; w < 8; ++w) tot += red[par * 8 + w];
            if (tot >= CAP) T = cand;
            par ^= 1;
        }
        int cgt = 0, ceq = 0;
#pragma unroll
        for (int i = 0; i < 8; ++i) { cgt += (v[i] > T) ? 1 : 0; ceq += (v[i] == T) ? 1 : 0; }
        int ngt, neq_tot;
        (void)block_excl_scan(cgt, red + 16, lane, wave, ngt);
        int eqb = block_excl_scan(ceq, red + 16, lane, wave, neq_tot);
        const int need_eq = CAP - ngt;
        int sel[8], csel = 0;
#pragma unroll
        for (int i = 0; i < 8; ++i) { const bool iseq = (v[i] == T); sel[i] = ((v[i] > T) || (iseq && eqb < need_eq)) ? 1 : 0; eqb += iseq ? 1 : 0; csel += sel[i]; }
        int nsel;
        int pos = block_excl_scan(csel, red + 16, lane, wave, nsel);
        int* idx = WSP(int, WS_IDX) + (size_t)(e * BATCH + b) * CAP; float* rg = WSP(float, WS_RG) + (size_t)(e * BATCH + b) * CAP; const float* rs3 = WSP(float, WS_RS3) + (size_t)b * SEQ;
        int* slot = WSP(int, WS_SLOT) + ((size_t)b * SEQ + (size_t)tid * 8) * NEXP + e;
#pragma unroll
        for (int i = 0; i < 8; ++i) { if (sel[i]) { if (pos < CAP) { idx[pos] = tid * 8 + i; rg[pos] = rs3[tid * 8 + i]; } slot[i * NEXP] = pos; ++pos; } else slot[i * NEXP] = -1; }
        __syncthreads();
    }
    if (l + 1 < DEPTH) {
        const bool split = F.G > BATCH * NEXP; const int nw = split ? (F.G - BATCH * NEXP) * NWAVES : F.NGW, wi = split ? (F.vcu - BATCH * NEXP) * NWAVES + F.wave : F.gw;
        LAS float* scr = (LAS float*)(F.lds + F.wave * 16640);
        const bool shared = (F.G == 2 * BATCH * NEXP);
        const int it0 = shared ? MOE_EARLY : 0;
        const int it1 = shared ? MOE_ITEMS - BATCH * NEXP * NWAVES : MOE_ITEMS;
        if (wi >= 0) { for (int it = it0 + wi; it < it1; it += nw) moe_weight_item(F, A, l + 1, it, scr); }
        else if (shared) moe_weight_item(F, A, l + 1, it1 + F.vcu * NWAVES + F.wave, scr);
    }
}

__device__ __forceinline__ void phase_gather(const Ctx& F) {
    int lane_ = F.lane; asm volatile("" : "+v"(lane_)); const int lane = lane_;
    for (int r = F.gw; r < MOE_ROWS; r += F.NGW) {
        const int b = (r >> 9) & 7; const int t = WSP(int, WS_IDX)[r];
        const GAS v4u* src = (const GAS v4u*)(WSP(bf16, WS_H) + ((size_t)b * SEQ + t) * DM) + lane;
        GAS v4u* dst = (GAS v4u*)(WSP(bf16, WS_XG) + (size_t)r * DM) + lane;
        const v4u a = src[0], c = src[64]; dst[0] = a; dst[64] = c;
    }
}

__device__ __forceinline__ void phase_combine(const Ctx& F, const Args& A, int l, float amul) {
    int lane_ = F.lane; asm volatile("" : "+v"(lane_)); const int lane = lane_; const bool lastl = (l == DEPTH - 1);
    const float* gfin = WSP(float, WS_GAINS) + 512;
    v4u xa_n = (v4u){0u, 0u, 0u, 0u}, xc_n = xa_n; int sl_n = -1; float af_n = 0.f;
    if (F.gw < MTOK) { const GAS v4u* xp = (const GAS v4u*)(F.x + (size_t)F.gw * DM) + lane; xa_n = xp[0]; xc_n = xp[64];
        sl_n = WSP(int, WS_SLOT)[(size_t)F.gw * NEXP + (lane & 15)]; af_n = WSP(float, WS_AFF)[(size_t)F.gw * NEXP + (lane & 15)]; }
    for (int m = F.gw; m < MTOK; m += F.NGW) {
        const int b = m >> 12;
        GAS v4u* xr = (GAS v4u*)(F.x + (size_t)m * DM) + lane;
        const v4u xa = xa_n, xc = xc_n; const int sl = sl_n; const float af = amul * af_n;
        if (m + F.NGW < MTOK) { const int mn = m + F.NGW; const GAS v4u* xp = (const GAS v4u*)(F.x + (size_t)mn * DM) + lane; xa_n = xp[0]; xc_n = xp[64];
            sl_n = WSP(int, WS_SLOT)[(size_t)mn * NEXP + (lane & 15)]; af_n = WSP(float, WS_AFF)[(size_t)mn * NEXP + (lane & 15)]; }
        f32x4 x0 = (f32x4){bflo(xa.x), bfhi(xa.x), bflo(xa.y), bfhi(xa.y)}, x1 = (f32x4){bflo(xa.z), bfhi(xa.z), bflo(xa.w), bfhi(xa.w)};
        f32x4 x2 = (f32x4){bflo(xc.x), bfhi(xc.x), bflo(xc.y), bfhi(xc.y)}, x3 = (f32x4){bflo(xc.z), bfhi(xc.z), bflo(xc.w), bfhi(xc.w)};
        unsigned mask = (unsigned)(__ballot(sl >= 0 && lane < 16));
#define CMB_ACC(Y0, Y1, AE) do { x0.x += AE * bflo(Y0.x); x0.y += AE * bfhi(Y0.x); x0.z += AE * bflo(Y0.y); x0.w += AE * bfhi(Y0.y); \
            x1.x += AE * bflo(Y0.z); x1.y += AE * bfhi(Y0.z); x1.z += AE * bflo(Y0.w); x1.w += AE * bfhi(Y0.w); \
            x2.x += AE * bflo(Y1.x); x2.y += AE * bfhi(Y1.x); x2.z += AE * bflo(Y1.y); x2.w += AE * bfhi(Y1.y); \
            x3.x += AE * bflo(Y1.z); x3.y += AE * bfhi(Y1.z); x3.z += AE * bflo(Y1.w); x3.w += AE * bfhi(Y1.w); } while (0)
        while (mask) {
            const int e1 = __builtin_ctz(mask); mask &= mask - 1u;
            const bool two = mask != 0u; const int e2 = two ? __builtin_ctz(mask) : e1; if (two) mask &= mask - 1u;
            const int s1 = __shfl(sl, e1), s2 = __shfl(sl, e2); const float a1 = __shfl(af, e1), a2 = two ? __shfl(af, e2) : 0.f;
            const GAS v4u* yr1 = (const GAS v4u*)(WSP(bf16, WS_Y) + ((size_t)(e1 * BATCH + b) * CAP + s1) * DM) + lane;
            const GAS v4u* yr2 = (const GAS v4u*)(WSP(bf16, WS_Y) + ((size_t)(e2 * BATCH + b) * CAP + s2) * DM) + lane;
            const v4u y0 = yr1[0], y1 = yr1[64], z0 = yr2[0], z1 = yr2[64];
            CMB_ACC(y0, y1, a1); CMB_ACC(z0, z1, a2);
        }
#undef CMB_ACC
        float s = (x0.x * x0.x + x0.y * x0.y) + (x0.z * x0.z + x0.w * x0.w) + (x1.x * x1.x + x1.y * x1.y) + (x1.z * x1.z + x1.w * x1.w)
                + (x2.x * x2.x + x2.y * x2.y) + (x2.z * x2.z + x2.w * x2.w) + (x3.x * x3.x + x3.y * x3.y) + (x3.z * x3.z + x3.w * x3.w);
        const float rstd = __builtin_amdgcn_rsqf(wave_sum(s) * (1.f / DM) + EPS);
        if (lastl) {
            const f32x4 g0 = *(const f32x4*)(gfin + 8 * lane), g1 = *(const f32x4*)(gfin + 8 * lane + 4), g2 = *(const f32x4*)(gfin + 512 + 8 * lane), g3 = *(const f32x4*)(gfin + 512 + 8 * lane + 4);
            GAS f32x4* ow = (GAS f32x4*)(F.out + (size_t)m * DM);
            ow[2 * lane] = x0 * rstd * g0; ow[2 * lane + 1] = x1 * rstd * g1; ow[128 + 2 * lane] = x2 * rstd * g2; ow[128 + 2 * lane + 1] = x3 * rstd * g3;
        } else {
            v4u n0, n1; n0.x = pk2(x0.x, x0.y); n0.y = pk2(x0.z, x0.w); n0.z = pk2(x1.x, x1.y); n0.w = pk2(x1.z, x1.w); n1.x = pk2(x2.x, x2.y); n1.y = pk2(x2.z, x2.w); n1.z = pk2(x3.x, x3.y); n1.w = pk2(x3.z, x3.w);
            xr[0] = n0; xr[64] = n1;
            if (lane == 0) WSP(float, WS_RS1)[m] = rstd;
        }
    }
}

__device__ __forceinline__ void phase_attn_self(const Ctx& F, int l) {
    float gmq = fabsf(WSP(float, WS_GAINS)[l * 64 + F.lane]), gmk = fabsf(WSP(float, WS_GAINS)[256 + l * 64 + F.lane]);
#pragma unroll
    for (int o = 1; o < 64; o <<= 1) { gmq = fmaxf(gmq, __shfl_xor(gmq, o)); gmk = fmaxf(gmk, __shfl_xor(gmk, o)); }
    const bool bounded = (8.0f * LOG2E * gmq * gmk) < 64.0f;
    const int lane = F.lane, r32 = lane & 31, hi = lane >> 5, wid = F.wave;
#ifndef DUPATT
#define DUPATT 0
#endif
    for (int g = 0; g < 2; ++g)
      for (int rep2_ = 0; rep2_ < 1 + ((DUPATT >> g) & 1); ++rep2_)
        for (int u = F.vcu; u < 256; u += F.G) {
            const int b = u >> 5, qb = (u >> 1) & 15, hh = u & 1;
            const size_t r0 = (size_t)b * SEQ, q0 = r0 + (size_t)qb * 256;
            float ssacc[16];
#pragma unroll
            for (int r = 0; r < 16; ++r) ssacc[r] = 0.f;
            if (g == 0 && bounded) {
                float* sslds = (float*)(F.ldsg + 4 * 8192 + 4 * 8320 + 2048 + 32768) + F.tid;
#pragma unroll
                for (int r = 0; r < 16; ++r) sslds[r * 512] = 0.f;
                for (int hq = 0; hq < 4; hq += 2) { const int h = hh * 4 + hq;
                    att::attn_unit_2h<true>(WSP(bf16, WS_QG) + q0 * 512 + h * 64, WSP(bf16, WS_QG) + q0 * 512 + (h + 1) * 64, 512, WSP(bf16, WS_KG) + r0 * 128 + hh * 64, 128,
                                            WSP(bf16, WS_VG) + r0 * 128 + hh * 64, 128, WSP(bf16, WS_O) + q0 * DM + h * 64, WSP(bf16, WS_O) + q0 * DM + (h + 1) * 64, DM, SEQ, F.ldsg, sslds); }
#pragma unroll
                for (int r = 0; r < 16; ++r) ssacc[r] = sslds[r * 512];
            } else
            for (int hq = 0; hq < 4; ++hq) {
                const int h = hh * 4 + hq;
                if (g == 0) {
                    att::attn_unit<64, 0, 64, 0, true>(WSP(bf16, WS_QG) + q0 * 512 + h * 64, nullptr, 512, WSP(bf16, WS_KG) + r0 * 128 + hh * 64, 128, nullptr, 0,
                                              WSP(bf16, WS_VG) + r0 * 128 + hh * 64, 128, WSP(bf16, WS_O) + q0 * DM + h * 64, DM, SEQ, F.ldsg, ssacc);
                } else {
                    const unsigned* bd = WSP(unsigned, WS_CTL) + CW_BND + l * 512 + b * 64 + h * 8;
                    const float q2 = __uint_as_float(__hip_atomic_load(bd + 0, __ATOMIC_RELAXED, __HIP_MEMORY_SCOPE_AGENT)) + __uint_as_float(__hip_atomic_load(bd + 1, __ATOMIC_RELAXED, __HIP_MEMORY_SCOPE_AGENT)) + __uint_as_float(__hip_atomic_load(bd + 2, __ATOMIC_RELAXED, __HIP_MEMORY_SCOPE_AGENT));
                    const float k2 = __uint_as_float(__hip_atomic_load(bd + 3, __ATOMIC_RELAXED, __HIP_MEMORY_SCOPE_AGENT)) + __uint_as_float(__hip_atomic_load(bd + 4, __ATOMIC_RELAXED, __HIP_MEMORY_SCOPE_AGENT)) + __uint_as_float(__hip_atomic_load(bd - h * 8 + 5, __ATOMIC_RELAXED, __HIP_MEMORY_SCOPE_AGENT));
                    const bool mb = __builtin_amdgcn_readfirstlane((int)(q2 * k2 * 1.05f < 96.0f * 96.0f)) != 0;
                    if (mb) att::attn_unit_2t<true>(WSP(bf16, WS_QM) + q0 * 768 + h * 64, WSP(bf16, WS_QM) + q0 * 768 + 512 + h * 32, 768, WSP(bf16, WS_KVM) + r0 * DM + h * 128, DM, WSP(bf16, WS_KROPE) + r0 * 32, 32,
                                               WSP(bf16, WS_KVM) + r0 * DM + h * 128 + 64, DM, WSP(bf16, WS_O) + q0 * DM + 512 + h * 64, DM, SEQ, F.ldsg, ssacc);
                    else    att::attn_unit<64, 32, 64, 0, true>(WSP(bf16, WS_QM) + q0 * 768 + h * 64, WSP(bf16, WS_QM) + q0 * 768 + 512 + h * 32, 768, WSP(bf16, WS_KVM) + r0 * DM + h * 128, DM, WSP(bf16, WS_KROPE) + r0 * 32, 32,
                                               WSP(bf16, WS_KVM) + r0 * DM + h * 128 + 64, DM, WSP(bf16, WS_O) + q0 * DM + 512 + h * 64, DM, SEQ, F.ldsg, ssacc);
                }
            }
#pragma unroll
            for (int r = 0; r < 16; ++r) { float s = ssacc[r];
                s += __shfl_xor(s, 1); s += __shfl_xor(s, 2); s += __shfl_xor(s, 4); s += __shfl_xor(s, 8); s += __shfl_xor(s, 16);
                if (r32 == 0) WSP(float, WS_SSO)[(q0 + wid * 32 + att::crow(r, hi)) * 4 + g * 2 + hh] = s; }
        }
}
__device__ __forceinline__ void phase_attn_mem(const Ctx& F, int l) {
    const bf16* kv = WSP(bf16, WS_MEMKV) + (size_t)l * MROWS * DM; float dummy[16];
    for (int idx = F.vcu; idx < 256; idx += F.G) {
        const int pm = idx >> 1, pn = idx & 1, b = pm >> 4;
        const size_t q0 = (size_t)pm * 256, k0 = (size_t)b * MEM_T;
        for (int hh = 0; hh < 2; ++hh) { const int h = 2 * pn + hh;
            att::attn_mem_unit(WSP(bf16, WS_QMEM) + q0 * 512 + h * 128, 512, kv + k0 * DM + h * 128, DM, kv + k0 * DM + 512 + h * 128, DM, WSP(bf16, WS_OMEM) + q0 * 512 + h * 128, 512, F.ldsg); }
    }
}

__global__ void __launch_bounds__(NWAVES * 64, 2) enc_fwd(Args args) {
    extern __shared__ __attribute__((aligned(16))) unsigned char lds[];
    Ctx F;
    F.lds = (LAS unsigned char*)lds; F.ldsg = (char*)lds;
    F.tid = threadIdx.x; F.lane = F.tid & 63; F.wave = __builtin_amdgcn_readfirstlane(F.tid >> 6);
    F.G = gridDim.x; F.G0 = F.G; { const int bx = blockIdx.x; F.vcu0 = (F.G % 8 == 0) ? (bx % 8) * (F.G / 8) + bx / 8 : bx; F.vcu = F.vcu0; }
    F.gw = F.vcu * NWAVES + F.wave; F.NGW = F.G * NWAVES;
    F.out = args.out; F.ws = args.ws; F.x = (bf16*)(args.ws + WS_X);
    volatile LAS unsigned* MISC = (volatile LAS unsigned*)(F.lds + MISC_OFF);
    for (int u = F.tid; u < (LDS_BYTES - LDSCTL_OFF) / 4; u += NWAVES * 64) ((LAS unsigned*)(F.lds + LDSCTL_OFF))[u] = 0u;
    __syncthreads();
    XcdBarrier bar; bar.bar = (unsigned*)(F.ws + WS_CTL) + CW_BAR; bar.x = 0; bar.st = nullptr;
    if (MK_N_LAUNCHES == 1) bar = xcd_barrier_post((unsigned*)(F.ws + WS_CTL) + CW_BAR, MISC + 8);
    const int lo = args.ph_lo, hi = args.ph_hi;
#ifndef ONLY_SITE
#define ONLY_SITE -1
#endif
#define ON(s) (ONLY_SITE < 0 || ONLY_SITE == (s))
#ifndef DUPMASK
#define DUPMASK 0u
#endif
#define REP(s) for (int rep_ = 0; rep_ < 1 + (int)((DUPMASK >> (s)) & 1u); ++rep_)
#define IN(k) (lo <= (k) && (k) < hi)
#define SEAM(k) do { if (IN(k) && IN((k) + 1)) xcd_barrier(bar); } while (0)
#define LOCAL_SEAM() do { asm volatile("s_waitcnt vmcnt(0)" ::: "memory"); __syncthreads(); __builtin_amdgcn_fence(__ATOMIC_ACQUIRE, "agent"); asm volatile("s_waitcnt vmcnt(0)" ::: "memory"); __syncthreads(); } while (0)
#define GEMM(EpiT, epi, Ap, lda_, Bp, ldb_, K_, nM_, nN_, gdiv_, gstride_) do { const pg8::Gemm g_{(const bf16*)(Ap), (const bf16*)(Bp), lda_, ldb_, K_, gdiv_, 1 << 30, (size_t)(gstride_), nullptr, nullptr}; \
        pg8::StaticOrder S_; S_.init(nM_, nN_, F.G, (int)blockIdx.x); pg8::gemm_phase<EpiT, pg8::StaticOrder, true>(F.lds, g_, S_, epi); } while (0)

    #ifndef PRODUP
#define PRODUP 0
#endif
    if (ON(100) && IN(0)) for (int rp_ = 0; rp_ <= PRODUP; ++rp_) { refresh(F); phase_prologue(F, args); }
    SEAM(0);
    if (ON(101) && IN(1)) {
        pg8::EpiBf16 E{WSP(bf16, WS_MEMKV), DM, 1.0f, nullptr, nullptr, 0.f, 0.f};
        const pg8::Gemm g_{WSP(bf16, WS_MEMN), WSP(bf16, WS_WSMALL + OFF_WMKV), DM, DM, DM, MROWS / 256, MROWS / 256, (size_t)(WSMALL_STRIDE / 2), nullptr, nullptr};
        pg8::StaticOrder S_; S_.init(DEPTH * MROWS / 256, DM / 256, F.G, (int)blockIdx.x); pg8::gemm_phase<pg8::EpiBf16, pg8::StaticOrder, true>(F.lds, g_, S_, E);
        refresh(F);
        if (F.G == 256) { const bool late = (int)blockIdx.x < 128; const int cu = late ? (int)blockIdx.x : (int)blockIdx.x - 128;
            phase_prologue2(F, args, cu * NWAVES + F.wave, 128 * NWAVES, late ? 11 : 0, late ? 16 : 11); }
        else phase_prologue2(F, args, F.gw, F.NGW, 0, 16); }
    SEAM(1);
    for (int l = 0; l < DEPTH; ++l) {
        const int pb = 2 + 16 * l;
        unsigned char* wl = F.ws + WS_WSMALL + (size_t)l * WSMALL_STRIDE;
        if (ON(0) && IN(pb + 0)) REP(0) if (refresh(F), true) {
            int bxs = (int)blockIdx.x; asm volatile("" : "+s"(bxs));
            pg8::EpiInProj E{WSP(float, WS_RS1), WSP(float, WS_GAINS) + l * 64, WSP(float, WS_GAINS) + 256 + l * 64, WSP(float, WS_TABG), WSP(float, WS_TABM),
                             WSP(bf16, WS_QG), WSP(bf16, WS_KG), WSP(bf16, WS_VG), WSP(bf16, WS_LAT), WSP(bf16, WS_KROPE), WSP(float, WS_SSL), 0.125f * LOG2E, EPS, WSP(unsigned, WS_CTL) + CW_BND + l * 512};
            const pg8::Gemm g_{(const bf16*)F.x, (const bf16*)(wl + OFF_WIN), DM, DM, DM, 1, 1 << 30, 0, nullptr, nullptr};
            typedef pg8::SplitOrder<2, 3, 0, 0> SO; SO S_; S_.init(MTOK / 256, F.G, bxs); pg8::gemm_phase<pg8::EpiInProj, SO, true>(F.lds, g_, S_, E); }
        SEAM(pb + 0);
        if ((ON(2) || ON(16) || ON(17)) && IN(pb + 2)) REP(2) { refresh(F);
            int bxs = (int)blockIdx.x; asm volatile("" : "+s"(bxs)); const int bxo = (F.G == 256) ? (bxs ^ 128) : bxs;
            if (ON(2)) {
                pg8::EpiInProj E{WSP(float, WS_RS1), WSP(float, WS_GAINS) + l * 64, WSP(float, WS_GAINS) + 256 + l * 64, WSP(float, WS_TABG), WSP(float, WS_TABM),
                                 WSP(bf16, WS_QG), WSP(bf16, WS_KG), WSP(bf16, WS_VG), WSP(bf16, WS_LAT), WSP(bf16, WS_KROPE), WSP(float, WS_SSL), 0.125f * LOG2E, EPS, WSP(unsigned, WS_CTL) + CW_BND + l * 512};
                const pg8::Gemm g_{(const bf16*)F.x, (const bf16*)(wl + OFF_WIN), DM, DM, DM, 1, 1 << 30, 0, nullptr, nullptr};
                typedef pg8::SplitOrder<3, 0, 2, 1> SO; SO S_; S_.init(MTOK / 256, F.G, bxs); pg8::gemm_phase<pg8::EpiInProj, SO, true>(F.lds, g_, S_, E); }
            if (ON(2) || ON(17)) { pg8::EpiQmRope E{WSP(bf16, WS_QM), 768, 0.10206207261596577f * LOG2E, WSP(float, WS_TABM), WSP(float, WS_SSL), 1.0f / 256.0f, EPS, WSP(unsigned, WS_CTL) + CW_BND + l * 512};
                const pg8::Gemm g_{WSP(bf16, WS_LAT), (const bf16*)(wl + OFF_WQB), 512, 256, 256, 1, 1 << 30, 0, nullptr, nullptr};
                typedef pg8::SplitOrder<3, 0, 2, 1> SO; SO S_; S_.init(MTOK / 256, F.G, bxo); pg8::gemm_phase<pg8::EpiQmRope, SO, true>(F.lds, g_, S_, E); }
            if (ON(2) || ON(16)) { pg8::EpiBf16Kv E{WSP(bf16, WS_KVM), DM, WSP(float, WS_SSL) + 4, 1.0f / 128.0f, EPS, WSP(unsigned, WS_CTL) + CW_BND + l * 512};
                const pg8::Gemm g_{WSP(bf16, WS_LAT) + 256, (const bf16*)(wl + OFF_WKVB), 512, 128, 128, 1, 1 << 30, 0, nullptr, nullptr};
                typedef pg8::SplitOrder<4, 0, 3, 1> SO; SO S_; S_.init(MTOK / 256, F.G, bxo); pg8::gemm_phase<pg8::EpiBf16Kv, SO, true>(F.lds, g_, S_, E); } }
        SEAM(pb + 2);
        if (ON(3) && IN(pb + 3)) REP(3) if (refresh(F), true) phase_attn_self(F, l);
        SEAM(pb + 3);
        if (ON(5) && IN(pb + 5)) REP(5) if (refresh(F), true) {
            pg8::EpiResidualX E{F.x, WSP(float, WS_SSX), DM, 1.0f / 512.0f, EPS, rep_ ? 0.f : 1.f};
            const pg8::Gemm g_{WSP(bf16, WS_O), (const bf16*)(wl + OFF_WO), DM, DM, DM, 1, 1 << 30, 0, nullptr, WSP(float, WS_SSO)};
            pg8::StaticOrder S_; S_.init(MTOK / 256, 4, F.G, (int)blockIdx.x); pg8::gemm_phase<pg8::EpiResidualX, pg8::StaticOrder, true, false, true>(F.lds, g_, S_, E, F.lds + STAB_OFF, 1.0f / 512.0f, EPS); }
        SEAM(pb + 5);
        if (ON(7) && IN(pb + 7)) REP(7) if (refresh(F), true) { pg8::EpiBf16RowNorm E{WSP(bf16, WS_QMEM), 512, 0.08838834764831845f * LOG2E, WSP(float, WS_SSX), 1.0f / DM, EPS}; GEMM(pg8::EpiBf16RowNorm, E, F.x, DM, wl + OFF_WMQ, DM, DM, MTOK / 256, 2, 1, 0); }
        SEAM(pb + 7);
        if (ON(8) && IN(pb + 8)) REP(8) if (refresh(F), true) phase_attn_mem(F, l);
        SEAM(pb + 8);
        if (ON(9) && IN(pb + 9)) REP(9) if (refresh(F), true) { pg8::EpiResidual E{F.x, DM, rep_ ? 0.f : 1.f}; GEMM(pg8::EpiResidual, E, WSP(bf16, WS_OMEM), 512, wl + OFF_WMO, 512, 512, MTOK / 256, 4, 1, 0); }
        SEAM(pb + 9);
        if (ON(10) && IN(pb + 10)) REP(10) if (refresh(F), true) phase_router(F, args, l);
        SEAM(pb + 10);
        if (ON(11) && IN(pb + 11)) REP(11) if (refresh(F), true) phase_select(F, args, l);
        SEAM(pb + 11);
        if (ON(13) && IN(pb + 13)) REP(13) if (refresh(F), true) { pg8::EpiSwiGLU E{WSP(bf16, WS_ACT), EFF, WSP(float, WS_RG)};
            const pg8::Gemm g_{F.x, WSP(bf16, (l & 1) ? WS_WGU2 : WS_WGU), DM, DM, DM, 16, 1 << 30, (size_t)(1024 * 1024), WSP(int, WS_IDX), nullptr};
            pg8::StaticOrder S_; S_.init(MOE_ROWS / 256, 4, F.G, (int)blockIdx.x); pg8::gemm_phase<pg8::EpiSwiGLU, pg8::StaticOrder, true, true>(F.lds, g_, S_, E, F.lds + GTAB_OFF); }
        SEAM(pb + 13);
        if (ON(14) && IN(pb + 14)) REP(14) if (refresh(F), true) { pg8::EpiBf16 E{WSP(bf16, WS_Y), DM, 1.0f, nullptr, nullptr, 0.f, 0.f}; GEMM(pg8::EpiBf16, E, WSP(bf16, WS_ACT), EFF, WSP(bf16, (l & 1) ? WS_WD2 : WS_WD), EFF, EFF, MOE_ROWS / 256, 4, 16, 1024 * 512); }
        SEAM(pb + 14);
        if (ON(15) && IN(pb + 15)) REP(15) if (refresh(F), true) phase_combine(F, args, l, (rep_ && l < DEPTH - 1) ? 0.f : 1.f);
        SEAM(pb + 15);
    }
#undef IN
#undef SEAM
#undef GEMM
}

extern "C" void kernel_launch(void* const* d_in, const int* in_sizes, int n_in, void* d_out, int out_size, void* d_ws, size_t ws_size, hipStream_t stream) {
    static int grid = 0;
    if (grid == 0) {
        if (n_in != 24 || out_size != MTOK * DM || ws_size < WS_END) { fprintf(stderr, "kernel_launch: unexpected shapes: n_in %d out %d ws %zu (need %zu)\n", n_in, out_size, ws_size, (size_t)WS_END); grid = -1; return; }
        int dev = 0, cus = 0, per_cu = 0;
        if (hipGetDevice(&dev) != hipSuccess || hipDeviceGetAttribute(&cus, hipDeviceAttributeMultiprocessorCount, dev) != hipSuccess) { grid = -1; return; }
        if (hipFuncSetAttribute((const void*)enc_fwd, hipFuncAttributeMaxDynamicSharedMemorySize, LDS_BYTES) != hipSuccess) { fprintf(stderr, "kernel_launch: hipFuncSetAttribute failed\n"); grid = -1; return; }
        if (hipOccupancyMaxActiveBlocksPerMultiprocessor(&per_cu, (const void*)enc_fwd, NWAVES * 64, LDS_BYTES) != hipSuccess || per_cu < 1)
            fprintf(stderr, "kernel_launch: occupancy query reports %d workgroups per CU\n", per_cu);
        (void)hipGetLastError();
        grid = cus;
        fprintf(stderr, "kernel_launch: grid %d, ws %zu bytes\n", grid, ws_size);
    }
    if (grid < 0) return;
    (void)hipMemsetAsync((char*)d_ws + WS_CTL, 0, CTL_ZERO_BYTES, stream);
    Args a{};
    for (int i = 0; i < 24; ++i) a.in[i] = (const float*)d_in[i];
    a.out = (float*)d_out; a.ws = (unsigned char*)d_ws;
#if MK_N_LAUNCHES == 1
    a.ph_lo = 0; a.ph_hi = NPH;
    hipLaunchKernelGGL(enc_fwd, dim3(grid), dim3(NWAVES * 64), LDS_BYTES, stream, a);
#else
    for (int p = 0; p < NPH; ++p) { a.ph_lo = p; a.ph_hi = p + 1; hipLaunchKernelGGL(enc_fwd, dim3(grid), dim3(NWAVES * 64), LDS_BYTES, stream, a); }
#endif
    const hipError_t le = hipPeekAtLastError();
    if (le != hipSuccess) fprintf(stderr, "kernel_launch: launch failed: %s\n", hipGetErrorName(le));
}
```
